# Optimizing an MI355X kernel written in HIP

```python
import jax, jax.numpy as jnp
from jax import lax
import numpy as np

D_MODEL = 1024
BATCH = 8
SEQ = 8192
DEPTH = 1

GRID_W = 64
CTX_LEN = 256
D_RNN = 1024
RNN_BLOCKS = 8
RNN_BW = D_RNN // RNN_BLOCKS
CONV_W = 4
CONV_LEFT = 2
LRU_C = 8.0
RET_HEADS = 8
RET_DK = 128
RET_DV = 256
RET_CHUNK = 128
D_QK = RET_HEADS * RET_DK
D_V = RET_HEADS * RET_DV
ROPE_BASE = 10000.0
IN_SPLITS = (D_RNN, D_RNN, D_QK, D_QK, D_V, D_V, D_MODEL, D_MODEL)
D_IN = sum(IN_SPLITS)
N_EXPERTS = 32
TOP_K = 4
D_EXPERT = 1024
SWIGLU_ALPHA = 1.702
SWIGLU_LIMIT = 7.0
MOE_BLOCK = 512
EPS = 1e-6

kernel_name = "hybrid_rglru_retention_moe_prefix_dit_layer"


def rmsnorm(x, g):
    xf = x.astype(jnp.float32)
    y = xf * lax.rsqrt(jnp.mean(xf * xf, axis=-1, keepdims=True) + EPS)
    return (y * g.astype(jnp.float32)).astype(x.dtype)


def modulate(h, shift, scale):
    return h * (1.0 + scale) + shift


def split_columns(z):
    points = [int(p) for p in np.cumsum(IN_SPLITS)[:-1]]
    return jnp.split(z, points, axis=-1)


def centred_depthwise_conv(x, w, b):
    T = x.shape[1]
    xp = jnp.pad(x, ((0, 0), (CONV_LEFT, CONV_W - 1 - CONV_LEFT), (0, 0)))
    y = b
    for k in range(CONV_W):
        y = y + xp[:, k:k + T] * w[k]
    return y


def _linear_combine(e1, e2):
    a1, b1 = e1
    a2, b2 = e2
    return a1 * a2, a2 * b1 + b2


def rglru_scan(xc, wa, ba, wx, bx, lam, h0, reverse):
    B, T, _ = xc.shape
    xb = xc.reshape(B, T, RNN_BLOCKS, RNN_BW)
    r = jax.nn.sigmoid(jnp.einsum('btnd,nde->btne', xb, wa).reshape(B, T, D_RNN) + ba)
    i = jax.nn.sigmoid(jnp.einsum('btnd,nde->btne', xb, wx).reshape(B, T, D_RNN) + bx)
    log_a = -LRU_C * r * jax.nn.softplus(-lam)
    a = jnp.exp(log_a)
    u = jnp.sqrt(-jnp.expm1(2.0 * log_a)) * (i * xc)
    a_cum, h = lax.associative_scan(_linear_combine, (a, u), axis=1, reverse=reverse)
    return h + a_cum * h0[:, None, :]


def axial_rope(t, rows, cols):
    n_freq = RET_DK // 4
    inv = ROPE_BASE ** (-jnp.arange(n_freq, dtype=jnp.float32) / n_freq)
    ang = jnp.concatenate([rows[:, None] * inv, cols[:, None] * inv], axis=-1)
    cos, sin = jnp.cos(ang), jnp.sin(ang)
    t1, t2 = t[..., 0::2], t[..., 1::2]
    return jnp.stack([t1 * cos - t2 * sin, t1 * sin + t2 * cos], axis=-1).reshape(t.shape)


def retention_context(q, k, v, log_g):
    L = q.shape[2]
    pos = jnp.arange(L, dtype=jnp.float32)
    decay = jnp.exp(jnp.abs(pos[:, None] - pos[None, :])[None] * log_g[:, None, None])
    scores = jnp.einsum('bhid,bhjd->bhij', q, k) * decay
    o = jnp.einsum('bhij,bhjv->bhiv', scores, v)
    k_f = k * jnp.exp((L - 1.0 - pos)[None, :] * log_g[:, None])[..., None]
    k_b = k * jnp.exp(pos[None, :] * log_g[:, None])[..., None]
    s_fwd = jnp.einsum('bhjd,bhjv->bhdv', k_f, v)
    s_bwd = jnp.einsum('bhjd,bhjv->bhdv', k_b, v)
    return o, s_fwd, s_bwd


def retention_chunked(q, k, v, s0, log_g, strict):
    B, H, S, dk = q.shape
    dv = v.shape[-1]
    C = RET_CHUNK
    n = S // C
    idx = jnp.arange(C, dtype=jnp.float32)
    diff = idx[:, None] - idx[None, :]
    mask = (diff > 0) if strict else (diff >= 0)
    intra = jnp.where(mask[None], jnp.exp(jnp.where(mask, diff, 0.0)[None] * log_g[:, None, None]), 0.0)
    q_dec = jnp.exp((idx + 1.0)[None, :] * log_g[:, None])[..., None]
    k_dec = jnp.exp((C - 1.0 - idx)[None, :] * log_g[:, None])[..., None]
    c_dec = jnp.exp(C * log_g)[:, None, None]

    def to_chunks(t):
        return jnp.moveaxis(t.reshape(B, H, n, C, t.shape[-1]), 2, 0)

    def step(state, blk):
        qb, kb, vb = blk
        s = jnp.einsum('bhid,bhjd->bhij', qb, kb) * intra
        o = jnp.einsum('bhij,bhjv->bhiv', s, vb) + jnp.einsum('bhid,bhdv->bhiv', qb * q_dec, state)
        state = state * c_dec + jnp.einsum('bhjd,bhjv->bhdv', kb * k_dec, vb)
        return state, o

    _, o = lax.scan(step, s0, (to_chunks(q), to_chunks(k), to_chunks(v)))
    return jnp.moveaxis(o, 0, 2).reshape(B, H, S, dv)


def head_groupnorm(o):
    mu = jnp.mean(o, axis=-1, keepdims=True)
    var = jnp.mean(jnp.square(o - mu), axis=-1, keepdims=True)
    return (o - mu) * lax.rsqrt(var + EPS)


def token_mixing(h_lat, h_ctx, rows, cols, w_in, conv_w, conv_b, lru_wa, lru_ba, lru_wx, lru_bx,
                 lru_lambda, w_rnn_proj, w_ret_proj, w_out, with_ctx_out):
    f32 = jnp.float32
    B, S, _ = h_lat.shape
    L = h_ctx.shape[1]
    xr_l, gr_l, q_l, k_l, v_l, gs_l, ga_l, gb_l = split_columns(h_lat @ w_in)
    xr_c, gr_c, q_c, k_c, v_c, gs_c, ga_c, gb_c = split_columns(h_ctx @ w_in)

    xr_c = centred_depthwise_conv(xr_c.astype(f32), conv_w, conv_b)
    xr_l = centred_depthwise_conv(xr_l.astype(f32), conv_w, conv_b)
    zeros = jnp.zeros((B, D_RNN), f32)
    rnn_l = 0.0
    rnn_c = 0.0
    for d in range(2):
        rev = d == 1
        hc = rglru_scan(xr_c, lru_wa[d], lru_ba[d], lru_wx[d], lru_bx[d], lru_lambda[d], zeros, rev)
        h0 = hc[:, 0] if rev else hc[:, -1]
        rnn_l = rnn_l + rglru_scan(xr_l, lru_wa[d], lru_ba[d], lru_wx[d], lru_bx[d], lru_lambda[d], h0, rev)
        rnn_c = rnn_c + hc

    log_g = jnp.log1p(-jnp.exp2(-5.0 - jnp.arange(RET_HEADS, dtype=f32)))
    k_scale = RET_DK ** -0.5

    def heads(t, dh):
        return jnp.swapaxes(t.astype(f32).reshape(B, t.shape[1], RET_HEADS, dh), 1, 2)

    qh_l = axial_rope(heads(q_l, RET_DK), rows, cols)
    kh_l = axial_rope(heads(k_l, RET_DK), rows, cols) * k_scale
    vh_l = heads(v_l, RET_DV)
    o_c, s_fwd, s_bwd = retention_context(heads(q_c, RET_DK), heads(k_c, RET_DK) * k_scale,
                                          heads(v_c, RET_DV), log_g)
    o_l = retention_chunked(qh_l, kh_l, vh_l, s_fwd, log_g, False) + jnp.flip(
        retention_chunked(jnp.flip(qh_l, 2), jnp.flip(kh_l, 2), jnp.flip(vh_l, 2), s_bwd, log_g, True), 2)

    def finish(rnn, gr, o, gs, ga, gb):
        T = o.shape[2]
        y_rnn = (rnn * jax.nn.gelu(gr.astype(f32))) @ w_rnn_proj
        ret = jnp.swapaxes(head_groupnorm(o), 1, 2).reshape(B, T, D_V)
        y_ret = (jax.nn.silu(gs.astype(f32)) * ret) @ w_ret_proj
        merged = jax.nn.sigmoid(ga.astype(f32)) * y_rnn + jax.nn.sigmoid(gb.astype(f32)) * y_ret
        return merged @ w_out

    out_l = finish(rnn_l, gr_l, o_l, gs_l, ga_l, gb_l)
    out_c = finish(rnn_c, gr_c, o_c, gs_c, ga_c, gb_c) if with_ctx_out else None
    return out_l, out_c


def moe_ffn(h, router_w, router_b, w1, b1, w2, b2):
    N, D = h.shape
    logits = (h @ router_w + router_b).astype(jnp.float32)
    top_val, top_idx = lax.top_k(logits, TOP_K)
    gates = jax.nn.softmax(top_val, axis=-1)
    flat_e = top_idx.reshape(-1).astype(jnp.int32)
    NK = flat_e.shape[0]
    order = jnp.argsort(flat_e).astype(jnp.int32)
    sorted_e = flat_e[order]
    counts = jnp.zeros((N_EXPERTS,), jnp.int32).at[flat_e].add(1)
    padded = (counts + MOE_BLOCK - 1) // MOE_BLOCK * MOE_BLOCK
    start = jnp.cumsum(counts) - counts
    pad_end = jnp.cumsum(padded)
    pad_start = pad_end - padded
    dest = pad_start[sorted_e] + jnp.arange(NK, dtype=jnp.int32) - start[sorted_e]
    n_blocks = -(-NK // MOE_BLOCK) + N_EXPERTS
    P = n_blocks * MOE_BLOCK
    row_token = jnp.full((P,), N, jnp.int32).at[dest].set(order // TOP_K)
    h_pad = jnp.concatenate([h, jnp.zeros((1, D), h.dtype)], axis=0)[row_token]
    blk_start = jnp.arange(n_blocks, dtype=jnp.int32) * MOE_BLOCK
    blk_expert = jnp.minimum(jnp.searchsorted(pad_end, blk_start, side='right'), N_EXPERTS - 1).astype(jnp.int32)

    def expert_block(args):
        hb, e = args
        gu = hb @ w1[e] + b1[e]
        glu, lin = gu[:, 0::2], gu[:, 1::2]
        glu = jnp.minimum(glu, SWIGLU_LIMIT)
        lin = jnp.clip(lin, -SWIGLU_LIMIT, SWIGLU_LIMIT)
        return (glu * jax.nn.sigmoid(SWIGLU_ALPHA * glu) * (lin + 1.0)) @ w2[e] + b2[e]

    y_pad = lax.map(expert_block, (h_pad.reshape(n_blocks, MOE_BLOCK, D), blk_expert)).reshape(P, D)
    row_of_assign = jnp.zeros((NK,), jnp.int32).at[order].set(dest)
    y = y_pad[row_of_assign].reshape(N, TOP_K, D)
    return jnp.einsum('nk,nkd->nd', gates.astype(y.dtype), y)


def setup_inputs(seed: int = 0) -> dict:
    key = jax.random.key(seed)
    ks = jax.random.split(key, 32)
    f32 = jnp.float32

    def nrm(k, shape, scale):
        return jax.random.normal(k, shape, f32) * scale

    u = jax.random.uniform(ks[14], (DEPTH, 2, D_RNN), f32, 0.9, 0.999)
    a0 = u ** (1.0 / LRU_C)
    lru_lambda = jnp.log(a0) - jnp.log1p(-a0)
    return {
        "x": nrm(ks[0], (BATCH, SEQ, D_MODEL), 1.0),
        "c": nrm(ks[1], (BATCH, D_MODEL), 1.0),
        "ctx": nrm(ks[2], (BATCH, CTX_LEN, D_MODEL), 1.0),
        "c_ctx": nrm(ks[3], (D_MODEL,), 1.0),
        "ada_w": nrm(ks[4], (DEPTH, D_MODEL, 6 * D_MODEL), 0.5 * D_MODEL ** -0.5),
        "ada_b": nrm(ks[5], (DEPTH, 6 * D_MODEL), 0.02),
        "norm1_g": 1.0 + nrm(ks[6], (DEPTH, D_MODEL), 0.05),
        "w_in": nrm(ks[7], (DEPTH, D_MODEL, D_IN), D_MODEL ** -0.5),
        "conv_w": nrm(ks[8], (DEPTH, CONV_W, D_RNN), CONV_W ** -0.5),
        "conv_b": nrm(ks[9], (DEPTH, D_RNN), 0.01),
        "lru_wa": nrm(ks[10], (DEPTH, 2, RNN_BLOCKS, RNN_BW, RNN_BW), RNN_BW ** -0.5),
        "lru_ba": nrm(ks[11], (DEPTH, 2, D_RNN), 0.01),
        "lru_wx": nrm(ks[12], (DEPTH, 2, RNN_BLOCKS, RNN_BW, RNN_BW), RNN_BW ** -0.5),
        "lru_bx": nrm(ks[13], (DEPTH, 2, D_RNN), 0.01),
        "lru_lambda": lru_lambda,
        "w_rnn_proj": nrm(ks[15], (DEPTH, D_RNN, D_MODEL), D_RNN ** -0.5),
        "w_ret_proj": nrm(ks[16], (DEPTH, D_V, D_MODEL), D_V ** -0.5),
        "w_out": nrm(ks[17], (DEPTH, D_MODEL, D_MODEL), D_MODEL ** -0.5),
        "norm2_g": 1.0 + nrm(ks[18], (DEPTH, D_MODEL), 0.05),
        "router_w": nrm(ks[19], (DEPTH, D_MODEL, N_EXPERTS), D_MODEL ** -0.5),
        "router_b": nrm(ks[20], (DEPTH, N_EXPERTS), 0.01),
        "moe_w1": nrm(ks[21], (DEPTH, N_EXPERTS, D_MODEL, 2 * D_EXPERT), D_MODEL ** -0.5),
        "moe_b1": nrm(ks[22], (DEPTH, N_EXPERTS, 2 * D_EXPERT), 0.01),
        "moe_w2": nrm(ks[23], (DEPTH, N_EXPERTS, D_EXPERT, D_MODEL), D_EXPERT ** -0.5),
        "moe_b2": nrm(ks[24], (DEPTH, N_EXPERTS, D_MODEL), 0.01),
        "final_g": 1.0 + nrm(ks[25], (D_MODEL,), 0.05),
    }


def reference(x, c, ctx, c_ctx, ada_w, ada_b, norm1_g, w_in, conv_w, conv_b, lru_wa, lru_ba, lru_wx,
              lru_bx, lru_lambda, w_rnn_proj, w_ret_proj, w_out, norm2_g, router_w, router_b,
              moe_w1, moe_b1, moe_w2, moe_b2, final_g):
    B, S, D = x.shape
    ROWS = S // GRID_W
    rows = jnp.repeat(jnp.arange(ROWS, dtype=jnp.float32), GRID_W)
    cols = jnp.tile(jnp.arange(GRID_W, dtype=jnp.float32), ROWS)
    h_c = ctx
    for layer in range(DEPTH):
        last = layer == DEPTH - 1
        mod_l = jnp.split(jax.nn.silu(c) @ ada_w[layer] + ada_b[layer], 6, axis=-1)
        sh1, sc1, g1, sh2, sc2, g2 = [m[:, None, :] for m in mod_l]
        mod_c = jnp.split(jax.nn.silu(c_ctx) @ ada_w[layer] + ada_b[layer], 6, axis=-1)
        csh1, csc1, cg1, csh2, csc2, cg2 = [m[None, None, :] for m in mod_c]

        hl = modulate(rmsnorm(x, norm1_g[layer]), sh1, sc1)
        hc = modulate(rmsnorm(h_c, norm1_g[layer]), csh1, csc1)
        y_l, y_c = token_mixing(hl, hc, rows, cols, w_in[layer], conv_w[layer], conv_b[layer],
                                lru_wa[layer], lru_ba[layer], lru_wx[layer], lru_bx[layer],
                                lru_lambda[layer], w_rnn_proj[layer], w_ret_proj[layer], w_out[layer],
                                not last)
        x = (x + g1 * y_l).astype(x.dtype)
        hl2 = modulate(rmsnorm(x, norm2_g[layer]), sh2, sc2)
        y_moe = moe_ffn(hl2.reshape(-1, D), router_w[layer], router_b[layer], moe_w1[layer],
                        moe_b1[layer], moe_w2[layer], moe_b2[layer]).reshape(B, S, D)
        x = (x + g2 * y_moe).astype(x.dtype)
        if not last:
            h_c = (h_c + cg1 * y_c).astype(h_c.dtype)
            hc2 = modulate(rmsnorm(h_c, norm2_g[layer]), csh2, csc2)
            y_cm = moe_ffn(hc2.reshape(-1, D), router_w[layer], router_b[layer], moe_w1[layer],
                           moe_b1[layer], moe_w2[layer], moe_b2[layer]).reshape(h_c.shape)
            h_c = (h_c + cg2 * y_cm).astype(h_c.dtype)
    return rmsnorm(x, final_g)
```

```cpp
#include <hip/hip_runtime.h>
#include <cstdio>
#include <cstdint>

#ifndef MK_PER_PHASE
#define MK_PER_PHASE 0
#endif

#ifndef MK_PHASES
#define MK_PHASES 0xFFFFu
#endif
#define PH_EN(k) (((MK_PHASES) >> (k)) & 1u)
#define LAS __attribute__((address_space(3)))
#define GAS __attribute__((address_space(1)))
typedef unsigned short bf16;
typedef short bf16x8 __attribute__((ext_vector_type(8)));
typedef short s16x4 __attribute__((ext_vector_type(4)));
typedef float f32x2 __attribute__((ext_vector_type(2)));
typedef float f32x4 __attribute__((ext_vector_type(4)));
typedef float f32x16 __attribute__((ext_vector_type(16)));
typedef unsigned u32x2 __attribute__((ext_vector_type(2)));
typedef unsigned u32x4 __attribute__((ext_vector_type(4)));

constexpr int D = 1024, NB = 8, SEQ = 8192, NTOK = NB * SEQ, CTXL = 256, NCTX = NB * CTXL, DIN = 10240;
constexpr int NROWS_HL = NTOK + NCTX;
constexpr int GB = 2, NGRP = NB / GB, GROWS = GB * SEQ;
constexpr int NEXP = 32, TOPK = 4, DEXP = 1024;
constexpr int NRANGE = 4, RTOK = NTOK / NRANGE;
constexpr int RROWS = 73728, RTILES = RROWS / 256;
constexpr float EPS = 1e-6f;
constexpr float K_SCALE = 0.08838834764831845f;
constexpr int C_XR = 0, C_GR = 1024, C_Q = 2048, C_K = 3072, C_V = 4096, C_GS = 6144, C_GA = 8192, C_GB = 9216;
constexpr int ZC_LD = 4096, ZC_XR = 0, ZC_K = 1024, ZC_V = 2048;

constexpr size_t MiB = 1u << 20;
constexpr size_t WS_CTL = 0, CTL_ZERO_BYTES = 1 * MiB;
constexpr size_t WS_MOD = 1 * MiB;
constexpr size_t WS_ROPE = 1 * MiB + 256 * 1024;
constexpr size_t WS_CARRY = 2 * MiB;
constexpr size_t WS_EIDX = 8 * MiB, WS_GATE = 9 * MiB, WS_LPOS = 10 * MiB, WS_AROW = 11 * MiB;
constexpr size_t WS_BCNT = 12 * MiB;
constexpr size_t WS_BBASE = 12 * MiB + 64 * 1024;
constexpr size_t WS_TILEE = 12 * MiB + 128 * 1024;
constexpr size_t WS_NTILE = 12 * MiB + 192 * 1024;
constexpr size_t WS_WG = 14 * MiB;
constexpr size_t WS_WRNN = 16 * MiB, WS_WOUT = 18 * MiB, WS_WRET = 20 * MiB, WS_WIN = 24 * MiB;
constexpr size_t WS_HL = 44 * MiB;
constexpr size_t WS_ZC = 176 * MiB;
constexpr size_t WS_CTXU = 192 * MiB;
constexpr size_t WS_Z = 208 * MiB;
constexpr size_t WS_ST = 528 * MiB;
constexpr size_t WS_T1 = 656 * MiB, WS_MG = 688 * MiB;
constexpr size_t WS_W1T = 208 * MiB;
constexpr size_t WS_W2T = 336 * MiB;
constexpr size_t WS_HPAD = 400 * MiB, WS_HID = 544 * MiB, WS_YPAD = 688 * MiB;
constexpr size_t WS_END = 832 * MiB;
constexpr int CW_BAR = 4096;

constexpr int LDS_BYTES = 147456;
constexpr int MISC_OFF = 147456 - 256;
constexpr int NWAVES = 8, NTHR = 512;

__device__ __forceinline__ unsigned f2bf(float f) { unsigned u = __builtin_bit_cast(unsigned, f); return (u + 0x7fffu + ((u >> 16) & 1u)) >> 16; }
__device__ __forceinline__ unsigned pk2(float lo, float hi) { return f2bf(lo) | (f2bf(hi) << 16); }
__device__ __forceinline__ float bflo(unsigned w) { return __builtin_bit_cast(float, w << 16); }
__device__ __forceinline__ float bfhi(unsigned w) { return __builtin_bit_cast(float, w & 0xffff0000u); }
__device__ __forceinline__ float bf2f(unsigned short h) { return __builtin_bit_cast(float, ((unsigned)h) << 16); }
__device__ __forceinline__ float sigmoidf_(float x) { return __builtin_amdgcn_rcpf(1.0f + __expf(-x)); }
__device__ __forceinline__ float wave_sum(float v) {
#pragma unroll
    for (int o = 1; o < 64; o <<= 1) v += __shfl_xor(v, o);
    return v;
}
#define LDS_WAIT() asm volatile("s_waitcnt lgkmcnt(0)" ::: "memory")
__device__ __forceinline__ int opaque_tid() { int t = threadIdx.x; asm volatile("" : "+v"(t)); return t; }
template <class T> __device__ __forceinline__ T* opaque_ptr(T* p) { unsigned long long u = (unsigned long long)p; asm volatile("" : "+s"(u)); return (T*)u; }

namespace pg8 {
constexpr int BM = 256, BK = 64, HALF = 128, HTB = HALF * BK * 2, STAGE_BYTES = 8 * HTB, NXCD = 8, WGM = 8;
__host__ __device__ __forceinline__ int lds_byte(int r, int c) { const int st = (r >> 4) * 2 + (c >> 5), rr = r & 15, cc = c & 31, ob = rr * 64 + cc * 2; return st * 1024 + (ob ^ (((ob >> 9) & 1) << 5)); }
__host__ __device__ __forceinline__ void stage_rc(int b, int& R, int& C) { const int st = b / 1024, sb = b % 1024, swz = sb ^ (((sb >> 9) & 1) << 5); R = (st >> 1) * 16 + swz / 64; C = (st & 1) * 32 + (swz % 64) / 2; }
__host__ __device__ __forceinline__ int perm32(int rho) { const int n = rho >> 4, i = rho & 15; return 8 * (i >> 2) + 4 * n + (i & 3); }
struct Unit { int pm, pn; };
struct Gemm { const bf16* A; const bf16* Bt; int lda, ldb, K; };
struct StaticOrder {
    int nM, nN, nwg, G, c;
    __device__ void init(int nM_, int nN_, int G_, int c_) { nM = nM_; nN = nN_; nwg = nM * nN; G = G_; c = c_; }
    __device__ bool next(int i, Unit& u) const {
        const long L = (long)i * G + c; if (L >= nwg) return false;
        int wgid = (int)L; { const int q = nwg / NXCD, r = nwg % NXCD, xcd = wgid % NXCD, off = wgid / NXCD; wgid = (xcd < r ? xcd * (q + 1) : r * (q + 1) + (xcd - r) * q) + off; }
        const int nig = WGM * nN, gid = wgid / nig, fm = gid * WGM, gsz = (nM - fm) < WGM ? (nM - fm) : WGM;
        u.pm = fm + ((wgid % nig) % gsz); u.pn = (wgid % nig) / gsz; return true;
    }
};
struct CtxOrder {
    int G, c;
    __device__ bool next(int i, Unit& u) const { const int L = i * G + c; if (L >= 128) return false; const int j = L >> 3; u.pm = 256 + (L & 7); u.pn = j < 4 ? j : j + 8; return true; }
};
struct MoeOrder {
    const int* tile_e; int ntiles, npn, G, c;
    __device__ bool next(int i, Unit& u) const { const long L = (long)i * G + c; if (L >= (long)ntiles * npn) return false; const int ti = (int)(L / npn), pl = (int)(L % npn);
        u.pm = ti; u.pn = tile_e[ti] * npn + pl; return true; }
};

template <class Epi, class Sched>
__device__ __forceinline__ void gemm_phase(LAS unsigned char* lds, const Gemm g, const Sched& S, const Epi& E) {
    const int tid = opaque_tid(), wid = __builtin_amdgcn_readfirstlane(tid >> 6), lane = tid & 63, wr = wid >> 2, wc = wid & 3, fr = lane & 15, fq = lane >> 4;
    const int K = g.K, nt = K / BK;
    const bf16* gA = opaque_ptr(g.A); const bf16* gBt = opaque_ptr(g.Bt);
    unsigned voffA[2], voffB[2];
#pragma unroll
    for (int i = 0; i < 2; ++i) { int R, C; stage_rc(tid * 16 + i * 8192, R, C); const int Rb = Epi::PERM ? ((R & ~31) + perm32(R & 31)) : R;
        voffA[i] = (unsigned)(R * g.lda + C) * 2u; voffB[i] = (unsigned)(Rb * g.ldb + C) * 2u; }
    const size_t kstep = (size_t)(BK * 2);
    const size_t hstepA = (size_t)HALF * g.lda * 2, hstepB = (size_t)HALF * g.ldb * 2;
    const size_t tstepA = 2 * hstepA, tstepB = 2 * hstepB;
    const unsigned ldsw = (unsigned)wid * 1024u;
    const int aoff = lds_byte(wr * 64 + fr, fq * 8), boff = lds_byte(wc * 32 + fr, fq * 8);
#define PG8_SA(b, h) (((b) * 2 + (h)) * HTB)
#define PG8_SB(b, h) ((4 + (b) * 2 + (h)) * HTB)
#define PG8_STAGE(bufoff, gbase, voff) do { _Pragma("unroll") for (int _i = 0; _i < 2; ++_i) \
        __builtin_amdgcn_global_load_lds((const unsigned*)((const char*)(gbase) + (voff)[_i]), (LAS unsigned*)(lds + (bufoff) + ldsw + _i * 8192), 16, 0, 0); } while (0)
#define PG8_LDA(dst, b, h) do { _Pragma("unroll") for (int m = 0; m < 4; ++m) _Pragma("unroll") for (int k = 0; k < 2; ++k) dst[m][k] = *(const LAS bf16x8*)(lds + PG8_SA(b, h) + aoff + m * 2048 + k * 1024); } while (0)
#define PG8_LDB(dst, b, h) do { _Pragma("unroll") for (int n = 0; n < 2; ++n) _Pragma("unroll") for (int k = 0; k < 2; ++k) dst[n][k] = *(const LAS bf16x8*)(lds + PG8_SB(b, h) + boff + n * 2048 + k * 1024); } while (0)
#define PG8_MMA(ai, bj, At, Bt) do { __builtin_amdgcn_s_setprio(1); _Pragma("unroll") for (int m = 0; m < 4; ++m) _Pragma("unroll") for (int n = 0; n < 2; ++n) _Pragma("unroll") for (int k = 0; k < 2; ++k) \
        acc[ai][bj][m][n] = __builtin_amdgcn_mfma_f32_16x16x32_bf16(Bt[n][k], At[m][k], acc[ai][bj][m][n], 0, 0, 0); __builtin_amdgcn_s_setprio(0); } while (0)
#define PG8_WAIT_V(n) asm volatile("s_waitcnt vmcnt(" #n ")" ::: "memory")
#define PG8_WAIT_L(n) asm volatile("s_waitcnt lgkmcnt(" #n ")" ::: "memory")
#define PG8_BAR __builtin_amdgcn_s_barrier()
#define PG8_SCHED __builtin_amdgcn_sched_barrier(0)
    Unit cur, nxt; int ui = 0;
    if (!S.next(0, cur)) return;
    f32x4 acc[2][2][4][2];
#pragma unroll
    for (int a = 0; a < 2; ++a)
#pragma unroll
        for (int b = 0; b < 2; ++b)
#pragma unroll
            for (int m = 0; m < 4; ++m)
#pragma unroll
                for (int n = 0; n < 2; ++n) acc[a][b][m][n] = (f32x4){0.f, 0.f, 0.f, 0.f};
    bf16x8 At[4][2], B0[2][2], B1[2][2];
    const char* cA = (const char*)gA + (size_t)cur.pm * tstepA; const char* cB = (const char*)gBt + (size_t)cur.pn * tstepB;
    PG8_STAGE(PG8_SB(0, 0), cB, voffB); PG8_STAGE(PG8_SB(0, 1), cB + hstepB, voffB); PG8_STAGE(PG8_SA(0, 0), cA, voffA); PG8_STAGE(PG8_SA(0, 1), cA + hstepA, voffA);
    if (wr == 1) PG8_BAR;
    PG8_WAIT_V(2); PG8_BAR;
    PG8_STAGE(PG8_SB(1, 0), cB + kstep, voffB); PG8_STAGE(PG8_SA(1, 0), cA + kstep, voffA); PG8_STAGE(PG8_SB(1, 1), cB + hstepB + kstep, voffB);
    PG8_WAIT_V(6); PG8_BAR;
    for (;;) {
        const bool has_next = S.next(ui + 1, nxt);
        const char* nA = has_next ? (const char*)gA + (size_t)nxt.pm * tstepA : cA; const char* nB = has_next ? (const char*)gBt + (size_t)nxt.pn * tstepB : cB;
        for (int t = 0; t < nt; t += 2) {
            const bool last = (t == nt - 2);
            const char* a1 = cA + (size_t)(t + 1) * kstep;
            const char* a2 = last ? nA : cA + (size_t)(t + 2) * kstep; const char* b2 = last ? nB : cB + (size_t)(t + 2) * kstep;
            const char* a3 = a2 + kstep; const char* b3 = b2 + kstep;
            PG8_LDB(B0, 0, 0); PG8_LDB(B1, 0, 1); PG8_SCHED; PG8_LDA(At, 0, 0); PG8_STAGE(PG8_SA(1, 1), a1 + hstepA, voffA);
            PG8_WAIT_V(8); PG8_WAIT_L(0); PG8_BAR; PG8_MMA(0, 0, At, B0); PG8_MMA(0, 1, At, B1); PG8_BAR; PG8_SCHED;
            PG8_LDA(At, 0, 1); PG8_STAGE(PG8_SB(0, 0), b2, voffB); PG8_STAGE(PG8_SB(0, 1), b2 + hstepB, voffB); PG8_STAGE(PG8_SA(0, 0), a2, voffA);
            PG8_WAIT_V(8); PG8_WAIT_L(0); PG8_BAR; PG8_MMA(1, 0, At, B0); PG8_MMA(1, 1, At, B1); PG8_BAR; PG8_SCHED;
            PG8_LDB(B0, 1, 0); PG8_LDB(B1, 1, 1); PG8_SCHED; PG8_LDA(At, 1, 0); PG8_STAGE(PG8_SA(0, 1), a2 + hstepA, voffA);
            PG8_WAIT_V(8); PG8_WAIT_L(0); PG8_BAR; PG8_MMA(0, 0, At, B0); PG8_MMA(0, 1, At, B1); PG8_BAR; PG8_SCHED;
            PG8_LDA(At, 1, 1); PG8_STAGE(PG8_SB(1, 0), b3, voffB); PG8_STAGE(PG8_SB(1, 1), b3 + hstepB, voffB); PG8_STAGE(PG8_SA(1, 0), a3, voffA);
            PG8_WAIT_V(8); PG8_WAIT_L(0); PG8_BAR; PG8_MMA(1, 0, At, B0); PG8_MMA(1, 1, At, B1); PG8_BAR; PG8_SCHED;
        }
        if (wr == 0) PG8_BAR;
        E(acc, cur, wr, wc, fr, fq);
        if (!has_next) break;
#pragma unroll
        for (int a = 0; a < 2; ++a)
#pragma unroll
            for (int b = 0; b < 2; ++b)
#pragma unroll
                for (int m = 0; m < 4; ++m)
#pragma unroll
                    for (int n = 0; n < 2; ++n) acc[a][b][m][n] = (f32x4){0.f, 0.f, 0.f, 0.f};
        cur = nxt; cA = nA; cB = nB; ++ui;
        if (wr == 1) PG8_BAR;
    }
    PG8_WAIT_V(0);
    PG8_BAR;
#undef PG8_SA
#undef PG8_SB
#undef PG8_STAGE
#undef PG8_LDA
#undef PG8_LDB
#undef PG8_MMA
#undef PG8_WAIT_V
#undef PG8_WAIT_L
#undef PG8_BAR
#undef PG8_SCHED
}
}
using pg8::Unit;

template <class F>
__device__ __forceinline__ void epi_perm_loop(const f32x4 (&acc)[2][2][4][2], int wr, int wc, int fr, int fq, F&& f) {
#pragma unroll
    for (int ai = 0; ai < 2; ++ai)
#pragma unroll
        for (int m = 0; m < 4; ++m) { const int rt = ai * 128 + wr * 64 + m * 16 + fr;
#pragma unroll
            for (int bj = 0; bj < 2; ++bj) { const int ct = bj * 128 + wc * 32 + 8 * fq; f(rt, ct, acc[ai][bj][m][0], acc[ai][bj][m][1]); }
            asm volatile("" ::: "memory"); }
}
__device__ __forceinline__ u32x4 pack8(f32x4 v0, f32x4 v1) { u32x4 w; w.x = pk2(v0[0], v0[1]); w.y = pk2(v0[2], v0[3]); w.z = pk2(v1[0], v1[1]); w.w = pk2(v1[2], v1[3]); return w; }
__device__ __forceinline__ float gelu_tanh(float x) { const float u = 1.5957691216057308f * (x + 0.044715f * x * x * x); return x * sigmoidf_(u); }
__device__ __forceinline__ void unpack8(u32x4 w, float (&f)[8]) { f[0] = bflo(w.x); f[1] = bfhi(w.x); f[2] = bflo(w.y); f[3] = bfhi(w.y); f[4] = bflo(w.z); f[5] = bfhi(w.z); f[6] = bflo(w.w); f[7] = bfhi(w.w); }

struct EpiCtx {
    static constexpr bool PERM = true;
    bf16* ZC;
    __device__ __forceinline__ void operator()(const f32x4 (&acc)[2][2][4][2], const Unit& u, int wr, int wc, int fr, int fq) const {
        const int pn = u.pn; const int ctile = pn < 4 ? pn : pn - 8;
        const float sc = (pn >= 12 && pn < 16) ? K_SCALE : 1.0f;
        const int row0 = (u.pm - 256) * 256; bf16* zc = ZC;
        epi_perm_loop(acc, wr, wc, fr, fq, [&](int rt, int ct, f32x4 v0, f32x4 v1) { v0 *= sc; v1 *= sc; *(u32x4*)(zc + (size_t)(row0 + rt) * ZC_LD + ctile * 256 + ct) = pack8(v0, v1); });
    }
};
struct EpiIn {
    static constexpr bool PERM = true;
    bf16* Z; const f32x2* rope;
    __device__ __forceinline__ void operator()(const f32x4 (&acc)[2][2][4][2], const Unit& u, int wr, int wc, int fr, int fq) const {
        const int pn = u.pn; const int row0 = u.pm * 256, col0 = pn * 256; const f32x2* rp_ = rope;
        const int kind = pn < 4 ? 0 : pn < 8 ? 1 : pn < 12 ? 2 : pn < 16 ? 3 : pn < 24 ? 0 : pn < 32 ? 4 : 5;
        const float sc = kind == 3 ? K_SCALE : 1.0f;
        char* zt = (char*)(Z + (size_t)row0 * DIN + col0); int ldz = DIN; asm volatile("" : "+s"(ldz));
        epi_perm_loop(acc, wr, wc, fr, fq, [&](int rt, int ct, f32x4 v0, f32x4 v1) {
            if (kind == 1) { for (int j = 0; j < 4; ++j) { v0[j] = gelu_tanh(v0[j]); v1[j] = gelu_tanh(v1[j]); } }
            else if (kind == 4) { for (int j = 0; j < 4; ++j) { v0[j] = v0[j] * sigmoidf_(v0[j]); v1[j] = v1[j] * sigmoidf_(v1[j]); } }
            else if (kind == 5) { for (int j = 0; j < 4; ++j) { v0[j] = sigmoidf_(v0[j]); v1[j] = sigmoidf_(v1[j]); } }
            else if (kind == 2 || kind == 3) {
                const int t = (row0 + rt) & (SEQ - 1);
                const int e0 = (col0 + ct) & 127; const int p0 = e0 >> 1;
                const int pos = p0 < 32 ? (t >> 6) : (t & 63); const int f0 = p0 & 31;
                const f32x4* rp = (const f32x4*)(rp_ + pos * 32 + f0);
                const f32x4 cs0 = rp[0]; const f32x4 cs1 = rp[1];
                f32x4 o0, o1;
                o0[0] = v0[0] * cs0[0] - v0[1] * cs0[1]; o0[1] = v0[0] * cs0[1] + v0[1] * cs0[0];
                o0[2] = v0[2] * cs0[2] - v0[3] * cs0[3]; o0[3] = v0[2] * cs0[3] + v0[3] * cs0[2];
                o1[0] = v1[0] * cs1[0] - v1[1] * cs1[1]; o1[1] = v1[0] * cs1[1] + v1[1] * cs1[0];
                o1[2] = v1[2] * cs1[2] - v1[3] * cs1[3]; o1[3] = v1[2] * cs1[3] + v1[3] * cs1[2];
                v0 = o0 * sc; v1 = o1 * sc;
            }
            *(u32x4*)(zt + (unsigned)((rt * ldz + ct) * 2)) = pack8(v0, v1); });
    }
};
struct EpiT1 {
    static constexpr bool PERM = true;
    const bf16* Z; bf16* T1;
    __device__ __forceinline__ void operator()(const f32x4 (&acc)[2][2][4][2], const Unit& u, int wr, int wc, int fr, int fq) const {
        const int row0 = u.pm * 256, col0 = u.pn * 256; const bf16* z = Z; bf16* t1 = T1;
        epi_perm_loop(acc, wr, wc, fr, fq, [&](int rt, int ct, f32x4 v0, f32x4 v1) { float gte[8]; unpack8(*(const u32x4*)(z + (size_t)(row0 + rt) * DIN + C_GA + col0 + ct), gte);
            for (int j = 0; j < 4; ++j) { v0[j] *= gte[j]; v1[j] *= gte[4 + j]; }
            *(u32x4*)(t1 + (size_t)(row0 + rt) * D + col0 + ct) = pack8(v0, v1); });
    }
};
struct EpiMg {
    static constexpr bool PERM = true;
    const bf16* Z; const bf16* T1; bf16* MG;
    __device__ __forceinline__ void operator()(const f32x4 (&acc)[2][2][4][2], const Unit& u, int wr, int wc, int fr, int fq) const {
        const int row0 = u.pm * 256, col0 = u.pn * 256; const bf16* z = Z; const bf16* t1 = T1; bf16* mg = MG;
        epi_perm_loop(acc, wr, wc, fr, fq, [&](int rt, int ct, f32x4 v0, f32x4 v1) { float gte[8], t1v[8]; unpack8(*(const u32x4*)(z + (size_t)(row0 + rt) * DIN + C_GB + col0 + ct), gte); unpack8(*(const u32x4*)(t1 + (size_t)(row0 + rt) * D + col0 + ct), t1v);
            for (int j = 0; j < 4; ++j) { v0[j] = t1v[j] + v0[j] * gte[j]; v1[j] = t1v[4 + j] + v1[j] * gte[4 + j]; }
            *(u32x4*)(mg + (size_t)(row0 + rt) * D + col0 + ct) = pack8(v0, v1); });
    }
};
struct EpiX1 {
    static constexpr bool PERM = false;
    const float* X; float* O; const float* mod; int grow0;
    __device__ __forceinline__ void operator()(const f32x4 (&acc)[2][2][4][2], const Unit& u, int wr, int wc, int fr, int fq) const {
        const int row0 = grow0 + u.pm * 256 + wr * 64 + fr, col0 = u.pn * 256 + wc * 32 + 4 * fq;
#pragma unroll
        for (int ai = 0; ai < 2; ++ai)
#pragma unroll
            for (int m = 0; m < 4; ++m) { const int row = row0 + ai * 128 + m * 16; const int b = row >> 13; const size_t off = (size_t)row * D + col0; const float* g1 = mod + b * 6144 + 2048 + col0;
#pragma unroll
                for (int bj = 0; bj < 2; ++bj)
#pragma unroll
                    for (int n = 0; n < 2; ++n) { const int co = bj * 128 + n * 16; const f32x4 xv = *(const f32x4*)(X + off + co); const f32x4 gv = *(const f32x4*)(g1 + co);
                        *(f32x4*)(O + off + co) = xv + gv * acc[ai][bj][m][n]; }
                asm volatile("" ::: "memory"); }
    }
};
__device__ __forceinline__ float swiglu1(float g, float l) { const float gl = fminf(g, 7.0f), li = fminf(fmaxf(l, -7.0f), 7.0f); return gl * sigmoidf_(1.702f * gl) * (li + 1.0f); }
struct EpiHid {
    static constexpr bool PERM = true;
    bf16* HID; const float* b1;
    __device__ __forceinline__ void operator()(const f32x4 (&acc)[2][2][4][2], const Unit& u, int wr, int wc, int fr, int fq) const {
        const int e = u.pn >> 3, pl = u.pn & 7; const int row0 = u.pm * 256; const float* bb = b1 + e * 2048 + pl * 256; bf16* hid = HID;
        epi_perm_loop(acc, wr, wc, fr, fq, [&](int rt, int ct, f32x4 v0, f32x4 v1) { const f32x4 ba = *(const f32x4*)(bb + ct); const f32x4 bc = *(const f32x4*)(bb + ct + 4); v0 += ba; v1 += bc;
            u32x2 w; w.x = pk2(swiglu1(v0[0], v0[1]), swiglu1(v0[2], v0[3])); w.y = pk2(swiglu1(v1[0], v1[1]), swiglu1(v1[2], v1[3]));
            *(u32x2*)(hid + (size_t)(row0 + rt) * DEXP + pl * 128 + (ct >> 1)) = w; });
    }
};
struct EpiY {
    static constexpr bool PERM = true;
    bf16* Y; const float* b2;
    __device__ __forceinline__ void operator()(const f32x4 (&acc)[2][2][4][2], const Unit& u, int wr, int wc, int fr, int fq) const {
        const int e = u.pn >> 2, pl = u.pn & 3; const int row0 = u.pm * 256; const float* bb = b2 + e * 1024 + pl * 256; bf16* y = Y;
        epi_perm_loop(acc, wr, wc, fr, fq, [&](int rt, int ct, f32x4 v0, f32x4 v1) { const f32x4 ba = *(const f32x4*)(bb + ct); const f32x4 bc = *(const f32x4*)(bb + ct + 4); v0 += ba; v1 += bc;
            *(u32x4*)(y + (size_t)(row0 + rt) * D + pl * 256 + ct) = pack8(v0, v1); });
    }
};

#define XB_TMO      128
#define XB_XCNT(j)  (256  + 64 * (j))
#define XB_XSUB(j)  (1280 + 64 * (j))
#define XB_XGEN(j)  (2304 + 64 * (j))
#define XB_TOP      3328
#define XB_TOPGEN   3392
#define XCD_BAR_WORDS 3456
#define XB_SPIN_CAP (1u << 22)
__device__ __forceinline__ unsigned xb_ld(unsigned* p)              { return __hip_atomic_load(p, __ATOMIC_RELAXED, __HIP_MEMORY_SCOPE_AGENT); }
__device__ __forceinline__ unsigned xb_add(unsigned* p, unsigned v) { return __hip_atomic_fetch_add(p, v, __ATOMIC_RELAXED, __HIP_MEMORY_SCOPE_AGENT); }
__device__ __forceinline__ unsigned xb_xcc_id() { return (unsigned)__builtin_amdgcn_s_getreg((3 << 11) | 20) & 0xFu; }
#define XB_SPIN(cond, bar) do { unsigned _sp = 0; while (cond) { __builtin_amdgcn_s_sleep(1); \
    if ((++_sp & 255u) == 0u) { if (xb_ld(&(bar)[XB_TMO])) break; if (_sp > XB_SPIN_CAP) { atomicAdd(&(bar)[XB_TMO], 1u); break; } } } } while (0)
struct XcdBarrier { unsigned* bar; unsigned x; volatile LAS unsigned* st; };
__device__ __forceinline__ XcdBarrier xcd_barrier_post(unsigned* bar, volatile LAS unsigned* st) {
    XcdBarrier b; b.bar = bar; b.x = xb_xcc_id(); b.st = st;
    if (threadIdx.x == 0) (void)xb_add(&bar[XB_XCNT(b.x)], 1u);
    return b;
}
__device__ __forceinline__ void xcd_barrier_complete(unsigned* bar, unsigned x, unsigned& nloc, unsigned& nx) {
    const unsigned G = gridDim.x * gridDim.y * gridDim.z;
    unsigned sum, cnt, mine, sp = 0u;
    for (;;) {
        sum = 0u; cnt = 0u; mine = 0u;
#pragma unroll
        for (unsigned j = 0; j < 16; ++j) { const unsigned c = xb_ld(&bar[XB_XCNT(j)]); sum += c; cnt += (c > 0u) ? 1u : 0u; mine = (j == x) ? c : mine; }
        if (sum == G) break;
        __builtin_amdgcn_s_sleep(1);
        if ((++sp & 255u) == 0u) { if (xb_ld(&bar[XB_TMO])) break; if (sp > XB_SPIN_CAP) { atomicAdd(&bar[XB_TMO], 1u); break; } }
    }
    nloc = mine > 0u ? mine : 1u; nx = cnt > 0u ? cnt : 1u;
}
__device__ __forceinline__ void xcd_barrier(const XcdBarrier& b) {
    asm volatile("s_waitcnt vmcnt(0)" ::: "memory");
    __syncthreads();
    if (threadIdx.x == 0) {
        unsigned* bar = b.bar;
        __builtin_amdgcn_s_waitcnt(0);
        unsigned nloc = b.st[0], nx = b.st[1];
        if (nloc == 0u) { xcd_barrier_complete(bar, b.x, nloc, nx); b.st[0] = nloc; b.st[1] = nx; }
        const unsigned old = xb_add(&bar[XB_XSUB(b.x)], 1u);
        const unsigned gen = old / nloc;
        if (old + 1u == (gen + 1u) * nloc) {
            __builtin_amdgcn_fence(__ATOMIC_RELEASE, "agent");
            asm volatile("s_waitcnt vmcnt(0)" ::: "memory");
            const unsigned og = xb_add(&bar[XB_TOP], 1u);
            const unsigned tg = og / nx;
            if (og + 1u == (tg + 1u) * nx) xb_add(&bar[XB_TOPGEN], 1u);
            else XB_SPIN(xb_ld(&bar[XB_TOPGEN]) == tg, bar);
            __builtin_amdgcn_fence(__ATOMIC_ACQUIRE, "agent");
            xb_add(&bar[XB_XGEN(b.x)], 1u);
            asm volatile("s_waitcnt vmcnt(0)" ::: "memory");
        } else {
            XB_SPIN(xb_ld(&bar[XB_XGEN(b.x)]) == gen, bar);
            __builtin_amdgcn_fence(__ATOMIC_ACQUIRE, "agent");
            asm volatile("s_waitcnt vmcnt(0)" ::: "memory");
        }
    }
    __syncthreads();
}

__device__ __forceinline__ void transpose_item(const float* W, int ldw, int K, int N, bf16* WT, LAS float* scr, int item, int lane) {
    const int nblk = N / 32, kb = item / nblk, nb = item % nblk, k0 = 64 * kb, n0 = 32 * nb;
#pragma unroll 8
    for (int i = 0; i < 32; ++i) { const int kk = 2 * i + (lane >> 5); scr[kk * 33 + (lane & 31)] = W[(size_t)(k0 + kk) * ldw + n0 + (lane & 31)]; }
    LDS_WAIT(); asm volatile("" ::: "memory");
    const int c = lane & 7;
#pragma unroll
    for (int j = 0; j < 4; ++j) { const int n = (lane >> 3) + 8 * j; const LAS float* s = scr + (8 * c) * 33 + n;
        u32x4 o; o.x = pk2(s[0 * 33], s[1 * 33]); o.y = pk2(s[2 * 33], s[3 * 33]); o.z = pk2(s[4 * 33], s[5 * 33]); o.w = pk2(s[6 * 33], s[7 * 33]);
        *(u32x4*)(WT + (size_t)(n0 + n) * K + k0 + 8 * c) = o; }
    LDS_WAIT(); asm volatile("" ::: "memory");
}
__device__ __forceinline__ unsigned offb(unsigned row, unsigned ch) { return 256u * row + 16u * (ch ^ (((row & 3u) << 2) | ((row >> 2) & 3u))); }
typedef short v4i16_t __attribute__((ext_vector_type(4)));
__device__ __forceinline__ s16x4 trd(const LAS unsigned char* p) { return __builtin_bit_cast(s16x4, __builtin_amdgcn_ds_read_tr16_b64_v4i16((LAS v4i16_t*)p)); }
#define MFMA32(a, b, c) __builtin_amdgcn_mfma_f32_32x32x16_bf16((a), (b), (c), 0, 0, 0)
#define MFMA16(a, b, c) __builtin_amdgcn_mfma_f32_16x16x32_bf16((a), (b), (c), 0, 0, 0)
__device__ __forceinline__ int crow(int reg, int h) { return (reg & 3) + 8 * (reg >> 2) + 4 * h; }

struct LruP { const float *conv_w, *conv_b, *ba, *bx, *lam; const bf16* wg; f32x2* carry; };
template <int PASS, int DIR>
__device__ __forceinline__ void lru_dir(LAS unsigned char* XC, LAS unsigned char* RN, const LruP& P, int b, int cp, int n, int w, int col, int g4) {
    const int ch = 128 * n + 16 * w + col;
    const float bav = P.ba[DIR * 1024 + ch], bxv = P.bx[DIR * 1024 + ch];
    const float c8 = 8.0f * log1pf(expf(-P.lam[DIR * 1024 + ch]));
    bf16x8 Ba[4], Bx[4];
    { const bf16* wa = P.wg + ((size_t)((n * 4 + DIR * 2 + 0) * 128 + 16 * w + col)) * 128 + 8 * g4; const bf16* wx = wa + 128 * 128;
#pragma unroll
      for (int ks = 0; ks < 4; ++ks) { Ba[ks] = *(const bf16x8*)(wa + 32 * ks); Bx[ks] = *(const bf16x8*)(wx + 32 * ks); } }
    float hrun = 0.f, atot = 1.f;
    if (PASS == 1) {
        const int Pn = DIR == 0 ? cp : 33 - cp; float Al = 1.f, Ul = 0.f;
#pragma unroll
        for (int k = 0; k < 9; ++k) { const int p = 9 * g4 + k;
            if (p < Pn) { const int cq = DIR == 0 ? p : (p == 0 ? 0 : 33 - p); const f32x2 ah = P.carry[((size_t)(b * 2 + DIR) * 33 + cq) * 1024 + ch]; Ul = ah.x * Ul + ah.y; Al = ah.x * Al; } }
#pragma unroll
        for (int gq = 0; gq < 4; ++gq) { const float Ag = __shfl(Al, col + 16 * gq), Ug = __shfl(Ul, col + 16 * gq); hrun = Ag * hrun + Ug; }
    }
#pragma unroll 1
    for (int mi = 0; mi < 16; ++mi) {
        const int m = DIR == 0 ? mi : 15 - mi;
        f32x4 ar = {0.f, 0.f, 0.f, 0.f}, ai = {0.f, 0.f, 0.f, 0.f};
        const LAS unsigned char* xrow = XC + (16 * m + col) * 272 + 16 * g4;
#pragma unroll
        for (int ks = 0; ks < 4; ++ks) { const bf16x8 af = *(const LAS bf16x8*)(xrow + 64 * ks); ar = MFMA16(af, Ba[ks], ar); ai = MFMA16(af, Bx[ks], ai); }
        float av[4], uv[4];
#pragma unroll
        for (int r = 0; r < 4; ++r) { const int t = 16 * m + 4 * g4 + r; const float xc = bf2f(*(const LAS unsigned short*)(XC + t * 272 + (16 * w + col) * 2));
            const float rg = sigmoidf_(ar[r] + bav), ig = sigmoidf_(ai[r] + bxv); const float la = -c8 * rg; const float a = __expf(la);
            av[r] = a; uv[r] = sqrtf(fmaxf(1.0f - a * a, 0.f)) * ig * xc; }
        float Al = 1.f, Ul = 0.f;
#pragma unroll
        for (int rr = 0; rr < 4; ++rr) { const int r = DIR == 0 ? rr : 3 - rr; Ul = av[r] * Ul + uv[r]; Al = av[r] * Al; }
        float Ag[4], Ug[4];
#pragma unroll
        for (int gq = 0; gq < 4; ++gq) { Ag[gq] = __shfl(Al, col + 16 * gq); Ug[gq] = __shfl(Ul, col + 16 * gq); }
        float h = hrun, hin = hrun;
#pragma unroll
        for (int gi = 0; gi < 4; ++gi) { const int gq = DIR == 0 ? gi : 3 - gi; if (gq == g4) hin = h; h = Ag[gq] * h + Ug[gq]; atot *= Ag[gq]; }
        hrun = h;
        if (PASS == 1) {
            float hh = hin;
#pragma unroll
            for (int rr = 0; rr < 4; ++rr) { const int r = DIR == 0 ? rr : 3 - rr; hh = av[r] * hh + uv[r];
                LAS unsigned short* rp = (LAS unsigned short*)(RN + (16 * m + 4 * g4 + r) * 272 + (16 * w + col) * 2);
                if (DIR == 0) *rp = (unsigned short)f2bf(hh); else *rp = (unsigned short)f2bf(bf2f(*rp) + hh); }
        }
    }
    if (PASS == 0) { if (g4 == 0) P.carry[((size_t)(b * 2 + DIR) * 33 + cp) * 1024 + ch] = (f32x2){atot, hrun}; }
}
template <int PASS>
__device__ __forceinline__ void lru_unit(LAS unsigned char* lds, const LruP& P, int b, int cp, int n, const bf16* xsrc, int ldx, int seqlen, bf16* grp) {
    const int tid = opaque_tid(), lane = tid & 63, w = __builtin_amdgcn_readfirstlane(tid >> 6), col = lane & 15, g4 = lane >> 4;
    const int t0 = cp == 0 ? 0 : (cp - 1) * 256;
    LAS unsigned char* XC = lds;
    LAS unsigned char* RN = lds + 69632;
    __syncthreads();
    {
        const int j8 = tid & 15, ch0 = 128 * n + 8 * j8;
        float cw[4][8], cb[8];
#pragma unroll
        for (int k = 0; k < 4; ++k) { const f32x4 a = *(const f32x4*)(P.conv_w + k * 1024 + ch0), c = *(const f32x4*)(P.conv_w + k * 1024 + ch0 + 4);
            cw[k][0] = a[0]; cw[k][1] = a[1]; cw[k][2] = a[2]; cw[k][3] = a[3]; cw[k][4] = c[0]; cw[k][5] = c[1]; cw[k][6] = c[2]; cw[k][7] = c[3]; }
        { const f32x4 a = *(const f32x4*)(P.conv_b + ch0), c = *(const f32x4*)(P.conv_b + ch0 + 4); cb[0] = a[0]; cb[1] = a[1]; cb[2] = a[2]; cb[3] = a[3]; cb[4] = c[0]; cb[5] = c[1]; cb[6] = c[2]; cb[7] = c[3]; }
#pragma unroll 2
        for (int i = 0; i < 8; ++i) {
            const int t = (tid >> 4) + 32 * i; float a[8];
#pragma unroll
            for (int j = 0; j < 8; ++j) a[j] = cb[j];
#pragma unroll
            for (int k = 0; k < 4; ++k) { const int row = t0 + t + k - 2;
                if (row >= 0 && row < seqlen) { float xv[8]; unpack8(*(const u32x4*)(xsrc + (size_t)row * ldx + ch0), xv);
#pragma unroll
                    for (int j = 0; j < 8; ++j) a[j] += cw[k][j] * xv[j]; } }
            u32x4 o; o.x = pk2(a[0], a[1]); o.y = pk2(a[2], a[3]); o.z = pk2(a[4], a[5]); o.w = pk2(a[6], a[7]);
            *(LAS u32x4*)(XC + t * 272 + j8 * 16) = o;
        }
    }
    __syncthreads();
    lru_dir<PASS, 0>(XC, RN, P, b, cp, n, w, col, g4);
    lru_dir<PASS, 1>(XC, RN, P, b, cp, n, w, col, g4);
    if (PASS == 1) {
        __syncthreads();
        const int j8 = tid & 15, ch0 = 128 * n + 8 * j8;
#pragma unroll 2
        for (int i = 0; i < 8; ++i) { const int t = (tid >> 4) + 32 * i; float rv[8], gv[8];
            unpack8(*(const LAS u32x4*)(RN + t * 272 + j8 * 16), rv); bf16* gp = grp + (size_t)(t0 + t) * DIN + C_GR + ch0; unpack8(*(const u32x4*)gp, gv);
            u32x4 o; o.x = pk2(rv[0] * gv[0], rv[1] * gv[1]); o.y = pk2(rv[2] * gv[2], rv[3] * gv[3]); o.z = pk2(rv[4] * gv[4], rv[5] * gv[5]); o.w = pk2(rv[6] * gv[6], rv[7] * gv[7]);
            *(u32x4*)gp = o; }
    }
}

__device__ __forceinline__ void kv_unit(LAS unsigned char* lds, const bf16* ksrc, const bf16* vsrc, int ld, float l2g, bf16* out) {
    const int tid = opaque_tid(), lane = tid & 63, w = __builtin_amdgcn_readfirstlane(tid >> 6);
    LAS unsigned char* KF = lds; LAS unsigned char* KB = lds + 32768; LAS unsigned char* VI = lds + 65536;
    __syncthreads();
#pragma unroll
    for (int i = 0; i < 4; ++i) { const int idx = tid + 512 * i, j = idx >> 4, chn = idx & 15; float kv[8]; unpack8(*(const u32x4*)(ksrc + (size_t)j * ld + 8 * chn), kv);
        const float wf = exp2f(l2g * (float)(127 - j)), wb = exp2f(l2g * (float)j);
        u32x4 of, ob; of.x = pk2(kv[0] * wf, kv[1] * wf); of.y = pk2(kv[2] * wf, kv[3] * wf); of.z = pk2(kv[4] * wf, kv[5] * wf); of.w = pk2(kv[6] * wf, kv[7] * wf);
        ob.x = pk2(kv[0] * wb, kv[1] * wb); ob.y = pk2(kv[2] * wb, kv[3] * wb); ob.z = pk2(kv[4] * wb, kv[5] * wb); ob.w = pk2(kv[6] * wb, kv[7] * wb);
        *(LAS u32x4*)(KF + offb(j, chn)) = of; *(LAS u32x4*)(KB + offb(j, chn)) = ob; }
#pragma unroll
    for (int i = 0; i < 8; ++i) { const int idx = tid + 512 * i, j = idx >> 5, chn = idx & 31;
        *(LAS u32x4*)(VI + (chn >> 4) * 32768 + offb(j, chn & 15)) = *(const u32x4*)(vsrc + (size_t)j * ld + 8 * chn); }
    __syncthreads();
    const int h = lane >> 5, blk = (lane >> 4) & 1, q = (lane & 15) >> 2, p = lane & 3;
    f32x16 accF[4], accB[4];
#pragma unroll
    for (int dt = 0; dt < 4; ++dt)
#pragma unroll
        for (int r = 0; r < 16; ++r) { accF[dt][r] = 0.f; accB[dt][r] = 0.f; }
    const LAS unsigned char* Vimg = VI + (w >> 2) * 32768; const int cv = w & 3;
#pragma unroll 1
    for (int ks = 0; ks < 8; ++ks) {
        const unsigned r0 = 16 * ks + 8 * h + q, r1 = r0 + 4;
        const s16x4 v0 = trd(Vimg + offb(r0, 4 * cv + 2 * blk + (p >> 1)) + 8 * (p & 1)), v1 = trd(Vimg + offb(r1, 4 * cv + 2 * blk + (p >> 1)) + 8 * (p & 1));
        const bf16x8 bv = __builtin_shufflevector(v0, v1, 0, 1, 2, 3, 4, 5, 6, 7);
#pragma unroll
        for (int dt = 0; dt < 4; ++dt) {
            const unsigned o0 = offb(r0, 4 * dt + 2 * blk + (p >> 1)) + 8 * (p & 1), o1 = offb(r1, 4 * dt + 2 * blk + (p >> 1)) + 8 * (p & 1);
            const bf16x8 af = __builtin_shufflevector(trd(KF + o0), trd(KF + o1), 0, 1, 2, 3, 4, 5, 6, 7);
            const bf16x8 ab = __builtin_shufflevector(trd(KB + o0), trd(KB + o1), 0, 1, 2, 3, 4, 5, 6, 7);
            accF[dt] = MFMA32(af, bv, accF[dt]); accB[dt] = MFMA32(ab, bv, accB[dt]);
        }
    }
    __syncthreads();
    { const int v = 32 * w + (lane & 31);
#pragma unroll
      for (int dt = 0; dt < 4; ++dt)
#pragma unroll
        for (int rg = 0; rg < 4; ++rg) { const int d = 32 * dt + 8 * rg + 4 * h;
            u32x2 of, ob; of.x = pk2(accF[dt][4 * rg], accF[dt][4 * rg + 1]); of.y = pk2(accF[dt][4 * rg + 2], accF[dt][4 * rg + 3]);
            ob.x = pk2(accB[dt][4 * rg], accB[dt][4 * rg + 1]); ob.y = pk2(accB[dt][4 * rg + 2], accB[dt][4 * rg + 3]);
            *(LAS u32x2*)(lds + v * 272 + d * 2) = of; *(LAS u32x2*)(lds + 69632 + v * 272 + d * 2) = ob; } }
    __syncthreads();
#pragma unroll
    for (int i = 0; i < 16; ++i) { const int idx = tid + 512 * i, dir = idx >> 12, v = (idx >> 4) & 255, chn = idx & 15;
        *(u32x4*)(out + (size_t)dir * 32768 + v * 128 + 8 * chn) = *(const LAS u32x4*)(lds + dir * 69632 + v * 272 + chn * 16); }
}

__device__ __forceinline__ void ro_unit(LAS unsigned char* lds, const bf16* qsrc, const bf16* ksrc, const bf16* vsrc, bf16* gsp, const bf16* Sf, const bf16* Sb, float l2g) {
    const int tid = opaque_tid(), lane = tid & 63, w = __builtin_amdgcn_readfirstlane(tid >> 6), wi = w & 3, wv = w >> 2;
    LAS unsigned char* QI = lds; LAS unsigned char* KI = lds + 32768; LAS unsigned char* VI = lds + 65536; LAS float* STATS = (LAS float*)(lds + 135168);
    __syncthreads();
#pragma unroll
    for (int i = 0; i < 4; ++i) { const int idx = tid + 512 * i, j = idx >> 4, chn = idx & 15;
        *(LAS u32x4*)(QI + offb(j, chn)) = *(const u32x4*)(qsrc + (size_t)j * DIN + 8 * chn); *(LAS u32x4*)(KI + offb(j, chn)) = *(const u32x4*)(ksrc + (size_t)j * DIN + 8 * chn); }
#pragma unroll
    for (int i = 0; i < 8; ++i) { const int idx = tid + 512 * i, j = idx >> 5, chn = idx & 31;
        *(LAS u32x4*)(VI + (chn >> 4) * 32768 + offb(j, chn & 15)) = *(const u32x4*)(vsrc + (size_t)j * DIN + 8 * chn); }
    __syncthreads();
    const int h = lane >> 5, l31 = lane & 31, blk = (lane >> 4) & 1, q = (lane & 15) >> 2, p = lane & 3;
    bf16x8 qf[8];
#pragma unroll
    for (int s = 0; s < 8; ++s) qf[s] = *(const LAS bf16x8*)(QI + offb(32 * wi + l31, 2 * s + h));
    f32x16 z[4];
#pragma unroll
    for (int c = 0; c < 4; ++c)
#pragma unroll
        for (int r = 0; r < 16; ++r) z[c][r] = 0.f;
#pragma unroll
    for (int s = 0; s < 8; ++s)
#pragma unroll
        for (int c = 0; c < 4; ++c) { const bf16x8 bs = *(const bf16x8*)(Sf + (size_t)(128 * wv + 32 * c + l31) * 128 + 16 * s + 8 * h); z[c] = MFMA32(qf[s], bs, z[c]); }
#pragma unroll
    for (int r = 0; r < 16; ++r) { const int i = 32 * wi + crow(r, h); const float f = exp2f(l2g * (float)(2 * i - 127));
#pragma unroll
        for (int c = 0; c < 4; ++c) z[c][r] *= f; }
#pragma unroll
    for (int s = 0; s < 8; ++s)
#pragma unroll
        for (int c = 0; c < 4; ++c) { const bf16x8 bs = *(const bf16x8*)(Sb + (size_t)(128 * wv + 32 * c + l31) * 128 + 16 * s + 8 * h); z[c] = MFMA32(qf[s], bs, z[c]); }
#pragma unroll
    for (int r = 0; r < 16; ++r) { const int i = 32 * wi + crow(r, h); const float f = exp2f(l2g * (float)(128 - i));
#pragma unroll
        for (int c = 0; c < 4; ++c) z[c][r] *= f; }
    const LAS unsigned char* Vimg = VI + wv * 32768;
#pragma unroll
    for (int jt = 0; jt < 4; ++jt) {
        f32x16 x;
#pragma unroll
        for (int r = 0; r < 16; ++r) x[r] = 0.f;
#pragma unroll
        for (int s = 0; s < 8; ++s) { const bf16x8 ak = *(const LAS bf16x8*)(KI + offb(32 * jt + l31, 2 * s + h)); x = MFMA32(ak, qf[s], x); }
        const int ii = 32 * wi + l31;
#pragma unroll
        for (int r = 0; r < 16; ++r) { const int jj = 32 * jt + crow(r, h); const int dd = ii > jj ? ii - jj : jj - ii; x[r] *= exp2f(l2g * (float)dd); }
#pragma unroll
        for (int s2 = 0; s2 < 2; ++s2) {
            u32x4 pw; pw.x = pk2(x[8 * s2], x[8 * s2 + 1]); pw.y = pk2(x[8 * s2 + 2], x[8 * s2 + 3]); pw.z = pk2(x[8 * s2 + 4], x[8 * s2 + 5]); pw.w = pk2(x[8 * s2 + 6], x[8 * s2 + 7]);
            const bf16x8 xs = __builtin_bit_cast(bf16x8, pw);
            const unsigned r0 = 32 * jt + 16 * s2 + 4 * h + q, r1 = r0 + 8;
#pragma unroll
            for (int c = 0; c < 4; ++c) {
                const s16x4 v0 = trd(Vimg + offb(r0, 4 * c + 2 * blk + (p >> 1)) + 8 * (p & 1)), v1 = trd(Vimg + offb(r1, 4 * c + 2 * blk + (p >> 1)) + 8 * (p & 1));
                const bf16x8 pb = __builtin_shufflevector(v0, v1, 0, 1, 2, 3, 4, 5, 6, 7);
                z[c] = MFMA32(xs, pb, z[c]);
            }
        }
    }
#pragma unroll
    for (int r = 0; r < 16; ++r) { float s1 = (z[0][r] + z[1][r]) + (z[2][r] + z[3][r]); float s2 = (z[0][r] * z[0][r] + z[1][r] * z[1][r]) + (z[2][r] * z[2][r] + z[3][r] * z[3][r]);
#pragma unroll
        for (int o = 1; o < 32; o <<= 1) { s1 += __shfl_xor(s1, o); s2 += __shfl_xor(s2, o); }
        if (l31 == 0) { STATS[((wi * 2 + wv) * 32 + crow(r, h)) * 2] = s1; STATS[((wi * 2 + wv) * 32 + crow(r, h)) * 2 + 1] = s2; } }
    __syncthreads();
#pragma unroll
    for (int r = 0; r < 16; ++r) { const int il = crow(r, h);
        const float s1 = STATS[((wi * 2 + 0) * 32 + il) * 2] + STATS[((wi * 2 + 1) * 32 + il) * 2], s2 = STATS[((wi * 2 + 0) * 32 + il) * 2 + 1] + STATS[((wi * 2 + 1) * 32 + il) * 2 + 1];
        const float mean = s1 * (1.0f / 256.0f); const float var = fmaxf(s2 * (1.0f / 256.0f) - mean * mean, 0.f); const float rstd = 1.0f / sqrtf(var + EPS);
#pragma unroll
        for (int c = 0; c < 4; ++c) *(LAS unsigned short*)(lds + (32 * wi + il) * 528 + (128 * wv + 32 * c + l31) * 2) = (unsigned short)f2bf((z[c][r] - mean) * rstd); }
    __syncthreads();
#pragma unroll
    for (int i = 0; i < 8; ++i) { const int idx = tid + 512 * i, r = idx >> 5, chn = idx & 31; float ov[8], gv[8];
        unpack8(*(const LAS u32x4*)(lds + r * 528 + chn * 16), ov); bf16* gp = gsp + (size_t)r * DIN + 8 * chn; unpack8(*(const u32x4*)gp, gv);
        u32x4 o; o.x = pk2(ov[0] * gv[0], ov[1] * gv[1]); o.y = pk2(ov[2] * gv[2], ov[3] * gv[3]); o.z = pk2(ov[4] * gv[4], ov[5] * gv[5]); o.w = pk2(ov[6] * gv[6], ov[7] * gv[7]);
        *(u32x4*)gp = o; }
}

struct Args { const float* in[26]; float* out; unsigned char* ws; int lo, hi; };
enum { I_X = 0, I_C, I_CTX, I_CCTX, I_ADAW, I_ADAB, I_N1G, I_WIN, I_CONVW, I_CONVB, I_WA, I_BA, I_WX, I_BX, I_LAM, I_WRNN, I_WRET, I_WOUT, I_N2G, I_RW, I_RB, I_W1, I_B1, I_W2, I_B2, I_FG };
constexpr int ST_GRP = 3, ST_M0 = 27, ST_M1 = 28, ST_RNG = 29, ST_END = 41;

__global__ void __launch_bounds__(NTHR, 2) fwd_kernel(Args args) {
    extern __shared__ __attribute__((aligned(16))) unsigned char lds_raw[];
    LAS unsigned char* lds = (LAS unsigned char*)lds_raw;
    const int tid = threadIdx.x, lane = tid & 63, wave = __builtin_amdgcn_readfirstlane(tid >> 6);
    const int G = gridDim.x, bid = blockIdx.x;
    const int gw = bid * NWAVES + wave, NGW = G * NWAVES;
    unsigned char* ws = args.ws;
    volatile LAS unsigned* MISC = (volatile LAS unsigned*)(lds + MISC_OFF);
    if (tid < 64) MISC[tid] = 0u;
    __syncthreads();
    const int lo = args.lo, hi = args.hi;
    XcdBarrier bar; bar.bar = (unsigned*)(ws + WS_CTL) + CW_BAR; bar.x = 0; bar.st = nullptr;
    if (!MK_PER_PHASE) bar = xcd_barrier_post((unsigned*)(ws + WS_CTL) + CW_BAR, MISC);
#define IN(k) (lo <= (k) && (k) < hi)
#define SEAM(k) do { if (IN(k) && IN((k) + 1)) xcd_barrier(bar); } while (0)

    float* mod = (float*)(ws + WS_MOD);
    f32x2* rope = (f32x2*)(ws + WS_ROPE);
    f32x2* carry = (f32x2*)(ws + WS_CARRY);
    bf16* WG = (bf16*)(ws + WS_WG); bf16* WRNN = (bf16*)(ws + WS_WRNN); bf16* WOUT = (bf16*)(ws + WS_WOUT); bf16* WRET = (bf16*)(ws + WS_WRET); bf16* WIN = (bf16*)(ws + WS_WIN);
    bf16* HL = (bf16*)(ws + WS_HL); bf16* ZC = (bf16*)(ws + WS_ZC); bf16* CTXU = (bf16*)(ws + WS_CTXU); bf16* Z = (bf16*)(ws + WS_Z); bf16* STB = (bf16*)(ws + WS_ST);
    bf16* T1 = (bf16*)(ws + WS_T1); bf16* MG = (bf16*)(ws + WS_MG);
    bf16* W1T = (bf16*)(ws + WS_W1T); bf16* W2T = (bf16*)(ws + WS_W2T); bf16* HPAD = (bf16*)(ws + WS_HPAD); bf16* HID = (bf16*)(ws + WS_HID); bf16* YPAD = (bf16*)(ws + WS_YPAD);
    int* EIDX = (int*)(ws + WS_EIDX); float* GATE = (float*)(ws + WS_GATE); int* LPOS = (int*)(ws + WS_LPOS); int* AROW = (int*)(ws + WS_AROW);
    int* BCNT = (int*)(ws + WS_BCNT); int* BBASE = (int*)(ws + WS_BBASE); int* TILEE = (int*)(ws + WS_TILEE); int* NTILE = (int*)(ws + WS_NTILE);

    if (PH_EN(0) && IN(0)) {
        if (bid < 96) {
            LAS float* sc = (LAS float*)lds;
            LAS float* red = (LAS float*)(lds + 40960);
            for (int i = tid; i < 9 * 1024; i += NTHR) { const int r = i >> 10, k = i & 1023; const float v = r < 8 ? args.in[I_C][r * 1024 + k] : args.in[I_CCTX][k]; sc[i] = v * sigmoidf_(v); }
            __syncthreads();
            const int n0 = bid * 64; float a9[9];
#pragma unroll
            for (int r = 0; r < 9; ++r) a9[r] = 0.f;
            for (int k = wave * 128; k < wave * 128 + 128; ++k) { const float wv = args.in[I_ADAW][(size_t)k * 6144 + n0 + lane];
#pragma unroll
                for (int r = 0; r < 9; ++r) a9[r] += sc[r * 1024 + k] * wv; }
#pragma unroll
            for (int r = 0; r < 9; ++r) red[(wave * 9 + r) * 64 + lane] = a9[r];
            __syncthreads();
            for (int i = tid; i < 9 * 64; i += NTHR) { const int r = i >> 6, l = i & 63; float s = 0.f;
#pragma unroll
                for (int w8 = 0; w8 < 8; ++w8) s += red[(w8 * 9 + r) * 64 + l];
                mod[r * 6144 + n0 + l] = s + args.in[I_ADAB][n0 + l]; }
            __syncthreads();
        }
        if (bid == 96) {
            for (int i = tid; i < 128 * 32; i += NTHR) { const int pos = i >> 5, f = i & 31; const float inv = powf(10000.0f, -(float)f / 32.0f); const float ang = (float)pos * inv; float s, c; sincosf(ang, &s, &c); rope[i] = (f32x2){c, s}; }
        }
        {
            LAS float* scr = (LAS float*)(lds + 65536 + wave * 8704);
            const int rot = (gw + 97 * NWAVES) % NGW;
            for (int it = rot; it < 5120; it += NGW) transpose_item(args.in[I_WIN], DIN, 1024, DIN, WIN, scr, it, lane);
            for (int it = rot; it < 512; it += NGW) transpose_item(args.in[I_WRNN], 1024, 1024, 1024, WRNN, scr, it, lane);
            for (int it = rot; it < 1024; it += NGW) transpose_item(args.in[I_WRET], 1024, 2048, 1024, WRET, scr, it, lane);
            for (int it = rot; it < 512; it += NGW) transpose_item(args.in[I_WOUT], 1024, 1024, 1024, WOUT, scr, it, lane);
            for (int it = rot; it < 256; it += NGW) { const int mtx = it >> 3, sub = it & 7; const int q = mtx & 3, n = mtx >> 2; const int dir = q >> 1, typ = q & 1;
                const float* src = (typ ? args.in[I_WX] : args.in[I_WA]) + (size_t)(dir * 8 + n) * 128 * 128;
                transpose_item(src, 128, 128, 128, WG + (size_t)(n * 4 + q) * 128 * 128, scr, sub, lane); }
        }
    }
    SEAM(0);
    if (PH_EN(1) && IN(1)) {
        for (int m = gw; m < NROWS_HL; m += NGW) {
            const float* src = m < NTOK ? args.in[I_X] + (size_t)m * D : args.in[I_CTX] + (size_t)(m - NTOK) * D; const int r = m < NTOK ? (m >> 13) : 8;
            const f32x4* xr = (const f32x4*)src + lane; f32x4 v[4]; float ss = 0.f;
#pragma unroll
            for (int j = 0; j < 4; ++j) { v[j] = xr[64 * j]; ss += (v[j].x * v[j].x + v[j].y * v[j].y) + (v[j].z * v[j].z + v[j].w * v[j].w); }
            const float rstd = 1.0f / sqrtf(wave_sum(ss) * (1.0f / D) + EPS);
            u32x2* o8 = (u32x2*)(HL + (size_t)m * D) + lane;
#pragma unroll
            for (int j = 0; j < 4; ++j) { const int c0 = 4 * lane + 256 * j; const f32x4 gn = *(const f32x4*)(args.in[I_N1G] + c0), sh = *(const f32x4*)(mod + r * 6144 + c0), sc = *(const f32x4*)(mod + r * 6144 + 1024 + c0);
                const f32x4 y = (v[j] * rstd * gn) * (sc + 1.0f) + sh; u32x2 w; w.x = pk2(y.x, y.y); w.y = pk2(y.z, y.w); o8[64 * j] = w; }
        }
    }
    SEAM(1);
    if (PH_EN(2) && IN(2)) {
        pg8::Gemm g{HL, WIN, D, D, D}; pg8::CtxOrder S{G, bid}; EpiCtx E{ZC};
        pg8::gemm_phase<EpiCtx, pg8::CtxOrder>(lds, g, S, E);
    }
    SEAM(2);
    for (int grp = 0; grp < NGRP; ++grp) {
        const int s0 = ST_GRP + 6 * grp;
        const int tid = opaque_tid(), lane = tid & 63, wave = __builtin_amdgcn_readfirstlane(tid >> 6), gw = bid * NWAVES + wave; (void)lane; (void)gw;
        if (PH_EN(3) && IN(s0 + 0)) {
            pg8::Gemm g{HL + (size_t)grp * GROWS * D, WIN, D, D, D}; pg8::StaticOrder S; S.init(GROWS / 256, DIN / 256, G, bid); EpiIn E{Z, rope};
            pg8::gemm_phase<EpiIn, pg8::StaticOrder>(lds, g, S, E);
        }
        SEAM(s0 + 0);
        if (PH_EN(4) && IN(s0 + 1)) {
            const int nKV = GB * 64 * 8, nKVc = grp == 0 ? NB * 2 * 8 : 0, nL = GB * 32 * 8, nLc = grp == 0 ? NB * 8 : 0;
            const int ntot = nKV + nKVc + nL + nLc;
            LruP LP{args.in[I_CONVW], args.in[I_CONVB], args.in[I_BA], args.in[I_BX], args.in[I_LAM], WG, carry};
            for (int u = bid; u < ntot; u += G) {
                if (u < nKV) { const int hd = u & 7, c = (u >> 3) & 63, bl = u >> 9; const float l2g = log1pf(-exp2f(-5.0f - (float)hd)) * 1.4426950408889634f;
                    const bf16* zr = Z + (size_t)(bl * SEQ + c * 128) * DIN;
                    kv_unit(lds, zr + C_K + hd * 128, zr + C_V + hd * 256, DIN, l2g, STB + (size_t)(((bl * 8 + hd) * 64 + c) * 2) * 32768);
                } else if (u < nKV + nKVc) { const int uu = u - nKV; const int hd = uu & 7, c = (uu >> 3) & 1, b = uu >> 4; const float l2g = log1pf(-exp2f(-5.0f - (float)hd)) * 1.4426950408889634f;
                    const bf16* zr = ZC + (size_t)(b * CTXL + c * 128) * ZC_LD;
                    kv_unit(lds, zr + ZC_K + hd * 128, zr + ZC_V + hd * 256, ZC_LD, l2g, CTXU + (size_t)(((b * 8 + hd) * 2 + c) * 2) * 32768);
                } else if (u < nKV + nKVc + nL) { const int uu = u - nKV - nKVc; const int n = uu & 7, c = (uu >> 3) & 31, bl = uu >> 8;
                    lru_unit<0>(lds, LP, grp * GB + bl, c + 1, n, Z + (size_t)(bl * SEQ) * DIN + C_XR, DIN, SEQ, nullptr);
                } else { const int uu = u - nKV - nKVc - nL; const int n = uu & 7, b = uu >> 3;
                    lru_unit<0>(lds, LP, b, 0, n, ZC + (size_t)(b * CTXL) * ZC_LD + ZC_XR, ZC_LD, CTXL, nullptr);
                }
            }
        }
        SEAM(s0 + 1);
        if (PH_EN(5) && IN(s0 + 2)) {
            for (int u = bid; u < GB * 8 * 2 * 8; u += G) {
                const int part = u & 7, dir = (u >> 3) & 1, hd = (u >> 4) & 7, bl = u >> 7; const int b = grp * GB + bl;
                const float lg = log1pf(-exp2f(-5.0f - (float)hd)); const float cdec = expf(128.0f * lg);
                const size_t eo = (size_t)part * 4096 + (size_t)tid * 8;
                float S[8];
#pragma unroll
                for (int j = 0; j < 8; ++j) S[j] = 0.f;
#pragma unroll
                for (int k = 0; k < 2; ++k) { const int c = dir == 0 ? k : 1 - k; float uv[8]; unpack8(*(const u32x4*)(CTXU + (size_t)(((b * 8 + hd) * 2 + c) * 2 + dir) * 32768 + eo), uv);
#pragma unroll
                    for (int j = 0; j < 8; ++j) S[j] = cdec * S[j] + uv[j]; }
#pragma unroll 4
                for (int k = 0; k < 64; ++k) { const int c = dir == 0 ? k : 63 - k; bf16* pp = STB + (size_t)(((bl * 8 + hd) * 64 + c) * 2 + dir) * 32768 + eo; float uv[8]; unpack8(*(const u32x4*)pp, uv);
                    u32x4 o; o.x = pk2(S[0], S[1]); o.y = pk2(S[2], S[3]); o.z = pk2(S[4], S[5]); o.w = pk2(S[6], S[7]); *(u32x4*)pp = o;
#pragma unroll
                    for (int j = 0; j < 8; ++j) S[j] = cdec * S[j] + uv[j]; }
            }
            LruP LP{args.in[I_CONVW], args.in[I_CONVB], args.in[I_BA], args.in[I_BX], args.in[I_LAM], WG, carry};
            for (int u = bid; u < GB * 32 * 8; u += G) { const int n = u & 7, c = (u >> 3) & 31, bl = u >> 8;
                lru_unit<1>(lds, LP, grp * GB + bl, c + 1, n, Z + (size_t)(bl * SEQ) * DIN + C_XR, DIN, SEQ, Z + (size_t)(bl * SEQ) * DIN); }
        }
        SEAM(s0 + 2);
        if (PH_EN(6) && IN(s0 + 3)) {
            for (int u = bid; u < GB * 64 * 8; u += G) { const int hd = u & 7, c = (u >> 3) & 63, bl = u >> 9; const float l2g = log1pf(-exp2f(-5.0f - (float)hd)) * 1.4426950408889634f;
                bf16* zr = Z + (size_t)(bl * SEQ + c * 128) * DIN; const bf16* sp = STB + (size_t)(((bl * 8 + hd) * 64 + c) * 2) * 32768;
                ro_unit(lds, zr + C_Q + hd * 128, zr + C_K + hd * 128, zr + C_V + hd * 256, zr + C_GS + hd * 256, sp, sp + 32768, l2g); }
        }
        SEAM(s0 + 3);
        if (PH_EN(7) && IN(s0 + 4)) {
            { pg8::Gemm g{Z + C_GR, WRNN, DIN, D, D}; pg8::StaticOrder S; S.init(GROWS / 256, 4, G, bid); EpiT1 E{Z, T1}; pg8::gemm_phase<EpiT1, pg8::StaticOrder>(lds, g, S, E); }
            asm volatile("s_waitcnt vmcnt(0)" ::: "memory"); __syncthreads();
            { pg8::Gemm g{Z + C_GS, WRET, DIN, 2048, 2048}; pg8::StaticOrder S; S.init(GROWS / 256, 4, G, bid); EpiMg E{Z, T1, MG}; pg8::gemm_phase<EpiMg, pg8::StaticOrder>(lds, g, S, E); }
        }
        SEAM(s0 + 4);
        if (PH_EN(8) && IN(s0 + 5)) {
            pg8::Gemm g{MG, WOUT, D, D, D}; pg8::StaticOrder S; S.init(GROWS / 256, 4, G, bid); EpiX1 E{args.in[I_X], args.out, mod, grp * GROWS};
            pg8::gemm_phase<EpiX1, pg8::StaticOrder>(lds, g, S, E);
        }
        if (grp == NGRP - 1) SEAM(s0 + 5);
    }
    if (PH_EN(9) && IN(ST_M0)) {
        {
            LAS float* scr = (LAS float*)(lds + wave * 8704);
            for (int it = gw; it < 32 * 1024; it += NGW) { const int e = it >> 10, sub = it & 1023; transpose_item(args.in[I_W1] + (size_t)e * 1024 * 2048, 2048, 1024, 2048, W1T + (size_t)e * 2048 * 1024, scr, sub, lane); }
            for (int it = gw; it < 32 * 512; it += NGW) { const int e = it >> 9, sub = it & 511; transpose_item(args.in[I_W2] + (size_t)e * 1024 * 1024, 1024, 1024, 1024, W2T + (size_t)e * 1024 * 1024, scr, sub, lane); }
        }
        __syncthreads();
        LAS float* RWT = (LAS float*)lds;
        LAS int* CNT = (LAS int*)(lds + 131072);
        for (int i = tid; i < 32 * 1024; i += NTHR) { const int d = i >> 5, e = i & 31; RWT[e * 1024 + d] = args.in[I_RW][i]; }
        for (int blk = bid; blk < NTOK / 256; blk += G) {
            __syncthreads();
            if (tid < 32) CNT[tid] = 0;
            __syncthreads();
            for (int rr = wave; rr < 256; rr += NWAVES) {
                const int m = blk * 256 + rr; const int b = m >> 13;
                const f32x4* xr = (const f32x4*)(args.out + (size_t)m * D) + lane; f32x4 v[4]; float ss = 0.f;
#pragma unroll
                for (int j = 0; j < 4; ++j) { v[j] = xr[64 * j]; ss += (v[j].x * v[j].x + v[j].y * v[j].y) + (v[j].z * v[j].z + v[j].w * v[j].w); }
                const float rstd = 1.0f / sqrtf(wave_sum(ss) * (1.0f / D) + EPS);
                u32x2* o8 = (u32x2*)(HL + (size_t)m * D) + lane;
#pragma unroll
                for (int j = 0; j < 4; ++j) { const int c0 = 4 * lane + 256 * j; const f32x4 gn = *(const f32x4*)(args.in[I_N2G] + c0), sh = *(const f32x4*)(mod + b * 6144 + 3072 + c0), sc = *(const f32x4*)(mod + b * 6144 + 4096 + c0);
                    v[j] = (v[j] * rstd * gn) * (sc + 1.0f) + sh; u32x2 w; w.x = pk2(v[j].x, v[j].y); w.y = pk2(v[j].z, v[j].w); o8[64 * j] = w; }
                float mylogit = -3.0e38f;
                for (int e = 0; e < 32; ++e) { float pe = 0.f;
#pragma unroll
                    for (int j = 0; j < 4; ++j) { const f32x4 wv = *(const LAS f32x4*)(RWT + e * 1024 + 4 * lane + 256 * j); pe += (v[j].x * wv.x + v[j].y * wv.y) + (v[j].z * wv.z + v[j].w * wv.w); }
                    pe = wave_sum(pe); if (lane == e) mylogit = pe + args.in[I_RB][e]; }
                float tv[4]; int ti[4]; float cur = mylogit;
#pragma unroll
                for (int k = 0; k < 4; ++k) { float mx = cur;
#pragma unroll
                    for (int o = 1; o < 64; o <<= 1) mx = fmaxf(mx, __shfl_xor(mx, o));
                    const unsigned long long msk = __ballot(cur == mx && lane < 32); const int sel = __ffsll((long long)msk) - 1; tv[k] = mx; ti[k] = sel; if (lane == sel) cur = -3.0e38f; }
                const float e1 = __expf(tv[1] - tv[0]), e2 = __expf(tv[2] - tv[0]), e3 = __expf(tv[3] - tv[0]); const float inv = 1.0f / (1.0f + e1 + e2 + e3);
                if (lane < 4) { const int k = lane; const int ee = k == 0 ? ti[0] : k == 1 ? ti[1] : k == 2 ? ti[2] : ti[3]; const float gg = (k == 0 ? 1.0f : k == 1 ? e1 : k == 2 ? e2 : e3) * inv;
                    const int lp = __hip_atomic_fetch_add(&CNT[ee], 1, __ATOMIC_RELAXED, __HIP_MEMORY_SCOPE_WORKGROUP);
                    EIDX[m * 4 + k] = ee; GATE[m * 4 + k] = gg; LPOS[m * 4 + k] = lp; }
            }
            __syncthreads();
            if (tid < 32) BCNT[blk * 32 + tid] = CNT[tid];
        }
    }
    SEAM(ST_M0);
#define MOE_TABLES() do { \
        LAS int* TB = (LAS int*)lds;                   \
        LAS int* EB = (LAS int*)(lds + 32768);         \
        __syncthreads(); \
        if (tid < 128) { const int r = tid >> 5, e = tid & 31; int run = 0; _Pragma("unroll 1") for (int wb = 0; wb < 64; ++wb) { TB[(r * 64 + wb) * 32 + e] = run; run += BCNT[(r * 64 + wb) * 32 + e]; } EB[128 + tid] = run; } \
        __syncthreads(); \
        if (tid < 4) { int run = 0; _Pragma("unroll 1") for (int e = 0; e < 32; ++e) { EB[tid * 32 + e] = run; run += (EB[128 + tid * 32 + e] + 255) & ~255; } EB[256 + tid] = run >> 8; } \
        __syncthreads(); \
        for (int i = tid; i < 4 * 64 * 32; i += NTHR) { const int r = i >> 11, e = i & 31; TB[i] += EB[r * 32 + e]; } \
        __syncthreads(); } while (0)
#define MOE_SCATTER(r) do { \
        LAS int* TB = (LAS int*)lds; LAS int* EB = (LAS int*)(lds + 32768); \
        for (int m = (r) * RTOK + gw; m < ((r) + 1) * RTOK; m += NGW) { const int wb = (m - (r) * RTOK) >> 8; \
            const u32x4* src = (const u32x4*)(HL + (size_t)m * D); const u32x4 a0 = src[lane], a1 = src[64 + lane]; \
            _Pragma("unroll") for (int k = 0; k < 4; ++k) { const int e = EIDX[m * 4 + k]; const int row = TB[((r) * 64 + wb) * 32 + e] + LPOS[m * 4 + k]; \
                u32x4* dst = (u32x4*)(HPAD + (size_t)row * D); dst[lane] = a0; dst[64 + lane] = a1; if (lane == 0) AROW[m * 4 + k] = row; } } \
        for (int e = bid; e < 32; e += G) { const int tot = EB[128 + (r) * 32 + e], base = EB[(r) * 32 + e]; const int npad = ((tot + 255) & ~255) - tot; \
            for (int i = tid; i < npad * 128; i += NTHR) ((u32x4*)(HPAD + (size_t)(base + tot) * D))[i] = (u32x4){0u, 0u, 0u, 0u}; } } while (0)
    if (PH_EN(10) && IN(ST_M1)) {
        const int tid = opaque_tid(), lane = tid & 63, wave = __builtin_amdgcn_readfirstlane(tid >> 6), gw = bid * NWAVES + wave;
        MOE_TABLES();
        if (bid == 0) {
            LAS int* TB = (LAS int*)lds; LAS int* EB = (LAS int*)(lds + 32768);
            for (int i = tid; i < 4 * 64 * 32; i += NTHR) BBASE[i] = TB[i];
            if (tid < 4) NTILE[tid] = EB[256 + tid];
            for (int i = tid; i < 4 * 32; i += NTHR) { const int r = i >> 5, e = i & 31; const int base = EB[r * 32 + e], nt = (EB[128 + i] + 255) >> 8; for (int t = 0; t < nt; ++t) TILEE[r * 320 + (base >> 8) + t] = e; }
        }
        MOE_SCATTER(0);
    }
    SEAM(ST_M1);
    for (int r = 0; r < NRANGE; ++r) {
        const int s0 = ST_RNG + 3 * r;
        const int tid = opaque_tid(), lane = tid & 63, wave = __builtin_amdgcn_readfirstlane(tid >> 6), gw = bid * NWAVES + wave; (void)lane; (void)gw;
        if (PH_EN(11) && IN(s0 + 0)) {
            pg8::Gemm g{HPAD, W1T, D, D, D}; pg8::MoeOrder S{TILEE + r * 320, NTILE[r], 8, G, bid}; EpiHid E{HID, args.in[I_B1]};
            pg8::gemm_phase<EpiHid, pg8::MoeOrder>(lds, g, S, E);
        }
        SEAM(s0 + 0);
        if (PH_EN(12) && IN(s0 + 1)) {
            pg8::Gemm g{HID, W2T, DEXP, DEXP, DEXP}; pg8::MoeOrder S{TILEE + r * 320, NTILE[r], 4, G, bid}; EpiY E{YPAD, args.in[I_B2]};
            pg8::gemm_phase<EpiY, pg8::MoeOrder>(lds, g, S, E);
        }
        SEAM(s0 + 1);
        if (PH_EN(13) && IN(s0 + 2)) {
            for (int m = r * RTOK + gw; m < (r + 1) * RTOK; m += NGW) {
                const int b = m >> 13; f32x4 v[4]; f32x4 y[4];
#pragma unroll
                for (int j = 0; j < 4; ++j) { v[j] = ((const f32x4*)(args.out + (size_t)m * D) + lane)[64 * j]; y[j] = (f32x4){0.f, 0.f, 0.f, 0.f}; }
#pragma unroll
                for (int k = 0; k < 4; ++k) { const int row = AROW[m * 4 + k]; const float gk = GATE[m * 4 + k]; const u32x2* yp = (const u32x2*)(YPAD + (size_t)row * D) + lane;
#pragma unroll
                    for (int j = 0; j < 4; ++j) { const u32x2 w = yp[64 * j]; y[j].x += gk * bflo(w.x); y[j].y += gk * bfhi(w.x); y[j].z += gk * bflo(w.y); y[j].w += gk * bfhi(w.y); } }
                float ss = 0.f;
#pragma unroll
                for (int j = 0; j < 4; ++j) { const f32x4 g2 = *(const f32x4*)(mod + b * 6144 + 5120 + 4 * lane + 256 * j); v[j] = v[j] + g2 * y[j]; ss += (v[j].x * v[j].x + v[j].y * v[j].y) + (v[j].z * v[j].z + v[j].w * v[j].w); }
                const float rstd = 1.0f / sqrtf(wave_sum(ss) * (1.0f / D) + EPS);
#pragma unroll
                for (int j = 0; j < 4; ++j) { const f32x4 fg = *(const f32x4*)(args.in[I_FG] + 4 * lane + 256 * j); ((f32x4*)(args.out + (size_t)m * D) + lane)[64 * j] = v[j] * rstd * fg; }
            }
            if (r + 1 < NRANGE) { MOE_TABLES(); MOE_SCATTER(r + 1); }
        }
        if (r + 1 < NRANGE) SEAM(s0 + 2);
    }
#undef IN
#undef SEAM
}

extern "C" void kernel_launch(void* const* d_in, const int* in_sizes, int n_in, void* d_out, int out_size, void* d_ws, size_t ws_size, hipStream_t stream) {
    static int grid = 0;
    if (grid == 0) {
        if (n_in != 26 || in_sizes[0] != NTOK * D || out_size != NTOK * D || ws_size < WS_END) { fprintf(stderr, "kernel_launch: unexpected shapes (n_in %d, in0 %d, out %d, ws %zu); nothing launched\n", n_in, n_in > 0 ? in_sizes[0] : -1, out_size, ws_size); grid = -1; return; }
        int dev = 0, cus = 0, per_cu = 0;
        if (hipGetDevice(&dev) != hipSuccess || hipDeviceGetAttribute(&cus, hipDeviceAttributeMultiprocessorCount, dev) != hipSuccess) { grid = -1; return; }
        if (hipFuncSetAttribute((const void*)fwd_kernel, hipFuncAttributeMaxDynamicSharedMemorySize, LDS_BYTES) != hipSuccess) { fprintf(stderr, "kernel_launch: hipFuncSetAttribute failed\n"); grid = -1; return; }
        if (hipOccupancyMaxActiveBlocksPerMultiprocessor(&per_cu, (const void*)fwd_kernel, NTHR, LDS_BYTES) != hipSuccess || per_cu < 1) fprintf(stderr, "kernel_launch: occupancy query reports %d\n", per_cu);
        (void)hipGetLastError();
        grid = cus;
    }
    if (grid < 0) return;
    if (hipMemsetAsync((char*)d_ws + WS_CTL, 0, CTL_ZERO_BYTES, stream) != hipSuccess) return;
    Args a{};
    for (int i = 0; i < 26; ++i) a.in[i] = (const float*)d_in[i];
    a.out = (float*)d_out; a.ws = (unsigned char*)d_ws;
#if MK_PER_PHASE
    for (int s = 0; s < ST_END; ++s) { a.lo = s; a.hi = s + 1; hipLaunchKernelGGL(fwd_kernel, dim3(grid), dim3(NTHR), LDS_BYTES, stream, a); }
#else
    a.lo = 0; a.hi = ST_END;
    hipLaunchKernelGGL(fwd_kernel, dim3(grid), dim3(NTHR), LDS_BYTES, stream, a);
#endif
    const hipError_t le = hipPeekAtLastError();
    if (le != hipSuccess) fprintf(stderr, "kernel_launch: launch failed: %s\n", hipGetErrorName(le));
}
```

```cpp
#include <hip/hip_runtime.h>
#include <cstdio>
#include <cstdint>

#ifndef MK_PER_PHASE
#define MK_PER_PHASE 0
#endif

#ifndef MK_PROBE
#define MK_PROBE 0
#endif
#ifndef PROBE_SEL1
#define PROBE_SEL1 3
#endif
#ifndef PROBE_SEL2
#define PROBE_SEL2 4
#endif
#ifndef MK_DUP
#define MK_DUP 0u
#endif
#define DUP_N(k) ((((MK_DUP) >> (k)) & 1u) ? 2 : 1)
#define DRY(k) ((((MK_DUP) >> (k)) & 1u) && rep == 0)
#ifndef MK_DRYMODE
#define MK_DRYMODE 0
#endif
#ifndef STAG_B
#define STAG_B 0
#endif
#ifndef STAG_M2
#define STAG_M2 0
#endif
#ifndef STAG_M3
#define STAG_M3 0
#endif
#define STAGGER(n) do { const int slot_ = (bid >> 3) & 3; for (int i_ = 0; i_ < slot_ * (n); ++i_) __builtin_amdgcn_s_sleep(127); } while (0)
#ifndef MK_PHASES
#define MK_PHASES 0xFFFFu
#endif
#define PH_EN(k) (((MK_PHASES) >> (k)) & 1u)
#define LAS __attribute__((address_space(3)))
#define GAS __attribute__((address_space(1)))
typedef unsigned short bf16;
typedef short bf16x8 __attribute__((ext_vector_type(8)));
typedef short s16x4 __attribute__((ext_vector_type(4)));
typedef float f32x2 __attribute__((ext_vector_type(2)));
typedef float f32x4 __attribute__((ext_vector_type(4)));
typedef float f32x16 __attribute__((ext_vector_type(16)));
typedef unsigned u32x2 __attribute__((ext_vector_type(2)));
typedef unsigned u32x4 __attribute__((ext_vector_type(4)));

constexpr int D = 1024, NB = 8, SEQ = 8192, NTOK = NB * SEQ, CTXL = 256, NCTX = NB * CTXL, DIN = 10240, ZLD = 10240 + 128;
constexpr int NROWS_HL = NTOK + NCTX;
constexpr int GB = 2, NGRP = NB / GB, GROWS = GB * SEQ;
constexpr int NEXP = 32, TOPK = 4, DEXP = 1024;
constexpr int NRANGE = 1, RTOK = NTOK / NRANGE, WBR = RTOK / 256;
constexpr int RROWS = 4 * RTOK + 32 * 256, RTILES = RROWS / 256, TILE_LD = RTILES + 32;
constexpr float EPS = 1e-6f;
constexpr float K_SCALE = 0.08838834764831845f;
constexpr int C_XR = 0, C_GR = 1024, C_Q = 2048, C_K = 3072, C_V = 4096, C_GS = 6144, C_GA = 8192, C_GB = 9216;
constexpr int ZC_LD = 4096, ZC_XR = 0, ZC_K = 1024, ZC_V = 2048;

constexpr size_t MiB = 1u << 20;
constexpr size_t WS_CTL = 0, CTL_ZERO_BYTES = 1 * MiB;
constexpr size_t WS_MOD = 1 * MiB;
constexpr size_t WS_ROPE = 1 * MiB + 256 * 1024;
constexpr size_t WS_RWB = 1 * MiB + 512 * 1024;
constexpr size_t WS_CARRY = 2 * MiB;
constexpr size_t WS_HLS = 7 * MiB;
constexpr size_t WS_WINS = 7 * MiB + 320 * 1024;
constexpr size_t WS_W1S = 7 * MiB + 384 * 1024;
constexpr size_t WS_HPS = 880 * MiB;
constexpr size_t WS_WFS = 7 * MiB + 640 * 1024;
constexpr size_t WS_EIDX = 8 * MiB, WS_GATE = 9 * MiB, WS_LPOS = 10 * MiB, WS_AROW = 11 * MiB;
constexpr size_t WS_BCNT = 12 * MiB;
constexpr size_t WS_BBASE = 12 * MiB + 64 * 1024;
constexpr size_t WS_TILEE = 12 * MiB + 128 * 1024;
constexpr size_t WS_NTILE = 12 * MiB + 192 * 1024;
constexpr size_t WS_WG = 14 * MiB;
constexpr size_t WS_WRNN = 16 * MiB, WS_WOUT = 22 * MiB, WS_WIN = 24 * MiB;
constexpr size_t WS_HL = 44 * MiB;
constexpr size_t WS_ZC = 176 * MiB;
constexpr size_t WS_CTXU = 192 * MiB;
constexpr size_t WS_Z = 208 * MiB;
constexpr size_t WS_ST = 536 * MiB;
constexpr size_t WS_T1 = 664 * MiB, WS_MG = 696 * MiB;
constexpr size_t WS_W1T = 736 * MiB;
constexpr size_t WS_W2T = 848 * MiB;
constexpr size_t WS_HPAD = 208 * MiB, WS_HID = 210 * MiB, WS_YPAD = 474 * MiB;
constexpr size_t WS_AR = 912 * MiB, WS_AT = 944 * MiB;
constexpr size_t WS_DUMMY = 912 * MiB;
constexpr size_t WS_END = 1024 * MiB;
constexpr int CW_BAR = 4096;

constexpr int LDS_BYTES = 147456;
constexpr int MISC_OFF = 147456 - 256;
constexpr int NWAVES = 8, NTHR = 512;

__device__ __forceinline__ unsigned f2bf(float f) { unsigned u = __builtin_bit_cast(unsigned, f); return (u + 0x7fffu + ((u >> 16) & 1u)) >> 16; }
typedef __bf16 hwbf16x2 __attribute__((ext_vector_type(2)));
__device__ __forceinline__ unsigned pk2(float lo, float hi) { const f32x2 v = {lo, hi}; return __builtin_bit_cast(unsigned, __builtin_convertvector(v, hwbf16x2)); }
__device__ __forceinline__ float bflo(unsigned w) { return __builtin_bit_cast(float, w << 16); }
__device__ __forceinline__ float bfhi(unsigned w) { return __builtin_bit_cast(float, w & 0xffff0000u); }
__device__ __forceinline__ float bf2f(unsigned short h) { return __builtin_bit_cast(float, ((unsigned)h) << 16); }
__device__ __forceinline__ float sigmoidf_(float x) { return __builtin_amdgcn_rcpf(1.0f + __expf(-x)); }
__device__ __forceinline__ float wave_sum(float v) {
#pragma unroll
    for (int o = 1; o < 64; o <<= 1) v += __shfl_xor(v, o);
    return v;
}
template <int CTRL> __device__ __forceinline__ float dpp_f(float v) { return __builtin_bit_cast(float, __builtin_amdgcn_update_dpp(0, __builtin_bit_cast(int, v), CTRL, 0xF, 0xF, true)); }
__device__ __forceinline__ float row16_sum(float v) { v += dpp_f<0xB1>(v); v += dpp_f<0x4E>(v); v += dpp_f<0x141>(v); v += dpp_f<0x140>(v); return v; }
__device__ __forceinline__ float wave_max(float v) {
#pragma unroll
    for (int o = 1; o < 64; o <<= 1) v = fmaxf(v, __shfl_xor(v, o));
    return v;
}
__device__ __forceinline__ unsigned q8x4(f32x4 v, float inv) {
    const int a = (int)rintf(v.x * inv), b = (int)rintf(v.y * inv), c = (int)rintf(v.z * inv), d = (int)rintf(v.w * inv);
    return ((unsigned)a & 0xffu) | (((unsigned)b & 0xffu) << 8) | (((unsigned)c & 0xffu) << 16) | (((unsigned)d & 0xffu) << 24);
}
#define LDS_WAIT() asm volatile("s_waitcnt lgkmcnt(0)" ::: "memory")
__device__ __forceinline__ int opaque_tid() { int t = threadIdx.x; asm volatile("" : "+v"(t)); return t; }
template <class T> __device__ __forceinline__ T* opaque_ptr(T* p) { unsigned long long u = (unsigned long long)p; asm volatile("" : "+s"(u)); return (T*)u; }

namespace pg8 {
constexpr int BM = 256, BK = 64, HALF = 128, HTB = HALF * BK * 2, STAGE_BYTES = 8 * HTB, NXCD = 8, WGM = 8;
__host__ __device__ __forceinline__ int lds_byte(int r, int c) { const int st = (r >> 4) * 2 + (c >> 5), rr = r & 15, cc = c & 31, ob = rr * 64 + cc * 2; return st * 1024 + (ob ^ (((ob >> 9) & 1) << 5)); }
__host__ __device__ __forceinline__ void stage_rc(int b, int& R, int& C) { const int st = b / 1024, sb = b % 1024, swz = sb ^ (((sb >> 9) & 1) << 5); R = (st >> 1) * 16 + swz / 64; C = (st & 1) * 32 + (swz % 64) / 2; }
__host__ __device__ __forceinline__ int perm32(int rho) { const int n = rho >> 4, i = rho & 15; return 8 * (i >> 2) + 4 * n + (i & 3); }
struct Unit { int pm, pn; int koff = 0, nt = 0; };
struct Gemm { const bf16* A; const bf16* Bt; int lda, ldb, K; const float* SA; const float* SB; const int* RT; };
struct StaticOrder {
    int nM, nN, nwg, G, c;
    __device__ void init(int nM_, int nN_, int G_, int c_) { nM = nM_; nN = nN_; nwg = nM * nN; G = G_; c = c_; }
    __device__ bool next(int i, Unit& u) const {
        const long L = (long)i * G + c; if (L >= nwg) return false;
        int wgid = (int)L; { const int q = nwg / NXCD, r = nwg % NXCD, xcd = wgid % NXCD, off = wgid / NXCD; wgid = (xcd < r ? xcd * (q + 1) : r * (q + 1) + (xcd - r) * q) + off; }
        const int nig = WGM * nN, gid = wgid / nig, fm = gid * WGM, gsz = (nM - fm) < WGM ? (nM - fm) : WGM;
        u.pm = fm + ((wgid % nig) % gsz); u.pn = (wgid % nig) / gsz; return true;
    }
};
struct CtxOrder {
    int G, c;
    __device__ bool next(int i, Unit& u) const { const int L = i * G + c; if (L >= 128) return false; const int j = L >> 3; u.pm = 256 + (L & 7); u.pn = j < 4 ? j : j + 8; return true; }
};
struct FOrder {
    StaticOrder so;
    __device__ bool next(int i, Unit& u) const { Unit t; if (!so.next(i >> 1, t)) return false; u.pm = t.pm; u.pn = t.pn; u.koff = (i & 1) ? 1024 : 0; u.nt = (i & 1) ? 32 : 16; return true; }
};
struct MoeOrder {
    const int* tile_e; int ntiles, npn, G, c;
    __device__ bool next(int i, Unit& u) const {
        if ((G & 7) == 0 && ((G >> 3) % npn) == 0) { const int x = c & 7, y = c >> 3, T = (G >> 3) / npn; const int ti = (i * 8 + x) * T + y / npn, pl = y % npn;
            if (ti >= ntiles) return false; u.pm = ti; u.pn = tile_e[ti] * npn + pl; return true; }
        const long L = (long)i * G + c; if (L >= (long)ntiles * npn) return false; const int ti = (int)(L / npn), pl = (int)(L % npn);
        u.pm = ti; u.pn = tile_e[ti] * npn + pl; return true; }
};

typedef int i32x4 __attribute__((ext_vector_type(4)));
typedef int i32x8 __attribute__((ext_vector_type(8)));
template <int MODE> struct Frag { bf16x8 v[2]; };
template <> struct Frag<2> { i32x8 w; };
template <class Epi, class Sched, int MODE = 0, bool GATHER = false>
__device__ __forceinline__ void gemm_phase(LAS unsigned char* lds, const Gemm g, const Sched& S, const Epi& E) {
    const int tid = opaque_tid(), wid = __builtin_amdgcn_readfirstlane(tid >> 6), lane = tid & 63, wr = wid >> 2, wc = wid & 3, fr = lane & 15, fq = lane >> 4;
    const int K = g.K, nt = K / BK;
    const bf16* gA = opaque_ptr(g.A); const bf16* gBt = opaque_ptr(g.Bt);
    unsigned voffA[2], voffB[2]; int RA[2]; unsigned CA[2];
#pragma unroll
    for (int i = 0; i < 2; ++i) { int R, C; stage_rc(tid * 16 + i * 8192, R, C); const int Rb = 64 * (R >> 5) + (Epi::PERM ? perm32(R & 31) : (R & 31));
        voffA[i] = (unsigned)(R * g.lda + C) * 2u; voffB[i] = (unsigned)(Rb * g.ldb + C) * 2u; RA[i] = R; CA[i] = (unsigned)C * 2u; }
    (void)RA; (void)CA;
    const size_t kstep = (size_t)(BK * 2);
    const size_t hstepA = GATHER ? (size_t)0 : (size_t)HALF * g.lda * 2, hstepB = (size_t)32 * g.ldb * 2;
    unsigned vC[2][2], vN[2][2];
    auto gather_offs = [&](int pm, unsigned (&v)[2][2]) {
#pragma unroll
        for (int hh = 0; hh < 2; ++hh)
#pragma unroll
            for (int i = 0; i < 2; ++i) { int tok = g.RT[pm * 256 + hh * 128 + RA[i]]; tok = tok < 0 ? 0 : tok; v[hh][i] = (unsigned)tok * (unsigned)(g.lda * 2) + CA[i]; } };
    const size_t tstepA = (size_t)BM * g.lda * 2, tstepB = (size_t)BM * g.ldb * 2;
    const unsigned ldsw = (unsigned)wid * 1024u;
    const int aoff = lds_byte(wr * 64 + fr, fq * 8), boff = lds_byte(wc * 32 + fr, fq * 8);
#define PG8_SA(b, h) (((b) * 2 + (h)) * HTB)
#define PG8_SB(b, h) ((4 + (b) * 2 + (h)) * HTB)
#define PG8_STAGE(bufoff, gbase, voff) do { _Pragma("unroll") for (int _i = 0; _i < 2; ++_i) \
        __builtin_amdgcn_global_load_lds((const unsigned*)((const char*)(gbase) + (voff)[_i]), (LAS unsigned*)(lds + (bufoff) + ldsw + _i * 8192), 16, 0, 0); } while (0)
#define PG8_STAGE_A(bufoff, gbase, hh, nx) do { if constexpr (GATHER) { _Pragma("unroll") for (int _i = 0; _i < 2; ++_i) { const unsigned _o = (nx) ? vN[hh][_i] : vC[hh][_i]; \
        __builtin_amdgcn_global_load_lds((const unsigned*)((const char*)(gbase) + _o), (LAS unsigned*)(lds + (bufoff) + ldsw + _i * 8192), 16, 0, 0); } } else PG8_STAGE(bufoff, gbase, voffA); } while (0)
#define PG8_LD1(dst, p) do { if constexpr (MODE == 2) (dst).w = __builtin_shufflevector(*(const LAS i32x4*)(p), *(const LAS i32x4*)((p) + 1024), 0, 1, 2, 3, 4, 5, 6, 7); \
        else { (dst).v[0] = *(const LAS bf16x8*)(p); (dst).v[1] = *(const LAS bf16x8*)((p) + 1024); } } while (0)
#define PG8_LDA(dst, b, h) do { _Pragma("unroll") for (int m = 0; m < 4; ++m) PG8_LD1(dst[m], lds + PG8_SA(b, h) + aoff + m * 2048); } while (0)
#define PG8_LDB(dst, b, h) do { _Pragma("unroll") for (int n = 0; n < 2; ++n) PG8_LD1(dst[n], lds + PG8_SB(b, h) + boff + n * 2048); } while (0)
#define PG8_MMA(ai, bj, At, Bt) do { __builtin_amdgcn_s_setprio(1); _Pragma("unroll") for (int m = 0; m < 4; ++m) _Pragma("unroll") for (int n = 0; n < 2; ++n) { \
        if constexpr (MODE == 2) {   \
              \
            asm volatile("v_mfma_scale_f32_16x16x128_f8f6f4 %0, %1, %2, %0, %3, %3 op_sel_hi:[0,0,0]" : "+v"(acc[ai][bj][m][n]) : "v"(Bt[n].w), "v"(At[m].w), "v"(sc1)); \
        } else { _Pragma("unroll") for (int k = 0; k < 2; ++k) \
        { if constexpr (MODE == 1) acc[ai][bj][m][n] = __builtin_bit_cast(f32x4, __builtin_amdgcn_mfma_i32_16x16x64_i8(__builtin_bit_cast(i32x4, Bt[n].v[k]), __builtin_bit_cast(i32x4, At[m].v[k]), __builtin_bit_cast(i32x4, acc[ai][bj][m][n]), 0, 0, 0)); \
          else acc[ai][bj][m][n] = __builtin_amdgcn_mfma_f32_16x16x32_bf16(Bt[n].v[k], At[m].v[k], acc[ai][bj][m][n], 0, 0, 0); } } } __builtin_amdgcn_s_setprio(0); } while (0)
#define PG8_WAIT_V(n) asm volatile("s_waitcnt vmcnt(" #n ")" ::: "memory")
#define PG8_WAIT_L(n) asm volatile("s_waitcnt lgkmcnt(" #n ")" ::: "memory")
#define PG8_BAR __builtin_amdgcn_s_barrier()
#define PG8_SCHED __builtin_amdgcn_sched_barrier(0)
    Unit cur, nxt; int ui = 0;
    if (!S.next(0, cur)) return;
    constexpr int SC_OFF = 8 * HTB;
    auto stage_scales = [&](const Unit& u, int par) {
        if constexpr (MODE != 0) { if (MODE == 1 || wid >= 4) { const float* sp = wid < 4 ? g.SA + u.pm * 256 + tid : g.SB + u.pn * 256 + (tid - 256);
            __builtin_amdgcn_global_load_lds((const unsigned*)sp, (LAS unsigned*)(lds + SC_OFF + par * 2048 + wid * 256), 4, 0, 0); } } };
    stage_scales(cur, 0);
    f32x4 acc[2][2][4][2];
#pragma unroll
    for (int a = 0; a < 2; ++a)
#pragma unroll
        for (int b = 0; b < 2; ++b)
#pragma unroll
            for (int m = 0; m < 4; ++m)
#pragma unroll
                for (int n = 0; n < 2; ++n) acc[a][b][m][n] = (f32x4){0.f, 0.f, 0.f, 0.f};
    Frag<MODE> At[4], B0[2], B1[2]; const int sc1 = 0x7f7f7f7f; (void)sc1;
    const char* cA = GATHER ? (const char*)gA : (const char*)gA + (size_t)cur.pm * tstepA + (size_t)cur.koff * 2; const char* cB = (const char*)gBt + (size_t)cur.pn * tstepB + (size_t)cur.koff * 2;
    if constexpr (GATHER) gather_offs(cur.pm, vC);
    PG8_STAGE(PG8_SB(0, 0), cB, voffB); PG8_STAGE(PG8_SB(0, 1), cB + hstepB, voffB); PG8_STAGE_A(PG8_SA(0, 0), cA, 0, false); PG8_STAGE_A(PG8_SA(0, 1), cA + hstepA, 1, false);
    if (wr == 1) PG8_BAR;
    PG8_WAIT_V(2); PG8_BAR;
    PG8_STAGE(PG8_SB(1, 0), cB + kstep, voffB); PG8_STAGE_A(PG8_SA(1, 0), cA + kstep, 0, false); PG8_STAGE(PG8_SB(1, 1), cB + hstepB + kstep, voffB);
    PG8_WAIT_V(6); PG8_BAR;
    for (;;) {
        const bool has_next = S.next(ui + 1, nxt);
        const char* nA = (has_next && !GATHER) ? (const char*)gA + (size_t)nxt.pm * tstepA + (size_t)nxt.koff * 2 : cA; const char* nB = has_next ? (const char*)gBt + (size_t)nxt.pn * tstepB + (size_t)nxt.koff * 2 : cB;
        const int ntc = cur.nt ? cur.nt : nt;
        if constexpr (GATHER) { if (has_next) gather_offs(nxt.pm, vN); else {
#pragma unroll
            for (int hh = 0; hh < 2; ++hh)
#pragma unroll
                for (int i = 0; i < 2; ++i) vN[hh][i] = vC[hh][i]; } }
#pragma unroll 1
        for (int t = 0; t < ntc; t += 2) {
            const bool last = (t == ntc - 2);
            const char* a1 = cA + (size_t)(t + 1) * kstep;
            const char* a2 = last ? nA : cA + (size_t)(t + 2) * kstep; const char* b2 = last ? nB : cB + (size_t)(t + 2) * kstep;
            const char* a3 = a2 + kstep; const char* b3 = b2 + kstep;
            PG8_LDB(B0, 0, 0); PG8_LDB(B1, 0, 1); PG8_SCHED; PG8_LDA(At, 0, 0); PG8_STAGE_A(PG8_SA(1, 1), a1 + hstepA, 1, false);
            PG8_WAIT_V(8); PG8_WAIT_L(0); PG8_BAR; PG8_MMA(0, 0, At, B0); PG8_MMA(0, 1, At, B1); PG8_SCHED; PG8_BAR; PG8_SCHED;
            PG8_LDA(At, 0, 1); PG8_STAGE(PG8_SB(0, 0), b2, voffB); PG8_STAGE(PG8_SB(0, 1), b2 + hstepB, voffB); PG8_STAGE_A(PG8_SA(0, 0), a2, 0, last);
            PG8_WAIT_V(8); PG8_WAIT_L(0); PG8_BAR; PG8_MMA(1, 0, At, B0); PG8_MMA(1, 1, At, B1); PG8_SCHED; PG8_BAR; PG8_SCHED;
            PG8_LDB(B0, 1, 0); PG8_LDB(B1, 1, 1); PG8_SCHED; PG8_LDA(At, 1, 0); PG8_STAGE_A(PG8_SA(0, 1), a2 + hstepA, 1, last);
            PG8_WAIT_V(8); PG8_WAIT_L(0); PG8_BAR; PG8_MMA(0, 0, At, B0); PG8_MMA(0, 1, At, B1); PG8_SCHED; PG8_BAR; PG8_SCHED;
            PG8_LDA(At, 1, 1); PG8_STAGE(PG8_SB(1, 0), b3, voffB); PG8_STAGE(PG8_SB(1, 1), b3 + hstepB, voffB); PG8_STAGE_A(PG8_SA(1, 0), a3, 0, last);
            PG8_WAIT_V(8); PG8_WAIT_L(0); PG8_BAR; PG8_MMA(1, 0, At, B0); PG8_MMA(1, 1, At, B1); PG8_SCHED; PG8_BAR; PG8_SCHED;
        }
        if (wr == 0) PG8_BAR;
        if constexpr (MODE == 2) {
            int fq_ = fq; asm volatile("" : "+v"(fq_));
            const LAS float* sb = (const LAS float*)(lds + SC_OFF + (ui & 1) * 2048) + 256 + wc * 64 + (Epi::PERM ? 8 : 4) * fq_;
            f32x4 cs[2][2];
#pragma unroll
            for (int b = 0; b < 2; ++b)
#pragma unroll
                for (int n = 0; n < 2; ++n) cs[b][n] = *(const LAS f32x4*)(sb + b * 32 + (Epi::PERM ? 4 : 16) * n);
#pragma unroll
            for (int a = 0; a < 2; ++a)
#pragma unroll
                for (int b = 0; b < 2; ++b)
#pragma unroll
                    for (int m = 0; m < 4; ++m)
#pragma unroll
                        for (int n = 0; n < 2; ++n) acc[a][b][m][n] *= cs[b][n];
        }
        if constexpr (MODE == 1) {
            static_assert(Epi::PERM, "int8 path is written for the PERM layout");
            int fr_ = fr, fq_ = fq; asm volatile("" : "+v"(fr_), "+v"(fq_));
            const LAS float* sa = (const LAS float*)(lds + SC_OFF + (ui & 1) * 2048) + wr * 64 + fr_; const LAS float* sb = (const LAS float*)(lds + SC_OFF + (ui & 1) * 2048) + 256 + wc * 64 + 8 * fq_;
            float rs[2][4]; f32x4 cs[2][2];
#pragma unroll
            for (int a = 0; a < 2; ++a)
#pragma unroll
                for (int m = 0; m < 4; ++m) rs[a][m] = sa[a * 128 + m * 16];
#pragma unroll
            for (int b = 0; b < 2; ++b)
#pragma unroll
                for (int n = 0; n < 2; ++n) cs[b][n] = *(const LAS f32x4*)(sb + b * 32 + 4 * n);
#pragma unroll
            for (int a = 0; a < 2; ++a)
#pragma unroll
                for (int b = 0; b < 2; ++b)
#pragma unroll
                    for (int m = 0; m < 4; ++m)
#pragma unroll
                        for (int n = 0; n < 2; ++n) { const i32x4 iv = __builtin_bit_cast(i32x4, acc[a][b][m][n]); acc[a][b][m][n] = __builtin_convertvector(iv, f32x4) * cs[b][n] * rs[a][m]; }
        }
        bool keep = false;
        { int fr_ = fr, fq_ = fq; asm volatile("" : "+v"(fr_), "+v"(fq_));
          if constexpr (Epi::MID) { if (E.is_mid(cur)) { E.mid(acc, cur, wr, wc, fr_, fq_); keep = true; } else E(acc, cur, wr, wc, fr_, fq_); } else E(acc, cur, wr, wc, fr_, fq_); }
        if (!has_next) break;
        if (!keep) {
#pragma unroll
        for (int a = 0; a < 2; ++a)
#pragma unroll
            for (int b = 0; b < 2; ++b)
#pragma unroll
                for (int m = 0; m < 4; ++m)
#pragma unroll
                    for (int n = 0; n < 2; ++n) acc[a][b][m][n] = (f32x4){0.f, 0.f, 0.f, 0.f}; }
        cur = nxt; cA = nA; cB = nB; ++ui;
        stage_scales(cur, ui & 1);
        if constexpr (GATHER) {
#pragma unroll
            for (int hh = 0; hh < 2; ++hh)
#pragma unroll
                for (int i = 0; i < 2; ++i) vC[hh][i] = vN[hh][i]; }
        if (wr == 1) PG8_BAR;
    }
    PG8_WAIT_V(0);
    PG8_BAR;
#undef PG8_SA
#undef PG8_SB
#undef PG8_STAGE
#undef PG8_STAGE_A
#undef PG8_LDA
#undef PG8_LD1
#undef PG8_LDB
#undef PG8_MMA
#undef PG8_WAIT_V
#undef PG8_WAIT_L
#undef PG8_BAR
#undef PG8_SCHED
}
}
using pg8::Unit;

template <class F>
__device__ __forceinline__ void epi_perm_loop(const f32x4 (&acc)[2][2][4][2], int wr, int wc, int fr, int fq, F&& f) {
#pragma unroll
    for (int ai = 0; ai < 2; ++ai)
#pragma unroll
        for (int m = 0; m < 4; ++m) { const int rt = ai * 128 + wr * 64 + m * 16 + fr;
#pragma unroll
            for (int bj = 0; bj < 2; ++bj) { const int ct = wc * 64 + bj * 32 + 8 * fq; f(rt, ct, acc[ai][bj][m][0], acc[ai][bj][m][1]); }
            asm volatile("" ::: "memory"); }
}
__device__ __forceinline__ unsigned pk4_fp8(float a, float b, float c, float d) { int w = 0; w = __builtin_amdgcn_cvt_pk_fp8_f32(a, b, w, false); w = __builtin_amdgcn_cvt_pk_fp8_f32(c, d, w, true); return (unsigned)w; }
__device__ __forceinline__ u32x4 xp16(u32x4 w, int src) { u32x4 r; r.x = __shfl(w.x, src); r.y = __shfl(w.y, src); r.z = __shfl(w.z, src); r.w = __shfl(w.w, src); return r; }
__device__ __forceinline__ u32x2 xp8(u32x2 w, int src) { u32x2 r; r.x = __shfl(w.x, src); r.y = __shfl(w.y, src); return r; }
template <class DT, class LD, class F>
__device__ __forceinline__ void epi_perm_pipe(const f32x4 (&acc)[2][2][4][2], int wr, int wc, int fr, int fq, LD&& ld, F&& f) {
    DT cur = ld(wr * 64 + fr, wc * 64 + 8 * fq);
#pragma unroll
    for (int it = 0; it < 16; ++it) { const int ai = it >> 3, m = (it >> 1) & 3, bj = it & 1; const int rt = ai * 128 + wr * 64 + m * 16 + fr, ct = wc * 64 + bj * 32 + 8 * fq;
        DT nxt = cur;
        if (it + 1 < 16) { const int i2 = it + 1, a2 = i2 >> 3, m2 = (i2 >> 1) & 3, b2 = i2 & 1; nxt = ld(a2 * 128 + wr * 64 + m2 * 16 + fr, wc * 64 + b2 * 32 + 8 * fq); }
        asm volatile("" ::: "memory");
        f(rt, ct, acc[ai][bj][m][0], acc[ai][bj][m][1], cur);
        cur = nxt; }
}
__device__ __forceinline__ u32x4 pack8(f32x4 v0, f32x4 v1) { u32x4 w; w.x = pk2(v0[0], v0[1]); w.y = pk2(v0[2], v0[3]); w.z = pk2(v1[0], v1[1]); w.w = pk2(v1[2], v1[3]); return w; }
__device__ __forceinline__ float gelu_tanh(float x) { const float u = 1.5957691216057308f * (x + 0.044715f * x * x * x); return x * sigmoidf_(u); }
__device__ __forceinline__ void unpack8(u32x4 w, float (&f)[8]) { f[0] = bflo(w.x); f[1] = bfhi(w.x); f[2] = bflo(w.y); f[3] = bfhi(w.y); f[4] = bflo(w.z); f[5] = bfhi(w.z); f[6] = bflo(w.w); f[7] = bfhi(w.w); }

struct EpiCtx {
    static constexpr bool PERM = true; static constexpr bool MID = false;
    bf16* ZC;
    __device__ __forceinline__ void operator()(const f32x4 (&acc)[2][2][4][2], const Unit& u, int wr, int wc, int fr, int fq) const {
        const int pn = u.pn; const int ctile = pn < 4 ? pn : pn - 8;
        const float sc = (pn >= 12 && pn < 16) ? K_SCALE : 1.0f;
        char* zc = (char*)(ZC + (size_t)(u.pm - 256) * 256 * ZC_LD + ctile * 256); int ldz = ZC_LD; asm volatile("" : "+s"(ldz));
        const int ln = fq * 16 + fr, xs = (ln & 3) * 16 + (ln >> 2), dr = (ln >> 2) - fr, dc = 8 * ((ln & 3) - fq);
        epi_perm_loop(acc, wr, wc, fr, fq, [&](int rt, int ct, f32x4 v0, f32x4 v1) { v0 *= sc; v1 *= sc; *(u32x4*)(zc + (unsigned)(((rt + dr) * ldz + ct + dc) * 2)) = xp16(pack8(v0, v1), xs); });
    }
};
struct EpiIn {
    static constexpr bool PERM = true; static constexpr bool MID = false;
    bf16* Z; const f32x2* rope; int dry;
    __device__ __forceinline__ void operator()(const f32x4 (&acc)[2][2][4][2], const Unit& u, int wr, int wc, int fr, int fq) const {
        if (MK_DRYMODE == 2 && dry) return;
        const int pn = u.pn; const int row0 = u.pm * 256, col0 = pn * 256; const f32x2* rp_ = rope;
        const int kind = (pn >= 8 && pn < 12) ? 2 : (pn >= 12 && pn < 16) ? 3 : 0;
        const float sc = kind == 3 ? K_SCALE : 1.0f;
        char* zt = (char*)(Z + (size_t)row0 * ZLD + col0); int ldz = ZLD; asm volatile("" : "+s"(ldz));
        const int ln = fq * 16 + fr;
#pragma unroll
        for (int ai = 0; ai < 2; ++ai)
#pragma unroll
            for (int m = 0; m < 4; ++m) { const int rt = ai * 128 + wr * 64 + m * 16 + fr; u32x4 pw[2];
#pragma unroll
                for (int bj = 0; bj < 2; ++bj) { f32x4 v0 = acc[ai][bj][m][0], v1 = acc[ai][bj][m][1]; const int ct = wc * 64 + bj * 32 + 8 * fq;
                    if (kind == 2 || kind == 3) {
                        const int t = (row0 + rt) & (SEQ - 1);
                        const int e0 = (col0 + ct) & 127; const int p0 = e0 >> 1;
                        const int pos = p0 < 32 ? (t >> 6) : (t & 63); const int f0 = p0 & 31;
                        const f32x4* rp = (const f32x4*)(rp_ + pos * 32 + f0);
                        const f32x4 cs0 = rp[0]; const f32x4 cs1 = rp[1];
                        f32x4 o0, o1;
                        o0[0] = v0[0] * cs0[0] - v0[1] * cs0[1]; o0[1] = v0[0] * cs0[1] + v0[1] * cs0[0];
                        o0[2] = v0[2] * cs0[2] - v0[3] * cs0[3]; o0[3] = v0[2] * cs0[3] + v0[3] * cs0[2];
                        o1[0] = v1[0] * cs1[0] - v1[1] * cs1[1]; o1[1] = v1[0] * cs1[1] + v1[1] * cs1[0];
                        o1[2] = v1[2] * cs1[2] - v1[3] * cs1[3]; o1[3] = v1[2] * cs1[3] + v1[3] * cs1[2];
                        v0 = o0 * sc; v1 = o1 * sc;
                    }
                    pw[bj] = pack8(v0, v1); }
#pragma unroll
                for (int s = 0; s < 2; ++s) { const int rr = 8 * s + (ln >> 3), pp = ln & 7; const int srcl = (pp & 3) * 16 + rr;
                    const u32x4 a0 = xp16(pw[0], srcl), a1 = xp16(pw[1], srcl); const u32x4 ow = (pp >> 2) ? a1 : a0;
                    if (!(MK_DRYMODE == 1 && dry) || ow.x == 0x7fc12345u) __builtin_nontemporal_store(ow, (u32x4*)(zt + (unsigned)(((rt - fr + rr) * ldz + wc * 64 + 8 * pp) * 2))); }
                asm volatile("" ::: "memory"); }
    }
};
struct EpiT1 {
    static constexpr bool PERM = true; static constexpr bool MID = false;
    const bf16* Z; bf16* T1;
    __device__ __forceinline__ void operator()(const f32x4 (&acc)[2][2][4][2], const Unit& u, int wr, int wc, int fr, int fq) const {
        const char* zt = (const char*)(Z + (size_t)u.pm * 256 * ZLD + C_GA + u.pn * 256); char* tt = (char*)(T1 + (size_t)u.pm * 256 * D + u.pn * 256);
        int ldz = ZLD, ldt = D; asm volatile("" : "+s"(ldz), "+s"(ldt));
        const int ln = fq * 16 + fr, xs = (ln & 3) * 16 + (ln >> 2), dr = (ln >> 2) - fr, dc = 8 * ((ln & 3) - fq);
        epi_perm_pipe<u32x4>(acc, wr, wc, fr, fq, [&](int rt, int ct) { return *(const u32x4*)(zt + (unsigned)((rt * ldz + ct) * 2)); },
            [&](int rt, int ct, f32x4 v0, f32x4 v1, u32x4 gw) { float gte[8]; unpack8(gw, gte);
            for (int j = 0; j < 4; ++j) { v0[j] *= sigmoidf_(gte[j]); v1[j] *= sigmoidf_(gte[4 + j]); }
            *(u32x4*)(tt + (unsigned)(((rt + dr) * ldt + ct + dc) * 2)) = xp16(pack8(v0, v1), xs); });
    }
};
struct EpiMg {
    static constexpr bool PERM = true; static constexpr bool MID = false;
    const bf16* Z; const bf16* T1; bf16* MG;
    __device__ __forceinline__ void operator()(const f32x4 (&acc)[2][2][4][2], const Unit& u, int wr, int wc, int fr, int fq) const {
        const char* zt = (const char*)(Z + (size_t)u.pm * 256 * ZLD + C_GB + u.pn * 256); const char* tt = (const char*)(T1 + (size_t)u.pm * 256 * D + u.pn * 256); char* mt = (char*)(MG + (size_t)u.pm * 256 * D + u.pn * 256);
        int ldz = ZLD, ldt = D; asm volatile("" : "+s"(ldz), "+s"(ldt));
        const int ln = fq * 16 + fr, xs = (ln & 3) * 16 + (ln >> 2), dr = (ln >> 2) - fr, dc = 8 * ((ln & 3) - fq);
        struct D2 { u32x4 a, b; };
        epi_perm_pipe<D2>(acc, wr, wc, fr, fq, [&](int rt, int ct) { D2 d; d.a = *(const u32x4*)(zt + (unsigned)((rt * ldz + ct) * 2)); d.b = *(const u32x4*)(tt + (unsigned)((rt * ldt + ct) * 2)); return d; },
            [&](int rt, int ct, f32x4 v0, f32x4 v1, D2 dd) { float gte[8], t1v[8]; unpack8(dd.a, gte); unpack8(dd.b, t1v);
            for (int j = 0; j < 4; ++j) { v0[j] = t1v[j] + v0[j] * sigmoidf_(gte[j]); v1[j] = t1v[4 + j] + v1[j] * sigmoidf_(gte[4 + j]); }
            *(u32x4*)(mt + (unsigned)(((rt + dr) * ldt + ct + dc) * 2)) = xp16(pack8(v0, v1), xs); });
    }
};
struct EpiF {
    static constexpr bool PERM = true; static constexpr bool MID = true;
    const bf16* Z; bf16* MG; int dry;
    __device__ __forceinline__ bool is_mid(const Unit& u) const { return u.koff == 0; }
    __device__ __forceinline__ void mid(f32x4 (&acc)[2][2][4][2], const Unit& u, int wr, int wc, int fr, int fq) const {
        if (MK_DRYMODE == 2 && dry) return;
        const char* za = (const char*)(Z + (size_t)u.pm * 256 * ZLD + C_GA + u.pn * 256); const char* zb = za + (C_GB - C_GA) * 2;
        int ldz = ZLD; asm volatile("" : "+s"(ldz));
        auto off = [&](int it) { const int ai = it >> 3, m = (it >> 1) & 3, bj = it & 1; return (unsigned)(((ai * 128 + wr * 64 + m * 16 + fr) * ldz + wc * 64 + bj * 32 + 8 * fq) * 2); };
        u32x4 qa[3], qb[3];
        qa[0] = *(const u32x4*)(za + off(0)); qb[0] = *(const u32x4*)(zb + off(0)); qa[1] = *(const u32x4*)(za + off(1)); qb[1] = *(const u32x4*)(zb + off(1));
#pragma unroll
        for (int it = 0; it < 16; ++it) { const int ai = it >> 3, m = (it >> 1) & 3, bj = it & 1;
            if (it + 2 < 16) { qa[(it + 2) % 3] = *(const u32x4*)(za + off(it + 2)); qb[(it + 2) % 3] = *(const u32x4*)(zb + off(it + 2)); }
            asm volatile("" ::: "memory");
            float ga[8], gb[8]; unpack8(qa[it % 3], ga); unpack8(qb[it % 3], gb);
#pragma unroll
            for (int j = 0; j < 4; ++j) {
                acc[ai][bj][m][0][j] *= (1.0f + fminf(__expf(-gb[j]), 1e30f)) * __builtin_amdgcn_rcpf(1.0f + __expf(-ga[j]));
                acc[ai][bj][m][1][j] *= (1.0f + fminf(__expf(-gb[4 + j]), 1e30f)) * __builtin_amdgcn_rcpf(1.0f + __expf(-ga[4 + j])); } }
    }
    __device__ __forceinline__ void operator()(const f32x4 (&acc)[2][2][4][2], const Unit& u, int wr, int wc, int fr, int fq) const {
        if (MK_DRYMODE == 2 && dry) return;
        const char* zb = (const char*)(Z + (size_t)u.pm * 256 * ZLD + C_GB + u.pn * 256); char* mt = (char*)(MG + (size_t)u.pm * 256 * D + u.pn * 256);
        int ldz = ZLD, ldt = D; asm volatile("" : "+s"(ldz), "+s"(ldt));
        const int ln = fq * 16 + fr, xs = (ln & 3) * 16 + (ln >> 2), dr = (ln >> 2) - fr, dc = 8 * ((ln & 3) - fq);
        auto off = [&](int it) { const int ai = it >> 3, m = (it >> 1) & 3, bj = it & 1; return (unsigned)(((ai * 128 + wr * 64 + m * 16 + fr) * ldz + wc * 64 + bj * 32 + 8 * fq) * 2); };
        u32x4 qb[4]; qb[0] = *(const u32x4*)(zb + off(0)); qb[1] = *(const u32x4*)(zb + off(1)); qb[2] = *(const u32x4*)(zb + off(2));
#pragma unroll
        for (int it = 0; it < 16; ++it) { const int ai = it >> 3, m = (it >> 1) & 3, bj = it & 1; const int rt = ai * 128 + wr * 64 + m * 16 + fr, ct = wc * 64 + bj * 32 + 8 * fq;
            if (it + 3 < 16) qb[(it + 3) & 3] = *(const u32x4*)(zb + off(it + 3));
            asm volatile("" ::: "memory");
            float gb[8]; unpack8(qb[it & 3], gb); f32x4 v0 = acc[ai][bj][m][0], v1 = acc[ai][bj][m][1];
#pragma unroll
            for (int j = 0; j < 4; ++j) { v0[j] *= __builtin_amdgcn_rcpf(1.0f + fminf(__expf(-gb[j]), 1e30f)); v1[j] *= __builtin_amdgcn_rcpf(1.0f + fminf(__expf(-gb[4 + j]), 1e30f)); }
            *(u32x4*)(mt + (unsigned)(((rt + dr) * ldt + ct + dc) * 2)) = xp16(pack8(v0, v1), xs); }
    }
};
struct EpiX1 {
    static constexpr bool PERM = false; static constexpr bool MID = false;
    const float* X; float* O; const float* mod; int grow0;
    __device__ __forceinline__ void operator()(const f32x4 (&acc)[2][2][4][2], const Unit& u, int wr, int wc, int fr, int fq) const {
        const int trow = grow0 + u.pm * 256; const int b = trow >> 13;
        const char* xt = (const char*)(X + (size_t)trow * D + u.pn * 256); char* ot = (char*)(O + (size_t)trow * D + u.pn * 256); const float* g1 = mod + b * 6144 + 2048 + u.pn * 256;
        int ldx = D; asm volatile("" : "+s"(ldx));
        const int ln = fq * 16 + fr, xs = (ln & 3) * 16 + (ln >> 2);
        const int r0 = wr * 64 + (ln >> 2), c0 = wc * 64 + 4 * (ln & 3), c0g = wc * 64 + 4 * fq;
        f32x4 gv[2][2];
#pragma unroll
        for (int bj = 0; bj < 2; ++bj)
#pragma unroll
            for (int n = 0; n < 2; ++n) gv[bj][n] = *(const f32x4*)(g1 + c0g + bj * 32 + n * 16);
        auto xoff = [&](int it) { const int bj = it >> 4, n = (it >> 3) & 1, ai = (it >> 2) & 1, m = it & 3; return (unsigned)(((r0 + ai * 128 + m * 16) * ldx + c0 + bj * 32 + n * 16) * 4); };
        f32x4 xq[3]; xq[0] = *(const f32x4*)(xt + xoff(0)); xq[1] = *(const f32x4*)(xt + xoff(1));
#pragma unroll
        for (int it = 0; it < 32; ++it) { const int bj = it >> 4, n = (it >> 3) & 1, ai = (it >> 2) & 1, m = it & 3;
            if (it + 2 < 32) xq[(it + 2) % 3] = *(const f32x4*)(xt + xoff(it + 2));
            asm volatile("" ::: "memory");
            const f32x4 pr = gv[bj][n] * acc[ai][bj][m][n]; const u32x4 ps = xp16(__builtin_bit_cast(u32x4, pr), xs);
            *(f32x4*)(ot + xoff(it)) = xq[it % 3] + __builtin_bit_cast(f32x4, ps); }
    }
};
__device__ __forceinline__ float swiglu1(float g, float l) { const float gl = fminf(g, 7.0f), li = fminf(fmaxf(l, -7.0f), 7.0f); return gl * sigmoidf_(1.702f * gl) * (li + 1.0f); }
struct EpiHid {
    static constexpr bool PERM = true; static constexpr bool MID = false;
    unsigned char* HID; const float* b1;
    __device__ __forceinline__ void operator()(const f32x4 (&acc)[2][2][4][2], const Unit& u, int wr, int wc, int fr, int fq) const {
        const int e = u.pn >> 3, pl = u.pn & 7; const float* bb = b1 + e * 2048 + pl * 256; char* ht = (char*)(HID + (size_t)u.pm * 256 * DEXP + pl * 128);
        int ldh = DEXP; asm volatile("" : "+s"(ldh));
        const int ln = fq * 16 + fr, xs = (ln & 3) * 16 + (ln >> 2), dr = (ln >> 2) - fr, dc = 8 * ((ln & 3) - fq);
        f32x4 bq[2][2];
#pragma unroll
        for (int bj = 0; bj < 2; ++bj) { bq[bj][0] = *(const f32x4*)(bb + wc * 64 + bj * 32 + 8 * fq); bq[bj][1] = *(const f32x4*)(bb + wc * 64 + bj * 32 + 8 * fq + 4); }
        epi_perm_loop(acc, wr, wc, fr, fq, [&](int rt, int ct, f32x4 v0, f32x4 v1) { v0 += bq[(ct >> 5) & 1][0]; v1 += bq[(ct >> 5) & 1][1];
            const unsigned w = pk4_fp8(swiglu1(v0[0], v0[1]), swiglu1(v0[2], v0[3]), swiglu1(v1[0], v1[1]), swiglu1(v1[2], v1[3]));
            *(unsigned*)(ht + (unsigned)((rt + dr) * ldh + ((ct + dc) >> 1))) = (unsigned)__shfl((int)w, xs); });
    }
};
struct EpiY {
    static constexpr bool PERM = true; static constexpr bool MID = false;
    unsigned char* Y; const float* b2;
    __device__ __forceinline__ void operator()(const f32x4 (&acc)[2][2][4][2], const Unit& u, int wr, int wc, int fr, int fq) const {
        const int e = u.pn >> 2, pl = u.pn & 3; const float* bb = b2 + e * 1024 + pl * 256; char* yt = (char*)(Y + (size_t)u.pm * 256 * D + pl * 256);
        int ldy = D; asm volatile("" : "+s"(ldy));
        const int ln = fq * 16 + fr, xs = (ln & 3) * 16 + (ln >> 2), dr = (ln >> 2) - fr, dc = 8 * ((ln & 3) - fq);
        f32x4 bq[2][2];
#pragma unroll
        for (int bj = 0; bj < 2; ++bj) { bq[bj][0] = *(const f32x4*)(bb + wc * 64 + bj * 32 + 8 * fq); bq[bj][1] = *(const f32x4*)(bb + wc * 64 + bj * 32 + 8 * fq + 4); }
        epi_perm_loop(acc, wr, wc, fr, fq, [&](int rt, int ct, f32x4 v0, f32x4 v1) { v0 += bq[(ct >> 5) & 1][0]; v1 += bq[(ct >> 5) & 1][1];
            u32x2 w8; w8.x = pk4_fp8(v0[0], v0[1], v0[2], v0[3]); w8.y = pk4_fp8(v1[0], v1[1], v1[2], v1[3]);
            *(u32x2*)(yt + (unsigned)((rt + dr) * ldy + ct + dc)) = xp8(w8, xs); });
    }
};

#define XB_TMO      128
#define XB_XCNT(j)  (256  + 64 * (j))
#define XB_XSUB(j)  (1280 + 64 * (j))
#define XB_XGEN(j)  (2304 + 64 * (j))
#define XB_TOP      3328
#define XB_TOPGEN   3392
#define XCD_BAR_WORDS 3456
#define XB_SPIN_CAP (1u << 22)
__device__ __forceinline__ unsigned xb_ld(unsigned* p)              { return __hip_atomic_load(p, __ATOMIC_RELAXED, __HIP_MEMORY_SCOPE_AGENT); }
__device__ __forceinline__ unsigned xb_add(unsigned* p, unsigned v) { return __hip_atomic_fetch_add(p, v, __ATOMIC_RELAXED, __HIP_MEMORY_SCOPE_AGENT); }
__device__ __forceinline__ unsigned xb_xcc_id() { return (unsigned)__builtin_amdgcn_s_getreg((3 << 11) | 20) & 0xFu; }
#define XB_SPIN(cond, bar) do { unsigned _sp = 0; while (cond) { __builtin_amdgcn_s_sleep(1); \
    if ((++_sp & 255u) == 0u) { if (xb_ld(&(bar)[XB_TMO])) break; if (_sp > XB_SPIN_CAP) { atomicAdd(&(bar)[XB_TMO], 1u); break; } } } } while (0)
struct XcdBarrier { unsigned* bar; unsigned x; volatile LAS unsigned* st; };
__device__ __forceinline__ XcdBarrier xcd_barrier_post(unsigned* bar, volatile LAS unsigned* st) {
    XcdBarrier b; b.bar = bar; b.x = xb_xcc_id(); b.st = st;
    if (threadIdx.x == 0) (void)xb_add(&bar[XB_XCNT(b.x)], 1u);
    return b;
}
__device__ __forceinline__ void xcd_barrier_complete(unsigned* bar, unsigned x, unsigned& nloc, unsigned& nx) {
    const unsigned G = gridDim.x * gridDim.y * gridDim.z;
    unsigned sum, cnt, mine, sp = 0u;
    for (;;) {
        sum = 0u; cnt = 0u; mine = 0u;
#pragma unroll
        for (unsigned j = 0; j < 16; ++j) { const unsigned c = xb_ld(&bar[XB_XCNT(j)]); sum += c; cnt += (c > 0u) ? 1u : 0u; mine = (j == x) ? c : mine; }
        if (sum == G) break;
        __builtin_amdgcn_s_sleep(1);
        if ((++sp & 255u) == 0u) { if (xb_ld(&bar[XB_TMO])) break; if (sp > XB_SPIN_CAP) { atomicAdd(&bar[XB_TMO], 1u); break; } }
    }
    nloc = mine > 0u ? mine : 1u; nx = cnt > 0u ? cnt : 1u;
}
__device__ __forceinline__ void xcd_barrier(const XcdBarrier& b) {
    asm volatile("s_waitcnt vmcnt(0)" ::: "memory");
    __syncthreads();
    if (threadIdx.x == 0) {
        unsigned* bar = b.bar;
        __builtin_amdgcn_s_waitcnt(0);
        unsigned nloc = b.st[0], nx = b.st[1];
        if (nloc == 0u) { xcd_barrier_complete(bar, b.x, nloc, nx); b.st[0] = nloc; b.st[1] = nx; }
        const unsigned old = xb_add(&bar[XB_XSUB(b.x)], 1u);
        const unsigned gen = old / nloc;
        if (old + 1u == (gen + 1u) * nloc) {
            __builtin_amdgcn_fence(__ATOMIC_RELEASE, "agent");
            asm volatile("s_waitcnt vmcnt(0)" ::: "memory");
            const unsigned og = xb_add(&bar[XB_TOP], 1u);
            const unsigned tg = og / nx;
            if (og + 1u == (tg + 1u) * nx) xb_add(&bar[XB_TOPGEN], 1u);
            else XB_SPIN(xb_ld(&bar[XB_TOPGEN]) == tg, bar);
            __builtin_amdgcn_fence(__ATOMIC_ACQUIRE, "agent");
            xb_add(&bar[XB_XGEN(b.x)], 1u);
            asm volatile("s_waitcnt vmcnt(0)" ::: "memory");
        } else {
            XB_SPIN(xb_ld(&bar[XB_XGEN(b.x)]) == gen, bar);
            __builtin_amdgcn_fence(__ATOMIC_ACQUIRE, "agent");
            asm volatile("s_waitcnt vmcnt(0)" ::: "memory");
        }
    }
    __syncthreads();
}

__device__ __forceinline__ void transpose_item(const float* W, int ldw, int K, int N, bf16* WT, LAS float* scr, int item, int lane) {
    const int nblk = N / 32, kb = item / nblk, nb = item % nblk, k0 = 64 * kb, n0 = 32 * nb;
#pragma unroll 8
    for (int i = 0; i < 32; ++i) { const int kk = 2 * i + (lane >> 5); scr[kk * 33 + (lane & 31)] = W[(size_t)(k0 + kk) * ldw + n0 + (lane & 31)]; }
    LDS_WAIT(); asm volatile("" ::: "memory");
    const int c = lane & 7;
#pragma unroll
    for (int j = 0; j < 4; ++j) { const int n = (lane >> 3) + 8 * j; const LAS float* s = scr + (8 * c) * 33 + n;
        u32x4 o; o.x = pk2(s[0 * 33], s[1 * 33]); o.y = pk2(s[2 * 33], s[3 * 33]); o.z = pk2(s[4 * 33], s[5 * 33]); o.w = pk2(s[6 * 33], s[7 * 33]);
        *(u32x4*)(WT + (size_t)(n0 + n) * K + k0 + 8 * c) = o; }
    LDS_WAIT(); asm volatile("" ::: "memory");
}
struct TrTile { const float* src; bf16* dst; int ldw, ldt; };
__device__ __forceinline__ void tr_load(const TrTile& t, int tid, f32x4 (&v)[8]) {
#pragma unroll
    for (int i = 0; i < 8; ++i) { const int id = tid + 512 * i, k = id >> 5, c4 = id & 31; v[i] = *(const f32x4*)(t.src + (size_t)k * t.ldw + 4 * c4); }
}
__device__ __forceinline__ void tr_store(const TrTile& t, int tid, const f32x4 (&v)[8], LAS float* L) {
#pragma unroll
    for (int i = 0; i < 8; ++i) { const int id = tid + 512 * i, k = id >> 5, c4 = id & 31;
        L[(4 * c4 + 0) * 129 + k] = v[i][0]; L[(4 * c4 + 1) * 129 + k] = v[i][1]; L[(4 * c4 + 2) * 129 + k] = v[i][2]; L[(4 * c4 + 3) * 129 + k] = v[i][3]; }
    __syncthreads();
#pragma unroll
    for (int i = 0; i < 4; ++i) { const int id = tid + 512 * i, kc = id & 15, n = id >> 4; const LAS float* s = L + n * 129 + 8 * kc;
        u32x4 o; o.x = pk2(s[0], s[1]); o.y = pk2(s[2], s[3]); o.z = pk2(s[4], s[5]); o.w = pk2(s[6], s[7]);
        *(u32x4*)(t.dst + (size_t)n * t.ldt + 8 * kc) = o; }
    __syncthreads();
}
template <bool FP8 = false>
__device__ __forceinline__ void tr_strip_i8(const float* src, int ldw, int K, signed char* dst, int ldt, float* scales, int tid, LAS unsigned* TL, LAS unsigned* CM) {
    constexpr float QMAX = FP8 ? 448.0f : 127.0f;
    const int c4 = tid & 31, g = tid >> 5, nk = K / 128;
    const float* p = src + (size_t)(4 * g) * ldw + 4 * c4;
    auto ld8 = [&](int kt, f32x4 (&v)[8]) {
#pragma unroll
        for (int h = 0; h < 2; ++h)
#pragma unroll
            for (int r = 0; r < 4; ++r) v[4 * h + r] = *(const f32x4*)(p + (size_t)(kt * 128 + 64 * h + r) * ldw); };
    float mx[4] = {0.f, 0.f, 0.f, 0.f};
    auto red = [&](const f32x4 (&v)[8]) {
#pragma unroll
        for (int i = 0; i < 8; ++i)
#pragma unroll
            for (int j = 0; j < 4; ++j) mx[j] = fmaxf(mx[j], fabsf(v[i][j])); };
    {   f32x4 va[8], vb[8]; ld8(0, va);
#pragma unroll 1
        for (int kt = 0; kt < nk; kt += 2) { ld8(kt + 1, vb); red(va); if (kt + 2 < nk) ld8(kt + 2, va); red(vb); } }
    f32x4 v[8]; ld8(0, v);
    if (tid < 128) CM[tid] = 0u;
    __syncthreads();
#pragma unroll
    for (int j = 0; j < 4; ++j) __hip_atomic_fetch_max(&CM[4 * c4 + j], __builtin_bit_cast(unsigned, mx[j]), __ATOMIC_RELAXED, __HIP_MEMORY_SCOPE_WORKGROUP);
    __syncthreads();
    if (tid < 128) { const float m = __builtin_bit_cast(float, CM[tid]); scales[tid] = m > 0.f ? m * (1.0f / QMAX) : 1.0f; }
    float inv[4];
#pragma unroll
    for (int j = 0; j < 4; ++j) { const float m = __builtin_bit_cast(float, CM[4 * c4 + j]); inv[j] = m > 0.f ? QMAX / m : 0.f; }
#pragma unroll 1
    for (int kt = 0; kt < nk; ++kt) {
        f32x4 w[8];
#pragma unroll
        for (int i = 0; i < 8; ++i) w[i] = v[i];
        if (kt + 1 < nk) ld8(kt + 1, v);
        LAS unsigned* T = TL + (kt & 1) * 4352;
#pragma unroll
        for (int h = 0; h < 2; ++h)
#pragma unroll
            for (int j = 0; j < 4; ++j) { unsigned pk;
                if constexpr (FP8) pk = pk4_fp8(w[4 * h][j] * inv[j], w[4 * h + 1][j] * inv[j], w[4 * h + 2][j] * inv[j], w[4 * h + 3][j] * inv[j]);
                else pk = q8x4((f32x4){w[4 * h][j], w[4 * h + 1][j], w[4 * h + 2][j], w[4 * h + 3][j]}, inv[j]);
                T[c4 * 133 + j * 33 + 16 * h + g] = pk; }
        __syncthreads();
#pragma unroll
        for (int i = 0; i < 2; ++i) { const int id = tid + 512 * i, kc = id & 7, n = id >> 3; const LAS unsigned* s = T + (n >> 2) * 133 + (n & 3) * 33 + 4 * kc;
            *(u32x4*)(dst + (size_t)n * ldt + kt * 128 + 16 * kc) = (u32x4){s[0], s[1], s[2], s[3]}; }
    }
    __syncthreads();
}
__device__ __forceinline__ unsigned offb(unsigned row, unsigned ch) { return 256u * row + 16u * (ch ^ (((row & 3u) << 2) | ((row >> 2) & 3u))); }
typedef short v4i16_t __attribute__((ext_vector_type(4)));
__device__ __forceinline__ s16x4 trd(const LAS unsigned char* p) { return __builtin_bit_cast(s16x4, __builtin_amdgcn_ds_read_tr16_b64_v4i16((LAS v4i16_t*)p)); }
#define MFMA32(a, b, c) __builtin_amdgcn_mfma_f32_32x32x16_bf16((a), (b), (c), 0, 0, 0)
#define MFMA16(a, b, c) __builtin_amdgcn_mfma_f32_16x16x32_bf16((a), (b), (c), 0, 0, 0)
__device__ __forceinline__ int crow(int reg, int h) { return (reg & 3) + 8 * (reg >> 2) + 4 * h; }

struct LruP { const float *conv_w, *conv_b, *ba, *bx, *lam; const bf16* wg; f32x2* carry; };
template <int PASS, int DIR>
__device__ __forceinline__ void lru_dir(LAS unsigned char* XC, LAS unsigned char* RN, const LruP& P, int b, int cp, int n, int w, int col, int g4) {
    const int ch = 128 * n + 16 * w + col;
    const float bav = P.ba[DIR * 1024 + ch], bxv = P.bx[DIR * 1024 + ch];
    const float c8 = 8.0f * log1pf(expf(-P.lam[DIR * 1024 + ch]));
    bf16x8 Ba[4], Bx[4];
    { const bf16* wa = P.wg + ((size_t)((n * 4 + DIR * 2 + 0) * 128 + 16 * w + col)) * 128 + 8 * g4; const bf16* wx = wa + 128 * 128;
#pragma unroll
      for (int ks = 0; ks < 4; ++ks) { Ba[ks] = *(const bf16x8*)(wa + 32 * ks); Bx[ks] = *(const bf16x8*)(wx + 32 * ks); } }
    float hrun = 0.f, atot = 1.f;
    if (PASS == 1) {
        const int Pn = DIR == 0 ? cp : 33 - cp; float Al = 1.f, Ul = 0.f;
#pragma unroll
        for (int k = 0; k < 9; ++k) { const int p = 9 * g4 + k;
            if (p < Pn) { const int cq = DIR == 0 ? p : (p == 0 ? 0 : 33 - p); const f32x2 ah = P.carry[((size_t)(b * 2 + DIR) * 33 + cq) * 1024 + ch]; Ul = ah.x * Ul + ah.y; Al = ah.x * Al; } }
#pragma unroll
        for (int gq = 0; gq < 4; ++gq) { const float Ag = __shfl(Al, col + 16 * gq), Ug = __shfl(Ul, col + 16 * gq); hrun = Ag * hrun + Ug; }
    }
#pragma unroll 4
    for (int mi = 0; mi < 16; ++mi) {
        const int m = DIR == 0 ? mi : 15 - mi;
        f32x4 ar = {0.f, 0.f, 0.f, 0.f}, ai = {0.f, 0.f, 0.f, 0.f};
        const LAS unsigned char* xrow = XC + (16 * m + col) * 272 + 16 * g4;
#pragma unroll
        for (int ks = 0; ks < 4; ++ks) { const bf16x8 af = *(const LAS bf16x8*)(xrow + 64 * ks); ar = MFMA16(af, Ba[ks], ar); ai = MFMA16(af, Bx[ks], ai); }
        float av[4], uv[4];
#pragma unroll
        for (int r = 0; r < 4; ++r) { const int t = 16 * m + 4 * g4 + r; const float xc = bf2f(*(const LAS unsigned short*)(XC + t * 272 + (16 * w + col) * 2));
            const float er = __expf(fminf(-(ar[r] + bav), 40.f)) + 1.0f, ei = __expf(fminf(-(ai[r] + bxv), 40.f)) + 1.0f; const float inv = __builtin_amdgcn_rcpf(er * ei);
            const float rg = inv * ei, ig = inv * er; const float a = __expf(-c8 * rg);
            av[r] = a; uv[r] = __builtin_amdgcn_sqrtf(fmaxf(1.0f - a * a, 0.f)) * ig * xc; }
        float Al = 1.f, Ul = 0.f;
#pragma unroll
        for (int rr = 0; rr < 4; ++rr) { const int r = DIR == 0 ? rr : 3 - rr; Ul = av[r] * Ul + uv[r]; Al = av[r] * Al; }
        float Ag[4], Ug[4];
#pragma unroll
        for (int gq = 0; gq < 4; ++gq) { Ag[gq] = __shfl(Al, col + 16 * gq); Ug[gq] = __shfl(Ul, col + 16 * gq); }
        float h = hrun, hin = hrun;
#pragma unroll
        for (int gi = 0; gi < 4; ++gi) { const int gq = DIR == 0 ? gi : 3 - gi; if (gq == g4) hin = h; h = Ag[gq] * h + Ug[gq]; atot *= Ag[gq]; }
        hrun = h;
        if (PASS == 1) {
            float hh = hin;
#pragma unroll
            for (int rr = 0; rr < 4; ++rr) { const int r = DIR == 0 ? rr : 3 - rr; hh = av[r] * hh + uv[r];
                LAS unsigned short* rp = (LAS unsigned short*)(RN + (16 * m + 4 * g4 + r) * 272 + (16 * w + col) * 2);
                if (DIR == 0) *rp = (unsigned short)f2bf(hh); else *rp = (unsigned short)f2bf(bf2f(*rp) + hh); }
        }
    }
    if (PASS == 0) { if (g4 == 0) P.carry[((size_t)(b * 2 + DIR) * 33 + cp) * 1024 + ch] = (f32x2){atot, hrun}; }
}
template <int PASS>
__device__ __forceinline__ void lru_unit(LAS unsigned char* lds, const LruP& P, int b, int cp, int n, const bf16* xsrc, int ldx, int seqlen, const bf16* grp, bf16* gout) {
    const int tid = opaque_tid(), lane = tid & 63, w = __builtin_amdgcn_readfirstlane(tid >> 6), col = lane & 15, g4 = lane >> 4;
    const int t0 = cp == 0 ? 0 : (cp - 1) * 256;
    LAS unsigned char* XC = lds;
    LAS unsigned char* RN = lds + 69632;
    __syncthreads();
    {
        const int j8 = tid & 15, ch0 = 128 * n + 8 * j8;
        float cw[4][8], cb[8];
#pragma unroll
        for (int k = 0; k < 4; ++k) { const f32x4 a = *(const f32x4*)(P.conv_w + k * 1024 + ch0), c = *(const f32x4*)(P.conv_w + k * 1024 + ch0 + 4);
            cw[k][0] = a[0]; cw[k][1] = a[1]; cw[k][2] = a[2]; cw[k][3] = a[3]; cw[k][4] = c[0]; cw[k][5] = c[1]; cw[k][6] = c[2]; cw[k][7] = c[3]; }
        { const f32x4 a = *(const f32x4*)(P.conv_b + ch0), c = *(const f32x4*)(P.conv_b + ch0 + 4); cb[0] = a[0]; cb[1] = a[1]; cb[2] = a[2]; cb[3] = a[3]; cb[4] = c[0]; cb[5] = c[1]; cb[6] = c[2]; cb[7] = c[3]; }
#pragma unroll 4
        for (int i = 0; i < 8; ++i) {
            const int t = (tid >> 4) + 32 * i; float a[8];
#pragma unroll
            for (int j = 0; j < 8; ++j) a[j] = cb[j];
#pragma unroll
            for (int k = 0; k < 4; ++k) { const int row = t0 + t + k - 2;
                if (row >= 0 && row < seqlen) { float xv[8]; unpack8(*(const u32x4*)(xsrc + (size_t)row * ldx + ch0), xv);
#pragma unroll
                    for (int j = 0; j < 8; ++j) a[j] += cw[k][j] * xv[j]; } }
            u32x4 o; o.x = pk2(a[0], a[1]); o.y = pk2(a[2], a[3]); o.z = pk2(a[4], a[5]); o.w = pk2(a[6], a[7]);
            *(LAS u32x4*)(XC + t * 272 + j8 * 16) = o;
        }
    }
    __syncthreads();
    lru_dir<PASS, 0>(XC, RN, P, b, cp, n, w, col, g4);
    lru_dir<PASS, 1>(XC, RN, P, b, cp, n, w, col, g4);
    if (PASS == 1) {
        __syncthreads();
        const int j8 = tid & 15, ch0 = 128 * n + 8 * j8;
#pragma unroll 4
        for (int i = 0; i < 8; ++i) { const int t = (tid >> 4) + 32 * i; float rv[8], gv[8];
            unpack8(*(const LAS u32x4*)(RN + t * 272 + j8 * 16), rv); const bf16* gp_in = grp + (size_t)(t0 + t) * ZLD + C_GR + ch0; unpack8(*(const u32x4*)gp_in, gv); bf16* gp = gout + (size_t)(t0 + t) * D + ch0;
            for (int j = 0; j < 8; ++j) gv[j] = gelu_tanh(gv[j]);
            u32x4 o; o.x = pk2(rv[0] * gv[0], rv[1] * gv[1]); o.y = pk2(rv[2] * gv[2], rv[3] * gv[3]); o.z = pk2(rv[4] * gv[4], rv[5] * gv[5]); o.w = pk2(rv[6] * gv[6], rv[7] * gv[7]);
            *(u32x4*)gp = o; }
    }
}

__device__ __forceinline__ void kv_unit(LAS unsigned char* lds, const bf16* ksrc, const bf16* vsrc, int ld, float l2g, bf16* out) {
    const int tid = opaque_tid(), lane = tid & 63, w = __builtin_amdgcn_readfirstlane(tid >> 6);
    LAS unsigned char* KF = lds; LAS unsigned char* KB = lds + 32768; LAS unsigned char* VI = lds + 65536;
    __syncthreads();
#pragma unroll
    for (int i = 0; i < 4; ++i) { const int idx = tid + 512 * i, j = idx >> 4, chn = idx & 15; float kv[8]; unpack8(*(const u32x4*)(ksrc + (size_t)j * ld + 8 * chn), kv);
        const float wf = exp2f(l2g * (float)(127 - j)), wb = exp2f(l2g * (float)j);
        u32x4 of, ob; of.x = pk2(kv[0] * wf, kv[1] * wf); of.y = pk2(kv[2] * wf, kv[3] * wf); of.z = pk2(kv[4] * wf, kv[5] * wf); of.w = pk2(kv[6] * wf, kv[7] * wf);
        ob.x = pk2(kv[0] * wb, kv[1] * wb); ob.y = pk2(kv[2] * wb, kv[3] * wb); ob.z = pk2(kv[4] * wb, kv[5] * wb); ob.w = pk2(kv[6] * wb, kv[7] * wb);
        *(LAS u32x4*)(KF + offb(j, chn)) = of; *(LAS u32x4*)(KB + offb(j, chn)) = ob; }
#pragma unroll
    for (int i = 0; i < 8; ++i) { const int idx = tid + 512 * i, j = idx >> 5, chn = idx & 31;
        *(LAS u32x4*)(VI + (chn >> 4) * 32768 + offb(j, chn & 15)) = *(const u32x4*)(vsrc + (size_t)j * ld + 8 * chn); }
    __syncthreads();
    const int h = lane >> 5, blk = (lane >> 4) & 1, q = (lane & 15) >> 2, p = lane & 3;
    f32x16 accF[4], accB[4];
#pragma unroll
    for (int dt = 0; dt < 4; ++dt)
#pragma unroll
        for (int r = 0; r < 16; ++r) { accF[dt][r] = 0.f; accB[dt][r] = 0.f; }
    const LAS unsigned char* Vimg = VI + (w >> 2) * 32768; const int cv = w & 3;
#pragma unroll 1
    for (int ks = 0; ks < 8; ++ks) {
        const unsigned r0 = 16 * ks + 8 * h + q, r1 = r0 + 4;
        const s16x4 v0 = trd(Vimg + offb(r0, 4 * cv + 2 * blk + (p >> 1)) + 8 * (p & 1)), v1 = trd(Vimg + offb(r1, 4 * cv + 2 * blk + (p >> 1)) + 8 * (p & 1));
        const bf16x8 bv = __builtin_shufflevector(v0, v1, 0, 1, 2, 3, 4, 5, 6, 7);
#pragma unroll
        for (int dt = 0; dt < 4; ++dt) {
            const unsigned o0 = offb(r0, 4 * dt + 2 * blk + (p >> 1)) + 8 * (p & 1), o1 = offb(r1, 4 * dt + 2 * blk + (p >> 1)) + 8 * (p & 1);
            const bf16x8 af = __builtin_shufflevector(trd(KF + o0), trd(KF + o1), 0, 1, 2, 3, 4, 5, 6, 7);
            const bf16x8 ab = __builtin_shufflevector(trd(KB + o0), trd(KB + o1), 0, 1, 2, 3, 4, 5, 6, 7);
            accF[dt] = MFMA32(af, bv, accF[dt]); accB[dt] = MFMA32(ab, bv, accB[dt]);
        }
    }
    __syncthreads();
    { const int v = 32 * w + (lane & 31);
#pragma unroll
      for (int dt = 0; dt < 4; ++dt)
#pragma unroll
        for (int rg = 0; rg < 4; ++rg) { const int d = 32 * dt + 8 * rg + 4 * h;
            u32x2 of, ob; of.x = pk2(accF[dt][4 * rg], accF[dt][4 * rg + 1]); of.y = pk2(accF[dt][4 * rg + 2], accF[dt][4 * rg + 3]);
            ob.x = pk2(accB[dt][4 * rg], accB[dt][4 * rg + 1]); ob.y = pk2(accB[dt][4 * rg + 2], accB[dt][4 * rg + 3]);
            *(LAS u32x2*)(lds + v * 272 + d * 2) = of; *(LAS u32x2*)(lds + 69632 + v * 272 + d * 2) = ob; } }
    __syncthreads();
#pragma unroll
    for (int i = 0; i < 16; ++i) { const int idx = tid + 512 * i, dir = idx >> 12, v = (idx >> 4) & 255, chn = idx & 15;
        *(u32x4*)(out + (size_t)dir * 32768 + v * 128 + 8 * chn) = *(const LAS u32x4*)(lds + dir * 69632 + v * 272 + chn * 16); }
}

__device__ __forceinline__ void xc_rows(const LruP& P, const bf16* xsrc, int ldx, int lgseq  , int nrows, bf16* dst, int gthread, int nthreads) {
    const int c8 = gthread & 127, ch0 = 8 * c8;
    float cw[4][8], cb[8];
#pragma unroll
    for (int k = 0; k < 4; ++k) { const f32x4 a = *(const f32x4*)(P.conv_w + k * 1024 + ch0), c = *(const f32x4*)(P.conv_w + k * 1024 + ch0 + 4);
        cw[k][0] = a[0]; cw[k][1] = a[1]; cw[k][2] = a[2]; cw[k][3] = a[3]; cw[k][4] = c[0]; cw[k][5] = c[1]; cw[k][6] = c[2]; cw[k][7] = c[3]; }
    { const f32x4 a = *(const f32x4*)(P.conv_b + ch0), c = *(const f32x4*)(P.conv_b + ch0 + 4); cb[0] = a[0]; cb[1] = a[1]; cb[2] = a[2]; cb[3] = a[3]; cb[4] = c[0]; cb[5] = c[1]; cb[6] = c[2]; cb[7] = c[3]; }
    const int seqmask = (1 << lgseq) - 1;
    for (int run = gthread >> 7; run < nrows / 16; run += nthreads >> 7) {
        const int row0 = run * 16, t0 = row0 & seqmask;
        u32x4 xw[19];
#pragma unroll
        for (int k = 0; k < 19; ++k) { const int tt = t0 + k - 2; xw[k] = (tt >= 0 && tt <= seqmask) ? *(const u32x4*)(xsrc + (size_t)(row0 + k - 2) * ldx + ch0) : (u32x4){0u, 0u, 0u, 0u}; }
#pragma unroll
        for (int r = 0; r < 16; ++r) { float a[8];
#pragma unroll
            for (int j = 0; j < 8; ++j) a[j] = cb[j];
#pragma unroll
            for (int k = 0; k < 4; ++k) { float xv[8]; unpack8(xw[r + k], xv);
#pragma unroll
                for (int j = 0; j < 8; ++j) a[j] += cw[k][j] * xv[j]; }
            u32x4 o; o.x = pk2(a[0], a[1]); o.y = pk2(a[2], a[3]); o.z = pk2(a[4], a[5]); o.w = pk2(a[6], a[7]);
            *(u32x4*)(dst + (size_t)(row0 + r) * 1024 + ch0) = o; }
    }
}
__device__ __forceinline__ void lru_sweep(LAS unsigned char* lds, const LruP& P, int n, int sub, int dir, const bf16* xcl, const bf16* xcc, bf16* hout) {
    const int tid = opaque_tid(), lane = tid & 63, w = __builtin_amdgcn_readfirstlane(tid >> 6), col = lane & 15, g4 = lane >> 4;
    LAS unsigned char* XC = lds;
    LAS f32x2* AGG = (LAS f32x2*)(lds + 69632);
    LAS unsigned char* OUT = lds + 69632 + 1024;
    const int chl = 16 * sub + col, ch = 128 * n + chl;
    const float bav = P.ba[dir * 1024 + ch], bxv = P.bx[dir * 1024 + ch];
    const float c8 = 8.0f * log1pf(expf(-P.lam[dir * 1024 + ch]));
    bf16x8 Ba[4], Bx[4];
    { const bf16* wa = P.wg + ((size_t)((n * 4 + dir * 2 + 0) * 128 + chl)) * 128 + 8 * g4; const bf16* wx = wa + 128 * 128;
#pragma unroll
      for (int ks = 0; ks < 4; ++ks) { Ba[ks] = *(const bf16x8*)(wa + 32 * ks); Bx[ks] = *(const bf16x8*)(wx + 32 * ks); } }
    u32x4 xq[8];
    auto gload = [&](int s) { const bf16* srcp = s == 0 ? xcc : xcl + (size_t)(dir ? 32 - s : s - 1) * 256 * 1024;
#pragma unroll
        for (int i = 0; i < 8; ++i) { const int it = tid + 512 * i; xq[i] = *(const u32x4*)(srcp + (size_t)(it >> 4) * 1024 + 128 * n + 8 * (it & 15)); } };
    auto lstore = [&]() {
#pragma unroll
        for (int i = 0; i < 8; ++i) { const int it = tid + 512 * i; *(LAS u32x4*)(XC + (it >> 4) * 272 + (it & 15) * 16) = xq[i]; } };
    float hchunk = 0.f;
    __syncthreads();
    gload(0); lstore();
#pragma unroll 1
    for (int s = 0; s < 33; ++s) {
        __syncthreads();
        if (s + 1 < 33) gload(s + 1);
        if (s >= 2) { const int cprev = dir ? 33 - s : s - 2; *(u32x4*)(hout + (size_t)cprev * 4096 + tid * 8) = *(const LAS u32x4*)(OUT + tid * 16); }
        float av[2][4], uv[2][4], Ag[2][4], Ug[2][4], Am[2], Um[2];
#pragma unroll
        for (int q2 = 0; q2 < 2; ++q2) {
            const int m = dir ? 2 * w + 1 - q2 : 2 * w + q2;
            f32x4 ar = {0.f, 0.f, 0.f, 0.f}, ai = {0.f, 0.f, 0.f, 0.f};
            const LAS unsigned char* xrow = XC + (16 * m + col) * 272 + 16 * g4;
#pragma unroll
            for (int ks = 0; ks < 4; ++ks) { const bf16x8 af = *(const LAS bf16x8*)(xrow + 64 * ks); ar = MFMA16(af, Ba[ks], ar); ai = MFMA16(af, Bx[ks], ai); }
#pragma unroll
            for (int r = 0; r < 4; ++r) { const int t = 16 * m + 4 * g4 + r; const float xc = bf2f(*(const LAS unsigned short*)(XC + t * 272 + chl * 2));
                const float er = __expf(fminf(-(ar[r] + bav), 40.f)) + 1.0f, ei = __expf(fminf(-(ai[r] + bxv), 40.f)) + 1.0f; const float inv = __builtin_amdgcn_rcpf(er * ei);
                const float rg = inv * ei, ig = inv * er; const float a = __expf(-c8 * rg);
                av[q2][r] = a; uv[q2][r] = __builtin_amdgcn_sqrtf(fmaxf(1.0f - a * a, 0.f)) * ig * xc; }
            float Al = 1.f, Ul = 0.f;
#pragma unroll
            for (int rr = 0; rr < 4; ++rr) { const int r = dir ? 3 - rr : rr; Ul = av[q2][r] * Ul + uv[q2][r]; Al = av[q2][r] * Al; }
            float am = 1.f, um = 0.f;
#pragma unroll
            for (int gq = 0; gq < 4; ++gq) { Ag[q2][gq] = __shfl(Al, col + 16 * gq); Ug[q2][gq] = __shfl(Ul, col + 16 * gq); }
#pragma unroll
            for (int gi = 0; gi < 4; ++gi) { const int gq = dir ? 3 - gi : gi; um = Ag[q2][gq] * um + Ug[q2][gq]; am = Ag[q2][gq] * am; }
            Am[q2] = am; Um[q2] = um;
        }
        if (g4 == 0) AGG[w * 16 + col] = (f32x2){Am[0] * Am[1], Am[1] * Um[0] + Um[1]};
        __syncthreads();
        float h = hchunk, hin = hchunk;
#pragma unroll
        for (int wi = 0; wi < 8; ++wi) { const int ww = dir ? 7 - wi : wi; const f32x2 au = AGG[ww * 16 + col]; if (ww == w) hin = h; h = au.x * h + au.y; }
        hchunk = h;
        float hrun = hin;
#pragma unroll
        for (int q2 = 0; q2 < 2; ++q2) {
            const int m = dir ? 2 * w + 1 - q2 : 2 * w + q2;
            float hg = hrun, hmy = hrun;
#pragma unroll
            for (int gi = 0; gi < 4; ++gi) { const int gq = dir ? 3 - gi : gi; if (gq == g4) hmy = hg; hg = Ag[q2][gq] * hg + Ug[q2][gq]; }
            hrun = hg;
            float hh = hmy;
#pragma unroll
            for (int rr = 0; rr < 4; ++rr) { const int r = dir ? 3 - rr : rr; hh = av[q2][r] * hh + uv[q2][r];
                *(LAS unsigned short*)(OUT + (16 * m + 4 * g4 + r) * 32 + col * 2) = (unsigned short)f2bf(hh); }
        }
        if (s + 1 < 33) lstore();
    }
    __syncthreads();
    { const int cprev = dir ? 0 : 31; *(u32x4*)(hout + (size_t)cprev * 4096 + tid * 8) = *(const LAS u32x4*)(OUT + tid * 16); }
}
__device__ __forceinline__ void lru_combine(const bf16* hf, const bf16* hb  , int c, const bf16* grp  , bf16* ar  , int tid) {
#pragma unroll
    for (int i = 0; i < 8; ++i) { const int it = tid + 512 * i, t = it >> 4, j8 = it & 15; const size_t ho = (size_t)(j8 >> 1) * (32 * 4096) + (size_t)c * 4096 + t * 16 + (j8 & 1) * 8;
        float a[8], b[8], g[8]; unpack8(__builtin_nontemporal_load((const u32x4*)(hf + ho)), a); unpack8(__builtin_nontemporal_load((const u32x4*)(hb + ho)), b); unpack8(*(const u32x4*)(grp + (size_t)t * ZLD + 8 * j8), g);
        u32x4 o; o.x = pk2((a[0] + b[0]) * gelu_tanh(g[0]), (a[1] + b[1]) * gelu_tanh(g[1])); o.y = pk2((a[2] + b[2]) * gelu_tanh(g[2]), (a[3] + b[3]) * gelu_tanh(g[3]));
        o.z = pk2((a[4] + b[4]) * gelu_tanh(g[4]), (a[5] + b[5]) * gelu_tanh(g[5])); o.w = pk2((a[6] + b[6]) * gelu_tanh(g[6]), (a[7] + b[7]) * gelu_tanh(g[7]));
        *(u32x4*)(ar + (size_t)t * 3072 + 8 * j8) = o; }
}

__device__ __forceinline__ void kvs_unit(LAS unsigned char* lds, const bf16* kctx, const bf16* vctx, const bf16* klat, const bf16* vlat, int dir, int part, float lg, bf16* st) {
    const int tid = opaque_tid(), lane = tid & 63, w = __builtin_amdgcn_readfirstlane(tid >> 6);
    const float l2g = lg * 1.4426950408889634f, cdec = __expf(128.0f * lg);
    const int h = lane >> 5, blk = (lane >> 4) & 1, q = (lane & 15) >> 2, p = lane & 3;
    float wj[4];
#pragma unroll
    for (int i = 0; i < 4; ++i) { const int j = (tid + 512 * i) >> 4; wj[i] = exp2f(l2g * (float)(dir ? j : 127 - j)); }
    f32x16 acc;
#pragma unroll
    for (int r = 0; r < 16; ++r) acc[r] = 0.f;
    u32x4 kq[2][4], vq[2];
    auto src = [&](int s, const bf16*& kp, const bf16*& vp, int& ld) {
        if (s < 2) { const int cc = dir ? 1 - s : s; kp = kctx + (size_t)cc * 128 * ZC_LD; vp = vctx + (size_t)cc * 128 * ZC_LD; ld = ZC_LD; }
        else { const int c = dir ? 65 - s : s - 2; kp = klat + (size_t)c * 128 * ZLD; vp = vlat + (size_t)c * 128 * ZLD; ld = ZLD; } };
    auto gload = [&](int s, u32x4 (&kk)[4], u32x4& vv) { const bf16* kp; const bf16* vp; int ld; src(s, kp, vp, ld);
#pragma unroll
        for (int i = 0; i < 4; ++i) { const int idx = tid + 512 * i, j = idx >> 4, chn = idx & 15; kk[i] = *(const u32x4*)(kp + (size_t)j * ld + 8 * chn); }
        vv = *(const u32x4*)(vp + (size_t)(tid >> 2) * ld + 32 * part + 8 * (tid & 3)); };
    auto lstore = [&](int buf, const u32x4 (&kk)[4], const u32x4& vv) { LAS unsigned char* KB = lds + buf * 65536; LAS unsigned char* VB = KB + 32768;
#pragma unroll
        for (int i = 0; i < 4; ++i) { const int idx = tid + 512 * i, j = idx >> 4, chn = idx & 15; float kv[8]; unpack8(kk[i], kv); const float ww = wj[i];
            u32x4 o; o.x = pk2(kv[0] * ww, kv[1] * ww); o.y = pk2(kv[2] * ww, kv[3] * ww); o.z = pk2(kv[4] * ww, kv[5] * ww); o.w = pk2(kv[6] * ww, kv[7] * ww);
            *(LAS u32x4*)(KB + offb(j, chn)) = o; }
        *(LAS u32x4*)(VB + offb(tid >> 2, tid & 3)) = vv; };
    __syncthreads();
    gload(0, kq[0], vq[0]); gload(1, kq[1], vq[1]); lstore(0, kq[0], vq[0]);
    __syncthreads();
#pragma unroll 1
    for (int s2 = 0; s2 < 66; s2 += 2)
#pragma unroll
    for (int sp = 0; sp < 2; ++sp) { const int s = s2 + sp;
        if (s + 2 < 66) gload(s + 2, kq[sp], vq[sp]);
        if (w < 4) {
            if (s >= 2) {
                const int c = dir ? 65 - s : s - 2; bf16* sp = st + (size_t)(c * 2 + dir) * 32768 + (size_t)(32 * part + (lane & 31)) * 128 + 32 * w + 4 * h;
#pragma unroll
                for (int rg = 0; rg < 4; ++rg) { u32x2 o; o.x = pk2(acc[4 * rg], acc[4 * rg + 1]); o.y = pk2(acc[4 * rg + 2], acc[4 * rg + 3]); *(u32x2*)(sp + 8 * rg) = o; }
            }
#pragma unroll
            for (int r = 0; r < 16; ++r) acc[r] *= cdec;
            const LAS unsigned char* KB = lds + (s & 1) * 65536; const LAS unsigned char* VB = KB + 32768;
#pragma unroll
            for (int ks = 0; ks < 8; ++ks) {
                const unsigned r0 = 16 * ks + 8 * h + q, r1 = r0 + 4;
                const bf16x8 bv = __builtin_shufflevector(trd(VB + offb(r0, 2 * blk + (p >> 1)) + 8 * (p & 1)), trd(VB + offb(r1, 2 * blk + (p >> 1)) + 8 * (p & 1)), 0, 1, 2, 3, 4, 5, 6, 7);
                const bf16x8 ak = __builtin_shufflevector(trd(KB + offb(r0, 4 * w + 2 * blk + (p >> 1)) + 8 * (p & 1)), trd(KB + offb(r1, 4 * w + 2 * blk + (p >> 1)) + 8 * (p & 1)), 0, 1, 2, 3, 4, 5, 6, 7);
                acc = MFMA32(ak, bv, acc);
            }
        }
        if (s + 1 < 66) lstore((s + 1) & 1, kq[sp ^ 1], vq[sp ^ 1]);
        __syncthreads();
    }
}

__device__ __forceinline__ void ro_unit(LAS unsigned char* lds, const bf16* qsrc, const bf16* ksrc, const bf16* vsrc, const bf16* gsp, bf16* gout, const bf16* Sf, const bf16* Sb, float l2g, int skip = 0) {
    const int tid = opaque_tid(), lane = tid & 63, w = __builtin_amdgcn_readfirstlane(tid >> 6), wi = w & 3, wv = w >> 2;
    LAS unsigned char* SF = lds; LAS unsigned char* SB = lds + 65536;
    LAS unsigned char* KI = lds; LAS unsigned char* VI = lds + 32768; LAS float* STATS = (LAS float*)(lds + 135168);
    const int h = lane >> 5, l31 = lane & 31, blk = (lane >> 4) & 1, q = (lane & 15) >> 2, p = lane & 3;
    __syncthreads();
    if (!(skip & 1)) {   u32x4 sf[8], sb[8];
#pragma unroll
        for (int i = 0; i < 8; ++i) { const int idx = tid + 512 * i; sf[i] = __builtin_nontemporal_load((const u32x4*)(Sf + (size_t)idx * 8)); sb[i] = __builtin_nontemporal_load((const u32x4*)(Sb + (size_t)idx * 8)); }
#pragma unroll
        for (int i = 0; i < 8; ++i) { const int idx = tid + 512 * i, v = idx >> 4, chn = idx & 15; *(LAS u32x4*)(SF + offb(v, chn)) = sf[i]; *(LAS u32x4*)(SB + offb(v, chn)) = sb[i]; }
    }
    bf16x8 qf[8];
#pragma unroll
    for (int s = 0; s < 8; ++s) qf[s] = *(const bf16x8*)(qsrc + (size_t)(32 * wi + l31) * ZLD + 16 * s + 8 * h);
    u32x4 kreg[4], vreg[8];
#pragma unroll
    for (int i = 0; i < 4; ++i) { const int idx = tid + 512 * i, j = idx >> 4, chn = idx & 15; kreg[i] = __builtin_nontemporal_load((const u32x4*)(ksrc + (size_t)j * ZLD + 8 * chn)); }
#pragma unroll
    for (int i = 0; i < 8; ++i) { const int idx = tid + 512 * i, j = idx >> 5, chn = idx & 31; vreg[i] = __builtin_nontemporal_load((const u32x4*)(vsrc + (size_t)j * ZLD + 8 * chn)); }
    __syncthreads();
    f32x16 z[4];
#pragma unroll
    for (int c = 0; c < 4; ++c)
#pragma unroll
        for (int r = 0; r < 16; ++r) z[c][r] = 0.f;
    if (!(skip & 1)) {
#pragma unroll
    for (int s = 0; s < 8; ++s)
#pragma unroll
        for (int c = 0; c < 4; ++c) { const bf16x8 bs = *(const LAS bf16x8*)(SF + offb(128 * wv + 32 * c + l31, 2 * s + h)); z[c] = MFMA32(qf[s], bs, z[c]); }
#pragma unroll
    for (int r = 0; r < 16; ++r) { const int i = 32 * wi + crow(r, h); const float f = exp2f(l2g * (float)(2 * i - 127));
#pragma unroll
        for (int c = 0; c < 4; ++c) z[c][r] *= f; }
#pragma unroll
    for (int s = 0; s < 8; ++s)
#pragma unroll
        for (int c = 0; c < 4; ++c) { const bf16x8 bs = *(const LAS bf16x8*)(SB + offb(128 * wv + 32 * c + l31, 2 * s + h)); z[c] = MFMA32(qf[s], bs, z[c]); }
#pragma unroll
    for (int r = 0; r < 16; ++r) { const int i = 32 * wi + crow(r, h); const float f = exp2f(l2g * (float)(128 - i));
#pragma unroll
        for (int c = 0; c < 4; ++c) z[c][r] *= f; }
    }
    __syncthreads();
#pragma unroll
    for (int i = 0; i < 4; ++i) { const int idx = tid + 512 * i, j = idx >> 4, chn = idx & 15; *(LAS u32x4*)(KI + offb(j, chn)) = kreg[i]; }
#pragma unroll
    for (int i = 0; i < 8; ++i) { const int idx = tid + 512 * i, j = idx >> 5, chn = idx & 31; *(LAS u32x4*)(VI + (chn >> 4) * 32768 + offb(j, chn & 15)) = vreg[i]; }
    __syncthreads();
    const LAS unsigned char* Vimg = VI + wv * 32768;
    u32x4 gsq[8];
#pragma unroll
    for (int i = 0; i < 8; ++i) { const int idx = tid + 512 * i, r = idx >> 5, chn = idx & 31; gsq[i] = __builtin_nontemporal_load((const u32x4*)(gsp + (size_t)r * ZLD + 8 * chn)); }
    if (!(skip & 2))
#pragma unroll
    for (int jt = 0; jt < 4; ++jt) {
        f32x16 x;
#pragma unroll
        for (int r = 0; r < 16; ++r) x[r] = 0.f;
#pragma unroll
        for (int s = 0; s < 8; ++s) { const bf16x8 ak = *(const LAS bf16x8*)(KI + offb(32 * jt + l31, 2 * s + h)); x = MFMA32(ak, qf[s], x); }
        const int ii = 32 * wi + l31;
#pragma unroll
        for (int r = 0; r < 16; ++r) { const int jj = 32 * jt + crow(r, h); const int dd = ii > jj ? ii - jj : jj - ii; x[r] *= exp2f(l2g * (float)dd); }
#pragma unroll
        for (int s2 = 0; s2 < 2; ++s2) {
            u32x4 pw; pw.x = pk2(x[8 * s2], x[8 * s2 + 1]); pw.y = pk2(x[8 * s2 + 2], x[8 * s2 + 3]); pw.z = pk2(x[8 * s2 + 4], x[8 * s2 + 5]); pw.w = pk2(x[8 * s2 + 6], x[8 * s2 + 7]);
            const bf16x8 xs = __builtin_bit_cast(bf16x8, pw);
            const unsigned r0 = 32 * jt + 16 * s2 + 4 * h + q, r1 = r0 + 8;
#pragma unroll
            for (int c = 0; c < 4; ++c) {
                const s16x4 v0 = trd(Vimg + offb(r0, 4 * c + 2 * blk + (p >> 1)) + 8 * (p & 1)), v1 = trd(Vimg + offb(r1, 4 * c + 2 * blk + (p >> 1)) + 8 * (p & 1));
                const bf16x8 pb = __builtin_shufflevector(v0, v1, 0, 1, 2, 3, 4, 5, 6, 7);
                z[c] = MFMA32(xs, pb, z[c]);
            }
        }
#pragma unroll
        for (int i2 = 0; i2 < 2; ++i2) { const int i = 2 * jt + i2; float gv[8]; unpack8(gsq[i], gv);
#pragma unroll
            for (int j = 0; j < 8; ++j) gv[j] = gv[j] * sigmoidf_(gv[j]);
            gsq[i].x = pk2(gv[0], gv[1]); gsq[i].y = pk2(gv[2], gv[3]); gsq[i].z = pk2(gv[4], gv[5]); gsq[i].w = pk2(gv[6], gv[7]); }
    }
#pragma unroll
    for (int r = 0; r < 16; ++r) { float s1 = (z[0][r] + z[1][r]) + (z[2][r] + z[3][r]); float s2 = (z[0][r] * z[0][r] + z[1][r] * z[1][r]) + (z[2][r] * z[2][r] + z[3][r] * z[3][r]);
        s1 = row16_sum(s1); s2 = row16_sum(s2);
        s1 += __shfl_xor(s1, 16); s2 += __shfl_xor(s2, 16);
        if (l31 == 0) { STATS[((wi * 2 + wv) * 32 + crow(r, h)) * 2] = s1; STATS[((wi * 2 + wv) * 32 + crow(r, h)) * 2 + 1] = s2; } }
    __syncthreads();
#pragma unroll
    for (int r = 0; r < 16; ++r) { const int il = crow(r, h);
        const float s1 = STATS[((wi * 2 + 0) * 32 + il) * 2] + STATS[((wi * 2 + 1) * 32 + il) * 2], s2 = STATS[((wi * 2 + 0) * 32 + il) * 2 + 1] + STATS[((wi * 2 + 1) * 32 + il) * 2 + 1];
        const float mean = s1 * (1.0f / 256.0f); const float var = fmaxf(s2 * (1.0f / 256.0f) - mean * mean, 0.f); const float rstd = __builtin_amdgcn_rsqf(var + EPS);
#pragma unroll
        for (int c = 0; c < 4; ++c) *(LAS unsigned short*)(lds + (32 * wi + il) * 528 + (128 * wv + 32 * c + l31) * 2) = (unsigned short)f2bf((z[c][r] - mean) * rstd); }
    __syncthreads();
    if (!(skip & 4))
#pragma unroll
    for (int i = 0; i < 8; ++i) { const int idx = tid + 512 * i, r = idx >> 5, chn = idx & 31; float ov[8], gv[8];
        unpack8(*(const LAS u32x4*)(lds + r * 528 + chn * 16), ov); unpack8(gsq[i], gv); bf16* gp = gout + (size_t)r * 3072 + 8 * chn;
        u32x4 o; o.x = pk2(ov[0] * gv[0], ov[1] * gv[1]); o.y = pk2(ov[2] * gv[2], ov[3] * gv[3]); o.z = pk2(ov[4] * gv[4], ov[5] * gv[5]); o.w = pk2(ov[6] * gv[6], ov[7] * gv[7]);
        *(u32x4*)gp = o; }
}

struct Args { const float* in[26]; float* out; unsigned char* ws; int lo, hi; };
enum { I_X = 0, I_C, I_CTX, I_CCTX, I_ADAW, I_ADAB, I_N1G, I_WIN, I_CONVW, I_CONVB, I_WA, I_BA, I_WX, I_BX, I_LAM, I_WRNN, I_WRET, I_WOUT, I_N2G, I_RW, I_RB, I_W1, I_B1, I_W2, I_B2, I_FG };
constexpr int ST_GRP = 3, ST_M0 = 27, ST_M1 = 28, ST_RNG = 29, ST_END = ST_RNG + 3 * NRANGE;

__global__ void __launch_bounds__(NTHR, 2) fwd_kernel(Args args) {
    extern __shared__ __attribute__((aligned(16))) unsigned char lds_raw[];
    LAS unsigned char* lds = (LAS unsigned char*)lds_raw;
    const int tid = threadIdx.x, lane = tid & 63, wave = __builtin_amdgcn_readfirstlane(tid >> 6);
    const int G = gridDim.x, bid = blockIdx.x;
    const int gw = bid * NWAVES + wave, NGW = G * NWAVES;
    unsigned char* ws = args.ws;
    volatile LAS unsigned* MISC = (volatile LAS unsigned*)(lds + MISC_OFF);
    if (tid < 64) MISC[tid] = 0u;
    __syncthreads();
    const int lo = args.lo, hi = args.hi;
    XcdBarrier bar; bar.bar = (unsigned*)(ws + WS_CTL) + CW_BAR; bar.x = 0; bar.st = nullptr;
    if (!MK_PER_PHASE) bar = xcd_barrier_post((unsigned*)(ws + WS_CTL) + CW_BAR, MISC);
#define IN(k) (lo <= (k) && (k) < hi)
#define SEAM(k) do { if (IN(k) && IN((k) + 1)) xcd_barrier(bar); } while (0)
#if MK_PROBE
    unsigned long long t_last = wall_clock64();
#define STAMP(kind) do { if (bid == 0 && threadIdx.x == 0) { const unsigned long long t_ = wall_clock64(); MISC[16 + (kind)] += (unsigned)(t_ - t_last); t_last = t_; } } while (0)
#else
#define STAMP(kind) do { } while (0)
#endif

    float* mod = (float*)(ws + WS_MOD);
    f32x2* rope = (f32x2*)(ws + WS_ROPE);
    f32x2* carry = (f32x2*)(ws + WS_CARRY); bf16* RWB = (bf16*)(ws + WS_RWB);
    bf16* WG = (bf16*)(ws + WS_WG); bf16* WRNN = (bf16*)(ws + WS_WRNN); bf16* WOUT = (bf16*)(ws + WS_WOUT); bf16* WRET = WRNN + 1024; bf16* WIN = (bf16*)(ws + WS_WIN);
    bf16* HL = (bf16*)(ws + WS_HL); bf16* ZC = (bf16*)(ws + WS_ZC); bf16* CTXU = (bf16*)(ws + WS_CTXU); bf16* Z = (bf16*)(ws + WS_Z); bf16* STB = (bf16*)(ws + WS_ST);
    bf16* T1 = (bf16*)(ws + WS_T1); bf16* MG = (bf16*)(ws + WS_MG);
    bf16* W1T = (bf16*)(ws + WS_W1T); bf16* W2T = (bf16*)(ws + WS_W2T); bf16* HPAD = (bf16*)(ws + WS_HPAD); bf16* HID = (bf16*)(ws + WS_HID); bf16* YPAD = (bf16*)(ws + WS_YPAD);
    float* WRNNS = (float*)(ws + WS_WFS); float* WRETS = WRNNS + 1024; float* WOUTS = WRNNS + 2048; float* W2S = WRNNS + 4096;
    bf16* AR = (bf16*)(ws + WS_AR); bf16* AT = (bf16*)(ws + WS_AT);
    bf16* XCB = T1; bf16* XCC = CTXU;
    bf16* HDF = MG; bf16* HDB = (bf16*)(ws + 880 * MiB);
    float* HLS = (float*)(ws + WS_HLS); float* WINS = (float*)(ws + WS_WINS); float* W1S = (float*)(ws + WS_W1S); float* HPS = (float*)(ws + WS_HPS);
    int* ROWTOK = (int*)(ws + WS_HPAD);
    int* EIDX = (int*)(ws + WS_EIDX); float* GATE = (float*)(ws + WS_GATE); int* LPOS = (int*)(ws + WS_LPOS); int* AROW = (int*)(ws + WS_AROW);
    int* BCNT = (int*)(ws + WS_BCNT); int* BBASE = (int*)(ws + WS_BBASE); int* TILEE = (int*)(ws + WS_TILEE); int* NTILE = (int*)(ws + WS_NTILE);

    if (PH_EN(0) && IN(0)) for (int rep = 0; rep < DUP_N(0); ++rep) {
        const int tid = opaque_tid(), lane = tid & 63, wave = __builtin_amdgcn_readfirstlane(tid >> 6), gw = bid * NWAVES + wave; (void)lane; (void)gw; (void)rep;
        if (bid < 96) {
            LAS float* sc = (LAS float*)lds;
            LAS float* red = (LAS float*)(lds + 40960);
            for (int i = tid; i < 9 * 1024; i += NTHR) { const int r = i >> 10, k = i & 1023; const float v = r < 8 ? args.in[I_C][r * 1024 + k] : args.in[I_CCTX][k]; sc[i] = v * sigmoidf_(v); }
            __syncthreads();
            const int n0 = bid * 64; float a9[9];
#pragma unroll
            for (int r = 0; r < 9; ++r) a9[r] = 0.f;
            for (int k = wave * 128; k < wave * 128 + 128; ++k) { const float wv = args.in[I_ADAW][(size_t)k * 6144 + n0 + lane];
#pragma unroll
                for (int r = 0; r < 9; ++r) a9[r] += sc[r * 1024 + k] * wv; }
#pragma unroll
            for (int r = 0; r < 9; ++r) red[(wave * 9 + r) * 64 + lane] = a9[r];
            __syncthreads();
            for (int i = tid; i < 9 * 64; i += NTHR) { const int r = i >> 6, l = i & 63; float s = 0.f;
#pragma unroll
                for (int w8 = 0; w8 < 8; ++w8) s += red[(w8 * 9 + r) * 64 + l];
                mod[r * 6144 + n0 + l] = s + args.in[I_ADAB][n0 + l]; }
            __syncthreads();
        }
        if (bid == 97 % G) {
            for (int i = tid; i < 32 * 1024; i += NTHR) { const int d = i >> 5, e = i & 31; const float wv = args.in[I_RW][i]; const unsigned hi = f2bf(wv); const float rem = wv - bf2f((unsigned short)hi);
                RWB[e * 1024 + d] = (bf16)hi; RWB[32 * 1024 + e * 1024 + d] = (bf16)f2bf(rem); }
        }
        if (bid == 96) {
            for (int i = tid; i < 128 * 32; i += NTHR) { const int pos = i >> 5, f = i & 31; const float inv = powf(10000.0f, -(float)f / 32.0f); const float ang = (float)pos * inv; float s, c; sincosf(ang, &s, &c); rope[i] = (f32x2){c, s}; }
        }
        {
            LAS float* L = (LAS float*)(lds + 65536); LAS unsigned* CM = (LAS unsigned*)(lds + 65536 + 66048); LAS unsigned* TL = (LAS unsigned*)lds;
            for (int it = bid; it < 848; it += G) {
                if (it < 80) tr_strip_i8<false>(args.in[I_WIN] + it * 128, DIN, 1024, (signed char*)WIN + (size_t)it * 128 * 1024, 1024, WINS + it * 128, tid, TL, CM);
                else if (it < 592) { const int s = it - 80, e = s >> 4, nt = s & 15; tr_strip_i8<false>(args.in[I_W1] + (size_t)e * 1024 * 2048 + nt * 128, 2048, 1024, (signed char*)W1T + ((size_t)e * 2048 + nt * 128) * 1024, 1024, W1S + e * 2048 + nt * 128, tid, TL, CM); }
                else { const int s = it - 592, e = s >> 3, nt = s & 7; tr_strip_i8<true>(args.in[I_W2] + (size_t)e * 1024 * 1024 + nt * 128, 1024, 1024, (signed char*)W2T + ((size_t)e * 1024 + nt * 128) * 1024, 1024, W2S + e * 1024 + nt * 128, tid, TL, CM); }
            }
            constexpr int NT_ALL = 64 + 128 + 64 + 32;
            auto desc = [&](int it) -> TrTile { TrTile t;
                if (it < 64) { const int kt = it >> 3, nt = it & 7; t.src = args.in[I_WRNN] + (size_t)kt * 128 * 1024 + nt * 128; t.ldw = 1024; t.dst = WRNN + (size_t)nt * 128 * 3072 + kt * 128; t.ldt = 3072; return t; }
                it -= 64;
                if (it < 128) { const int kt = it >> 3, nt = it & 7; t.src = args.in[I_WRET] + (size_t)kt * 128 * 1024 + nt * 128; t.ldw = 1024; t.dst = WRET + (size_t)nt * 128 * 3072 + kt * 128; t.ldt = 3072; return t; }
                it -= 128;
                if (it < 64) { const int kt = it >> 3, nt = it & 7; t.src = args.in[I_WOUT] + (size_t)kt * 128 * 1024 + nt * 128; t.ldw = 1024; t.dst = WOUT + (size_t)nt * 128 * 1024 + kt * 128; t.ldt = 1024; return t; }
                it -= 64;
                { const int q = it & 3, n = it >> 2; const int dir = q >> 1, typ = q & 1;
                  t.src = (typ ? args.in[I_WX] : args.in[I_WA]) + (size_t)(dir * 8 + n) * 128 * 128; t.ldw = 128; t.dst = WG + (size_t)(n * 4 + q) * 128 * 128; t.ldt = 128; return t; } };
            f32x4 v[8];
            int it = NT_ALL - 1 - ((bid + 80) % G);
            if (it >= 0) { const TrTile t0 = desc(it); tr_load(t0, tid, v); }
            while (it >= 0) {
                const TrTile tc = desc(it); const int nx = it - G;
                f32x4 w[8];
#pragma unroll
                for (int i = 0; i < 8; ++i) w[i] = v[i];
                if (nx >= 0) { const TrTile tn = desc(nx); tr_load(tn, tid, v); }
                tr_store(tc, tid, w, L);
                it = nx;
            }
        }
    }
    SEAM(0); STAMP(0);
    if (PH_EN(1) && IN(1)) for (int rep = 0; rep < DUP_N(1); ++rep) {
        const int tid = opaque_tid(), lane = tid & 63, wave = __builtin_amdgcn_readfirstlane(tid >> 6), gw = bid * NWAVES + wave; (void)lane; (void)gw; (void)rep;
        for (int m = gw; m < NROWS_HL; m += NGW) {
            const float* src = m < NTOK ? args.in[I_X] + (size_t)m * D : args.in[I_CTX] + (size_t)(m - NTOK) * D; const int r = m < NTOK ? (m >> 13) : 8;
            const f32x4* xr = (const f32x4*)src + lane; f32x4 v[4]; float ss = 0.f;
#pragma unroll
            for (int j = 0; j < 4; ++j) { v[j] = xr[64 * j]; ss += (v[j].x * v[j].x + v[j].y * v[j].y) + (v[j].z * v[j].z + v[j].w * v[j].w); }
            const float rstd = 1.0f / sqrtf(wave_sum(ss) * (1.0f / D) + EPS);
            float am = 0.f;
#pragma unroll
            for (int j = 0; j < 4; ++j) { const int c0 = 4 * lane + 256 * j; const f32x4 gn = *(const f32x4*)(args.in[I_N1G] + c0), sh = *(const f32x4*)(mod + r * 6144 + c0), sc = *(const f32x4*)(mod + r * 6144 + 1024 + c0);
                v[j] = (v[j] * rstd * gn) * (sc + 1.0f) + sh; am = fmaxf(fmaxf(am, fmaxf(fabsf(v[j].x), fabsf(v[j].y))), fmaxf(fabsf(v[j].z), fabsf(v[j].w))); }
            am = wave_max(am); const float inv = am > 0.f ? 127.0f / am : 0.f;
            if (lane == 0) HLS[m] = am > 0.f ? am * (1.0f / 127.0f) : 1.0f;
            unsigned* o4 = (unsigned*)((signed char*)HL + (size_t)m * D) + lane;
#pragma unroll
            for (int j = 0; j < 4; ++j) o4[64 * j] = q8x4(v[j], inv);
        }
    }
    SEAM(1); STAMP(1);
    if (PH_EN(2) && IN(2)) for (int rep = 0; rep < DUP_N(2); ++rep) {
        const int tid = opaque_tid(), lane = tid & 63, wave = __builtin_amdgcn_readfirstlane(tid >> 6), gw = bid * NWAVES + wave; (void)lane; (void)gw; (void)rep;
        pg8::Gemm g{HL, WIN, 512, 512, 512, HLS, WINS, nullptr}; pg8::CtxOrder S{G, bid}; EpiCtx E{ZC};
        pg8::gemm_phase<EpiCtx, pg8::CtxOrder, 1>(lds, g, S, E);
    }
    SEAM(2); STAMP(2);
    for (int grp = 0; grp < NGRP; ++grp) {
        const int s0 = ST_GRP + 6 * grp;
        if (PH_EN(3) && IN(s0 + 0)) for (int rep = 0; rep < DUP_N(3); ++rep) {
        const int tid = opaque_tid(), lane = tid & 63, wave = __builtin_amdgcn_readfirstlane(tid >> 6), gw = bid * NWAVES + wave; (void)lane; (void)gw; (void)rep;
            pg8::Gemm g{HL + (size_t)grp * GROWS * 512, WIN, 512, 512, 512, HLS + grp * GROWS, WINS, nullptr}; pg8::StaticOrder S; S.init(GROWS / 256, DIN / 256, G, bid); EpiIn E{Z, rope, DRY(3) ? 1 : 0};
            STAGGER(STAG_B); pg8::gemm_phase<EpiIn, pg8::StaticOrder, 1>(lds, g, S, E);
        }
        SEAM(s0 + 0); STAMP(3);
        if (PH_EN(4) && IN(s0 + 1)) for (int rep = 0; rep < DUP_N(4); ++rep) {
        const int tid = opaque_tid(), lane = tid & 63, wave = __builtin_amdgcn_readfirstlane(tid >> 6), gw = bid * NWAVES + wave; (void)lane; (void)gw; (void)rep;
            for (int u = bid; u < GB * 8 * 2 * 8; u += G) { const int hd = u & 7, y = u >> 3, bl = y >> 4, dir = (y >> 3) & 1, part = y & 7; const int b = grp * GB + bl;
                const float lg = log1pf(-exp2f(-5.0f - (float)hd));
                const bf16* zc = ZC + (size_t)(b * CTXL) * ZC_LD; const bf16* zl = Z + (size_t)(bl * SEQ) * ZLD;
                kvs_unit(lds, zc + ZC_K + hd * 128, zc + ZC_V + hd * 256, zl + C_K + hd * 128, zl + C_V + hd * 256, dir, part, lg, STB + (size_t)((bl * 8 + hd) * 64) * 2 * 32768); }
            LruP LP{args.in[I_CONVW], args.in[I_CONVB], args.in[I_BA], args.in[I_BX], args.in[I_LAM], WG, carry};
            xc_rows(LP, Z + C_XR, ZLD, 13, GROWS, XCB, bid * NTHR + tid, G * NTHR);
            if (grp == 0) xc_rows(LP, ZC + ZC_XR, ZC_LD, 8, NCTX, XCC, bid * NTHR + tid, G * NTHR);
        }
        SEAM(s0 + 1); STAMP(4);
        if (PH_EN(5) && IN(s0 + 2)) for (int rep = 0; rep < DUP_N(5); ++rep) {
        const int tid = opaque_tid(), lane = tid & 63, wave = __builtin_amdgcn_readfirstlane(tid >> 6), gw = bid * NWAVES + wave; (void)lane; (void)gw; (void)rep;
            LruP LP{args.in[I_CONVW], args.in[I_CONVB], args.in[I_BA], args.in[I_BX], args.in[I_LAM], WG, carry};
            for (int u = bid; u < GB * 8 * 8 * 2; u += G) { const int n = u & 7, bl = (u >> 3) & 1, y = u >> 4, dir = y & 1, sub = y >> 1;
                bf16* hb_ = (dir ? HDB : HDF) + (size_t)((bl * 8 + n) * 8 + sub) * (32 * 4096);
                lru_sweep(lds, LP, n, sub, dir, XCB + (size_t)(bl * SEQ) * 1024, XCC + (size_t)((grp * GB + bl) * CTXL) * 1024, hb_); }
        }
        SEAM(s0 + 2); STAMP(5);
        if (PH_EN(6) && IN(s0 + 3)) for (int rep = 0; rep < DUP_N(6); ++rep) {
        const int tid = opaque_tid(), lane = tid & 63, wave = __builtin_amdgcn_readfirstlane(tid >> 6), gw = bid * NWAVES + wave; (void)lane; (void)gw; (void)rep;
            for (int u = bid; u < GB * 64 * 8; u += G) { const int hd = u & 7, c = (u >> 3) & 63, bl = u >> 9; const float l2g = log1pf(-exp2f(-5.0f - (float)hd)) * 1.4426950408889634f;
                bf16* zr = Z + (size_t)(bl * SEQ + c * 128) * ZLD; const bf16* sp = STB + (size_t)(((bl * 8 + hd) * 64 + c) * 2) * 32768;
                ro_unit(lds, zr + C_Q + hd * 128, zr + C_K + hd * 128, zr + C_V + hd * 256, zr + C_GS + hd * 256, AR + (size_t)(bl * SEQ + c * 128) * 3072 + 1024 + hd * 256, sp, sp + 32768, l2g, DRY(6) ? (MK_DRYMODE >= 8 ? MK_DRYMODE - 8 : 0) : 0); }
            if (!(DRY(6) && MK_DRYMODE >= 8))
            for (int u = bid; u < GB * 32 * 8; u += G) { const int n = u & 7, c = (u >> 3) & 31, bl = u >> 8; const size_t ub = (size_t)((bl * 8 + n) * 8) * (32 * 4096);
                lru_combine(HDF + ub, HDB + ub, c, Z + (size_t)(bl * SEQ + c * 256) * ZLD + C_GR + 128 * n, AR + (size_t)(bl * SEQ + c * 256) * 3072 + 128 * n, tid); }
        }
        SEAM(s0 + 3); STAMP(6);
        if (PH_EN(7) && IN(s0 + 4)) for (int rep = 0; rep < DUP_N(7); ++rep) {
        const int tid = opaque_tid(), lane = tid & 63, wave = __builtin_amdgcn_readfirstlane(tid >> 6), gw = bid * NWAVES + wave; (void)lane; (void)gw; (void)rep;
            { pg8::Gemm g{AR, WRNN, 3072, 3072, 3072, nullptr, nullptr, nullptr}; pg8::FOrder S; S.so.init(GROWS / 256, 4, G, bid); EpiF E{Z, MG, DRY(7) ? 1 : 0};
              pg8::gemm_phase<EpiF, pg8::FOrder>(lds, g, S, E); }
        }
        SEAM(s0 + 4); STAMP(7);
        if (PH_EN(8) && IN(s0 + 5)) for (int rep = 0; rep < DUP_N(8); ++rep) {
        const int tid = opaque_tid(), lane = tid & 63, wave = __builtin_amdgcn_readfirstlane(tid >> 6), gw = bid * NWAVES + wave; (void)lane; (void)gw; (void)rep;
            pg8::Gemm g{MG, WOUT, D, D, D, nullptr, nullptr, nullptr}; pg8::StaticOrder S; S.init(GROWS / 256, 4, G, bid); EpiX1 E{args.in[I_X], args.out, mod, grp * GROWS};
            pg8::gemm_phase<EpiX1, pg8::StaticOrder>(lds, g, S, E);
        }
        if (grp == NGRP - 1) SEAM(s0 + 5);
        STAMP(8);
    }
    if (PH_EN(9) && IN(ST_M0)) for (int rep = 0; rep < DUP_N(9); ++rep) {
        const int tid = opaque_tid(), lane = tid & 63, wave = __builtin_amdgcn_readfirstlane(tid >> 6), gw = bid * NWAVES + wave; (void)lane; (void)gw; (void)rep;
        LAS unsigned char* AH = lds;
        LAS unsigned char* AL = lds + 66048;
        LAS float* RED = (LAS float*)lds;
        LAS float* LOG = (LAS float*)(lds + 32768);
        LAS int* CNT = (LAS int*)(lds + 132096 + 512);
        const int h5 = lane >> 5, l31 = lane & 31;
        bf16x8 bh[8], bl[8];
#pragma unroll
        for (int s = 0; s < 8; ++s) { bh[s] = *(const bf16x8*)(RWB + (size_t)l31 * 1024 + 128 * wave + 16 * s + 8 * h5); bl[s] = *(const bf16x8*)(RWB + 32 * 1024 + (size_t)l31 * 1024 + 128 * wave + 16 * s + 8 * h5); }
        for (int blk = bid; blk < NTOK / 256; blk += G) {
            __syncthreads();
            if (tid < 32) CNT[tid] = 0;
            for (int tile = 0; tile < 8; ++tile) {
                __syncthreads();
                const int m0 = blk * 256 + tile * 32 + wave * 4; const int b = m0 >> 13;
#pragma unroll
                for (int r4 = 0; r4 < 4; ++r4) {
                    const int m = m0 + r4; const f32x4* xr = (const f32x4*)(args.out + (size_t)m * D) + lane; f32x4 v[4]; float ss = 0.f;
#pragma unroll
                    for (int j = 0; j < 4; ++j) { v[j] = __builtin_nontemporal_load(xr + 64 * j); ss += (v[j].x * v[j].x + v[j].y * v[j].y) + (v[j].z * v[j].z + v[j].w * v[j].w); }
                    const float rstd = 1.0f / sqrtf(wave_sum(ss) * (1.0f / D) + EPS);
                    float am = 0.f;
#pragma unroll
                    for (int j = 0; j < 4; ++j) { const int c0 = 4 * lane + 256 * j; const f32x4 gn = *(const f32x4*)(args.in[I_N2G] + c0), sh = *(const f32x4*)(mod + b * 6144 + 3072 + c0), sc = *(const f32x4*)(mod + b * 6144 + 4096 + c0);
                        v[j] = (v[j] * rstd * gn) * (sc + 1.0f) + sh; am = fmaxf(fmaxf(am, fmaxf(fabsf(v[j].x), fabsf(v[j].y))), fmaxf(fabsf(v[j].z), fabsf(v[j].w))); }
                    am = wave_max(am); const float inv = am > 0.f ? 127.0f / am : 0.f;
                    if (lane == 0) HLS[m] = am > 0.f ? am * (1.0f / 127.0f) : 1.0f;
                    unsigned* o4 = (unsigned*)((signed char*)HL + (size_t)m * D) + lane;
                    const int rowl = wave * 4 + r4;
#pragma unroll
                    for (int j = 0; j < 4; ++j) { o4[64 * j] = q8x4(v[j], inv);
                        u32x2 hi; hi.x = pk2(v[j].x, v[j].y); hi.y = pk2(v[j].z, v[j].w);
                        u32x2 lo; lo.x = pk2(v[j].x - bflo(hi.x), v[j].y - bfhi(hi.x)); lo.y = pk2(v[j].z - bflo(hi.y), v[j].w - bfhi(hi.y));
                        *(LAS u32x2*)(AH + rowl * 2064 + (4 * lane + 256 * j) * 2) = hi; *(LAS u32x2*)(AL + rowl * 2064 + (4 * lane + 256 * j) * 2) = lo; }
                }
                __syncthreads();
                f32x16 acc;
#pragma unroll
                for (int r = 0; r < 16; ++r) acc[r] = 0.f;
#pragma unroll
                for (int s = 0; s < 8; ++s) { const int ko = (128 * wave + 16 * s + 8 * h5) * 2;
                    const bf16x8 ah = *(const LAS bf16x8*)(AH + l31 * 2064 + ko), al = *(const LAS bf16x8*)(AL + l31 * 2064 + ko);
                    acc = MFMA32(ah, bh[s], acc); acc = MFMA32(ah, bl[s], acc); acc = MFMA32(al, bh[s], acc); }
                __syncthreads();
#pragma unroll
                for (int r = 0; r < 16; ++r) RED[(wave * 32 + crow(r, h5)) * 32 + l31] = acc[r];
                __syncthreads();
#pragma unroll
                for (int i = 0; i < 2; ++i) { const int idx = tid + 512 * i, t = idx >> 5, e = idx & 31; float sum = args.in[I_RB][e];
#pragma unroll
                    for (int w8 = 0; w8 < 8; ++w8) sum += RED[(w8 * 32 + t) * 32 + e];
                    LOG[t * 33 + e] = sum; }
                __syncthreads();
#pragma unroll
                for (int r4 = 0; r4 < 4; ++r4) {
                    const int m = m0 + r4; float tv[4]; int ti[4]; float cur = lane < 32 ? LOG[(wave * 4 + r4) * 33 + lane] : -3.0e38f;
#pragma unroll
                    for (int k = 0; k < 4; ++k) { float mx = cur;
#pragma unroll
                        for (int o = 1; o < 64; o <<= 1) mx = fmaxf(mx, __shfl_xor(mx, o));
                        const unsigned long long msk = __ballot(cur == mx && lane < 32); const int sel = __ffsll((long long)msk) - 1; tv[k] = mx; ti[k] = sel; if (lane == sel) cur = -3.0e38f; }
                    const float e1 = __expf(tv[1] - tv[0]), e2 = __expf(tv[2] - tv[0]), e3 = __expf(tv[3] - tv[0]); const float inv = 1.0f / (1.0f + e1 + e2 + e3);
                    if (lane < 4) { const int k = lane; const int ee = k == 0 ? ti[0] : k == 1 ? ti[1] : k == 2 ? ti[2] : ti[3]; const float gg = (k == 0 ? 1.0f : k == 1 ? e1 : k == 2 ? e2 : e3) * inv;
                        const int lp = __hip_atomic_fetch_add(&CNT[ee], 1, __ATOMIC_RELAXED, __HIP_MEMORY_SCOPE_WORKGROUP);
                        EIDX[m * 4 + k] = ee; GATE[m * 4 + k] = gg; LPOS[m * 4 + k] = lp; }
                }
            }
            __syncthreads();
            if (tid < 32) BCNT[blk * 32 + tid] = CNT[tid];
        }
    }
    SEAM(ST_M0); STAMP(9);
#define MOE_TABLES() do { \
        LAS int* TB = (LAS int*)lds;                   \
        LAS int* EB = (LAS int*)(lds + 32768);         \
        __syncthreads(); \
        for (int i = tid; i < NRANGE * WBR * 32; i += NTHR) TB[i] = BCNT[i]; \
        __syncthreads(); \
        if (tid < NRANGE * 32) { const int r = tid >> 5, e = tid & 31; int run = 0; _Pragma("unroll 4") for (int wb = 0; wb < WBR; ++wb) { const int c_ = TB[(r * WBR + wb) * 32 + e]; TB[(r * WBR + wb) * 32 + e] = run; run += c_; } EB[128 + tid] = run; } \
        __syncthreads(); \
        if (tid < NRANGE) { int run = 0; _Pragma("unroll 1") for (int e = 0; e < 32; ++e) { EB[tid * 32 + e] = run; run += (EB[128 + tid * 32 + e] + 255) & ~255; } EB[256 + tid] = run >> 8; } \
        __syncthreads(); \
        for (int i = tid; i < NRANGE * WBR * 32; i += NTHR) { const int r = i / (WBR * 32), e = i & 31; TB[i] += EB[r * 32 + e]; } \
        __syncthreads(); } while (0)
#define MOE_SCATTER(r) do { \
        LAS int* TB = (LAS int*)lds; LAS int* EB = (LAS int*)(lds + 32768); \
        for (int idx = bid * NTHR + tid; idx < RTOK * 4; idx += G * NTHR) { const int m = (r) * RTOK + (idx >> 2), k = idx & 3; const int wb = (idx >> 2) >> 8; \
            const int e = EIDX[m * 4 + k]; const int row = TB[((r) * WBR + wb) * 32 + e] + LPOS[m * 4 + k]; AROW[m * 4 + k] = row; HPS[row] = HLS[m]; ROWTOK[row] = m; } \
        for (int e = bid; e < 32; e += G) { const int tot = EB[128 + (r) * 32 + e], base = EB[(r) * 32 + e]; const int npad = ((tot + 255) & ~255) - tot; \
            for (int i = tid; i < npad; i += NTHR) { HPS[base + tot + i] = 0.f; ROWTOK[base + tot + i] = -1; } } } while (0)
    if (PH_EN(10) && IN(ST_M1)) for (int rep = 0; rep < DUP_N(10); ++rep) {
        const int tid = opaque_tid(), lane = tid & 63, wave = __builtin_amdgcn_readfirstlane(tid >> 6), gw = bid * NWAVES + wave; (void)lane; (void)gw; (void)rep;
        MOE_TABLES();
        if (bid == 0) {
            LAS int* TB = (LAS int*)lds; LAS int* EB = (LAS int*)(lds + 32768);
            for (int i = tid; i < NRANGE * WBR * 32; i += NTHR) BBASE[i] = TB[i];
            if (tid < NRANGE) NTILE[tid] = EB[256 + tid];
            for (int i = tid; i < NRANGE * 32; i += NTHR) { const int r = i >> 5, e = i & 31; const int base = EB[r * 32 + e], nt = (EB[128 + i] + 255) >> 8; for (int t = 0; t < nt; ++t) TILEE[r * TILE_LD + (base >> 8) + t] = e; }
        }
        MOE_SCATTER(0);
    }
    SEAM(ST_M1); STAMP(10);
    for (int r = 0; r < NRANGE; ++r) {
        const int s0 = ST_RNG + 3 * r;
        if (PH_EN(11) && IN(s0 + 0)) for (int rep = 0; rep < DUP_N(11); ++rep) {
        const int tid = opaque_tid(), lane = tid & 63, wave = __builtin_amdgcn_readfirstlane(tid >> 6), gw = bid * NWAVES + wave; (void)lane; (void)gw; (void)rep;
            pg8::Gemm g{HL, W1T, 512, 512, 512, HPS, W1S, ROWTOK}; pg8::MoeOrder S{TILEE + r * TILE_LD, NTILE[r], 8, G, bid}; EpiHid E{(unsigned char*)HID, args.in[I_B1]};
            STAGGER(STAG_M2); pg8::gemm_phase<EpiHid, pg8::MoeOrder, 1, true>(lds, g, S, E);
        }
        SEAM(s0 + 0); STAMP(11);
        if (PH_EN(12) && IN(s0 + 1)) for (int rep = 0; rep < DUP_N(12); ++rep) {
        const int tid = opaque_tid(), lane = tid & 63, wave = __builtin_amdgcn_readfirstlane(tid >> 6), gw = bid * NWAVES + wave; (void)lane; (void)gw; (void)rep;
            pg8::Gemm g{HID, W2T, 512, 512, 512, nullptr, W2S, nullptr}; pg8::MoeOrder S{TILEE + r * TILE_LD, NTILE[r], 4, G, bid}; EpiY E{(unsigned char*)YPAD, args.in[I_B2]};
            STAGGER(STAG_M3); pg8::gemm_phase<EpiY, pg8::MoeOrder, 2>(lds, g, S, E);
        }
        SEAM(s0 + 1); STAMP(12);
        if (PH_EN(13) && IN(s0 + 2)) for (int rep = 0; rep < DUP_N(13); ++rep) {
        const int tid = opaque_tid(), lane = tid & 63, wave = __builtin_amdgcn_readfirstlane(tid >> 6), gw = bid * NWAVES + wave; (void)lane; (void)gw; (void)rep;
            for (int mb = r * RTOK + gw * 16; mb < (r + 1) * RTOK; mb += NGW * 16) {
                const int arow_l = AROW[mb * 4 + lane]; const float gate_l = GATE[mb * 4 + lane];
                const int b = mb >> 13;
                f32x4 g2v[4], fgv[4];
#pragma unroll
                for (int j = 0; j < 4; ++j) { g2v[j] = *(const f32x4*)(mod + b * 6144 + 5120 + 4 * lane + 256 * j); fgv[j] = *(const f32x4*)(args.in[I_FG] + 4 * lane + 256 * j); }
                f32x4 xv[2][4]; unsigned yw[2][4][4];
                auto issue = [&](int i, f32x4 (&xx)[4], unsigned (&yy)[4][4]) { const int m = mb + i;
#pragma unroll
                    for (int j = 0; j < 4; ++j) xx[j] = __builtin_nontemporal_load((const f32x4*)(args.out + (size_t)m * D) + lane + 64 * j);
#pragma unroll
                    for (int k = 0; k < 4; ++k) { const int row = __shfl(arow_l, 4 * i + k); const unsigned* yp = (const unsigned*)((const unsigned char*)YPAD + (size_t)row * D) + lane;
#pragma unroll
                        for (int j = 0; j < 4; ++j) yy[k][j] = __builtin_nontemporal_load(yp + 64 * j); } };
                auto finish = [&](int i, const f32x4 (&xx)[4], const unsigned (&yy)[4][4]) { const int m = mb + i; f32x4 v[4]; float ss = 0.f;
#pragma unroll
                    for (int j = 0; j < 4; ++j) { f32x4 y = {0.f, 0.f, 0.f, 0.f};
#pragma unroll
                        for (int k = 0; k < 4; ++k) { const float gk = __shfl(gate_l, 4 * i + k); const int w = (int)yy[k][j]; const f32x2 lo = __builtin_amdgcn_cvt_pk_f32_fp8(w, false), hi = __builtin_amdgcn_cvt_pk_f32_fp8(w, true);
                            y.x += gk * lo.x; y.y += gk * lo.y; y.z += gk * hi.x; y.w += gk * hi.y; }
                        v[j] = xx[j] + g2v[j] * y; ss += (v[j].x * v[j].x + v[j].y * v[j].y) + (v[j].z * v[j].z + v[j].w * v[j].w); }
                    const float rstd = 1.0f / sqrtf(wave_sum(ss) * (1.0f / D) + EPS);
#pragma unroll
                    for (int j = 0; j < 4; ++j) ((f32x4*)((DRY(13) ? (float*)(ws + WS_DUMMY) + (size_t)((m - r * RTOK) & 16383) * D : args.out + (size_t)m * D)) + lane)[64 * j] = v[j] * rstd * fgv[j]; };
                issue(0, xv[0], yw[0]);
#pragma unroll 1
                for (int i = 0; i < 16; i += 2) {
                    issue(i + 1, xv[1], yw[1]);
                    finish(i, xv[0], yw[0]);
                    if (i + 2 < 16) issue(i + 2, xv[0], yw[0]);
                    finish(i + 1, xv[1], yw[1]);
                }
            }
            if (r + 1 < NRANGE) { MOE_TABLES(); MOE_SCATTER(r + 1); }
        }
        if (r + 1 < NRANGE) SEAM(s0 + 2);
        STAMP(13);
    }
#if MK_PROBE
    {
        unsigned* PR = (unsigned*)(ws + WS_CTL) + 8192;
        xcd_barrier(bar);
        if (bid == 0 && threadIdx.x == 0) { PR[0] = MISC[16 + PROBE_SEL1]; PR[1] = MISC[16 + PROBE_SEL2]; }
        xcd_barrier(bar);
        const float d1 = (float)__hip_atomic_load(PR, __ATOMIC_RELAXED, __HIP_MEMORY_SCOPE_AGENT) * 0.01f, d2 = (float)__hip_atomic_load(PR + 1, __ATOMIC_RELAXED, __HIP_MEMORY_SCOPE_AGENT) * 0.01f;
        const float sc = 1.0f + sqrtf(d1 * 1e-4f);
        for (size_t i = (size_t)bid * NTHR + threadIdx.x; i < (size_t)NTOK * D / 4; i += (size_t)G * NTHR) { f32x4 v = ((f32x4*)args.out)[i]; v *= sc; if (i == 0) v.x += d2 * 0.25f; ((f32x4*)args.out)[i] = v; }
    }
#endif
#undef IN
#undef SEAM
}

extern "C" void kernel_launch(void* const* d_in, const int* in_sizes, int n_in, void* d_out, int out_size, void* d_ws, size_t ws_size, hipStream_t stream) {
    static int grid = 0;
    if (grid == 0) {
        if (n_in != 26 || in_sizes[0] != NTOK * D || out_size != NTOK * D || ws_size < WS_END) { fprintf(stderr, "kernel_launch: unexpected shapes (n_in %d, in0 %d, out %d, ws %zu); nothing launched\n", n_in, n_in > 0 ? in_sizes[0] : -1, out_size, ws_size); grid = -1; return; }
        int dev = 0, cus = 0, per_cu = 0;
        if (hipGetDevice(&dev) != hipSuccess || hipDeviceGetAttribute(&cus, hipDeviceAttributeMultiprocessorCount, dev) != hipSuccess) { grid = -1; return; }
        if (hipFuncSetAttribute((const void*)fwd_kernel, hipFuncAttributeMaxDynamicSharedMemorySize, LDS_BYTES) != hipSuccess) { fprintf(stderr, "kernel_launch: hipFuncSetAttribute failed\n"); grid = -1; return; }
        if (hipOccupancyMaxActiveBlocksPerMultiprocessor(&per_cu, (const void*)fwd_kernel, NTHR, LDS_BYTES) != hipSuccess || per_cu < 1) fprintf(stderr, "kernel_launch: occupancy query reports %d\n", per_cu);
        (void)hipGetLastError();
        grid = cus;
    }
    if (grid < 0) return;
    if (hipMemsetAsync((char*)d_ws + WS_CTL, 0, CTL_ZERO_BYTES, stream) != hipSuccess) return;
    Args a{};
    for (int i = 0; i < 26; ++i) a.in[i] = (const float*)d_in[i];
    a.out = (float*)d_out; a.ws = (unsigned char*)d_ws;
#if MK_PER_PHASE
    for (int s = 0; s < ST_END; ++s) { a.lo = s; a.hi = s + 1; hipLaunchKernelGGL(fwd_kernel, dim3(grid), dim3(NTHR), LDS_BYTES, stream, a); }
#else
    a.lo = 0; a.hi = ST_END;
    hipLaunchKernelGGL(fwd_kernel, dim3(grid), dim3(NTHR), LDS_BYTES, stream, a);
#endif
    const hipError_t le = hipPeekAtLastError();
    if (le != hipSuccess) fprintf(stderr, "kernel_launch: launch failed: %s\n", hipGetErrorName(le));
}
```

```cpp
#include <hip/hip_runtime.h>
#include <cstdio>
#include <cstdint>

#ifndef MK_PER_PHASE
#define MK_PER_PHASE 0
#endif

#ifndef MK_PROBE
#define MK_PROBE 0
#endif
#ifndef PROBE_SEL1
#define PROBE_SEL1 3
#endif
#ifndef PROBE_SEL2
#define PROBE_SEL2 4
#endif
#ifndef MK_DUP
#define MK_DUP 0u
#endif
#define DUP_N(k) ((((MK_DUP) >> (k)) & 1u) ? 2 : 1)
#define DRY(k) ((((MK_DUP) >> (k)) & 1u) && rep == 0)
#ifndef MK_DRYMODE
#define MK_DRYMODE 0
#endif
#ifndef STAG_B
#define STAG_B 0
#endif
#ifndef STAG_M2
#define STAG_M2 0
#endif
#ifndef STAG_M3
#define STAG_M3 0
#endif
#define STAGGER(n) do { const int slot_ = (bid >> 3) & 3; for (int i_ = 0; i_ < slot_ * (n); ++i_) __builtin_amdgcn_s_sleep(127); } while (0)
#ifndef MK_PHASES
#define MK_PHASES 0xFFFFu
#endif
#define PH_EN(k) (((MK_PHASES) >> (k)) & 1u)
#define LAS __attribute__((address_space(3)))
#define GAS __attribute__((address_space(1)))
typedef unsigned short bf16;
typedef short bf16x8 __attribute__((ext_vector_type(8)));
typedef short s16x4 __attribute__((ext_vector_type(4)));
typedef float f32x2 __attribute__((ext_vector_type(2)));
typedef float f32x4 __attribute__((ext_vector_type(4)));
typedef float f32x16 __attribute__((ext_vector_type(16)));
typedef unsigned u32x2 __attribute__((ext_vector_type(2)));
typedef unsigned u32x4 __attribute__((ext_vector_type(4)));

constexpr int D = 1024, NB = 8, SEQ = 8192, NTOK = NB * SEQ, CTXL = 256, NCTX = NB * CTXL, DIN = 10240, ZLD = 10240 + 128;
constexpr int NROWS_HL = NTOK + NCTX;
constexpr int GB = 2, NGRP = NB / GB, GROWS = GB * SEQ;
constexpr int NEXP = 32, TOPK = 4, DEXP = 1024;
constexpr int NRANGE = 1, RTOK = NTOK / NRANGE, WBR = RTOK / 256;
constexpr int RROWS = 4 * RTOK + 32 * 256, RTILES = RROWS / 256, TILE_LD = RTILES + 32;
constexpr float EPS = 1e-6f;
constexpr float K_SCALE = 0.08838834764831845f;
constexpr int C_XR = 0, C_GR = 1024, C_Q = 2048, C_K = 3072, C_V = 4096, C_GS = 6144, C_GA = 8192, C_GB = 9216;
constexpr int ZC_LD = 4096, ZC_XR = 0, ZC_K = 1024, ZC_V = 2048;

constexpr size_t MiB = 1u << 20;
constexpr size_t WS_CTL = 0, CTL_ZERO_BYTES = 1 * MiB;
constexpr size_t WS_MOD = 1 * MiB;
constexpr size_t WS_ROPE = 1 * MiB + 256 * 1024;
constexpr size_t WS_RWB = 1 * MiB + 512 * 1024;
constexpr size_t WS_CARRY = 2 * MiB;
constexpr size_t WS_HLS = 7 * MiB;
constexpr size_t WS_WINS = 7 * MiB + 320 * 1024;
constexpr size_t WS_W1S = 7 * MiB + 384 * 1024;
constexpr size_t WS_HPS = 880 * MiB;
constexpr size_t WS_WFS = 7 * MiB + 640 * 1024;
constexpr size_t WS_EIDX = 8 * MiB, WS_GATE = 9 * MiB, WS_LPOS = 10 * MiB, WS_AROW = 11 * MiB;
constexpr size_t WS_BCNT = 12 * MiB;
constexpr size_t WS_BBASE = 12 * MiB + 64 * 1024;
constexpr size_t WS_TILEE = 12 * MiB + 128 * 1024;
constexpr size_t WS_NTILE = 12 * MiB + 192 * 1024;
constexpr size_t WS_WG = 14 * MiB;
constexpr size_t WS_WRNN = 16 * MiB, WS_WOUT = 22 * MiB, WS_WIN = 24 * MiB;
constexpr size_t WS_HL = 44 * MiB;
constexpr size_t WS_ZC = 176 * MiB;
constexpr size_t WS_CTXU = 192 * MiB;
constexpr size_t WS_Z = 208 * MiB;
constexpr size_t WS_ST = 536 * MiB;
constexpr size_t WS_T1 = 664 * MiB, WS_MG = 696 * MiB;
constexpr size_t WS_W1T = 736 * MiB;
constexpr size_t WS_W2T = 848 * MiB;
constexpr size_t WS_HPAD = 208 * MiB, WS_HID = 210 * MiB, WS_YPAD = 474 * MiB;
constexpr size_t WS_AR = 912 * MiB, WS_AT = 944 * MiB;
constexpr size_t WS_DUMMY = 912 * MiB;
constexpr size_t WS_END = 1024 * MiB;
constexpr int CW_BAR = 4096;

constexpr int LDS_BYTES = 147456;
constexpr int MISC_OFF = 147456 - 256;
constexpr int NWAVES = 8, NTHR = 512;

__device__ __forceinline__ unsigned f2bf(float f) { unsigned u = __builtin_bit_cast(unsigned, f); return (u + 0x7fffu + ((u >> 16) & 1u)) >> 16; }
typedef __bf16 hwbf16x2 __attribute__((ext_vector_type(2)));
__device__ __forceinline__ unsigned pk2(float lo, float hi) { const f32x2 v = {lo, hi}; return __builtin_bit_cast(unsigned, __builtin_convertvector(v, hwbf16x2)); }
__device__ __forceinline__ float bflo(unsigned w) { return __builtin_bit_cast(float, w << 16); }
__device__ __forceinline__ float bfhi(unsigned w) { return __builtin_bit_cast(float, w & 0xffff0000u); }
__device__ __forceinline__ float bf2f(unsigned short h) { return __builtin_bit_cast(float, ((unsigned)h) << 16); }
__device__ __forceinline__ float sigmoidf_(float x) { return __builtin_amdgcn_rcpf(1.0f + __expf(-x)); }
__device__ __forceinline__ float wave_sum(float v) {
#pragma unroll
    for (int o = 1; o < 64; o <<= 1) v += __shfl_xor(v, o);
    return v;
}
template <int CTRL> __device__ __forceinline__ float dpp_f(float v) { return __builtin_bit_cast(float, __builtin_amdgcn_update_dpp(0, __builtin_bit_cast(int, v), CTRL, 0xF, 0xF, true)); }
__device__ __forceinline__ float row16_sum(float v) { v += dpp_f<0xB1>(v); v += dpp_f<0x4E>(v); v += dpp_f<0x141>(v); v += dpp_f<0x140>(v); return v; }
__device__ __forceinline__ float wave_max(float v) {
#pragma unroll
    for (int o = 1; o < 64; o <<= 1) v = fmaxf(v, __shfl_xor(v, o));
    return v;
}
__device__ __forceinline__ unsigned q8x4(f32x4 v, float inv) {
    const int a = (int)rintf(v.x * inv), b = (int)rintf(v.y * inv), c = (int)rintf(v.z * inv), d = (int)rintf(v.w * inv);
    return ((unsigned)a & 0xffu) | (((unsigned)b & 0xffu) << 8) | (((unsigned)c & 0xffu) << 16) | (((unsigned)d & 0xffu) << 24);
}
#define LDS_WAIT() asm volatile("s_waitcnt lgkmcnt(0)" ::: "memory")
__device__ __forceinline__ int opaque_tid() { int t = threadIdx.x; asm volatile("" : "+v"(t)); return t; }
template <class T> __device__ __forceinline__ T* opaque_ptr(T* p) { unsigned long long u = (unsigned long long)p; asm volatile("" : "+s"(u)); return (T*)u; }

namespace pg8 {
constexpr int BM = 256, BK = 64, HALF = 128, HTB = HALF * BK * 2, STAGE_BYTES = 8 * HTB, NXCD = 8, WGM = 8;
__host__ __device__ __forceinline__ int lds_byte(int r, int c) { const int st = (r >> 4) * 2 + (c >> 5), rr = r & 15, cc = c & 31, ob = rr * 64 + cc * 2; return st * 1024 + (ob ^ (((ob >> 9) & 1) << 5)); }
__host__ __device__ __forceinline__ void stage_rc(int b, int& R, int& C) { const int st = b / 1024, sb = b % 1024, swz = sb ^ (((sb >> 9) & 1) << 5); R = (st >> 1) * 16 + swz / 64; C = (st & 1) * 32 + (swz % 64) / 2; }
__host__ __device__ __forceinline__ int perm32(int rho) { const int n = rho >> 4, i = rho & 15; return 8 * (i >> 2) + 4 * n + (i & 3); }
struct Unit { int pm, pn; int koff = 0, nt = 0; };
struct Gemm { const bf16* A; const bf16* Bt; int lda, ldb, K; const float* SA; const float* SB; const int* RT; };
struct StaticOrder {
    int nM, nN, nwg, G, c;
    __device__ void init(int nM_, int nN_, int G_, int c_) { nM = nM_; nN = nN_; nwg = nM * nN; G = G_; c = c_; }
    __device__ bool next(int i, Unit& u) const {
        const long L = (long)i * G + c; if (L >= nwg) return false;
        int wgid = (int)L; { const int q = nwg / NXCD, r = nwg % NXCD, xcd = wgid % NXCD, off = wgid / NXCD; wgid = (xcd < r ? xcd * (q + 1) : r * (q + 1) + (xcd - r) * q) + off; }
        const int nig = WGM * nN, gid = wgid / nig, fm = gid * WGM, gsz = (nM - fm) < WGM ? (nM - fm) : WGM;
        u.pm = fm + ((wgid % nig) % gsz); u.pn = (wgid % nig) / gsz; return true;
    }
};
struct CtxOrder {
    int G, c;
    __device__ bool next(int i, Unit& u) const { const int L = i * G + c; if (L >= 128) return false; const int j = L >> 3; u.pm = 256 + (L & 7); u.pn = j < 4 ? j : j + 8; return true; }
};
struct FOrder {
    StaticOrder so;
    __device__ bool next(int i, Unit& u) const { Unit t; if (!so.next(i >> 1, t)) return false; u.pm = t.pm; u.pn = t.pn; u.koff = (i & 1) ? 1024 : 0; u.nt = (i & 1) ? 32 : 16; return true; }
};
struct MoeOrder {
    const int* tile_e; int ntiles, npn, G, c;
    __device__ bool next(int i, Unit& u) const {
        if ((G & 7) == 0 && ((G >> 3) % npn) == 0) { const int x = c & 7, y = c >> 3, T = (G >> 3) / npn; const int ti = (i * 8 + x) * T + y / npn, pl = y % npn;
            if (ti >= ntiles) return false; u.pm = ti; u.pn = tile_e[ti] * npn + pl; return true; }
        const long L = (long)i * G + c; if (L >= (long)ntiles * npn) return false; const int ti = (int)(L / npn), pl = (int)(L % npn);
        u.pm = ti; u.pn = tile_e[ti] * npn + pl; return true; }
};

typedef int i32x4 __attribute__((ext_vector_type(4)));
typedef int i32x8 __attribute__((ext_vector_type(8)));
template <int MODE> struct Frag { bf16x8 v[2]; };
template <> struct Frag<2> { i32x8 w; };
template <class Epi, class Sched, int MODE = 0, bool GATHER = false>
__device__ __forceinline__ void gemm_phase(LAS unsigned char* lds, const Gemm g, const Sched& S, const Epi& E) {
    const int tid = opaque_tid(), wid = __builtin_amdgcn_readfirstlane(tid >> 6), lane = tid & 63, wr = wid >> 2, wc = wid & 3, fr = lane & 15, fq = lane >> 4;
    const int K = g.K, nt = K / BK;
    const bf16* gA = opaque_ptr(g.A); const bf16* gBt = opaque_ptr(g.Bt);
    unsigned voffA[2], voffB[2]; int RA[2]; unsigned CA[2];
#pragma unroll
    for (int i = 0; i < 2; ++i) { int R, C; stage_rc(tid * 16 + i * 8192, R, C); const int Rb = 64 * (R >> 5) + (Epi::PERM ? perm32(R & 31) : (R & 31));
        voffA[i] = (unsigned)(R * g.lda + C) * 2u; voffB[i] = (unsigned)(Rb * g.ldb + C) * 2u; RA[i] = R; CA[i] = (unsigned)C * 2u; }
    (void)RA; (void)CA;
    const size_t kstep = (size_t)(BK * 2);
    const size_t hstepA = GATHER ? (size_t)0 : (size_t)HALF * g.lda * 2, hstepB = (size_t)32 * g.ldb * 2;
    unsigned vC[2][2], vN[2][2];
    auto gather_offs = [&](int pm, unsigned (&v)[2][2]) {
#pragma unroll
        for (int hh = 0; hh < 2; ++hh)
#pragma unroll
            for (int i = 0; i < 2; ++i) { int tok = g.RT[pm * 256 + hh * 128 + RA[i]]; tok = tok < 0 ? 0 : tok; v[hh][i] = (unsigned)tok * (unsigned)(g.lda * 2) + CA[i]; } };
    const size_t tstepA = (size_t)BM * g.lda * 2, tstepB = (size_t)BM * g.ldb * 2;
    const unsigned ldsw = (unsigned)wid * 1024u;
    const int aoff = lds_byte(wr * 64 + fr, fq * 8), boff = lds_byte(wc * 32 + fr, fq * 8);
#define PG8_SA(b, h) (((b) * 2 + (h)) * HTB)
#define PG8_SB(b, h) ((4 + (b) * 2 + (h)) * HTB)
#define PG8_STAGE(bufoff, gbase, voff) do { _Pragma("unroll") for (int _i = 0; _i < 2; ++_i) \
        __builtin_amdgcn_global_load_lds((const unsigned*)((const char*)(gbase) + (voff)[_i]), (LAS unsigned*)(lds + (bufoff) + ldsw + _i * 8192), 16, 0, 0); } while (0)
#define PG8_STAGE_A(bufoff, gbase, hh, nx) do { if constexpr (GATHER) { _Pragma("unroll") for (int _i = 0; _i < 2; ++_i) { const unsigned _o = (nx) ? vN[hh][_i] : vC[hh][_i]; \
        __builtin_amdgcn_global_load_lds((const unsigned*)((const char*)(gbase) + _o), (LAS unsigned*)(lds + (bufoff) + ldsw + _i * 8192), 16, 0, 0); } } else PG8_STAGE(bufoff, gbase, voffA); } while (0)
#define PG8_LD1(dst, p) do { if constexpr (MODE == 2) (dst).w = __builtin_shufflevector(*(const LAS i32x4*)(p), *(const LAS i32x4*)((p) + 1024), 0, 1, 2, 3, 4, 5, 6, 7); \
        else { (dst).v[0] = *(const LAS bf16x8*)(p); (dst).v[1] = *(const LAS bf16x8*)((p) + 1024); } } while (0)
#define PG8_LDA(dst, b, h) do { _Pragma("unroll") for (int m = 0; m < 4; ++m) PG8_LD1(dst[m], lds + PG8_SA(b, h) + aoff + m * 2048); } while (0)
#define PG8_LDB(dst, b, h) do { _Pragma("unroll") for (int n = 0; n < 2; ++n) PG8_LD1(dst[n], lds + PG8_SB(b, h) + boff + n * 2048); } while (0)
#define PG8_MMA(ai, bj, At, Bt) do { __builtin_amdgcn_s_setprio(1); _Pragma("unroll") for (int m = 0; m < 4; ++m) _Pragma("unroll") for (int n = 0; n < 2; ++n) { \
        if constexpr (MODE == 2) {   \
              \
            asm volatile("v_mfma_scale_f32_16x16x128_f8f6f4 %0, %1, %2, %0, %3, %3 op_sel_hi:[0,0,0]" : "+v"(acc[ai][bj][m][n]) : "v"(Bt[n].w), "v"(At[m].w), "v"(sc1)); \
        } else { _Pragma("unroll") for (int k = 0; k < 2; ++k) \
        { if constexpr (MODE == 1) acc[ai][bj][m][n] = __builtin_bit_cast(f32x4, __builtin_amdgcn_mfma_i32_16x16x64_i8(__builtin_bit_cast(i32x4, Bt[n].v[k]), __builtin_bit_cast(i32x4, At[m].v[k]), __builtin_bit_cast(i32x4, acc[ai][bj][m][n]), 0, 0, 0)); \
          else acc[ai][bj][m][n] = __builtin_amdgcn_mfma_f32_16x16x32_bf16(Bt[n].v[k], At[m].v[k], acc[ai][bj][m][n], 0, 0, 0); } } } __builtin_amdgcn_s_setprio(0); } while (0)
#define PG8_WAIT_V(n) asm volatile("s_waitcnt vmcnt(" #n ")" ::: "memory")
#define PG8_WAIT_L(n) asm volatile("s_waitcnt lgkmcnt(" #n ")" ::: "memory")
#define PG8_BAR __builtin_amdgcn_s_barrier()
#define PG8_SCHED __builtin_amdgcn_sched_barrier(0)
    Unit cur, nxt; int ui = 0;
    if (!S.next(0, cur)) return;
    constexpr int SC_OFF = 8 * HTB;
    auto stage_scales = [&](const Unit& u, int par) {
        if constexpr (MODE != 0) { if (MODE == 1 || wid >= 4) { const float* sp = wid < 4 ? g.SA + u.pm * 256 + tid : g.SB + u.pn * 256 + (tid - 256);
            __builtin_amdgcn_global_load_lds((const unsigned*)sp, (LAS unsigned*)(lds + SC_OFF + par * 2048 + wid * 256), 4, 0, 0); } } };
    stage_scales(cur, 0);
    f32x4 acc[2][2][4][2];
#pragma unroll
    for (int a = 0; a < 2; ++a)
#pragma unroll
        for (int b = 0; b < 2; ++b)
#pragma unroll
            for (int m = 0; m < 4; ++m)
#pragma unroll
                for (int n = 0; n < 2; ++n) acc[a][b][m][n] = (f32x4){0.f, 0.f, 0.f, 0.f};
    Frag<MODE> At[4], B0[2], B1[2]; const int sc1 = 0x7f7f7f7f; (void)sc1;
    const char* cA = GATHER ? (const char*)gA : (const char*)gA + (size_t)cur.pm * tstepA + (size_t)cur.koff * 2; const char* cB = (const char*)gBt + (size_t)cur.pn * tstepB + (size_t)cur.koff * 2;
    if constexpr (GATHER) gather_offs(cur.pm, vC);
    PG8_STAGE(PG8_SB(0, 0), cB, voffB); PG8_STAGE(PG8_SB(0, 1), cB + hstepB, voffB); PG8_STAGE_A(PG8_SA(0, 0), cA, 0, false); PG8_STAGE_A(PG8_SA(0, 1), cA + hstepA, 1, false);
    if (wr == 1) PG8_BAR;
    PG8_WAIT_V(2); PG8_BAR;
    PG8_STAGE(PG8_SB(1, 0), cB + kstep, voffB); PG8_STAGE_A(PG8_SA(1, 0), cA + kstep, 0, false); PG8_STAGE(PG8_SB(1, 1), cB + hstepB + kstep, voffB);
    PG8_WAIT_V(6); PG8_BAR;
    for (;;) {
        const bool has_next = S.next(ui + 1, nxt);
        const char* nA = (has_next && !GATHER) ? (const char*)gA + (size_t)nxt.pm * tstepA + (size_t)nxt.koff * 2 : cA; const char* nB = has_next ? (const char*)gBt + (size_t)nxt.pn * tstepB + (size_t)nxt.koff * 2 : cB;
        const int ntc = cur.nt ? cur.nt : nt;
        if constexpr (GATHER) { if (has_next) gather_offs(nxt.pm, vN); else {
#pragma unroll
            for (int hh = 0; hh < 2; ++hh)
#pragma unroll
                for (int i = 0; i < 2; ++i) vN[hh][i] = vC[hh][i]; } }
#pragma unroll 1
        for (int t = 0; t < ntc; t += 2) {
            const bool last = (t == ntc - 2);
            const char* a1 = cA + (size_t)(t + 1) * kstep;
            const char* a2 = last ? nA : cA + (size_t)(t + 2) * kstep; const char* b2 = last ? nB : cB + (size_t)(t + 2) * kstep;
            const char* a3 = a2 + kstep; const char* b3 = b2 + kstep;
            PG8_LDB(B0, 0, 0); PG8_LDB(B1, 0, 1); PG8_SCHED; PG8_LDA(At, 0, 0); PG8_STAGE_A(PG8_SA(1, 1), a1 + hstepA, 1, false);
            PG8_WAIT_V(8); PG8_WAIT_L(0); PG8_BAR; PG8_MMA(0, 0, At, B0); PG8_MMA(0, 1, At, B1); PG8_SCHED; PG8_BAR; PG8_SCHED;
            PG8_LDA(At, 0, 1); PG8_STAGE(PG8_SB(0, 0), b2, voffB); PG8_STAGE(PG8_SB(0, 1), b2 + hstepB, voffB); PG8_STAGE_A(PG8_SA(0, 0), a2, 0, last);
            PG8_WAIT_V(8); PG8_WAIT_L(0); PG8_BAR; PG8_MMA(1, 0, At, B0); PG8_MMA(1, 1, At, B1); PG8_SCHED; PG8_BAR; PG8_SCHED;
            PG8_LDB(B0, 1, 0); PG8_LDB(B1, 1, 1); PG8_SCHED; PG8_LDA(At, 1, 0); PG8_STAGE_A(PG8_SA(0, 1), a2 + hstepA, 1, last);
            PG8_WAIT_V(8); PG8_WAIT_L(0); PG8_BAR; PG8_MMA(0, 0, At, B0); PG8_MMA(0, 1, At, B1); PG8_SCHED; PG8_BAR; PG8_SCHED;
            PG8_LDA(At, 1, 1); PG8_STAGE(PG8_SB(1, 0), b3, voffB); PG8_STAGE(PG8_SB(1, 1), b3 + hstepB, voffB); PG8_STAGE_A(PG8_SA(1, 0), a3, 0, last);
            PG8_WAIT_V(8); PG8_WAIT_L(0); PG8_BAR; PG8_MMA(1, 0, At, B0); PG8_MMA(1, 1, At, B1); PG8_SCHED; PG8_BAR; PG8_SCHED;
        }
        if (wr == 0) PG8_BAR;
        if constexpr (MODE == 2) {
            int fq_ = fq; asm volatile("" : "+v"(fq_));
            const LAS float* sb = (const LAS float*)(lds + SC_OFF + (ui & 1) * 2048) + 256 + wc * 64 + (Epi::PERM ? 8 : 4) * fq_;
            f32x4 cs[2][2];
#pragma unroll
            for (int b = 0; b < 2; ++b)
#pragma unroll
                for (int n = 0; n < 2; ++n) cs[b][n] = *(const LAS f32x4*)(sb + b * 32 + (Epi::PERM ? 4 : 16) * n);
#pragma unroll
            for (int a = 0; a < 2; ++a)
#pragma unroll
                for (int b = 0; b < 2; ++b)
#pragma unroll
                    for (int m = 0; m < 4; ++m)
#pragma unroll
                        for (int n = 0; n < 2; ++n) acc[a][b][m][n] *= cs[b][n];
        }
        if constexpr (MODE == 1) {
            static_assert(Epi::PERM, "int8 path is written for the PERM layout");
            int fr_ = fr, fq_ = fq; asm volatile("" : "+v"(fr_), "+v"(fq_));
            const LAS float* sa = (const LAS float*)(lds + SC_OFF + (ui & 1) * 2048) + wr * 64 + fr_; const LAS float* sb = (const LAS float*)(lds + SC_OFF + (ui & 1) * 2048) + 256 + wc * 64 + 8 * fq_;
            float rs[2][4]; f32x4 cs[2][2];
#pragma unroll
            for (int a = 0; a < 2; ++a)
#pragma unroll
                for (int m = 0; m < 4; ++m) rs[a][m] = sa[a * 128 + m * 16];
#pragma unroll
            for (int b = 0; b < 2; ++b)
#pragma unroll
                for (int n = 0; n < 2; ++n) cs[b][n] = *(const LAS f32x4*)(sb + b * 32 + 4 * n);
#pragma unroll
            for (int a = 0; a < 2; ++a)
#pragma unroll
                for (int b = 0; b < 2; ++b)
#pragma unroll
                    for (int m = 0; m < 4; ++m)
#pragma unroll
                        for (int n = 0; n < 2; ++n) { const i32x4 iv = __builtin_bit_cast(i32x4, acc[a][b][m][n]); acc[a][b][m][n] = __builtin_convertvector(iv, f32x4) * cs[b][n] * rs[a][m]; }
        }
        bool keep = false;
        { int fr_ = fr, fq_ = fq; asm volatile("" : "+v"(fr_), "+v"(fq_));
          if constexpr (Epi::MID) { if (E.is_mid(cur)) { E.mid(acc, cur, wr, wc, fr_, fq_); keep = true; } else E(acc, cur, wr, wc, fr_, fq_); } else E(acc, cur, wr, wc, fr_, fq_); }
        if (!has_next) break;
        if (!keep) {
#pragma unroll
        for (int a = 0; a < 2; ++a)
#pragma unroll
            for (int b = 0; b < 2; ++b)
#pragma unroll
                for (int m = 0; m < 4; ++m)
#pragma unroll
                    for (int n = 0; n < 2; ++n) acc[a][b][m][n] = (f32x4){0.f, 0.f, 0.f, 0.f}; }
        cur = nxt; cA = nA; cB = nB; ++ui;
        stage_scales(cur, ui & 1);
        if constexpr (GATHER) {
#pragma unroll
            for (int hh = 0; hh < 2; ++hh)
#pragma unroll
                for (int i = 0; i < 2; ++i) vC[hh][i] = vN[hh][i]; }
        if (wr == 1) PG8_BAR;
    }
    PG8_WAIT_V(0);
    PG8_BAR;
#undef PG8_SA
#undef PG8_SB
#undef PG8_STAGE
#undef PG8_STAGE_A
#undef PG8_LDA
#undef PG8_LD1
#undef PG8_LDB
#undef PG8_MMA
#undef PG8_WAIT_V
#undef PG8_WAIT_L
#undef PG8_BAR
#undef PG8_SCHED
}
}
using pg8::Unit;

template <class F>
__device__ __forceinline__ void epi_perm_loop(const f32x4 (&acc)[2][2][4][2], int wr, int wc, int fr, int fq, F&& f) {
#pragma unroll
    for (int ai = 0; ai < 2; ++ai)
#pragma unroll
        for (int m = 0; m < 4; ++m) { const int rt = ai * 128 + wr * 64 + m * 16 + fr;
#pragma unroll
            for (int bj = 0; bj < 2; ++bj) { const int ct = wc * 64 + bj * 32 + 8 * fq; f(rt, ct, acc[ai][bj][m][0], acc[ai][bj][m][1]); }
            asm volatile("" ::: "memory"); }
}
__device__ __forceinline__ unsigned pk4_fp8(float a, float b, float c, float d) { int w = 0; w = __builtin_amdgcn_cvt_pk_fp8_f32(a, b, w, false); w = __builtin_amdgcn_cvt_pk_fp8_f32(c, d, w, true); return (unsigned)w; }
__device__ __forceinline__ u32x4 xp16(u32x4 w, int src) { u32x4 r; r.x = __shfl(w.x, src); r.y = __shfl(w.y, src); r.z = __shfl(w.z, src); r.w = __shfl(w.w, src); return r; }
__device__ __forceinline__ u32x2 xp8(u32x2 w, int src) { u32x2 r; r.x = __shfl(w.x, src); r.y = __shfl(w.y, src); return r; }
template <class DT, class LD, class F>
__device__ __forceinline__ void epi_perm_pipe(const f32x4 (&acc)[2][2][4][2], int wr, int wc, int fr, int fq, LD&& ld, F&& f) {
    DT cur = ld(wr * 64 + fr, wc * 64 + 8 * fq);
#pragma unroll
    for (int it = 0; it < 16; ++it) { const int ai = it >> 3, m = (it >> 1) & 3, bj = it & 1; const int rt = ai * 128 + wr * 64 + m * 16 + fr, ct = wc * 64 + bj * 32 + 8 * fq;
        DT nxt = cur;
        if (it + 1 < 16) { const int i2 = it + 1, a2 = i2 >> 3, m2 = (i2 >> 1) & 3, b2 = i2 & 1; nxt = ld(a2 * 128 + wr * 64 + m2 * 16 + fr, wc * 64 + b2 * 32 + 8 * fq); }
        asm volatile("" ::: "memory");
        f(rt, ct, acc[ai][bj][m][0], acc[ai][bj][m][1], cur);
        cur = nxt; }
}
__device__ __forceinline__ u32x4 pack8(f32x4 v0, f32x4 v1) { u32x4 w; w.x = pk2(v0[0], v0[1]); w.y = pk2(v0[2], v0[3]); w.z = pk2(v1[0], v1[1]); w.w = pk2(v1[2], v1[3]); return w; }
__device__ __forceinline__ float gelu_tanh(float x) { const float u = 1.5957691216057308f * (x + 0.044715f * x * x * x); return x * sigmoidf_(u); }
__device__ __forceinline__ void unpack8(u32x4 w, float (&f)[8]) { f[0] = bflo(w.x); f[1] = bfhi(w.x); f[2] = bflo(w.y); f[3] = bfhi(w.y); f[4] = bflo(w.z); f[5] = bfhi(w.z); f[6] = bflo(w.w); f[7] = bfhi(w.w); }

struct EpiCtx {
    static constexpr bool PERM = true; static constexpr bool MID = false;
    bf16* ZC;
    __device__ __forceinline__ void operator()(const f32x4 (&acc)[2][2][4][2], const Unit& u, int wr, int wc, int fr, int fq) const {
        const int pn = u.pn; const int ctile = pn < 4 ? pn : pn - 8;
        const float sc = (pn >= 12 && pn < 16) ? K_SCALE : 1.0f;
        char* zc = (char*)(ZC + (size_t)(u.pm - 256) * 256 * ZC_LD + ctile * 256); int ldz = ZC_LD; asm volatile("" : "+s"(ldz));
        const int ln = fq * 16 + fr, xs = (ln & 3) * 16 + (ln >> 2), dr = (ln >> 2) - fr, dc = 8 * ((ln & 3) - fq);
        epi_perm_loop(acc, wr, wc, fr, fq, [&](int rt, int ct, f32x4 v0, f32x4 v1) { v0 *= sc; v1 *= sc; *(u32x4*)(zc + (unsigned)(((rt + dr) * ldz + ct + dc) * 2)) = xp16(pack8(v0, v1), xs); });
    }
};
struct EpiIn {
    static constexpr bool PERM = true; static constexpr bool MID = false;
    bf16* Z; const f32x2* rope; int dry;
    __device__ __forceinline__ void operator()(const f32x4 (&acc)[2][2][4][2], const Unit& u, int wr, int wc, int fr, int fq) const {
        if (MK_DRYMODE == 2 && dry) return;
        const int pn = u.pn; const int row0 = u.pm * 256, col0 = pn * 256; const f32x2* rp_ = rope;
        const int kind = (pn >= 8 && pn < 12) ? 2 : (pn >= 12 && pn < 16) ? 3 : 0;
        const float sc = kind == 3 ? K_SCALE : 1.0f;
        char* zt = (char*)(Z + (size_t)row0 * ZLD + col0); int ldz = ZLD; asm volatile("" : "+s"(ldz));
        const int ln = fq * 16 + fr;
#pragma unroll
        for (int ai = 0; ai < 2; ++ai)
#pragma unroll
            for (int m = 0; m < 4; ++m) { const int rt = ai * 128 + wr * 64 + m * 16 + fr; u32x4 pw[2];
#pragma unroll
                for (int bj = 0; bj < 2; ++bj) { f32x4 v0 = acc[ai][bj][m][0], v1 = acc[ai][bj][m][1]; const int ct = wc * 64 + bj * 32 + 8 * fq;
                    if (kind == 2 || kind == 3) {
                        const int t = (row0 + rt) & (SEQ - 1);
                        const int e0 = (col0 + ct) & 127; const int p0 = e0 >> 1;
                        const int pos = p0 < 32 ? (t >> 6) : (t & 63); const int f0 = p0 & 31;
                        const f32x4* rp = (const f32x4*)(rp_ + pos * 32 + f0);
                        const f32x4 cs0 = rp[0]; const f32x4 cs1 = rp[1];
                        f32x4 o0, o1;
                        o0[0] = v0[0] * cs0[0] - v0[1] * cs0[1]; o0[1] = v0[0] * cs0[1] + v0[1] * cs0[0];
                        o0[2] = v0[2] * cs0[2] - v0[3] * cs0[3]; o0[3] = v0[2] * cs0[3] + v0[3] * cs0[2];
                        o1[0] = v1[0] * cs1[0] - v1[1] * cs1[1]; o1[1] = v1[0] * cs1[1] + v1[1] * cs1[0];
                        o1[2] = v1[2] * cs1[2] - v1[3] * cs1[3]; o1[3] = v1[2] * cs1[3] + v1[3] * cs1[2];
                        v0 = o0 * sc; v1 = o1 * sc;
                    }
                    pw[bj] = pack8(v0, v1); }
#pragma unroll
                for (int s = 0; s < 2; ++s) { const int rr = 8 * s + (ln >> 3), pp = ln & 7; const int srcl = (pp & 3) * 16 + rr;
                    const u32x4 a0 = xp16(pw[0], srcl), a1 = xp16(pw[1], srcl); const u32x4 ow = (pp >> 2) ? a1 : a0;
                    if (!(MK_DRYMODE == 1 && dry) || ow.x == 0x7fc12345u) __builtin_nontemporal_store(ow, (u32x4*)(zt + (unsigned)(((rt - fr + rr) * ldz + wc * 64 + 8 * pp) * 2))); }
                asm volatile("" ::: "memory"); }
    }
};
struct EpiT1 {
    static constexpr bool PERM = true; static constexpr bool MID = false;
    const bf16* Z; bf16* T1;
    __device__ __forceinline__ void operator()(const f32x4 (&acc)[2][2][4][2], const Unit& u, int wr, int wc, int fr, int fq) const {
        const char* zt = (const char*)(Z + (size_t)u.pm * 256 * ZLD + C_GA + u.pn * 256); char* tt = (char*)(T1 + (size_t)u.pm * 256 * D + u.pn * 256);
        int ldz = ZLD, ldt = D; asm volatile("" : "+s"(ldz), "+s"(ldt));
        const int ln = fq * 16 + fr, xs = (ln & 3) * 16 + (ln >> 2), dr = (ln >> 2) - fr, dc = 8 * ((ln & 3) - fq);
        epi_perm_pipe<u32x4>(acc, wr, wc, fr, fq, [&](int rt, int ct) { return *(const u32x4*)(zt + (unsigned)((rt * ldz + ct) * 2)); },
            [&](int rt, int ct, f32x4 v0, f32x4 v1, u32x4 gw) { float gte[8]; unpack8(gw, gte);
            for (int j = 0; j < 4; ++j) { v0[j] *= sigmoidf_(gte[j]); v1[j] *= sigmoidf_(gte[4 + j]); }
            *(u32x4*)(tt + (unsigned)(((rt + dr) * ldt + ct + dc) * 2)) = xp16(pack8(v0, v1), xs); });
    }
};
struct EpiMg {
    static constexpr bool PERM = true; static constexpr bool MID = false;
    const bf16* Z; const bf16* T1; bf16* MG;
    __device__ __forceinline__ void operator()(const f32x4 (&acc)[2][2][4][2], const Unit& u, int wr, int wc, int fr, int fq) const {
        const char* zt = (const char*)(Z + (size_t)u.pm * 256 * ZLD + C_GB + u.pn * 256); const char* tt = (const char*)(T1 + (size_t)u.pm * 256 * D + u.pn * 256); char* mt = (char*)(MG + (size_t)u.pm * 256 * D + u.pn * 256);
        int ldz = ZLD, ldt = D; asm volatile("" : "+s"(ldz), "+s"(ldt));
        const int ln = fq * 16 + fr, xs = (ln & 3) * 16 + (ln >> 2), dr = (ln >> 2) - fr, dc = 8 * ((ln & 3) - fq);
        struct D2 { u32x4 a, b; };
        epi_perm_pipe<D2>(acc, wr, wc, fr, fq, [&](int rt, int ct) { D2 d; d.a = *(const u32x4*)(zt + (unsigned)((rt * ldz + ct) * 2)); d.b = *(const u32x4*)(tt + (unsigned)((rt * ldt + ct) * 2)); return d; },
            [&](int rt, int ct, f32x4 v0, f32x4 v1, D2 dd) { float gte[8], t1v[8]; unpack8(dd.a, gte); unpack8(dd.b, t1v);
            for (int j = 0; j < 4; ++j) { v0[j] = t1v[j] + v0[j] * sigmoidf_(gte[j]); v1[j] = t1v[4 + j] + v1[j] * sigmoidf_(gte[4 + j]); }
            *(u32x4*)(mt + (unsigned)(((rt + dr) * ldt + ct + dc) * 2)) = xp16(pack8(v0, v1), xs); });
    }
};
struct EpiF {
    static constexpr bool PERM = true; static constexpr bool MID = true;
    const bf16* Z; bf16* MG; int dry;
    __device__ __forceinline__ bool is_mid(const Unit& u) const { return u.koff == 0; }
    __device__ __forceinline__ void mid(f32x4 (&acc)[2][2][4][2], const Unit& u, int wr, int wc, int fr, int fq) const {
        if (MK_DRYMODE == 2 && dry) return;
        const char* za = (const char*)(Z + (size_t)u.pm * 256 * ZLD + C_GA + u.pn * 256); const char* zb = za + (C_GB - C_GA) * 2;
        int ldz = ZLD; asm volatile("" : "+s"(ldz));
        auto off = [&](int it) { const int ai = it >> 3, m = (it >> 1) & 3, bj = it & 1; return (unsigned)(((ai * 128 + wr * 64 + m * 16 + fr) * ldz + wc * 64 + bj * 32 + 8 * fq) * 2); };
        u32x4 qa[3], qb[3];
        qa[0] = *(const u32x4*)(za + off(0)); qb[0] = *(const u32x4*)(zb + off(0)); qa[1] = *(const u32x4*)(za + off(1)); qb[1] = *(const u32x4*)(zb + off(1));
#pragma unroll
        for (int it = 0; it < 16; ++it) { const int ai = it >> 3, m = (it >> 1) & 3, bj = it & 1;
            if (it + 2 < 16) { qa[(it + 2) % 3] = *(const u32x4*)(za + off(it + 2)); qb[(it + 2) % 3] = *(const u32x4*)(zb + off(it + 2)); }
            asm volatile("" ::: "memory");
            float ga[8], gb[8]; unpack8(qa[it % 3], ga); unpack8(qb[it % 3], gb);
#pragma unroll
            for (int j = 0; j < 4; ++j) {
                acc[ai][bj][m][0][j] *= (1.0f + fminf(__expf(-gb[j]), 1e30f)) * __builtin_amdgcn_rcpf(1.0f + __expf(-ga[j]));
                acc[ai][bj][m][1][j] *= (1.0f + fminf(__expf(-gb[4 + j]), 1e30f)) * __builtin_amdgcn_rcpf(1.0f + __expf(-ga[4 + j])); } }
    }
    __device__ __forceinline__ void operator()(const f32x4 (&acc)[2][2][4][2], const Unit& u, int wr, int wc, int fr, int fq) const {
        if (MK_DRYMODE == 2 && dry) return;
        const char* zb = (const char*)(Z + (size_t)u.pm * 256 * ZLD + C_GB + u.pn * 256); char* mt = (char*)(MG + (size_t)u.pm * 256 * D + u.pn * 256);
        int ldz = ZLD, ldt = D; asm volatile("" : "+s"(ldz), "+s"(ldt));
        const int ln = fq * 16 + fr, xs = (ln & 3) * 16 + (ln >> 2), dr = (ln >> 2) - fr, dc = 8 * ((ln & 3) - fq);
        auto off = [&](int it) { const int ai = it >> 3, m = (it >> 1) & 3, bj = it & 1; return (unsigned)(((ai * 128 + wr * 64 + m * 16 + fr) * ldz + wc * 64 + bj * 32 + 8 * fq) * 2); };
        u32x4 qb[4]; qb[0] = *(const u32x4*)(zb + off(0)); qb[1] = *(const u32x4*)(zb + off(1)); qb[2] = *(const u32x4*)(zb + off(2));
#pragma unroll
        for (int it = 0; it < 16; ++it) { const int ai = it >> 3, m = (it >> 1) & 3, bj = it & 1; const int rt = ai * 128 + wr * 64 + m * 16 + fr, ct = wc * 64 + bj * 32 + 8 * fq;
            if (it + 3 < 16) qb[(it + 3) & 3] = *(const u32x4*)(zb + off(it + 3));
            asm volatile("" ::: "memory");
            float gb[8]; unpack8(qb[it & 3], gb); f32x4 v0 = acc[ai][bj][m][0], v1 = acc[ai][bj][m][1];
#pragma unroll
            for (int j = 0; j < 4; ++j) { v0[j] *= __builtin_amdgcn_rcpf(1.0f + fminf(__expf(-gb[j]), 1e30f)); v1[j] *= __builtin_amdgcn_rcpf(1.0f + fminf(__expf(-gb[4 + j]), 1e30f)); }
            *(u32x4*)(mt + (unsigned)(((rt + dr) * ldt + ct + dc) * 2)) = xp16(pack8(v0, v1), xs); }
    }
};
struct EpiX1 {
    static constexpr bool PERM = false; static constexpr bool MID = false;
    const float* X; float* O; const float* mod; int grow0;
    __device__ __forceinline__ void operator()(const f32x4 (&acc)[2][2][4][2], const Unit& u, int wr, int wc, int fr, int fq) const {
        const int trow = grow0 + u.pm * 256; const int b = trow >> 13;
        const char* xt = (const char*)(X + (size_t)trow * D + u.pn * 256); char* ot = (char*)(O + (size_t)trow * D + u.pn * 256); const float* g1 = mod + b * 6144 + 2048 + u.pn * 256;
        int ldx = D; asm volatile("" : "+s"(ldx));
        const int ln = fq * 16 + fr, xs = (ln & 3) * 16 + (ln >> 2);
        const int r0 = wr * 64 + (ln >> 2), c0 = wc * 64 + 4 * (ln & 3), c0g = wc * 64 + 4 * fq;
        f32x4 gv[2][2];
#pragma unroll
        for (int bj = 0; bj < 2; ++bj)
#pragma unroll
            for (int n = 0; n < 2; ++n) gv[bj][n] = *(const f32x4*)(g1 + c0g + bj * 32 + n * 16);
        auto xoff = [&](int it) { const int bj = it >> 4, n = (it >> 3) & 1, ai = (it >> 2) & 1, m = it & 3; return (unsigned)(((r0 + ai * 128 + m * 16) * ldx + c0 + bj * 32 + n * 16) * 4); };
        f32x4 xq[3]; xq[0] = *(const f32x4*)(xt + xoff(0)); xq[1] = *(const f32x4*)(xt + xoff(1));
#pragma unroll
        for (int it = 0; it < 32; ++it) { const int bj = it >> 4, n = (it >> 3) & 1, ai = (it >> 2) & 1, m = it & 3;
            if (it + 2 < 32) xq[(it + 2) % 3] = *(const f32x4*)(xt + xoff(it + 2));
            asm volatile("" ::: "memory");
            const f32x4 pr = gv[bj][n] * acc[ai][bj][m][n]; const u32x4 ps = xp16(__builtin_bit_cast(u32x4, pr), xs);
            *(f32x4*)(ot + xoff(it)) = xq[it % 3] + __builtin_bit_cast(f32x4, ps); }
    }
};
__device__ __forceinline__ float swiglu1(float g, float l) { const float gl = fminf(g, 7.0f), li = fminf(fmaxf(l, -7.0f), 7.0f); return gl * sigmoidf_(1.702f * gl) * (li + 1.0f); }
struct EpiHid {
    static constexpr bool PERM = true; static constexpr bool MID = false;
    unsigned char* HID; const float* b1;
    __device__ __forceinline__ void operator()(const f32x4 (&acc)[2][2][4][2], const Unit& u, int wr, int wc, int fr, int fq) const {
        const int e = u.pn >> 3, pl = u.pn & 7; const float* bb = b1 + e * 2048 + pl * 256; char* ht = (char*)(HID + (size_t)u.pm * 256 * DEXP + pl * 128);
        int ldh = DEXP; asm volatile("" : "+s"(ldh));
        const int ln = fq * 16 + fr, xs = (ln & 3) * 16 + (ln >> 2), dr = (ln >> 2) - fr, dc = 8 * ((ln & 3) - fq);
        f32x4 bq[2][2];
#pragma unroll
        for (int bj = 0; bj < 2; ++bj) { bq[bj][0] = *(const f32x4*)(bb + wc * 64 + bj * 32 + 8 * fq); bq[bj][1] = *(const f32x4*)(bb + wc * 64 + bj * 32 + 8 * fq + 4); }
        epi_perm_loop(acc, wr, wc, fr, fq, [&](int rt, int ct, f32x4 v0, f32x4 v1) { v0 += bq[(ct >> 5) & 1][0]; v1 += bq[(ct >> 5) & 1][1];
            const unsigned w = pk4_fp8(swiglu1(v0[0], v0[1]), swiglu1(v0[2], v0[3]), swiglu1(v1[0], v1[1]), swiglu1(v1[2], v1[3]));
            *(unsigned*)(ht + (unsigned)((rt + dr) * ldh + ((ct + dc) >> 1))) = (unsigned)__shfl((int)w, xs); });
    }
};
struct EpiY {
    static constexpr bool PERM = true; static constexpr bool MID = false;
    unsigned char* Y; const float* b2;
    __device__ __forceinline__ void operator()(const f32x4 (&acc)[2][2][4][2], const Unit& u, int wr, int wc, int fr, int fq) const {
        const int e = u.pn >> 2, pl = u.pn & 3; const float* bb = b2 + e * 1024 + pl * 256; char* yt = (char*)(Y + (size_t)u.pm * 256 * D + pl * 256);
        int ldy = D; asm volatile("" : "+s"(ldy));
        const int ln = fq * 16 + fr, xs = (ln & 3) * 16 + (ln >> 2), dr = (ln >> 2) - fr, dc = 8 * ((ln & 3) - fq);
        f32x4 bq[2][2];
#pragma unroll
        for (int bj = 0; bj < 2; ++bj) { bq[bj][0] = *(const f32x4*)(bb + wc * 64 + bj * 32 + 8 * fq); bq[bj][1] = *(const f32x4*)(bb + wc * 64 + bj * 32 + 8 * fq + 4); }
        epi_perm_loop(acc, wr, wc, fr, fq, [&](int rt, int ct, f32x4 v0, f32x4 v1) { v0 += bq[(ct >> 5) & 1][0]; v1 += bq[(ct >> 5) & 1][1];
            u32x2 w8; w8.x = pk4_fp8(v0[0], v0[1], v0[2], v0[3]); w8.y = pk4_fp8(v1[0], v1[1], v1[2], v1[3]);
            *(u32x2*)(yt + (unsigned)((rt + dr) * ldy + ct + dc)) = xp8(w8, xs); });
    }
};

#define XB_TMO      128
#define XB_XCNT(j)  (256  + 64 * (j))
#define XB_XSUB(j)  (1280 + 64 * (j))
#define XB_XGEN(j)  (2304 + 64 * (j))
#define XB_TOP      3328
#define XB_TOPGEN   3392
#define XCD_BAR_WORDS 3456
#define XB_SPIN_CAP (1u << 22)
__device__ __forceinline__ unsigned xb_ld(unsigned* p)              { return __hip_atomic_load(p, __ATOMIC_RELAXED, __HIP_MEMORY_SCOPE_AGENT); }
__device__ __forceinline__ unsigned xb_add(unsigned* p, unsigned v) { return __hip_atomic_fetch_add(p, v, __ATOMIC_RELAXED, __HIP_MEMORY_SCOPE_AGENT); }
__device__ __forceinline__ unsigned xb_xcc_id() { return (unsigned)__builtin_amdgcn_s_getreg((3 << 11) | 20) & 0xFu; }
#define XB_SPIN(cond, bar) do { unsigned _sp = 0; while (cond) { __builtin_amdgcn_s_sleep(1); \
    if ((++_sp & 255u) == 0u) { if (xb_ld(&(bar)[XB_TMO])) break; if (_sp > XB_SPIN_CAP) { atomicAdd(&(bar)[XB_TMO], 1u); break; } } } } while (0)
struct XcdBarrier { unsigned* bar; unsigned x; volatile LAS unsigned* st; };
__device__ __forceinline__ XcdBarrier xcd_barrier_post(unsigned* bar, volatile LAS unsigned* st) {
    XcdBarrier b; b.bar = bar; b.x = xb_xcc_id(); b.st = st;
    if (threadIdx.x == 0) (void)xb_add(&bar[XB_XCNT(b.x)], 1u);
    return b;
}
__device__ __forceinline__ void xcd_barrier_complete(unsigned* bar, unsigned x, unsigned& nloc, unsigned& nx) {
    const unsigned G = gridDim.x * gridDim.y * gridDim.z;
    unsigned sum, cnt, mine, sp = 0u;
    for (;;) {
        sum = 0u; cnt = 0u; mine = 0u;
#pragma unroll
        for (unsigned j = 0; j < 16; ++j) { const unsigned c = xb_ld(&bar[XB_XCNT(j)]); sum += c; cnt += (c > 0u) ? 1u : 0u; mine = (j == x) ? c : mine; }
        if (sum == G) break;
        __builtin_amdgcn_s_sleep(1);
        if ((++sp & 255u) == 0u) { if (xb_ld(&bar[XB_TMO])) break; if (sp > XB_SPIN_CAP) { atomicAdd(&bar[XB_TMO], 1u); break; } }
    }
    nloc = mine > 0u ? mine : 1u; nx = cnt > 0u ? cnt : 1u;
}
__device__ __forceinline__ void xcd_barrier(const XcdBarrier& b) {
    asm volatile("s_waitcnt vmcnt(0)" ::: "memory");
    __syncthreads();
    if (threadIdx.x == 0) {
        unsigned* bar = b.bar;
        __builtin_amdgcn_s_waitcnt(0);
        unsigned nloc = b.st[0], nx = b.st[1];
        if (nloc == 0u) { xcd_barrier_complete(bar, b.x, nloc, nx); b.st[0] = nloc; b.st[1] = nx; }
        const unsigned old = xb_add(&bar[XB_XSUB(b.x)], 1u);
        const unsigned gen = old / nloc;
        if (old + 1u == (gen + 1u) * nloc) {
            __builtin_amdgcn_fence(__ATOMIC_RELEASE, "agent");
            asm volatile("s_waitcnt vmcnt(0)" ::: "memory");
            const unsigned og = xb_add(&bar[XB_TOP], 1u);
            const unsigned tg = og / nx;
            if (og + 1u == (tg + 1u) * nx) xb_add(&bar[XB_TOPGEN], 1u);
            else XB_SPIN(xb_ld(&bar[XB_TOPGEN]) == tg, bar);
            __builtin_amdgcn_fence(__ATOMIC_ACQUIRE, "agent");
            xb_add(&bar[XB_XGEN(b.x)], 1u);
            asm volatile("s_waitcnt vmcnt(0)" ::: "memory");
        } else {
            XB_SPIN(xb_ld(&bar[XB_XGEN(b.x)]) == gen, bar);
            __builtin_amdgcn_fence(__ATOMIC_ACQUIRE, "agent");
            asm volatile("s_waitcnt vmcnt(0)" ::: "memory");
        }
    }
    __syncthreads();
}

__device__ __forceinline__ void transpose_item(const float* W, int ldw, int K, int N, bf16* WT, LAS float* scr, int item, int lane) {
    const int nblk = N / 32, kb = item / nblk, nb = item % nblk, k0 = 64 * kb, n0 = 32 * nb;
#pragma unroll 8
    for (int i = 0; i < 32; ++i) { const int kk = 2 * i + (lane >> 5); scr[kk * 33 + (lane & 31)] = W[(size_t)(k0 + kk) * ldw + n0 + (lane & 31)]; }
    LDS_WAIT(); asm volatile("" ::: "memory");
    const int c = lane & 7;
#pragma unroll
    for (int j = 0; j < 4; ++j) { const int n = (lane >> 3) + 8 * j; const LAS float* s = scr + (8 * c) * 33 + n;
        u32x4 o; o.x = pk2(s[0 * 33], s[1 * 33]); o.y = pk2(s[2 * 33], s[3 * 33]); o.z = pk2(s[4 * 33], s[5 * 33]); o.w = pk2(s[6 * 33], s[7 * 33]);
        *(u32x4*)(WT + (size_t)(n0 + n) * K + k0 + 8 * c) = o; }
    LDS_WAIT(); asm volatile("" ::: "memory");
}
struct TrTile { const float* src; bf16* dst; int ldw, ldt; };
__device__ __forceinline__ void tr_load(const TrTile& t, int tid, f32x4 (&v)[8]) {
#pragma unroll
    for (int i = 0; i < 8; ++i) { const int id = tid + 512 * i, k = id >> 5, c4 = id & 31; v[i] = *(const f32x4*)(t.src + (size_t)k * t.ldw + 4 * c4); }
}
__device__ __forceinline__ void tr_store(const TrTile& t, int tid, const f32x4 (&v)[8], LAS float* L) {
#pragma unroll
    for (int i = 0; i < 8; ++i) { const int id = tid + 512 * i, k = id >> 5, c4 = id & 31;
        L[(4 * c4 + 0) * 129 + k] = v[i][0]; L[(4 * c4 + 1) * 129 + k] = v[i][1]; L[(4 * c4 + 2) * 129 + k] = v[i][2]; L[(4 * c4 + 3) * 129 + k] = v[i][3]; }
    __syncthreads();
#pragma unroll
    for (int i = 0; i < 4; ++i) { const int id = tid + 512 * i, kc = id & 15, n = id >> 4; const LAS float* s = L + n * 129 + 8 * kc;
        u32x4 o; o.x = pk2(s[0], s[1]); o.y = pk2(s[2], s[3]); o.z = pk2(s[4], s[5]); o.w = pk2(s[6], s[7]);
        *(u32x4*)(t.dst + (size_t)n * t.ldt + 8 * kc) = o; }
    __syncthreads();
}
template <bool FP8 = false>
__device__ __forceinline__ void tr_strip_i8(const float* src, int ldw, int K, signed char* dst, int ldt, float* scales, int tid, LAS unsigned* TL, LAS unsigned* CM) {
    constexpr float QMAX = FP8 ? 448.0f : 127.0f;
    const int c4 = tid & 31, g = tid >> 5, nk = K / 128;
    const float* p = src + (size_t)(4 * g) * ldw + 4 * c4;
    auto ld8 = [&](int kt, f32x4 (&v)[8]) {
#pragma unroll
        for (int h = 0; h < 2; ++h)
#pragma unroll
            for (int r = 0; r < 4; ++r) v[4 * h + r] = *(const f32x4*)(p + (size_t)(kt * 128 + 64 * h + r) * ldw); };
    float mx[4] = {0.f, 0.f, 0.f, 0.f};
    auto red = [&](const f32x4 (&v)[8]) {
#pragma unroll
        for (int i = 0; i < 8; ++i)
#pragma unroll
            for (int j = 0; j < 4; ++j) mx[j] = fmaxf(mx[j], fabsf(v[i][j])); };
    {   f32x4 va[8], vb[8]; ld8(0, va);
#pragma unroll 1
        for (int kt = 0; kt < nk; kt += 2) { ld8(kt + 1, vb); red(va); if (kt + 2 < nk) ld8(kt + 2, va); red(vb); } }
    f32x4 v[8]; ld8(0, v);
    if (tid < 128) CM[tid] = 0u;
    __syncthreads();
#pragma unroll
    for (int j = 0; j < 4; ++j) __hip_atomic_fetch_max(&CM[4 * c4 + j], __builtin_bit_cast(unsigned, mx[j]), __ATOMIC_RELAXED, __HIP_MEMORY_SCOPE_WORKGROUP);
    __syncthreads();
    if (tid < 128) { const float m = __builtin_bit_cast(float, CM[tid]); scales[tid] = m > 0.f ? m * (1.0f / QMAX) : 1.0f; }
    float inv[4];
#pragma unroll
    for (int j = 0; j < 4; ++j) { const float m = __builtin_bit_cast(float, CM[4 * c4 + j]); inv[j] = m > 0.f ? QMAX / m : 0.f; }
#pragma unroll 1
    for (int kt = 0; kt < nk; ++kt) {
        f32x4 w[8];
#pragma unroll
        for (int i = 0; i < 8; ++i) w[i] = v[i];
        if (kt + 1 < nk) ld8(kt + 1, v);
        LAS unsigned* T = TL + (kt & 1) * 4352;
#pragma unroll
        for (int h = 0; h < 2; ++h)
#pragma unroll
            for (int j = 0; j < 4; ++j) { unsigned pk;
                if constexpr (FP8) pk = pk4_fp8(w[4 * h][j] * inv[j], w[4 * h + 1][j] * inv[j], w[4 * h + 2][j] * inv[j], w[4 * h + 3][j] * inv[j]);
                else pk = q8x4((f32x4){w[4 * h][j], w[4 * h + 1][j], w[4 * h + 2][j], w[4 * h + 3][j]}, inv[j]);
                T[c4 * 133 + j * 33 + 16 * h + g] = pk; }
        __syncthreads();
#pragma unroll
        for (int i = 0; i < 2; ++i) { const int id = tid + 512 * i, kc = id & 7, n = id >> 3; const LAS unsigned* s = T + (n >> 2) * 133 + (n & 3) * 33 + 4 * kc;
            *(u32x4*)(dst + (size_t)n * ldt + kt * 128 + 16 * kc) = (u32x4){s[0], s[1], s[2], s[3]}; }
    }
    __syncthreads();
}
__device__ __forceinline__ unsigned offb(unsigned row, unsigned ch) { return 256u * row + 16u * (ch ^ (((row & 3u) << 2) | ((row >> 2) & 3u))); }
typedef short v4i16_t __attribute__((ext_vector_type(4)));
__device__ __forceinline__ s16x4 trd(const LAS unsigned char* p) { return __builtin_bit_cast(s16x4, __builtin_amdgcn_ds_read_tr16_b64_v4i16((LAS v4i16_t*)p)); }
#define MFMA32(a, b, c) __builtin_amdgcn_mfma_f32_32x32x16_bf16((a), (b), (c), 0, 0, 0)
#define MFMA16(a, b, c) __builtin_amdgcn_mfma_f32_16x16x32_bf16((a), (b), (c), 0, 0, 0)
__device__ __forceinline__ int crow(int reg, int h) { return (reg & 3) + 8 * (reg >> 2) + 4 * h; }

struct LruP { const float *conv_w, *conv_b, *ba, *bx, *lam; const bf16* wg; f32x2* carry; };
template <int PASS, int DIR>
__device__ __forceinline__ void lru_dir(LAS unsigned char* XC, LAS unsigned char* RN, const LruP& P, int b, int cp, int n, int w, int col, int g4) {
    const int ch = 128 * n + 16 * w + col;
    const float bav = P.ba[DIR * 1024 + ch], bxv = P.bx[DIR * 1024 + ch];
    const float c8 = 8.0f * log1pf(expf(-P.lam[DIR * 1024 + ch]));
    bf16x8 Ba[4], Bx[4];
    { const bf16* wa = P.wg + ((size_t)((n * 4 + DIR * 2 + 0) * 128 + 16 * w + col)) * 128 + 8 * g4; const bf16* wx = wa + 128 * 128;
#pragma unroll
      for (int ks = 0; ks < 4; ++ks) { Ba[ks] = *(const bf16x8*)(wa + 32 * ks); Bx[ks] = *(const bf16x8*)(wx + 32 * ks); } }
    float hrun = 0.f, atot = 1.f;
    if (PASS == 1) {
        const int Pn = DIR == 0 ? cp : 33 - cp; float Al = 1.f, Ul = 0.f;
#pragma unroll
        for (int k = 0; k < 9; ++k) { const int p = 9 * g4 + k;
            if (p < Pn) { const int cq = DIR == 0 ? p : (p == 0 ? 0 : 33 - p); const f32x2 ah = P.carry[((size_t)(b * 2 + DIR) * 33 + cq) * 1024 + ch]; Ul = ah.x * Ul + ah.y; Al = ah.x * Al; } }
#pragma unroll
        for (int gq = 0; gq < 4; ++gq) { const float Ag = __shfl(Al, col + 16 * gq), Ug = __shfl(Ul, col + 16 * gq); hrun = Ag * hrun + Ug; }
    }
#pragma unroll 4
    for (int mi = 0; mi < 16; ++mi) {
        const int m = DIR == 0 ? mi : 15 - mi;
        f32x4 ar = {0.f, 0.f, 0.f, 0.f}, ai = {0.f, 0.f, 0.f, 0.f};
        const LAS unsigned char* xrow = XC + (16 * m + col) * 272 + 16 * g4;
#pragma unroll
        for (int ks = 0; ks < 4; ++ks) { const bf16x8 af = *(const LAS bf16x8*)(xrow + 64 * ks); ar = MFMA16(af, Ba[ks], ar); ai = MFMA16(af, Bx[ks], ai); }
        float av[4], uv[4];
#pragma unroll
        for (int r = 0; r < 4; ++r) { const int t = 16 * m + 4 * g4 + r; const float xc = bf2f(*(const LAS unsigned short*)(XC + t * 272 + (16 * w + col) * 2));
            const float er = __expf(fminf(-(ar[r] + bav), 40.f)) + 1.0f, ei = __expf(fminf(-(ai[r] + bxv), 40.f)) + 1.0f; const float inv = __builtin_amdgcn_rcpf(er * ei);
            const float rg = inv * ei, ig = inv * er; const float a = __expf(-c8 * rg);
            av[r] = a; uv[r] = __builtin_amdgcn_sqrtf(fmaxf(1.0f - a * a, 0.f)) * ig * xc; }
        float Al = 1.f, Ul = 0.f;
#pragma unroll
        for (int rr = 0; rr < 4; ++rr) { const int r = DIR == 0 ? rr : 3 - rr; Ul = av[r] * Ul + uv[r]; Al = av[r] * Al; }
        float Ag[4], Ug[4];
#pragma unroll
        for (int gq = 0; gq < 4; ++gq) { Ag[gq] = __shfl(Al, col + 16 * gq); Ug[gq] = __shfl(Ul, col + 16 * gq); }
        float h = hrun, hin = hrun;
#pragma unroll
        for (int gi = 0; gi < 4; ++gi) { const int gq = DIR == 0 ? gi : 3 - gi; if (gq == g4) hin = h; h = Ag[gq] * h + Ug[gq]; atot *= Ag[gq]; }
        hrun = h;
        if (PASS == 1) {
            float hh = hin;
#pragma unroll
            for (int rr = 0; rr < 4; ++rr) { const int r = DIR == 0 ? rr : 3 - rr; hh = av[r] * hh + uv[r];
                LAS unsigned short* rp = (LAS unsigned short*)(RN + (16 * m + 4 * g4 + r) * 272 + (16 * w + col) * 2);
                if (DIR == 0) *rp = (unsigned short)f2bf(hh); else *rp = (unsigned short)f2bf(bf2f(*rp) + hh); }
        }
    }
    if (PASS == 0) { if (g4 == 0) P.carry[((size_t)(b * 2 + DIR) * 33 + cp) * 1024 + ch] = (f32x2){atot, hrun}; }
}
template <int PASS>
__device__ __forceinline__ void lru_unit(LAS unsigned char* lds, const LruP& P, int b, int cp, int n, const bf16* xsrc, int ldx, int seqlen, const bf16* grp, bf16* gout) {
    const int tid = opaque_tid(), lane = tid & 63, w = __builtin_amdgcn_readfirstlane(tid >> 6), col = lane & 15, g4 = lane >> 4;
    const int t0 = cp == 0 ? 0 : (cp - 1) * 256;
    LAS unsigned char* XC = lds;
    LAS unsigned char* RN = lds + 69632;
    __syncthreads();
    {
        const int j8 = tid & 15, ch0 = 128 * n + 8 * j8;
        float cw[4][8], cb[8];
#pragma unroll
        for (int k = 0; k < 4; ++k) { const f32x4 a = *(const f32x4*)(P.conv_w + k * 1024 + ch0), c = *(const f32x4*)(P.conv_w + k * 1024 + ch0 + 4);
            cw[k][0] = a[0]; cw[k][1] = a[1]; cw[k][2] = a[2]; cw[k][3] = a[3]; cw[k][4] = c[0]; cw[k][5] = c[1]; cw[k][6] = c[2]; cw[k][7] = c[3]; }
        { const f32x4 a = *(const f32x4*)(P.conv_b + ch0), c = *(const f32x4*)(P.conv_b + ch0 + 4); cb[0] = a[0]; cb[1] = a[1]; cb[2] = a[2]; cb[3] = a[3]; cb[4] = c[0]; cb[5] = c[1]; cb[6] = c[2]; cb[7] = c[3]; }
#pragma unroll 4
        for (int i = 0; i < 8; ++i) {
            const int t = (tid >> 4) + 32 * i; float a[8];
#pragma unroll
            for (int j = 0; j < 8; ++j) a[j] = cb[j];
#pragma unroll
            for (int k = 0; k < 4; ++k) { const int row = t0 + t + k - 2;
                if (row >= 0 && row < seqlen) { float xv[8]; unpack8(*(const u32x4*)(xsrc + (size_t)row * ldx + ch0), xv);
#pragma unroll
                    for (int j = 0; j < 8; ++j) a[j] += cw[k][j] * xv[j]; } }
            u32x4 o; o.x = pk2(a[0], a[1]); o.y = pk2(a[2], a[3]); o.z = pk2(a[4], a[5]); o.w = pk2(a[6], a[7]);
            *(LAS u32x4*)(XC + t * 272 + j8 * 16) = o;
        }
    }
    __syncthreads();
    lru_dir<PASS, 0>(XC, RN, P, b, cp, n, w, col, g4);
    lru_dir<PASS, 1>(XC, RN, P, b, cp, n, w, col, g4);
    if (PASS == 1) {
        __syncthreads();
        const int j8 = tid & 15, ch0 = 128 * n + 8 * j8;
#pragma unroll 4
        for (int i = 0; i < 8; ++i) { const int t = (tid >> 4) + 32 * i; float rv[8], gv[8];
            unpack8(*(const LAS u32x4*)(RN + t * 272 + j8 * 16), rv); const bf16* gp_in = grp + (size_t)(t0 + t) * ZLD + C_GR + ch0; unpack8(*(const u32x4*)gp_in, gv); bf16* gp = gout + (size_t)(t0 + t) * D + ch0;
            for (int j = 0; j < 8; ++j) gv[j] = gelu_tanh(gv[j]);
            u32x4 o; o.x = pk2(rv[0] * gv[0], rv[1] * gv[1]); o.y = pk2(rv[2] * gv[2], rv[3] * gv[3]); o.z = pk2(rv[4] * gv[4], rv[5] * gv[5]); o.w = pk2(rv[6] * gv[6], rv[7] * gv[7]);
            *(u32x4*)gp = o; }
    }
}

__device__ __forceinline__ void kv_unit(LAS unsigned char* lds, const bf16* ksrc, const bf16* vsrc, int ld, float l2g, bf16* out) {
    const int tid = opaque_tid(), lane = tid & 63, w = __builtin_amdgcn_readfirstlane(tid >> 6);
    LAS unsigned char* KF = lds; LAS unsigned char* KB = lds + 32768; LAS unsigned char* VI = lds + 65536;
    __syncthreads();
#pragma unroll
    for (int i = 0; i < 4; ++i) { const int idx = tid + 512 * i, j = idx >> 4, chn = idx & 15; float kv[8]; unpack8(*(const u32x4*)(ksrc + (size_t)j * ld + 8 * chn), kv);
        const float wf = exp2f(l2g * (float)(127 - j)), wb = exp2f(l2g * (float)j);
        u32x4 of, ob; of.x = pk2(kv[0] * wf, kv[1] * wf); of.y = pk2(kv[2] * wf, kv[3] * wf); of.z = pk2(kv[4] * wf, kv[5] * wf); of.w = pk2(kv[6] * wf, kv[7] * wf);
        ob.x = pk2(kv[0] * wb, kv[1] * wb); ob.y = pk2(kv[2] * wb, kv[3] * wb); ob.z = pk2(kv[4] * wb, kv[5] * wb); ob.w = pk2(kv[6] * wb, kv[7] * wb);
        *(LAS u32x4*)(KF + offb(j, chn)) = of; *(LAS u32x4*)(KB + offb(j, chn)) = ob; }
#pragma unroll
    for (int i = 0; i < 8; ++i) { const int idx = tid + 512 * i, j = idx >> 5, chn = idx & 31;
        *(LAS u32x4*)(VI + (chn >> 4) * 32768 + offb(j, chn & 15)) = *(const u32x4*)(vsrc + (size_t)j * ld + 8 * chn); }
    __syncthreads();
    const int h = lane >> 5, blk = (lane >> 4) & 1, q = (lane & 15) >> 2, p = lane & 3;
    f32x16 accF[4], accB[4];
#pragma unroll
    for (int dt = 0; dt < 4; ++dt)
#pragma unroll
        for (int r = 0; r < 16; ++r) { accF[dt][r] = 0.f; accB[dt][r] = 0.f; }
    const LAS unsigned char* Vimg = VI + (w >> 2) * 32768; const int cv = w & 3;
#pragma unroll 1
    for (int ks = 0; ks < 8; ++ks) {
        const unsigned r0 = 16 * ks + 8 * h + q, r1 = r0 + 4;
        const s16x4 v0 = trd(Vimg + offb(r0, 4 * cv + 2 * blk + (p >> 1)) + 8 * (p & 1)), v1 = trd(Vimg + offb(r1, 4 * cv + 2 * blk + (p >> 1)) + 8 * (p & 1));
        const bf16x8 bv = __builtin_shufflevector(v0, v1, 0, 1, 2, 3, 4, 5, 6, 7);
#pragma unroll
        for (int dt = 0; dt < 4; ++dt) {
            const unsigned o0 = offb(r0, 4 * dt + 2 * blk + (p >> 1)) + 8 * (p & 1), o1 = offb(r1, 4 * dt + 2 * blk + (p >> 1)) + 8 * (p & 1);
            const bf16x8 af = __builtin_shufflevector(trd(KF + o0), trd(KF + o1), 0, 1, 2, 3, 4, 5, 6, 7);
            const bf16x8 ab = __builtin_shufflevector(trd(KB + o0), trd(KB + o1), 0, 1, 2, 3, 4, 5, 6, 7);
            accF[dt] = MFMA32(af, bv, accF[dt]); accB[dt] = MFMA32(ab, bv, accB[dt]);
        }
    }
    __syncthreads();
    { const int v = 32 * w + (lane & 31);
#pragma unroll
      for (int dt = 0; dt < 4; ++dt)
#pragma unroll
        for (int rg = 0; rg < 4; ++rg) { const int d = 32 * dt + 8 * rg + 4 * h;
            u32x2 of, ob; of.x = pk2(accF[dt][4 * rg], accF[dt][4 * rg + 1]); of.y = pk2(accF[dt][4 * rg + 2], accF[dt][4 * rg + 3]);
            ob.x = pk2(accB[dt][4 * rg], accB[dt][4 * rg + 1]); ob.y = pk2(accB[dt][4 * rg + 2], accB[dt][4 * rg + 3]);
            *(LAS u32x2*)(lds + v * 272 + d * 2) = of; *(LAS u32x2*)(lds + 69632 + v * 272 + d * 2) = ob; } }
    __syncthreads();
#pragma unroll
    for (int i = 0; i < 16; ++i) { const int idx = tid + 512 * i, dir = idx >> 12, v = (idx >> 4) & 255, chn = idx & 15;
        *(u32x4*)(out + (size_t)dir * 32768 + v * 128 + 8 * chn) = *(const LAS u32x4*)(lds + dir * 69632 + v * 272 + chn * 16); }
}

__device__ __forceinline__ void xc_rows(const LruP& P, const bf16* xsrc, int ldx, int lgseq  , int nrows, bf16* dst, int gthread, int nthreads) {
    const int c8 = gthread & 127, ch0 = 8 * c8;
    float cw[4][8], cb[8];
#pragma unroll
    for (int k = 0; k < 4; ++k) { const f32x4 a = *(const f32x4*)(P.conv_w + k * 1024 + ch0), c = *(const f32x4*)(P.conv_w + k * 1024 + ch0 + 4);
        cw[k][0] = a[0]; cw[k][1] = a[1]; cw[k][2] = a[2]; cw[k][3] = a[3]; cw[k][4] = c[0]; cw[k][5] = c[1]; cw[k][6] = c[2]; cw[k][7] = c[3]; }
    { const f32x4 a = *(const f32x4*)(P.conv_b + ch0), c = *(const f32x4*)(P.conv_b + ch0 + 4); cb[0] = a[0]; cb[1] = a[1]; cb[2] = a[2]; cb[3] = a[3]; cb[4] = c[0]; cb[5] = c[1]; cb[6] = c[2]; cb[7] = c[3]; }
    const int seqmask = (1 << lgseq) - 1;
    for (int run = gthread >> 7; run < nrows / 16; run += nthreads >> 7) {
        const int row0 = run * 16, t0 = row0 & seqmask;
        u32x4 xw[19];
#pragma unroll
        for (int k = 0; k < 19; ++k) { const int tt = t0 + k - 2; xw[k] = (tt >= 0 && tt <= seqmask) ? *(const u32x4*)(xsrc + (size_t)(row0 + k - 2) * ldx + ch0) : (u32x4){0u, 0u, 0u, 0u}; }
#pragma unroll
        for (int r = 0; r < 16; ++r) { float a[8];
#pragma unroll
            for (int j = 0; j < 8; ++j) a[j] = cb[j];
#pragma unroll
            for (int k = 0; k < 4; ++k) { float xv[8]; unpack8(xw[r + k], xv);
#pragma unroll
                for (int j = 0; j < 8; ++j) a[j] += cw[k][j] * xv[j]; }
            u32x4 o; o.x = pk2(a[0], a[1]); o.y = pk2(a[2], a[3]); o.z = pk2(a[4], a[5]); o.w = pk2(a[6], a[7]);
            *(u32x4*)(dst + (size_t)(row0 + r) * 1024 + ch0) = o; }
    }
}
__device__ __forceinline__ void lru_sweep(LAS unsigned char* lds, const LruP& P, int n, int sub, int dir, const bf16* xcl, const bf16* xcc, bf16* hout) {
    const int tid = opaque_tid(), lane = tid & 63, w = __builtin_amdgcn_readfirstlane(tid >> 6), col = lane & 15, g4 = lane >> 4;
    LAS unsigned char* XC = lds;
    LAS f32x2* AGG = (LAS f32x2*)(lds + 69632);
    LAS unsigned char* OUT = lds + 69632 + 1024;
    const int chl = 16 * sub + col, ch = 128 * n + chl;
    const float bav = P.ba[dir * 1024 + ch], bxv = P.bx[dir * 1024 + ch];
    const float c8 = 8.0f * log1pf(expf(-P.lam[dir * 1024 + ch]));
    bf16x8 Ba[4], Bx[4];
    { const bf16* wa = P.wg + ((size_t)((n * 4 + dir * 2 + 0) * 128 + chl)) * 128 + 8 * g4; const bf16* wx = wa + 128 * 128;
#pragma unroll
      for (int ks = 0; ks < 4; ++ks) { Ba[ks] = *(const bf16x8*)(wa + 32 * ks); Bx[ks] = *(const bf16x8*)(wx + 32 * ks); } }
    u32x4 xq[8];
    auto gload = [&](int s) { const bf16* srcp = s == 0 ? xcc : xcl + (size_t)(dir ? 32 - s : s - 1) * 256 * 1024;
#pragma unroll
        for (int i = 0; i < 8; ++i) { const int it = tid + 512 * i; xq[i] = *(const u32x4*)(srcp + (size_t)(it >> 4) * 1024 + 128 * n + 8 * (it & 15)); } };
    auto lstore = [&]() {
#pragma unroll
        for (int i = 0; i < 8; ++i) { const int it = tid + 512 * i; *(LAS u32x4*)(XC + (it >> 4) * 272 + (it & 15) * 16) = xq[i]; } };
    float hchunk = 0.f;
    __syncthreads();
    gload(0); lstore();
#pragma unroll 1
    for (int s = 0; s < 33; ++s) {
        __syncthreads();
        if (s + 1 < 33) gload(s + 1);
        if (s >= 2) { const int cprev = dir ? 33 - s : s - 2; *(u32x4*)(hout + (size_t)cprev * 4096 + tid * 8) = *(const LAS u32x4*)(OUT + tid * 16); }
        float av[2][4], uv[2][4], Ag[2][4], Ug[2][4], Am[2], Um[2];
#pragma unroll
        for (int q2 = 0; q2 < 2; ++q2) {
            const int m = dir ? 2 * w + 1 - q2 : 2 * w + q2;
            f32x4 ar = {0.f, 0.f, 0.f, 0.f}, ai = {0.f, 0.f, 0.f, 0.f};
            const LAS unsigned char* xrow = XC + (16 * m + col) * 272 + 16 * g4;
#pragma unroll
            for (int ks = 0; ks < 4; ++ks) { const bf16x8 af = *(const LAS bf16x8*)(xrow + 64 * ks); ar = MFMA16(af, Ba[ks], ar); ai = MFMA16(af, Bx[ks], ai); }
#pragma unroll
            for (int r = 0; r < 4; ++r) { const int t = 16 * m + 4 * g4 + r; const float xc = bf2f(*(const LAS unsigned short*)(XC + t * 272 + chl * 2));
                const float er = __expf(fminf(-(ar[r] + bav), 40.f)) + 1.0f, ei = __expf(fminf(-(ai[r] + bxv), 40.f)) + 1.0f; const float inv = __builtin_amdgcn_rcpf(er * ei);
                const float rg = inv * ei, ig = inv * er; const float a = __expf(-c8 * rg);
                av[q2][r] = a; uv[q2][r] = __builtin_amdgcn_sqrtf(fmaxf(1.0f - a * a, 0.f)) * ig * xc; }
            float Al = 1.f, Ul = 0.f;
#pragma unroll
            for (int rr = 0; rr < 4; ++rr) { const int r = dir ? 3 - rr : rr; Ul = av[q2][r] * Ul + uv[q2][r]; Al = av[q2][r] * Al; }
            float am = 1.f, um = 0.f;
#pragma unroll
            for (int gq = 0; gq < 4; ++gq) { Ag[q2][gq] = __shfl(Al, col + 16 * gq); Ug[q2][gq] = __shfl(Ul, col + 16 * gq); }
#pragma unroll
            for (int gi = 0; gi < 4; ++gi) { const int gq = dir ? 3 - gi : gi; um = Ag[q2][gq] * um + Ug[q2][gq]; am = Ag[q2][gq] * am; }
            Am[q2] = am; Um[q2] = um;
        }
        if (g4 == 0) AGG[w * 16 + col] = (f32x2){Am[0] * Am[1], Am[1] * Um[0] + Um[1]};
        __syncthreads();
        float h = hchunk, hin = hchunk;
#pragma unroll
        for (int wi = 0; wi < 8; ++wi) { const int ww = dir ? 7 - wi : wi; const f32x2 au = AGG[ww * 16 + col]; if (ww == w) hin = h; h = au.x * h + au.y; }
        hchunk = h;
        float hrun = hin;
#pragma unroll
        for (int q2 = 0; q2 < 2; ++q2) {
            const int m = dir ? 2 * w + 1 - q2 : 2 * w + q2;
            float hg = hrun, hmy = hrun;
#pragma unroll
            for (int gi = 0; gi < 4; ++gi) { const int gq = dir ? 3 - gi : gi; if (gq == g4) hmy = hg; hg = Ag[q2][gq] * hg + Ug[q2][gq]; }
            hrun = hg;
            float hh = hmy;
#pragma unroll
            for (int rr = 0; rr < 4; ++rr) { const int r = dir ? 3 - rr : rr; hh = av[q2][r] * hh + uv[q2][r];
                *(LAS unsigned short*)(OUT + (16 * m + 4 * g4 + r) * 32 + col * 2) = (unsigned short)f2bf(hh); }
        }
        if (s + 1 < 33) lstore();
    }
    __syncthreads();
    { const int cprev = dir ? 0 : 31; *(u32x4*)(hout + (size_t)cprev * 4096 + tid * 8) = *(const LAS u32x4*)(OUT + tid * 16); }
}
__device__ __forceinline__ void lru_combine(const bf16* hf, const bf16* hb  , int c, const bf16* grp  , bf16* ar  , int tid) {
#pragma unroll
    for (int i = 0; i < 8; ++i) { const int it = tid + 512 * i, t = it >> 4, j8 = it & 15; const size_t ho = (size_t)(j8 >> 1) * (32 * 4096) + (size_t)c * 4096 + t * 16 + (j8 & 1) * 8;
        float a[8], b[8], g[8]; unpack8(__builtin_nontemporal_load((const u32x4*)(hf + ho)), a); unpack8(__builtin_nontemporal_load((const u32x4*)(hb + ho)), b); unpack8(*(const u32x4*)(grp + (size_t)t * ZLD + 8 * j8), g);
        u32x4 o; o.x = pk2((a[0] + b[0]) * gelu_tanh(g[0]), (a[1] + b[1]) * gelu_tanh(g[1])); o.y = pk2((a[2] + b[2]) * gelu_tanh(g[2]), (a[3] + b[3]) * gelu_tanh(g[3]));
        o.z = pk2((a[4] + b[4]) * gelu_tanh(g[4]), (a[5] + b[5]) * gelu_tanh(g[5])); o.w = pk2((a[6] + b[6]) * gelu_tanh(g[6]), (a[7] + b[7]) * gelu_tanh(g[7]));
        *(u32x4*)(ar + (size_t)t * 3072 + 8 * j8) = o; }
}

__device__ __forceinline__ void kvs_unit(LAS unsigned char* lds, const bf16* kctx, const bf16* vctx, const bf16* klat, const bf16* vlat, int dir, int part, float lg, bf16* st) {
    const int tid = opaque_tid(), lane = tid & 63, w = __builtin_amdgcn_readfirstlane(tid >> 6);
    const float l2g = lg * 1.4426950408889634f, cdec = __expf(128.0f * lg);
    const int h = lane >> 5, blk = (lane >> 4) & 1, q = (lane & 15) >> 2, p = lane & 3;
    float wj[4];
#pragma unroll
    for (int i = 0; i < 4; ++i) { const int j = (tid + 512 * i) >> 4; wj[i] = exp2f(l2g * (float)(dir ? j : 127 - j)); }
    f32x16 acc;
#pragma unroll
    for (int r = 0; r < 16; ++r) acc[r] = 0.f;
    u32x4 kq[2][4], vq[2];
    auto src = [&](int s, const bf16*& kp, const bf16*& vp, int& ld) {
        if (s < 2) { const int cc = dir ? 1 - s : s; kp = kctx + (size_t)cc * 128 * ZC_LD; vp = vctx + (size_t)cc * 128 * ZC_LD; ld = ZC_LD; }
        else { const int c = dir ? 65 - s : s - 2; kp = klat + (size_t)c * 128 * ZLD; vp = vlat + (size_t)c * 128 * ZLD; ld = ZLD; } };
    auto gload = [&](int s, u32x4 (&kk)[4], u32x4& vv) { const bf16* kp; const bf16* vp; int ld; src(s, kp, vp, ld);
#pragma unroll
        for (int i = 0; i < 4; ++i) { const int idx = tid + 512 * i, j = idx >> 4, chn = idx & 15; kk[i] = *(const u32x4*)(kp + (size_t)j * ld + 8 * chn); }
        vv = *(const u32x4*)(vp + (size_t)(tid >> 2) * ld + 32 * part + 8 * (tid & 3)); };
    auto lstore = [&](int buf, const u32x4 (&kk)[4], const u32x4& vv) { LAS unsigned char* KB = lds + buf * 65536; LAS unsigned char* VB = KB + 32768;
#pragma unroll
        for (int i = 0; i < 4; ++i) { const int idx = tid + 512 * i, j = idx >> 4, chn = idx & 15; float kv[8]; unpack8(kk[i], kv); const float ww = wj[i];
            u32x4 o; o.x = pk2(kv[0] * ww, kv[1] * ww); o.y = pk2(kv[2] * ww, kv[3] * ww); o.z = pk2(kv[4] * ww, kv[5] * ww); o.w = pk2(kv[6] * ww, kv[7] * ww);
            *(LAS u32x4*)(KB + offb(j, chn)) = o; }
        *(LAS u32x4*)(VB + offb(tid >> 2, tid & 3)) = vv; };
    __syncthreads();
    gload(0, kq[0], vq[0]); gload(1, kq[1], vq[1]); lstore(0, kq[0], vq[0]);
    __syncthreads();
#pragma unroll 1
    for (int s2 = 0; s2 < 66; s2 += 2)
#pragma unroll
    for (int sp = 0; sp < 2; ++sp) { const int s = s2 + sp;
        if (s + 2 < 66) gload(s + 2, kq[sp], vq[sp]);
        if (w < 4) {
            if (s >= 2) {
                const int c = dir ? 65 - s : s - 2; bf16* sp = st + (size_t)(c * 2 + dir) * 32768 + (size_t)(32 * part + (lane & 31)) * 128 + 32 * w + 4 * h;
#pragma unroll
                for (int rg = 0; rg < 4; ++rg) { u32x2 o; o.x = pk2(acc[4 * rg], acc[4 * rg + 1]); o.y = pk2(acc[4 * rg + 2], acc[4 * rg + 3]); *(u32x2*)(sp + 8 * rg) = o; }
            }
#pragma unroll
            for (int r = 0; r < 16; ++r) acc[r] *= cdec;
            const LAS unsigned char* KB = lds + (s & 1) * 65536; const LAS unsigned char* VB = KB + 32768;
#pragma unroll
            for (int ks = 0; ks < 8; ++ks) {
                const unsigned r0 = 16 * ks + 8 * h + q, r1 = r0 + 4;
                const bf16x8 bv = __builtin_shufflevector(trd(VB + offb(r0, 2 * blk + (p >> 1)) + 8 * (p & 1)), trd(VB + offb(r1, 2 * blk + (p >> 1)) + 8 * (p & 1)), 0, 1, 2, 3, 4, 5, 6, 7);
                const bf16x8 ak = __builtin_shufflevector(trd(KB + offb(r0, 4 * w + 2 * blk + (p >> 1)) + 8 * (p & 1)), trd(KB + offb(r1, 4 * w + 2 * blk + (p >> 1)) + 8 * (p & 1)), 0, 1, 2, 3, 4, 5, 6, 7);
                acc = MFMA32(ak, bv, acc);
            }
        }
        if (s + 1 < 66) lstore((s + 1) & 1, kq[sp ^ 1], vq[sp ^ 1]);
        __syncthreads();
    }
}

__device__ __forceinline__ void ro_unit(LAS unsigned char* lds, const bf16* qsrc, const bf16* ksrc, const bf16* vsrc, const bf16* gsp, bf16* gout, const bf16* Sf, const bf16* Sb, float l2g, int skip = 0) {
    const int tid = opaque_tid(), lane = tid & 63, w = __builtin_amdgcn_readfirstlane(tid >> 6), wi = w & 3, wv = w >> 2;
    LAS unsigned char* SF = lds; LAS unsigned char* SB = lds + 65536;
    LAS unsigned char* KI = lds; LAS unsigned char* VI = lds + 32768; LAS float* STATS = (LAS float*)(lds + 135168);
    const int h = lane >> 5, l31 = lane & 31, blk = (lane >> 4) & 1, q = (lane & 15) >> 2, p = lane & 3;
    __syncthreads();
    if (!(skip & 1)) {   u32x4 sf[8], sb[8];
#pragma unroll
        for (int i = 0; i < 8; ++i) { const int idx = tid + 512 * i; sf[i] = __builtin_nontemporal_load((const u32x4*)(Sf + (size_t)idx * 8)); sb[i] = __builtin_nontemporal_load((const u32x4*)(Sb + (size_t)idx * 8)); }
#pragma unroll
        for (int i = 0; i < 8; ++i) { const int idx = tid + 512 * i, v = idx >> 4, chn = idx & 15; *(LAS u32x4*)(SF + offb(v, chn)) = sf[i]; *(LAS u32x4*)(SB + offb(v, chn)) = sb[i]; }
    }
    bf16x8 qf[8];
#pragma unroll
    for (int s = 0; s < 8; ++s) qf[s] = *(const bf16x8*)(qsrc + (size_t)(32 * wi + l31) * ZLD + 16 * s + 8 * h);
    u32x4 kreg[4], vreg[8];
#pragma unroll
    for (int i = 0; i < 4; ++i) { const int idx = tid + 512 * i, j = idx >> 4, chn = idx & 15; kreg[i] = __builtin_nontemporal_load((const u32x4*)(ksrc + (size_t)j * ZLD + 8 * chn)); }
#pragma unroll
    for (int i = 0; i < 8; ++i) { const int idx = tid + 512 * i, j = idx >> 5, chn = idx & 31; vreg[i] = __builtin_nontemporal_load((const u32x4*)(vsrc + (size_t)j * ZLD + 8 * chn)); }
    __syncthreads();
    f32x16 z[4];
#pragma unroll
    for (int c = 0; c < 4; ++c)
#pragma unroll
        for (int r = 0; r < 16; ++r) z[c][r] = 0.f;
    if (!(skip & 1)) {
#pragma unroll
    for (int s = 0; s < 8; ++s)
#pragma unroll
        for (int c = 0; c < 4; ++c) { const bf16x8 bs = *(const LAS bf16x8*)(SF + offb(128 * wv + 32 * c + l31, 2 * s + h)); z[c] = MFMA32(qf[s], bs, z[c]); }
#pragma unroll
    for (int r = 0; r < 16; ++r) { const int i = 32 * wi + crow(r, h); const float f = exp2f(l2g * (float)(2 * i - 127));
#pragma unroll
        for (int c = 0; c < 4; ++c) z[c][r] *= f; }
#pragma unroll
    for (int s = 0; s < 8; ++s)
#pragma unroll
        for (int c = 0; c < 4; ++c) { const bf16x8 bs = *(const LAS bf16x8*)(SB + offb(128 * wv + 32 * c + l31, 2 * s + h)); z[c] = MFMA32(qf[s], bs, z[c]); }
#pragma unroll
    for (int r = 0; r < 16; ++r) { const int i = 32 * wi + crow(r, h); const float f = exp2f(l2g * (float)(128 - i));
#pragma unroll
        for (int c = 0; c < 4; ++c) z[c][r] *= f; }
    }
    __syncthreads();
#pragma unroll
    for (int i = 0; i < 4; ++i) { const int idx = tid + 512 * i, j = idx >> 4, chn = idx & 15; *(LAS u32x4*)(KI + offb(j, chn)) = kreg[i]; }
#pragma unroll
    for (int i = 0; i < 8; ++i) { const int idx = tid + 512 * i, j = idx >> 5, chn = idx & 31; *(LAS u32x4*)(VI + (chn >> 4) * 32768 + offb(j, chn & 15)) = vreg[i]; }
    __syncthreads();
    const LAS unsigned char* Vimg = VI + wv * 32768;
    u32x4 gsq[8];
#pragma unroll
    for (int i = 0; i < 8; ++i) { const int idx = tid + 512 * i, r = idx >> 5, chn = idx & 31; gsq[i] = __builtin_nontemporal_load((const u32x4*)(gsp + (size_t)r * ZLD + 8 * chn)); }
    if (!(skip & 2))
#pragma unroll
    for (int jt = 0; jt < 4; ++jt) {
        f32x16 x;
#pragma unroll
        for (int r = 0; r < 16; ++r) x[r] = 0.f;
#pragma unroll
        for (int s = 0; s < 8; ++s) { const bf16x8 ak = *(const LAS bf16x8*)(KI + offb(32 * jt + l31, 2 * s + h)); x = MFMA32(ak, qf[s], x); }
        const int ii = 32 * wi + l31;
#pragma unroll
        for (int r = 0; r < 16; ++r) { const int jj = 32 * jt + crow(r, h); const int dd = ii > jj ? ii - jj : jj - ii; x[r] *= exp2f(l2g * (float)dd); }
#pragma unroll
        for (int s2 = 0; s2 < 2; ++s2) {
            u32x4 pw; pw.x = pk2(x[8 * s2], x[8 * s2 + 1]); pw.y = pk2(x[8 * s2 + 2], x[8 * s2 + 3]); pw.z = pk2(x[8 * s2 + 4], x[8 * s2 + 5]); pw.w = pk2(x[8 * s2 + 6], x[8 * s2 + 7]);
            const bf16x8 xs = __builtin_bit_cast(bf16x8, pw);
            const unsigned r0 = 32 * jt + 16 * s2 + 4 * h + q, r1 = r0 + 8;
#pragma unroll
            for (int c = 0; c < 4; ++c) {
                const s16x4 v0 = trd(Vimg + offb(r0, 4 * c + 2 * blk + (p >> 1)) + 8 * (p & 1)), v1 = trd(Vimg + offb(r1, 4 * c + 2 * blk + (p >> 1)) + 8 * (p & 1));
                const bf16x8 pb = __builtin_shufflevector(v0, v1, 0, 1, 2, 3, 4, 5, 6, 7);
                z[c] = MFMA32(xs, pb, z[c]);
            }
        }
#pragma unroll
        for (int i2 = 0; i2 < 2; ++i2) { const int i = 2 * jt + i2; float gv[8]; unpack8(gsq[i], gv);
#pragma unroll
            for (int j = 0; j < 8; ++j) gv[j] = gv[j] * sigmoidf_(gv[j]);
            gsq[i].x = pk2(gv[0], gv[1]); gsq[i].y = pk2(gv[2], gv[3]); gsq[i].z = pk2(gv[4], gv[5]); gsq[i].w = pk2(gv[6], gv[7]); }
    }
#pragma unroll
    for (int r = 0; r < 16; ++r) { float s1 = (z[0][r] + z[1][r]) + (z[2][r] + z[3][r]); float s2 = (z[0][r] * z[0][r] + z[1][r] * z[1][r]) + (z[2][r] * z[2][r] + z[3][r] * z[3][r]);
        s1 = row16_sum(s1); s2 = row16_sum(s2);
        s1 += __shfl_xor(s1, 16); s2 += __shfl_xor(s2, 16);
        if (l31 == 0) { STATS[((wi * 2 + wv) * 32 + crow(r, h)) * 2] = s1; STATS[((wi * 2 + wv) * 32 + crow(r, h)) * 2 + 1] = s2; } }
    __syncthreads();
#pragma unroll
    for (int r = 0; r < 16; ++r) { const int il = crow(r, h);
        const float s1 = STATS[((wi * 2 + 0) * 32 + il) * 2] + STATS[((wi * 2 + 1) * 32 + il) * 2], s2 = STATS[((wi * 2 + 0) * 32 + il) * 2 + 1] + STATS[((wi * 2 + 1) * 32 + il) * 2 + 1];
        const float mean = s1 * (1.0f / 256.0f); const float var = fmaxf(s2 * (1.0f / 256.0f) - mean * mean, 0.f); const float rstd = __builtin_amdgcn_rsqf(var + EPS);
#pragma unroll
        for (int c = 0; c < 4; ++c) *(LAS unsigned short*)(lds + (32 * wi + il) * 528 + (128 * wv + 32 * c + l31) * 2) = (unsigned short)f2bf((z[c][r] - mean) * rstd); }
    __syncthreads();
    if (!(skip & 4))
#pragma unroll
    for (int i = 0; i < 8; ++i) { const int idx = tid + 512 * i, r = idx >> 5, chn = idx & 31; float ov[8], gv[8];
        unpack8(*(const LAS u32x4*)(lds + r * 528 + chn * 16), ov); unpack8(gsq[i], gv); bf16* gp = gout + (size_t)r * 3072 + 8 * chn;
        u32x4 o; o.x = pk2(ov[0] * gv[0], ov[1] * gv[1]); o.y = pk2(ov[2] * gv[2], ov[3] * gv[3]); o.z = pk2(ov[4] * gv[4], ov[5] * gv[5]); o.w = pk2(ov[6] * gv[6], ov[7] * gv[7]);
        *(u32x4*)gp = o; }
}

struct Args { const float* in[26]; float* out; unsigned char* ws; int lo, hi; };
enum { I_X = 0, I_C, I_CTX, I_CCTX, I_ADAW, I_ADAB, I_N1G, I_WIN, I_CONVW, I_CONVB, I_WA, I_BA, I_WX, I_BX, I_LAM, I_WRNN, I_WRET, I_WOUT, I_N2G, I_RW, I_RB, I_W1, I_B1, I_W2, I_B2, I_FG };
constexpr int ST_GRP = 3, ST_M0 = 27, ST_M1 = 28, ST_RNG = 29, ST_END = ST_RNG + 3 * NRANGE;

__global__ void __launch_bounds__(NTHR, 2) fwd_kernel(Args args) {
    extern __shared__ __attribute__((aligned(16))) unsigned char lds_raw[];
    LAS unsigned char* lds = (LAS unsigned char*)lds_raw;
    const int tid = threadIdx.x, lane = tid & 63, wave = __builtin_amdgcn_readfirstlane(tid >> 6);
    const int G = gridDim.x, bid = blockIdx.x;
    const int gw = bid * NWAVES + wave, NGW = G * NWAVES;
    unsigned char* ws = args.ws;
    volatile LAS unsigned* MISC = (volatile LAS unsigned*)(lds + MISC_OFF);
    if (tid < 64) MISC[tid] = 0u;
    __syncthreads();
    const int lo = args.lo, hi = args.hi;
    XcdBarrier bar; bar.bar = (unsigned*)(ws + WS_CTL) + CW_BAR; bar.x = 0; bar.st = nullptr;
    if (!MK_PER_PHASE) bar = xcd_barrier_post((unsigned*)(ws + WS_CTL) + CW_BAR, MISC);
#define IN(k) (lo <= (k) && (k) < hi)
#define SEAM(k) do { if (IN(k) && IN((k) + 1)) xcd_barrier(bar); } while (0)
#if MK_PROBE
    unsigned long long t_last = wall_clock64();
#define STAMP(kind) do { if (bid == 0 && threadIdx.x == 0) { const unsigned long long t_ = wall_clock64(); MISC[16 + (kind)] += (unsigned)(t_ - t_last); t_last = t_; } } while (0)
#else
#define STAMP(kind) do { } while (0)
#endif

    float* mod = (float*)(ws + WS_MOD);
    f32x2* rope = (f32x2*)(ws + WS_ROPE);
    f32x2* carry = (f32x2*)(ws + WS_CARRY); bf16* RWB = (bf16*)(ws + WS_RWB);
    bf16* WG = (bf16*)(ws + WS_WG); bf16* WRNN = (bf16*)(ws + WS_WRNN); bf16* WOUT = (bf16*)(ws + WS_WOUT); bf16* WRET = WRNN + 1024; bf16* WIN = (bf16*)(ws + WS_WIN);
    bf16* HL = (bf16*)(ws + WS_HL); bf16* ZC = (bf16*)(ws + WS_ZC); bf16* CTXU = (bf16*)(ws + WS_CTXU); bf16* Z = (bf16*)(ws + WS_Z); bf16* STB = (bf16*)(ws + WS_ST);
    bf16* T1 = (bf16*)(ws + WS_T1); bf16* MG = (bf16*)(ws + WS_MG);
    bf16* W1T = (bf16*)(ws + WS_W1T); bf16* W2T = (bf16*)(ws + WS_W2T); bf16* HPAD = (bf16*)(ws + WS_HPAD); bf16* HID = (bf16*)(ws + WS_HID); bf16* YPAD = (bf16*)(ws + WS_YPAD);
    float* WRNNS = (float*)(ws + WS_WFS); float* WRETS = WRNNS + 1024; float* WOUTS = WRNNS + 2048; float* W2S = WRNNS + 4096;
    bf16* AR = (bf16*)(ws + WS_AR); bf16* AT = (bf16*)(ws + WS_AT);
    bf16* XCB = T1; bf16* XCC = CTXU;
    bf16* HDF = MG; bf16* HDB = (bf16*)(ws + 880 * MiB);
    float* HLS = (float*)(ws + WS_HLS); float* WINS = (float*)(ws + WS_WINS); float* W1S = (float*)(ws + WS_W1S); float* HPS = (float*)(ws + WS_HPS);
    int* ROWTOK = (int*)(ws + WS_HPAD);
    int* EIDX = (int*)(ws + WS_EIDX); float* GATE = (float*)(ws + WS_GATE); int* LPOS = (int*)(ws + WS_LPOS); int* AROW = (int*)(ws + WS_AROW);
    int* BCNT = (int*)(ws + WS_BCNT); int* BBASE = (int*)(ws + WS_BBASE); int* TILEE = (int*)(ws + WS_TILEE); int* NTILE = (int*)(ws + WS_NTILE);

    if (PH_EN(0) && IN(0)) for (int rep = 0; rep < DUP_N(0); ++rep) {
        const int tid = opaque_tid(), lane = tid & 63, wave = __builtin_amdgcn_readfirstlane(tid >> 6), gw = bid * NWAVES + wave; (void)lane; (void)gw; (void)rep;
        if (bid < 96) {
            LAS float* sc = (LAS float*)lds;
            LAS float* red = (LAS float*)(lds + 40960);
            for (int i = tid; i < 9 * 1024; i += NTHR) { const int r = i >> 10, k = i & 1023; const float v = r < 8 ? args.in[I_C][r * 1024 + k] : args.in[I_CCTX][k]; sc[i] = v * sigmoidf_(v); }
            __syncthreads();
            const int n0 = bid * 64; float a9[9];
#pragma unroll
            for (int r = 0; r < 9; ++r) a9[r] = 0.f;
            for (int k = wave * 128; k < wave * 128 + 128; ++k) { const float wv = args.in[I_ADAW][(size_t)k * 6144 + n0 + lane];
#pragma unroll
                for (int r = 0; r < 9; ++r) a9[r] += sc[r * 1024 + k] * wv; }
#pragma unroll
            for (int r = 0; r < 9; ++r) red[(wave * 9 + r) * 64 + lane] = a9[r];
            __syncthreads();
            for (int i = tid; i < 9 * 64; i += NTHR) { const int r = i >> 6, l = i & 63; float s = 0.f;
#pragma unroll
                for (int w8 = 0; w8 < 8; ++w8) s += red[(w8 * 9 + r) * 64 + l];
                mod[r * 6144 + n0 + l] = s + args.in[I_ADAB][n0 + l]; }
            __syncthreads();
        }
        if (bid == 97 % G) {
            for (int i = tid; i < 32 * 1024; i += NTHR) { const int d = i >> 5, e = i & 31; const float wv = args.in[I_RW][i]; const unsigned hi = f2bf(wv); const float rem = wv - bf2f((unsigned short)hi);
                RWB[e * 1024 + d] = (bf16)hi; RWB[32 * 1024 + e * 1024 + d] = (bf16)f2bf(rem); }
        }
        if (bid == 96) {
            for (int i = tid; i < 128 * 32; i += NTHR) { const int pos = i >> 5, f = i & 31; const float inv = powf(10000.0f, -(float)f / 32.0f); const float ang = (float)pos * inv; float s, c; sincosf(ang, &s, &c); rope[i] = (f32x2){c, s}; }
        }
        {
            LAS float* L = (LAS float*)(lds + 65536); LAS unsigned* CM = (LAS unsigned*)(lds + 65536 + 66048); LAS unsigned* TL = (LAS unsigned*)lds;
            for (int it = bid; it < 848; it += G) {
                if (it < 80) tr_strip_i8<false>(args.in[I_WIN] + it * 128, DIN, 1024, (signed char*)WIN + (size_t)it * 128 * 1024, 1024, WINS + it * 128, tid, TL, CM);
                else if (it < 592) { const int s = it - 80, e = s >> 4, nt = s & 15; tr_strip_i8<false>(args.in[I_W1] + (size_t)e * 1024 * 2048 + nt * 128, 2048, 1024, (signed char*)W1T + ((size_t)e * 2048 + nt * 128) * 1024, 1024, W1S + e * 2048 + nt * 128, tid, TL, CM); }
                else { const int s = it - 592, e = s >> 3, nt = s & 7; tr_strip_i8<true>(args.in[I_W2] + (size_t)e * 1024 * 1024 + nt * 128, 1024, 1024, (signed char*)W2T + ((size_t)e * 1024 + nt * 128) * 1024, 1024, W2S + e * 1024 + nt * 128, tid, TL, CM); }
            }
            constexpr int NT_ALL = 64 + 128 + 64 + 32;
            auto desc = [&](int it) -> TrTile { TrTile t;
                if (it < 64) { const int kt = it >> 3, nt = it & 7; t.src = args.in[I_WRNN] + (size_t)kt * 128 * 1024 + nt * 128; t.ldw = 1024; t.dst = WRNN + (size_t)nt * 128 * 3072 + kt * 128; t.ldt = 3072; return t; }
                it -= 64;
                if (it < 128) { const int kt = it >> 3, nt = it & 7; t.src = args.in[I_WRET] + (size_t)kt * 128 * 1024 + nt * 128; t.ldw = 1024; t.dst = WRET + (size_t)nt * 128 * 3072 + kt * 128; t.ldt = 3072; return t; }
                it -= 128;
                if (it < 64) { const int kt = it >> 3, nt = it & 7; t.src = args.in[I_WOUT] + (size_t)kt * 128 * 1024 + nt * 128; t.ldw = 1024; t.dst = WOUT + (size_t)nt * 128 * 1024 + kt * 128; t.ldt = 1024; return t; }
                it -= 64;
                { const int q = it & 3, n = it >> 2; const int dir = q >> 1, typ = q & 1;
                  t.src = (typ ? args.in[I_WX] : args.in[I_WA]) + (size_t)(dir * 8 + n) * 128 * 128; t.ldw = 128; t.dst = WG + (size_t)(n * 4 + q) * 128 * 128; t.ldt = 128; return t; } };
            f32x4 v[8];
            int it = NT_ALL - 1 - ((bid + 80) % G);
            if (it >= 0) { const TrTile t0 = desc(it); tr_load(t0, tid, v); }
            while (it >= 0) {
                const TrTile tc = desc(it); const int nx = it - G;
                f32x4 w[8];
#pragma unroll
                for (int i = 0; i < 8; ++i) w[i] = v[i];
                if (nx >= 0) { const TrTile tn = desc(nx); tr_load(tn, tid, v); }
                tr_store(tc, tid, w, L);
                it = nx;
            }
        }
    }
    SEAM(0); STAMP(0);
    if (PH_EN(1) && IN(1)) for (int rep = 0; rep < DUP_N(1); ++rep) {
        const int tid = opaque_tid(), lane = tid & 63, wave = __builtin_amdgcn_readfirstlane(tid >> 6), gw = bid * NWAVES + wave; (void)lane; (void)gw; (void)rep;
        auto rowsrc = [&](int m) { return (const f32x4*)(m < NTOK ? args.in[I_X] + (size_t)m * D : args.in[I_CTX] + (size_t)(m - NTOK) * D) + lane; };
        f32x4 nx[4];
        if (gw < NROWS_HL) { const f32x4* xr = rowsrc(gw);
#pragma unroll
            for (int j = 0; j < 4; ++j) nx[j] = xr[64 * j]; }
#pragma unroll 1
        for (int m = gw; m < NROWS_HL; m += NGW) {
            const int r = m < NTOK ? (m >> 13) : 8;
            f32x4 v[4]; float ss = 0.f;
#pragma unroll
            for (int j = 0; j < 4; ++j) v[j] = nx[j];
            if (m + NGW < NROWS_HL) { const f32x4* xr = rowsrc(m + NGW);
#pragma unroll
                for (int j = 0; j < 4; ++j) nx[j] = xr[64 * j]; }
#pragma unroll
            for (int j = 0; j < 4; ++j) ss += (v[j].x * v[j].x + v[j].y * v[j].y) + (v[j].z * v[j].z + v[j].w * v[j].w);
            const float rstd = 1.0f / sqrtf(wave_sum(ss) * (1.0f / D) + EPS);
            float am = 0.f;
#pragma unroll
            for (int j = 0; j < 4; ++j) { const int c0 = 4 * lane + 256 * j; const f32x4 gn = *(const f32x4*)(args.in[I_N1G] + c0), sh = *(const f32x4*)(mod + r * 6144 + c0), sc = *(const f32x4*)(mod + r * 6144 + 1024 + c0);
                v[j] = (v[j] * rstd * gn) * (sc + 1.0f) + sh; am = fmaxf(fmaxf(am, fmaxf(fabsf(v[j].x), fabsf(v[j].y))), fmaxf(fabsf(v[j].z), fabsf(v[j].w))); }
            am = wave_max(am); const float inv = am > 0.f ? 127.0f / am : 0.f;
            if (lane == 0) HLS[m] = am > 0.f ? am * (1.0f / 127.0f) : 1.0f;
            unsigned* o4 = (unsigned*)((signed char*)HL + (size_t)m * D) + lane;
#pragma unroll
            for (int j = 0; j < 4; ++j) o4[64 * j] = q8x4(v[j], inv);
        }
    }
    SEAM(1); STAMP(1);
    if (PH_EN(2) && IN(2)) for (int rep = 0; rep < DUP_N(2); ++rep) {
        const int tid = opaque_tid(), lane = tid & 63, wave = __builtin_amdgcn_readfirstlane(tid >> 6), gw = bid * NWAVES + wave; (void)lane; (void)gw; (void)rep;
        pg8::Gemm g{HL, WIN, 512, 512, 512, HLS, WINS, nullptr}; pg8::CtxOrder S{G, bid}; EpiCtx E{ZC};
        pg8::gemm_phase<EpiCtx, pg8::CtxOrder, 1>(lds, g, S, E);
    }
    SEAM(2); STAMP(2);
    for (int grp = 0; grp < NGRP; ++grp) {
        const int s0 = ST_GRP + 6 * grp;
        if (PH_EN(3) && IN(s0 + 0)) for (int rep = 0; rep < DUP_N(3); ++rep) {
        const int tid = opaque_tid(), lane = tid & 63, wave = __builtin_amdgcn_readfirstlane(tid >> 6), gw = bid * NWAVES + wave; (void)lane; (void)gw; (void)rep;
            pg8::Gemm g{HL + (size_t)grp * GROWS * 512, WIN, 512, 512, 512, HLS + grp * GROWS, WINS, nullptr}; pg8::StaticOrder S; S.init(GROWS / 256, DIN / 256, G, bid); EpiIn E{Z, rope, DRY(3) ? 1 : 0};
            STAGGER(STAG_B); pg8::gemm_phase<EpiIn, pg8::StaticOrder, 1>(lds, g, S, E);
        }
        SEAM(s0 + 0); STAMP(3);
        if (PH_EN(4) && IN(s0 + 1)) for (int rep = 0; rep < DUP_N(4); ++rep) {
        const int tid = opaque_tid(), lane = tid & 63, wave = __builtin_amdgcn_readfirstlane(tid >> 6), gw = bid * NWAVES + wave; (void)lane; (void)gw; (void)rep;
            for (int u = bid; u < GB * 8 * 2 * 8; u += G) { const int hd = u & 7, y = u >> 3, bl = y >> 4, dir = (y >> 3) & 1, part = y & 7; const int b = grp * GB + bl;
                const float lg = log1pf(-exp2f(-5.0f - (float)hd));
                const bf16* zc = ZC + (size_t)(b * CTXL) * ZC_LD; const bf16* zl = Z + (size_t)(bl * SEQ) * ZLD;
                kvs_unit(lds, zc + ZC_K + hd * 128, zc + ZC_V + hd * 256, zl + C_K + hd * 128, zl + C_V + hd * 256, dir, part, lg, STB + (size_t)((bl * 8 + hd) * 64) * 2 * 32768); }
            LruP LP{args.in[I_CONVW], args.in[I_CONVB], args.in[I_BA], args.in[I_BX], args.in[I_LAM], WG, carry};
            xc_rows(LP, Z + C_XR, ZLD, 13, GROWS, XCB, bid * NTHR + tid, G * NTHR);
            if (grp == 0) xc_rows(LP, ZC + ZC_XR, ZC_LD, 8, NCTX, XCC, bid * NTHR + tid, G * NTHR);
        }
        SEAM(s0 + 1); STAMP(4);
        if (PH_EN(5) && IN(s0 + 2)) for (int rep = 0; rep < DUP_N(5); ++rep) {
        const int tid = opaque_tid(), lane = tid & 63, wave = __builtin_amdgcn_readfirstlane(tid >> 6), gw = bid * NWAVES + wave; (void)lane; (void)gw; (void)rep;
            LruP LP{args.in[I_CONVW], args.in[I_CONVB], args.in[I_BA], args.in[I_BX], args.in[I_LAM], WG, carry};
            for (int u = bid; u < GB * 8 * 8 * 2; u += G) { const int n = u & 7, bl = (u >> 3) & 1, y = u >> 4, dir = y & 1, sub = y >> 1;
                bf16* hb_ = (dir ? HDB : HDF) + (size_t)((bl * 8 + n) * 8 + sub) * (32 * 4096);
                lru_sweep(lds, LP, n, sub, dir, XCB + (size_t)(bl * SEQ) * 1024, XCC + (size_t)((grp * GB + bl) * CTXL) * 1024, hb_); }
        }
        SEAM(s0 + 2); STAMP(5);
        if (PH_EN(6) && IN(s0 + 3)) for (int rep = 0; rep < DUP_N(6); ++rep) {
        const int tid = opaque_tid(), lane = tid & 63, wave = __builtin_amdgcn_readfirstlane(tid >> 6), gw = bid * NWAVES + wave; (void)lane; (void)gw; (void)rep;
            for (int u = bid; u < GB * 64 * 8; u += G) { const int hd = u & 7, c = (u >> 3) & 63, bl = u >> 9; const float l2g = log1pf(-exp2f(-5.0f - (float)hd)) * 1.4426950408889634f;
                bf16* zr = Z + (size_t)(bl * SEQ + c * 128) * ZLD; const bf16* sp = STB + (size_t)(((bl * 8 + hd) * 64 + c) * 2) * 32768;
                ro_unit(lds, zr + C_Q + hd * 128, zr + C_K + hd * 128, zr + C_V + hd * 256, zr + C_GS + hd * 256, AR + (size_t)(bl * SEQ + c * 128) * 3072 + 1024 + hd * 256, sp, sp + 32768, l2g, DRY(6) ? (MK_DRYMODE >= 8 ? MK_DRYMODE - 8 : 0) : 0); }
            if (!(DRY(6) && MK_DRYMODE >= 8))
            for (int u = bid; u < GB * 32 * 8; u += G) { const int n = u & 7, c = (u >> 3) & 31, bl = u >> 8; const size_t ub = (size_t)((bl * 8 + n) * 8) * (32 * 4096);
                lru_combine(HDF + ub, HDB + ub, c, Z + (size_t)(bl * SEQ + c * 256) * ZLD + C_GR + 128 * n, AR + (size_t)(bl * SEQ + c * 256) * 3072 + 128 * n, tid); }
        }
        SEAM(s0 + 3); STAMP(6);
        if (PH_EN(7) && IN(s0 + 4)) for (int rep = 0; rep < DUP_N(7); ++rep) {
        const int tid = opaque_tid(), lane = tid & 63, wave = __builtin_amdgcn_readfirstlane(tid >> 6), gw = bid * NWAVES + wave; (void)lane; (void)gw; (void)rep;
            { pg8::Gemm g{AR, WRNN, 3072, 3072, 3072, nullptr, nullptr, nullptr}; pg8::FOrder S; S.so.init(GROWS / 256, 4, G, bid); EpiF E{Z, MG, DRY(7) ? 1 : 0};
              pg8::gemm_phase<EpiF, pg8::FOrder>(lds, g, S, E); }
        }
        SEAM(s0 + 4); STAMP(7);
        if (PH_EN(8) && IN(s0 + 5)) for (int rep = 0; rep < DUP_N(8); ++rep) {
        const int tid = opaque_tid(), lane = tid & 63, wave = __builtin_amdgcn_readfirstlane(tid >> 6), gw = bid * NWAVES + wave; (void)lane; (void)gw; (void)rep;
            pg8::Gemm g{MG, WOUT, D, D, D, nullptr, nullptr, nullptr}; pg8::StaticOrder S; S.init(GROWS / 256, 4, G, bid); EpiX1 E{args.in[I_X], args.out, mod, grp * GROWS};
            pg8::gemm_phase<EpiX1, pg8::StaticOrder>(lds, g, S, E);
        }
        if (grp == NGRP - 1) SEAM(s0 + 5);
        STAMP(8);
    }
    if (PH_EN(9) && IN(ST_M0)) for (int rep = 0; rep < DUP_N(9); ++rep) {
        const int tid = opaque_tid(), lane = tid & 63, wave = __builtin_amdgcn_readfirstlane(tid >> 6), gw = bid * NWAVES + wave; (void)lane; (void)gw; (void)rep;
        LAS unsigned char* AH = lds;
        LAS unsigned char* AL = lds + 66048;
        LAS float* RED = (LAS float*)lds;
        LAS float* LOG = (LAS float*)(lds + 32768);
        LAS int* CNT = (LAS int*)(lds + 132096 + 512);
        const int h5 = lane >> 5, l31 = lane & 31;
        bf16x8 bh[8], bl[8];
#pragma unroll
        for (int s = 0; s < 8; ++s) { bh[s] = *(const bf16x8*)(RWB + (size_t)l31 * 1024 + 128 * wave + 16 * s + 8 * h5); bl[s] = *(const bf16x8*)(RWB + 32 * 1024 + (size_t)l31 * 1024 + 128 * wave + 16 * s + 8 * h5); }
        f32x4 xv[4][4];
        auto ldtile = [&](int blk, int tile) { const int m0 = blk * 256 + tile * 32 + wave * 4;
#pragma unroll
            for (int r4 = 0; r4 < 4; ++r4)
#pragma unroll
                for (int j = 0; j < 4; ++j) xv[r4][j] = __builtin_nontemporal_load((const f32x4*)(args.out + (size_t)(m0 + r4) * D) + lane + 64 * j); };
        for (int blk = bid; blk < NTOK / 256; blk += G) {
            __syncthreads();
            if (tid < 32) CNT[tid] = 0;
            ldtile(blk, 0);
#pragma unroll 1
            for (int tile = 0; tile < 8; ++tile) {
                __syncthreads();
                const int m0 = blk * 256 + tile * 32 + wave * 4; const int b = m0 >> 13;
#pragma unroll
                for (int r4 = 0; r4 < 4; ++r4) {
                    const int m = m0 + r4; f32x4 v[4]; float ss = 0.f;
#pragma unroll
                    for (int j = 0; j < 4; ++j) { v[j] = xv[r4][j]; ss += (v[j].x * v[j].x + v[j].y * v[j].y) + (v[j].z * v[j].z + v[j].w * v[j].w); }
                    const float rstd = 1.0f / sqrtf(wave_sum(ss) * (1.0f / D) + EPS);
                    float am = 0.f;
#pragma unroll
                    for (int j = 0; j < 4; ++j) { const int c0 = 4 * lane + 256 * j; const f32x4 gn = *(const f32x4*)(args.in[I_N2G] + c0), sh = *(const f32x4*)(mod + b * 6144 + 3072 + c0), sc = *(const f32x4*)(mod + b * 6144 + 4096 + c0);
                        v[j] = (v[j] * rstd * gn) * (sc + 1.0f) + sh; am = fmaxf(fmaxf(am, fmaxf(fabsf(v[j].x), fabsf(v[j].y))), fmaxf(fabsf(v[j].z), fabsf(v[j].w))); }
                    am = wave_max(am); const float inv = am > 0.f ? 127.0f / am : 0.f;
                    if (lane == 0) HLS[m] = am > 0.f ? am * (1.0f / 127.0f) : 1.0f;
                    unsigned* o4 = (unsigned*)((signed char*)HL + (size_t)m * D) + lane;
                    const int rowl = wave * 4 + r4;
#pragma unroll
                    for (int j = 0; j < 4; ++j) { o4[64 * j] = q8x4(v[j], inv);
                        u32x2 hi; hi.x = pk2(v[j].x, v[j].y); hi.y = pk2(v[j].z, v[j].w);
                        u32x2 lo; lo.x = pk2(v[j].x - bflo(hi.x), v[j].y - bfhi(hi.x)); lo.y = pk2(v[j].z - bflo(hi.y), v[j].w - bfhi(hi.y));
                        *(LAS u32x2*)(AH + rowl * 2064 + (4 * lane + 256 * j) * 2) = hi; *(LAS u32x2*)(AL + rowl * 2064 + (4 * lane + 256 * j) * 2) = lo; }
                }
                if (tile + 1 < 8) ldtile(blk, tile + 1);
                __syncthreads();
                f32x16 acc;
#pragma unroll
                for (int r = 0; r < 16; ++r) acc[r] = 0.f;
#pragma unroll
                for (int s = 0; s < 8; ++s) { const int ko = (128 * wave + 16 * s + 8 * h5) * 2;
                    const bf16x8 ah = *(const LAS bf16x8*)(AH + l31 * 2064 + ko), al = *(const LAS bf16x8*)(AL + l31 * 2064 + ko);
                    acc = MFMA32(ah, bh[s], acc); acc = MFMA32(ah, bl[s], acc); acc = MFMA32(al, bh[s], acc); }
                __syncthreads();
#pragma unroll
                for (int r = 0; r < 16; ++r) RED[(wave * 32 + crow(r, h5)) * 32 + l31] = acc[r];
                __syncthreads();
#pragma unroll
                for (int i = 0; i < 2; ++i) { const int idx = tid + 512 * i, t = idx >> 5, e = idx & 31; float sum = args.in[I_RB][e];
#pragma unroll
                    for (int w8 = 0; w8 < 8; ++w8) sum += RED[(w8 * 32 + t) * 32 + e];
                    LOG[t * 33 + e] = sum; }
                __syncthreads();
#pragma unroll
                for (int r4 = 0; r4 < 4; ++r4) {
                    const int m = m0 + r4; float tv[4]; int ti[4]; float cur = lane < 32 ? LOG[(wave * 4 + r4) * 33 + lane] : -3.0e38f;
#pragma unroll
                    for (int k = 0; k < 4; ++k) { float mx = cur;
#pragma unroll
                        for (int o = 1; o < 64; o <<= 1) mx = fmaxf(mx, __shfl_xor(mx, o));
                        const unsigned long long msk = __ballot(cur == mx && lane < 32); const int sel = __ffsll((long long)msk) - 1; tv[k] = mx; ti[k] = sel; if (lane == sel) cur = -3.0e38f; }
                    const float e1 = __expf(tv[1] - tv[0]), e2 = __expf(tv[2] - tv[0]), e3 = __expf(tv[3] - tv[0]); const float inv = 1.0f / (1.0f + e1 + e2 + e3);
                    if (lane < 4) { const int k = lane; const int ee = k == 0 ? ti[0] : k == 1 ? ti[1] : k == 2 ? ti[2] : ti[3]; const float gg = (k == 0 ? 1.0f : k == 1 ? e1 : k == 2 ? e2 : e3) * inv;
                        const int lp = __hip_atomic_fetch_add(&CNT[ee], 1, __ATOMIC_RELAXED, __HIP_MEMORY_SCOPE_WORKGROUP);
                        EIDX[m * 4 + k] = ee; GATE[m * 4 + k] = gg; LPOS[m * 4 + k] = lp; }
                }
            }
            __syncthreads();
            if (tid < 32) BCNT[blk * 32 + tid] = CNT[tid];
        }
    }
    SEAM(ST_M0); STAMP(9);
#define MOE_TABLES() do { \
        LAS int* TB = (LAS int*)lds;                   \
        LAS int* EB = (LAS int*)(lds + 32768);         \
        __syncthreads(); \
        for (int i = tid; i < NRANGE * WBR * 32; i += NTHR) TB[i] = BCNT[i]; \
        __syncthreads(); \
        if (tid < NRANGE * 32) { const int r = tid >> 5, e = tid & 31; int run = 0; _Pragma("unroll 4") for (int wb = 0; wb < WBR; ++wb) { const int c_ = TB[(r * WBR + wb) * 32 + e]; TB[(r * WBR + wb) * 32 + e] = run; run += c_; } EB[128 + tid] = run; } \
        __syncthreads(); \
        if (tid < NRANGE) { int run = 0; _Pragma("unroll 1") for (int e = 0; e < 32; ++e) { EB[tid * 32 + e] = run; run += (EB[128 + tid * 32 + e] + 255) & ~255; } EB[256 + tid] = run >> 8; } \
        __syncthreads(); \
        for (int i = tid; i < NRANGE * WBR * 32; i += NTHR) { const int r = i / (WBR * 32), e = i & 31; TB[i] += EB[r * 32 + e]; } \
        __syncthreads(); } while (0)
#define MOE_SCATTER(r) do { \
        LAS int* TB = (LAS int*)lds; LAS int* EB = (LAS int*)(lds + 32768); \
        for (int idx = bid * NTHR + tid; idx < RTOK * 4; idx += G * NTHR) { const int m = (r) * RTOK + (idx >> 2), k = idx & 3; const int wb = (idx >> 2) >> 8; \
            const int e = EIDX[m * 4 + k]; const int row = TB[((r) * WBR + wb) * 32 + e] + LPOS[m * 4 + k]; AROW[m * 4 + k] = row; HPS[row] = HLS[m]; ROWTOK[row] = m; } \
        for (int e = bid; e < 32; e += G) { const int tot = EB[128 + (r) * 32 + e], base = EB[(r) * 32 + e]; const int npad = ((tot + 255) & ~255) - tot; \
            for (int i = tid; i < npad; i += NTHR) { HPS[base + tot + i] = 0.f; ROWTOK[base + tot + i] = -1; } } } while (0)
    if (PH_EN(10) && IN(ST_M1)) for (int rep = 0; rep < DUP_N(10); ++rep) {
        const int tid = opaque_tid(), lane = tid & 63, wave = __builtin_amdgcn_readfirstlane(tid >> 6), gw = bid * NWAVES + wave; (void)lane; (void)gw; (void)rep;
        MOE_TABLES();
        if (bid == 0) {
            LAS int* TB = (LAS int*)lds; LAS int* EB = (LAS int*)(lds + 32768);
            for (int i = tid; i < NRANGE * WBR * 32; i += NTHR) BBASE[i] = TB[i];
            if (tid < NRANGE) NTILE[tid] = EB[256 + tid];
            for (int i = tid; i < NRANGE * 32; i += NTHR) { const int r = i >> 5, e = i & 31; const int base = EB[r * 32 + e], nt = (EB[128 + i] + 255) >> 8; for (int t = 0; t < nt; ++t) TILEE[r * TILE_LD + (base >> 8) + t] = e; }
        }
        MOE_SCATTER(0);
    }
    SEAM(ST_M1); STAMP(10);
    for (int r = 0; r < NRANGE; ++r) {
        const int s0 = ST_RNG + 3 * r;
        if (PH_EN(11) && IN(s0 + 0)) for (int rep = 0; rep < DUP_N(11); ++rep) {
        const int tid = opaque_tid(), lane = tid & 63, wave = __builtin_amdgcn_readfirstlane(tid >> 6), gw = bid * NWAVES + wave; (void)lane; (void)gw; (void)rep;
            pg8::Gemm g{HL, W1T, 512, 512, 512, HPS, W1S, ROWTOK}; pg8::MoeOrder S{TILEE + r * TILE_LD, NTILE[r], 8, G, bid}; EpiHid E{(unsigned char*)HID, args.in[I_B1]};
            STAGGER(STAG_M2); pg8::gemm_phase<EpiHid, pg8::MoeOrder, 1, true>(lds, g, S, E);
        }
        SEAM(s0 + 0); STAMP(11);
        if (PH_EN(12) && IN(s0 + 1)) for (int rep = 0; rep < DUP_N(12); ++rep) {
        const int tid = opaque_tid(), lane = tid & 63, wave = __builtin_amdgcn_readfirstlane(tid >> 6), gw = bid * NWAVES + wave; (void)lane; (void)gw; (void)rep;
            pg8::Gemm g{HID, W2T, 512, 512, 512, nullptr, W2S, nullptr}; pg8::MoeOrder S{TILEE + r * TILE_LD, NTILE[r], 4, G, bid}; EpiY E{(unsigned char*)YPAD, args.in[I_B2]};
            STAGGER(STAG_M3); pg8::gemm_phase<EpiY, pg8::MoeOrder, 2>(lds, g, S, E);
        }
        SEAM(s0 + 1); STAMP(12);
        if (PH_EN(13) && IN(s0 + 2)) for (int rep = 0; rep < DUP_N(13); ++rep) {
        const int tid = opaque_tid(), lane = tid & 63, wave = __builtin_amdgcn_readfirstlane(tid >> 6), gw = bid * NWAVES + wave; (void)lane; (void)gw; (void)rep;
            for (int mb = r * RTOK + gw * 16; mb < (r + 1) * RTOK; mb += NGW * 16) {
                const int arow_l = AROW[mb * 4 + lane]; const float gate_l = GATE[mb * 4 + lane];
                const int b = mb >> 13;
                f32x4 g2v[4], fgv[4];
#pragma unroll
                for (int j = 0; j < 4; ++j) { g2v[j] = *(const f32x4*)(mod + b * 6144 + 5120 + 4 * lane + 256 * j); fgv[j] = *(const f32x4*)(args.in[I_FG] + 4 * lane + 256 * j); }
                f32x4 xv[2][4]; unsigned yw[2][4][4];
                auto issue = [&](int i, f32x4 (&xx)[4], unsigned (&yy)[4][4]) { const int m = mb + i;
#pragma unroll
                    for (int j = 0; j < 4; ++j) xx[j] = __builtin_nontemporal_load((const f32x4*)(args.out + (size_t)m * D) + lane + 64 * j);
#pragma unroll
                    for (int k = 0; k < 4; ++k) { const int row = __shfl(arow_l, 4 * i + k); const unsigned* yp = (const unsigned*)((const unsigned char*)YPAD + (size_t)row * D) + lane;
#pragma unroll
                        for (int j = 0; j < 4; ++j) yy[k][j] = __builtin_nontemporal_load(yp + 64 * j); } };
                auto finish = [&](int i, const f32x4 (&xx)[4], const unsigned (&yy)[4][4]) { const int m = mb + i; f32x4 v[4]; float ss = 0.f;
#pragma unroll
                    for (int j = 0; j < 4; ++j) { f32x4 y = {0.f, 0.f, 0.f, 0.f};
#pragma unroll
                        for (int k = 0; k < 4; ++k) { const float gk = __shfl(gate_l, 4 * i + k); const int w = (int)yy[k][j]; const f32x2 lo = __builtin_amdgcn_cvt_pk_f32_fp8(w, false), hi = __builtin_amdgcn_cvt_pk_f32_fp8(w, true);
                            y.x += gk * lo.x; y.y += gk * lo.y; y.z += gk * hi.x; y.w += gk * hi.y; }
                        v[j] = xx[j] + g2v[j] * y; ss += (v[j].x * v[j].x + v[j].y * v[j].y) + (v[j].z * v[j].z + v[j].w * v[j].w); }
                    const float rstd = 1.0f / sqrtf(wave_sum(ss) * (1.0f / D) + EPS);
#pragma unroll
                    for (int j = 0; j < 4; ++j) ((f32x4*)((DRY(13) ? (float*)(ws + WS_DUMMY) + (size_t)((m - r * RTOK) & 16383) * D : args.out + (size_t)m * D)) + lane)[64 * j] = v[j] * rstd * fgv[j]; };
                issue(0, xv[0], yw[0]);
#pragma unroll 1
                for (int i = 0; i < 16; i += 2) {
                    issue(i + 1, xv[1], yw[1]);
                    finish(i, xv[0], yw[0]);
                    if (i + 2 < 16) issue(i + 2, xv[0], yw[0]);
                    finish(i + 1, xv[1], yw[1]);
                }
            }
            if (r + 1 < NRANGE) { MOE_TABLES(); MOE_SCATTER(r + 1); }
        }
        if (r + 1 < NRANGE) SEAM(s0 + 2);
        STAMP(13);
    }
#if MK_PROBE
    {
        unsigned* PR = (unsigned*)(ws + WS_CTL) + 8192;
        xcd_barrier(bar);
        if (bid == 0 && threadIdx.x == 0) { PR[0] = MISC[16 + PROBE_SEL1]; PR[1] = MISC[16 + PROBE_SEL2]; }
        xcd_barrier(bar);
        const float d1 = (float)__hip_atomic_load(PR, __ATOMIC_RELAXED, __HIP_MEMORY_SCOPE_AGENT) * 0.01f, d2 = (float)__hip_atomic_load(PR + 1, __ATOMIC_RELAXED, __HIP_MEMORY_SCOPE_AGENT) * 0.01f;
        const float sc = 1.0f + sqrtf(d1 * 1e-4f);
        for (size_t i = (size_t)bid * NTHR + threadIdx.x; i < (size_t)NTOK * D / 4; i += (size_t)G * NTHR) { f32x4 v = ((f32x4*)args.out)[i]; v *= sc; if (i == 0) v.x += d2 * 0.25f; ((f32x4*)args.out)[i] = v; }
    }
#endif
#undef IN
#undef SEAM
}

extern "C" void kernel_launch(void* const* d_in, const int* in_sizes, int n_in, void* d_out, int out_size, void* d_ws, size_t ws_size, hipStream_t stream) {
    static int grid = 0;
    if (grid == 0) {
        if (n_in != 26 || in_sizes[0] != NTOK * D || out_size != NTOK * D || ws_size < WS_END) { fprintf(stderr, "kernel_launch: unexpected shapes (n_in %d, in0 %d, out %d, ws %zu); nothing launched\n", n_in, n_in > 0 ? in_sizes[0] : -1, out_size, ws_size); grid = -1; return; }
        int dev = 0, cus = 0, per_cu = 0;
        if (hipGetDevice(&dev) != hipSuccess || hipDeviceGetAttribute(&cus, hipDeviceAttributeMultiprocessorCount, dev) != hipSuccess) { grid = -1; return; }
        if (hipFuncSetAttribute((const void*)fwd_kernel, hipFuncAttributeMaxDynamicSharedMemorySize, LDS_BYTES) != hipSuccess) { fprintf(stderr, "kernel_launch: hipFuncSetAttribute failed\n"); grid = -1; return; }
        if (hipOccupancyMaxActiveBlocksPerMultiprocessor(&per_cu, (const void*)fwd_kernel, NTHR, LDS_BYTES) != hipSuccess || per_cu < 1) fprintf(stderr, "kernel_launch: occupancy query reports %d\n", per_cu);
        (void)hipGetLastError();
        grid = cus;
    }
    if (grid < 0) return;
    if (hipMemsetAsync((char*)d_ws + WS_CTL, 0, CTL_ZERO_BYTES, stream) != hipSuccess) return;
    Args a{};
    for (int i = 0; i < 26; ++i) a.in[i] = (const float*)d_in[i];
    a.out = (float*)d_out; a.ws = (unsigned char*)d_ws;
#if MK_PER_PHASE
    for (int s = 0; s < ST_END; ++s) { a.lo = s; a.hi = s + 1; hipLaunchKernelGGL(fwd_kernel, dim3(grid), dim3(NTHR), LDS_BYTES, stream, a); }
#else
    a.lo = 0; a.hi = ST_END;
    hipLaunchKernelGGL(fwd_kernel, dim3(grid), dim3(NTHR), LDS_BYTES, stream, a);
#endif
    const hipError_t le = hipPeekAtLastError();
    if (le != hipSuccess) fprintf(stderr, "kernel_launch: launch failed: %s\n", hipGetErrorName(le));
}
```

```cpp
#include <hip/hip_runtime.h>
#include <type_traits>
#include <cstdio>
#include <cstdint>

#ifndef MK_PER_PHASE
#define MK_PER_PHASE 0
#endif

#ifndef MK_PROBE
#define MK_PROBE 0
#endif
#ifndef PROBE_SEL1
#define PROBE_SEL1 3
#endif
#ifndef PROBE_SEL2
#define PROBE_SEL2 4
#endif
#ifndef MK_DUP
#define MK_DUP 0u
#endif
#define DUP_N(k) ((((MK_DUP) >> (k)) & 1u) ? 2 : 1)
#define DRY(k) ((((MK_DUP) >> (k)) & 1u) && rep == 0)
#ifndef MK_DRYMODE
#define MK_DRYMODE 0
#endif
#ifndef STAG_B
#define STAG_B 0
#endif
#ifndef STAG_M2
#define STAG_M2 0
#endif
#ifndef STAG_M3
#define STAG_M3 0
#endif
#define STAGGER(n) do { const int slot_ = (bid >> 3) & 3; for (int i_ = 0; i_ < slot_ * (n); ++i_) __builtin_amdgcn_s_sleep(127); } while (0)
#ifndef MK_PHASES
#define MK_PHASES 0xFFFFu
#endif
#define PH_EN(k) (((MK_PHASES) >> (k)) & 1u)
#define LAS __attribute__((address_space(3)))
#define GAS __attribute__((address_space(1)))
typedef unsigned short bf16;
typedef short bf16x8 __attribute__((ext_vector_type(8)));
typedef short s16x4 __attribute__((ext_vector_type(4)));
typedef float f32x2 __attribute__((ext_vector_type(2)));
typedef float f32x4 __attribute__((ext_vector_type(4)));
typedef float f32x16 __attribute__((ext_vector_type(16)));
typedef unsigned u32x2 __attribute__((ext_vector_type(2)));
typedef unsigned u32x4 __attribute__((ext_vector_type(4)));

constexpr int D = 1024, NB = 8, SEQ = 8192, NTOK = NB * SEQ, CTXL = 256, NCTX = NB * CTXL, DIN = 10240, ZLD = 10240 + 128;
constexpr int NROWS_HL = NTOK + NCTX;
constexpr int GB = 2, NGRP = NB / GB, GROWS = GB * SEQ;
constexpr int NEXP = 32, TOPK = 4, DEXP = 1024;
constexpr int NRANGE = 1, RTOK = NTOK / NRANGE, WBR = RTOK / 256;
constexpr int RROWS = 4 * RTOK + 32 * 256, RTILES = RROWS / 256, TILE_LD = RTILES + 32;
constexpr float EPS = 1e-6f;
constexpr float K_SCALE = 0.08838834764831845f;
constexpr int C_XR = 0, C_GR = 1024, C_Q = 2048, C_K = 3072, C_V = 4096, C_GS = 6144, C_GA = 8192, C_GB = 9216;
constexpr int ZC_LD = 4096, ZC_XR = 0, ZC_K = 1024, ZC_V = 2048;

constexpr size_t MiB = 1u << 20;
constexpr size_t WS_CTL = 0, CTL_ZERO_BYTES = 1 * MiB;
constexpr size_t WS_MOD = 1 * MiB;
constexpr size_t WS_ROPE = 1 * MiB + 256 * 1024;
constexpr size_t WS_RWB = 1 * MiB + 512 * 1024;
constexpr size_t WS_CARRY = 2 * MiB;
constexpr size_t WS_HLS = 7 * MiB;
constexpr size_t WS_WINS = 7 * MiB + 320 * 1024;
constexpr size_t WS_W1S = 7 * MiB + 384 * 1024;
constexpr size_t WS_HPS = 880 * MiB;
constexpr size_t WS_WFS = 7 * MiB + 640 * 1024;
constexpr size_t WS_EIDX = 8 * MiB, WS_GATE = 9 * MiB, WS_LPOS = 10 * MiB, WS_AROW = 11 * MiB;
constexpr size_t WS_BCNT = 12 * MiB;
constexpr size_t WS_BBASE = 12 * MiB + 64 * 1024;
constexpr size_t WS_TILEE = 12 * MiB + 128 * 1024;
constexpr size_t WS_NTILE = 12 * MiB + 192 * 1024;
constexpr size_t WS_WG = 14 * MiB;
constexpr size_t WS_WRNN = 16 * MiB, WS_WOUT = 22 * MiB, WS_WIN = 24 * MiB;
constexpr size_t WS_HL = 44 * MiB;
constexpr size_t WS_ZC = 176 * MiB;
constexpr size_t WS_CTXU = 192 * MiB;
constexpr size_t WS_Z = 208 * MiB;
constexpr size_t WS_ST = 536 * MiB;
constexpr size_t WS_T1 = 664 * MiB, WS_MG = 696 * MiB;
constexpr size_t WS_W1T = 736 * MiB;
constexpr size_t WS_W2T = 848 * MiB;
constexpr size_t WS_HPAD = 208 * MiB, WS_HID = 210 * MiB, WS_YPAD = 474 * MiB;
constexpr size_t WS_AR = 912 * MiB, WS_AT = 944 * MiB;
constexpr size_t WS_DUMMY = 912 * MiB;
constexpr size_t WS_END = 1024 * MiB;
constexpr int CW_BAR = 4096;

constexpr int LDS_BYTES = 149504;
constexpr int MISC_OFF = LDS_BYTES - 256;
constexpr int NWAVES = 8, NTHR = 512;

__device__ __forceinline__ unsigned f2bf(float f) { unsigned u = __builtin_bit_cast(unsigned, f); return (u + 0x7fffu + ((u >> 16) & 1u)) >> 16; }
typedef __bf16 hwbf16x2 __attribute__((ext_vector_type(2)));
__device__ __forceinline__ unsigned pk2(float lo, float hi) { const f32x2 v = {lo, hi}; return __builtin_bit_cast(unsigned, __builtin_convertvector(v, hwbf16x2)); }
__device__ __forceinline__ float bflo(unsigned w) { return __builtin_bit_cast(float, w << 16); }
__device__ __forceinline__ float bfhi(unsigned w) { return __builtin_bit_cast(float, w & 0xffff0000u); }
__device__ __forceinline__ float bf2f(unsigned short h) { return __builtin_bit_cast(float, ((unsigned)h) << 16); }
__device__ __forceinline__ float sigmoidf_(float x) { return __builtin_amdgcn_rcpf(1.0f + __expf(-x)); }
__device__ __forceinline__ float wave_sum(float v) {
#pragma unroll
    for (int o = 1; o < 64; o <<= 1) v += __shfl_xor(v, o);
    return v;
}
template <int CTRL> __device__ __forceinline__ float dpp_f(float v) { return __builtin_bit_cast(float, __builtin_amdgcn_update_dpp(0, __builtin_bit_cast(int, v), CTRL, 0xF, 0xF, true)); }
__device__ __forceinline__ float row16_sum(float v) { v += dpp_f<0xB1>(v); v += dpp_f<0x4E>(v); v += dpp_f<0x141>(v); v += dpp_f<0x140>(v); return v; }
__device__ __forceinline__ float wave_max(float v) {
#pragma unroll
    for (int o = 1; o < 64; o <<= 1) v = fmaxf(v, __shfl_xor(v, o));
    return v;
}
__device__ __forceinline__ unsigned q8x4(f32x4 v, float inv) {
    const int a = (int)rintf(v.x * inv), b = (int)rintf(v.y * inv), c = (int)rintf(v.z * inv), d = (int)rintf(v.w * inv);
    return ((unsigned)a & 0xffu) | (((unsigned)b & 0xffu) << 8) | (((unsigned)c & 0xffu) << 16) | (((unsigned)d & 0xffu) << 24);
}
#define LDS_WAIT() asm volatile("s_waitcnt lgkmcnt(0)" ::: "memory")
__device__ __forceinline__ int opaque_tid() { int t = threadIdx.x; asm volatile("" : "+v"(t)); return t; }
template <class T> __device__ __forceinline__ T* opaque_ptr(T* p) { unsigned long long u = (unsigned long long)p; asm volatile("" : "+s"(u)); return (T*)u; }

namespace pg8 {
constexpr int BM = 256, BK = 64, HALF = 128, HTB = HALF * BK * 2, STAGE_BYTES = 8 * HTB, NXCD = 8, WGM = 8;
__host__ __device__ __forceinline__ int lds_byte(int r, int c) { const int st = (r >> 4) * 2 + (c >> 5), rr = r & 15, cc = c & 31, ob = rr * 64 + cc * 2; return st * 1024 + (ob ^ (((ob >> 9) & 1) << 5)); }
__host__ __device__ __forceinline__ void stage_rc(int b, int& R, int& C) { const int st = b / 1024, sb = b % 1024, swz = sb ^ (((sb >> 9) & 1) << 5); R = (st >> 1) * 16 + swz / 64; C = (st & 1) * 32 + (swz % 64) / 2; }
__host__ __device__ __forceinline__ int perm32(int rho) { const int n = rho >> 4, i = rho & 15; return 8 * (i >> 2) + 4 * n + (i & 3); }
struct Unit { int pm, pn; int koff = 0, nt = 0; };
struct Gemm { const bf16* A; const bf16* Bt; int lda, ldb, K; const float* SA; const float* SB; const int* RT; };
struct StaticOrder {
    int nM, nN, nwg, G, c;
    __device__ void init(int nM_, int nN_, int G_, int c_) { nM = nM_; nN = nN_; nwg = nM * nN; G = G_; c = c_; }
    __device__ bool next(int i, Unit& u) const {
        const long L = (long)i * G + c; if (L >= nwg) return false;
        int wgid = (int)L; { const int q = nwg / NXCD, r = nwg % NXCD, xcd = wgid % NXCD, off = wgid / NXCD; wgid = (xcd < r ? xcd * (q + 1) : r * (q + 1) + (xcd - r) * q) + off; }
        const int nig = WGM * nN, gid = wgid / nig, fm = gid * WGM, gsz = (nM - fm) < WGM ? (nM - fm) : WGM;
        u.pm = fm + ((wgid % nig) % gsz); u.pn = (wgid % nig) / gsz; return true;
    }
};
struct CtxOrder {
    int G, c;
    __device__ bool next(int i, Unit& u) const { const int L = i * G + c; if (L >= 128) return false; const int j = L >> 3; u.pm = 256 + (L & 7); u.pn = j < 4 ? j : j + 8; return true; }
};
struct FOrder {
    StaticOrder so;
    __device__ bool next(int i, Unit& u) const { Unit t; if (!so.next(i >> 1, t)) return false; u.pm = t.pm; u.pn = t.pn; u.koff = (i & 1) ? 1024 : 0; u.nt = (i & 1) ? 32 : 16; return true; }
};
struct MoeOrder {
    const int* tile_e; int ntiles, npn, G, c;
    __device__ bool next(int i, Unit& u) const {
        if ((G & 7) == 0 && ((G >> 3) % npn) == 0) { const int x = c & 7, y = c >> 3, T = (G >> 3) / npn; const int ti = (i * 8 + x) * T + y / npn, pl = y % npn;
            if (ti >= ntiles) return false; u.pm = ti; u.pn = tile_e[ti] * npn + pl; return true; }
        const long L = (long)i * G + c; if (L >= (long)ntiles * npn) return false; const int ti = (int)(L / npn), pl = (int)(L % npn);
        u.pm = ti; u.pn = tile_e[ti] * npn + pl; return true; }
};

typedef int i32x4 __attribute__((ext_vector_type(4)));
typedef int i32x8 __attribute__((ext_vector_type(8)));
template <int MODE> struct Frag { bf16x8 v[2]; };
template <> struct Frag<2> { i32x8 w; };
template <class Epi, class Sched, int MODE = 0, bool GATHER = false>
__device__ __forceinline__ void gemm_phase(LAS unsigned char* lds, const Gemm g, const Sched& S, const Epi& E) {
    const int tid = opaque_tid(), wid = __builtin_amdgcn_readfirstlane(tid >> 6), lane = tid & 63, wr = wid >> 2, wc = wid & 3, fr = lane & 15, fq = lane >> 4;
    const int K = g.K, nt = K / BK;
    const bf16* gA = opaque_ptr(g.A); const bf16* gBt = opaque_ptr(g.Bt);
    unsigned voffA[2], voffB[2]; int RA[2]; unsigned CA[2];
#pragma unroll
    for (int i = 0; i < 2; ++i) { int R, C; stage_rc(tid * 16 + i * 8192, R, C); const int Rb = 64 * (R >> 5) + (Epi::PERM ? perm32(R & 31) : (R & 31));
        voffA[i] = (unsigned)(R * g.lda + C) * 2u; voffB[i] = (unsigned)(Rb * g.ldb + C) * 2u; RA[i] = R; CA[i] = (unsigned)C * 2u; }
    (void)RA; (void)CA;
    const size_t kstep = (size_t)(BK * 2);
    const size_t hstepA = GATHER ? (size_t)0 : (size_t)HALF * g.lda * 2, hstepB = (size_t)32 * g.ldb * 2;
    unsigned vC[2][2], vN[2][2];
    auto gather_offs = [&](int pm, unsigned (&v)[2][2]) {
#pragma unroll
        for (int hh = 0; hh < 2; ++hh)
#pragma unroll
            for (int i = 0; i < 2; ++i) { int tok = g.RT[pm * 256 + hh * 128 + RA[i]]; tok = tok < 0 ? 0 : tok; v[hh][i] = (unsigned)tok * (unsigned)(g.lda * 2) + CA[i]; } };
    const size_t tstepA = (size_t)BM * g.lda * 2, tstepB = (size_t)BM * g.ldb * 2;
    const unsigned ldsw = (unsigned)wid * 1024u;
    const int aoff = lds_byte(wr * 64 + fr, fq * 8), boff = lds_byte(wc * 32 + fr, fq * 8);
#define PG8_SA(b, h) (((b) * 2 + (h)) * HTB)
#define PG8_SB(b, h) ((4 + (b) * 2 + (h)) * HTB)
#define PG8_STAGE(bufoff, gbase, voff) do { _Pragma("unroll") for (int _i = 0; _i < 2; ++_i) \
        __builtin_amdgcn_global_load_lds((const unsigned*)((const char*)(gbase) + (voff)[_i]), (LAS unsigned*)(lds + (bufoff) + ldsw + _i * 8192), 16, 0, 0); } while (0)
#define PG8_STAGE_A(bufoff, gbase, hh, nx) do { if constexpr (GATHER) { _Pragma("unroll") for (int _i = 0; _i < 2; ++_i) { const unsigned _o = (nx) ? vN[hh][_i] : vC[hh][_i]; \
        __builtin_amdgcn_global_load_lds((const unsigned*)((const char*)(gbase) + _o), (LAS unsigned*)(lds + (bufoff) + ldsw + _i * 8192), 16, 0, 0); } } else PG8_STAGE(bufoff, gbase, voffA); } while (0)
#define PG8_LD1(dst, p) do { if constexpr (MODE == 2) (dst).w = __builtin_shufflevector(*(const LAS i32x4*)(p), *(const LAS i32x4*)((p) + 1024), 0, 1, 2, 3, 4, 5, 6, 7); \
        else { (dst).v[0] = *(const LAS bf16x8*)(p); (dst).v[1] = *(const LAS bf16x8*)((p) + 1024); } } while (0)
#define PG8_LDA(dst, b, h) do { _Pragma("unroll") for (int m = 0; m < 4; ++m) PG8_LD1(dst[m], lds + PG8_SA(b, h) + aoff + m * 2048); } while (0)
#define PG8_LDB(dst, b, h) do { _Pragma("unroll") for (int n = 0; n < 2; ++n) PG8_LD1(dst[n], lds + PG8_SB(b, h) + boff + n * 2048); } while (0)
#define PG8_MMA(ai, bj, At, Bt) do { __builtin_amdgcn_s_setprio(1); _Pragma("unroll") for (int m = 0; m < 4; ++m) _Pragma("unroll") for (int n = 0; n < 2; ++n) { \
        if constexpr (MODE == 2) {   \
              \
            asm volatile("v_mfma_scale_f32_16x16x128_f8f6f4 %0, %1, %2, %0, %3, %3 op_sel_hi:[0,0,0]" : "+v"(acc[ai][bj][m][n]) : "v"(Bt[n].w), "v"(At[m].w), "v"(sc1)); \
        } else { _Pragma("unroll") for (int k = 0; k < 2; ++k) \
        { if constexpr (MODE == 1) acc[ai][bj][m][n] = __builtin_bit_cast(f32x4, __builtin_amdgcn_mfma_i32_16x16x64_i8(__builtin_bit_cast(i32x4, Bt[n].v[k]), __builtin_bit_cast(i32x4, At[m].v[k]), __builtin_bit_cast(i32x4, acc[ai][bj][m][n]), 0, 0, 0)); \
          else acc[ai][bj][m][n] = __builtin_amdgcn_mfma_f32_16x16x32_bf16(Bt[n].v[k], At[m].v[k], acc[ai][bj][m][n], 0, 0, 0); } } } __builtin_amdgcn_s_setprio(0); } while (0)
#define PG8_WAIT_V(n) asm volatile("s_waitcnt vmcnt(" #n ")" ::: "memory")
#define PG8_WAIT_L(n) asm volatile("s_waitcnt lgkmcnt(" #n ")" ::: "memory")
#define PG8_BAR __builtin_amdgcn_s_barrier()
#define PG8_SCHED __builtin_amdgcn_sched_barrier(0)
    Unit cur, nxt; int ui = 0;
    if (!S.next(0, cur)) return;
    constexpr int SC_OFF = 8 * HTB;
    auto stage_scales = [&](const Unit& u, int par) {
        if constexpr (MODE != 0) { if (MODE == 1 || wid >= 4) { const float* sp = wid < 4 ? g.SA + u.pm * 256 + tid : g.SB + u.pn * 256 + (tid - 256);
            __builtin_amdgcn_global_load_lds((const unsigned*)sp, (LAS unsigned*)(lds + SC_OFF + par * 2048 + wid * 256), 4, 0, 0); } } };
    stage_scales(cur, 0);
    f32x4 acc[2][2][4][2];
#pragma unroll
    for (int a = 0; a < 2; ++a)
#pragma unroll
        for (int b = 0; b < 2; ++b)
#pragma unroll
            for (int m = 0; m < 4; ++m)
#pragma unroll
                for (int n = 0; n < 2; ++n) acc[a][b][m][n] = (f32x4){0.f, 0.f, 0.f, 0.f};
    Frag<MODE> At[4], B0[2], B1[2]; const int sc1 = 0x7f7f7f7f; (void)sc1;
    const char* cA = GATHER ? (const char*)gA : (const char*)gA + (size_t)cur.pm * tstepA + (size_t)cur.koff * 2; const char* cB = (const char*)gBt + (size_t)cur.pn * tstepB + (size_t)cur.koff * 2;
    if constexpr (GATHER) gather_offs(cur.pm, vC);
    PG8_STAGE(PG8_SB(0, 0), cB, voffB); PG8_STAGE(PG8_SB(0, 1), cB + hstepB, voffB); PG8_STAGE_A(PG8_SA(0, 0), cA, 0, false); PG8_STAGE_A(PG8_SA(0, 1), cA + hstepA, 1, false);
    if (wr == 1) PG8_BAR;
    PG8_WAIT_V(2); PG8_BAR;
    PG8_STAGE(PG8_SB(1, 0), cB + kstep, voffB); PG8_STAGE_A(PG8_SA(1, 0), cA + kstep, 0, false); PG8_STAGE(PG8_SB(1, 1), cB + hstepB + kstep, voffB);
    PG8_WAIT_V(6); PG8_BAR;
    for (;;) {
        const bool has_next = S.next(ui + 1, nxt);
        const char* nA = (has_next && !GATHER) ? (const char*)gA + (size_t)nxt.pm * tstepA + (size_t)nxt.koff * 2 : cA; const char* nB = has_next ? (const char*)gBt + (size_t)nxt.pn * tstepB + (size_t)nxt.koff * 2 : cB;
        const int ntc = cur.nt ? cur.nt : nt;
        if constexpr (GATHER) { if (has_next) gather_offs(nxt.pm, vN); else {
#pragma unroll
            for (int hh = 0; hh < 2; ++hh)
#pragma unroll
                for (int i = 0; i < 2; ++i) vN[hh][i] = vC[hh][i]; } }
#pragma unroll 1
        for (int t = 0; t < ntc; t += 2) {
            const bool last = (t == ntc - 2);
            const char* a1 = cA + (size_t)(t + 1) * kstep;
            const char* a2 = last ? nA : cA + (size_t)(t + 2) * kstep; const char* b2 = last ? nB : cB + (size_t)(t + 2) * kstep;
            const char* a3 = a2 + kstep; const char* b3 = b2 + kstep;
            PG8_LDB(B0, 0, 0); PG8_LDB(B1, 0, 1); PG8_SCHED; PG8_LDA(At, 0, 0); PG8_STAGE_A(PG8_SA(1, 1), a1 + hstepA, 1, false);
            PG8_WAIT_V(8); PG8_WAIT_L(0); PG8_BAR; PG8_MMA(0, 0, At, B0); PG8_MMA(0, 1, At, B1); PG8_SCHED; PG8_BAR; PG8_SCHED;
            PG8_LDA(At, 0, 1); PG8_STAGE(PG8_SB(0, 0), b2, voffB); PG8_STAGE(PG8_SB(0, 1), b2 + hstepB, voffB); PG8_STAGE_A(PG8_SA(0, 0), a2, 0, last);
            PG8_WAIT_V(8); PG8_WAIT_L(0); PG8_BAR; PG8_MMA(1, 0, At, B0); PG8_MMA(1, 1, At, B1); PG8_SCHED; PG8_BAR; PG8_SCHED;
            PG8_LDB(B0, 1, 0); PG8_LDB(B1, 1, 1); PG8_SCHED; PG8_LDA(At, 1, 0); PG8_STAGE_A(PG8_SA(0, 1), a2 + hstepA, 1, last);
            PG8_WAIT_V(8); PG8_WAIT_L(0); PG8_BAR; PG8_MMA(0, 0, At, B0); PG8_MMA(0, 1, At, B1); PG8_SCHED; PG8_BAR; PG8_SCHED;
            PG8_LDA(At, 1, 1); PG8_STAGE(PG8_SB(1, 0), b3, voffB); PG8_STAGE(PG8_SB(1, 1), b3 + hstepB, voffB); PG8_STAGE_A(PG8_SA(1, 0), a3, 0, last);
            PG8_WAIT_V(8); PG8_WAIT_L(0); PG8_BAR; PG8_MMA(1, 0, At, B0); PG8_MMA(1, 1, At, B1); PG8_SCHED; PG8_BAR; PG8_SCHED;
        }
        if (wr == 0) PG8_BAR;
        if constexpr (MODE == 2) {
            int fq_ = fq; asm volatile("" : "+v"(fq_));
            const LAS float* sb = (const LAS float*)(lds + SC_OFF + (ui & 1) * 2048) + 256 + wc * 64 + (Epi::PERM ? 8 : 4) * fq_;
            f32x4 cs[2][2];
#pragma unroll
            for (int b = 0; b < 2; ++b)
#pragma unroll
                for (int n = 0; n < 2; ++n) cs[b][n] = *(const LAS f32x4*)(sb + b * 32 + (Epi::PERM ? 4 : 16) * n);
#pragma unroll
            for (int a = 0; a < 2; ++a)
#pragma unroll
                for (int b = 0; b < 2; ++b)
#pragma unroll
                    for (int m = 0; m < 4; ++m)
#pragma unroll
                        for (int n = 0; n < 2; ++n) acc[a][b][m][n] *= cs[b][n];
        }
        if constexpr (MODE == 1) {
            static_assert(Epi::PERM, "int8 path is written for the PERM layout");
            int fr_ = fr, fq_ = fq; asm volatile("" : "+v"(fr_), "+v"(fq_));
            const LAS float* sa = (const LAS float*)(lds + SC_OFF + (ui & 1) * 2048) + wr * 64 + fr_; const LAS float* sb = (const LAS float*)(lds + SC_OFF + (ui & 1) * 2048) + 256 + wc * 64 + 8 * fq_;
            float rs[2][4]; f32x4 cs[2][2];
#pragma unroll
            for (int a = 0; a < 2; ++a)
#pragma unroll
                for (int m = 0; m < 4; ++m) rs[a][m] = sa[a * 128 + m * 16];
#pragma unroll
            for (int b = 0; b < 2; ++b)
#pragma unroll
                for (int n = 0; n < 2; ++n) cs[b][n] = *(const LAS f32x4*)(sb + b * 32 + 4 * n);
#pragma unroll
            for (int a = 0; a < 2; ++a)
#pragma unroll
                for (int b = 0; b < 2; ++b)
#pragma unroll
                    for (int m = 0; m < 4; ++m)
#pragma unroll
                        for (int n = 0; n < 2; ++n) { const i32x4 iv = __builtin_bit_cast(i32x4, acc[a][b][m][n]); acc[a][b][m][n] = __builtin_convertvector(iv, f32x4) * cs[b][n] * rs[a][m]; }
        }
        bool keep = false;
        { int fr_ = fr, fq_ = fq; asm volatile("" : "+v"(fr_), "+v"(fq_));
          if constexpr (Epi::MID) { if (E.is_mid(cur)) { E.mid(acc, cur, wr, wc, fr_, fq_); keep = true; } else E(acc, cur, wr, wc, fr_, fq_); } else E(acc, cur, wr, wc, fr_, fq_); }
        if (!has_next) break;
        if (!keep) {
#pragma unroll
        for (int a = 0; a < 2; ++a)
#pragma unroll
            for (int b = 0; b < 2; ++b)
#pragma unroll
                for (int m = 0; m < 4; ++m)
#pragma unroll
                    for (int n = 0; n < 2; ++n) acc[a][b][m][n] = (f32x4){0.f, 0.f, 0.f, 0.f}; }
        cur = nxt; cA = nA; cB = nB; ++ui;
        stage_scales(cur, ui & 1);
        if constexpr (GATHER) {
#pragma unroll
            for (int hh = 0; hh < 2; ++hh)
#pragma unroll
                for (int i = 0; i < 2; ++i) vC[hh][i] = vN[hh][i]; }
        if (wr == 1) PG8_BAR;
    }
    PG8_WAIT_V(0);
    PG8_BAR;
#undef PG8_SA
#undef PG8_SB
#undef PG8_STAGE
#undef PG8_STAGE_A
#undef PG8_LDA
#undef PG8_LD1
#undef PG8_LDB
#undef PG8_MMA
#undef PG8_WAIT_V
#undef PG8_WAIT_L
#undef PG8_BAR
#undef PG8_SCHED
}
}
using pg8::Unit;

template <class F>
__device__ __forceinline__ void epi_perm_loop(const f32x4 (&acc)[2][2][4][2], int wr, int wc, int fr, int fq, F&& f) {
#pragma unroll
    for (int ai = 0; ai < 2; ++ai)
#pragma unroll
        for (int m = 0; m < 4; ++m) { const int rt = ai * 128 + wr * 64 + m * 16 + fr;
#pragma unroll
            for (int bj = 0; bj < 2; ++bj) { const int ct = wc * 64 + bj * 32 + 8 * fq; f(rt, ct, acc[ai][bj][m][0], acc[ai][bj][m][1]); }
            asm volatile("" ::: "memory"); }
}
__device__ __forceinline__ unsigned pk4_fp8(float a, float b, float c, float d) { int w = 0; w = __builtin_amdgcn_cvt_pk_fp8_f32(a, b, w, false); w = __builtin_amdgcn_cvt_pk_fp8_f32(c, d, w, true); return (unsigned)w; }
__device__ __forceinline__ u32x4 xp16(u32x4 w, int src) { u32x4 r; r.x = __shfl(w.x, src); r.y = __shfl(w.y, src); r.z = __shfl(w.z, src); r.w = __shfl(w.w, src); return r; }
__device__ __forceinline__ u32x2 xp8(u32x2 w, int src) { u32x2 r; r.x = __shfl(w.x, src); r.y = __shfl(w.y, src); return r; }
template <class DT, class LD, class F>
__device__ __forceinline__ void epi_perm_pipe(const f32x4 (&acc)[2][2][4][2], int wr, int wc, int fr, int fq, LD&& ld, F&& f) {
    DT cur = ld(wr * 64 + fr, wc * 64 + 8 * fq);
#pragma unroll
    for (int it = 0; it < 16; ++it) { const int ai = it >> 3, m = (it >> 1) & 3, bj = it & 1; const int rt = ai * 128 + wr * 64 + m * 16 + fr, ct = wc * 64 + bj * 32 + 8 * fq;
        DT nxt = cur;
        if (it + 1 < 16) { const int i2 = it + 1, a2 = i2 >> 3, m2 = (i2 >> 1) & 3, b2 = i2 & 1; nxt = ld(a2 * 128 + wr * 64 + m2 * 16 + fr, wc * 64 + b2 * 32 + 8 * fq); }
        asm volatile("" ::: "memory");
        f(rt, ct, acc[ai][bj][m][0], acc[ai][bj][m][1], cur);
        cur = nxt; }
}
__device__ __forceinline__ u32x4 pack8(f32x4 v0, f32x4 v1) { u32x4 w; w.x = pk2(v0[0], v0[1]); w.y = pk2(v0[2], v0[3]); w.z = pk2(v1[0], v1[1]); w.w = pk2(v1[2], v1[3]); return w; }
__device__ __forceinline__ float gelu_tanh(float x) { const float u = 1.5957691216057308f * (x + 0.044715f * x * x * x); return x * sigmoidf_(u); }
__device__ __forceinline__ void unpack8(u32x4 w, float (&f)[8]) { f[0] = bflo(w.x); f[1] = bfhi(w.x); f[2] = bflo(w.y); f[3] = bfhi(w.y); f[4] = bflo(w.z); f[5] = bfhi(w.z); f[6] = bflo(w.w); f[7] = bfhi(w.w); }

struct EpiCtx {
    static constexpr bool PERM = true; static constexpr bool MID = false;
    bf16* ZC;
    __device__ __forceinline__ void operator()(const f32x4 (&acc)[2][2][4][2], const Unit& u, int wr, int wc, int fr, int fq) const {
        const int pn = u.pn; const int ctile = pn < 4 ? pn : pn - 8;
        const float sc = (pn >= 12 && pn < 16) ? K_SCALE : 1.0f;
        char* zc = (char*)(ZC + (size_t)(u.pm - 256) * 256 * ZC_LD + ctile * 256); int ldz = ZC_LD; asm volatile("" : "+s"(ldz));
        const int ln = fq * 16 + fr, xs = (ln & 3) * 16 + (ln >> 2), dr = (ln >> 2) - fr, dc = 8 * ((ln & 3) - fq);
        epi_perm_loop(acc, wr, wc, fr, fq, [&](int rt, int ct, f32x4 v0, f32x4 v1) { v0 *= sc; v1 *= sc; *(u32x4*)(zc + (unsigned)(((rt + dr) * ldz + ct + dc) * 2)) = xp16(pack8(v0, v1), xs); });
    }
};
struct EpiIn {
    static constexpr bool PERM = true; static constexpr bool MID = false;
    bf16* Z; const f32x2* rope; int dry;
    __device__ __forceinline__ void operator()(const f32x4 (&acc)[2][2][4][2], const Unit& u, int wr, int wc, int fr, int fq) const {
        if (MK_DRYMODE == 2 && dry) return;
        const int pn = u.pn; const int row0 = u.pm * 256, col0 = pn * 256; const f32x2* rp_ = rope;
        const int kind = (pn >= 8 && pn < 12) ? 2 : (pn >= 12 && pn < 16) ? 3 : 0;
        const float sc = kind == 3 ? K_SCALE : 1.0f;
        char* zt = (char*)(Z + (size_t)row0 * ZLD + col0); int ldz = ZLD; asm volatile("" : "+s"(ldz));
        const int ln = fq * 16 + fr;
#pragma unroll
        for (int ai = 0; ai < 2; ++ai)
#pragma unroll
            for (int m = 0; m < 4; ++m) { const int rt = ai * 128 + wr * 64 + m * 16 + fr; u32x4 pw[2];
#pragma unroll
                for (int bj = 0; bj < 2; ++bj) { f32x4 v0 = acc[ai][bj][m][0], v1 = acc[ai][bj][m][1]; const int ct = wc * 64 + bj * 32 + 8 * fq;
                    if (kind == 2 || kind == 3) {
                        const int t = (row0 + rt) & (SEQ - 1);
                        const int e0 = (col0 + ct) & 127; const int p0 = e0 >> 1;
                        const int pos = p0 < 32 ? (t >> 6) : (t & 63); const int f0 = p0 & 31;
                        const f32x4* rp = (const f32x4*)(rp_ + pos * 32 + f0);
                        const f32x4 cs0 = rp[0]; const f32x4 cs1 = rp[1];
                        f32x4 o0, o1;
                        o0[0] = v0[0] * cs0[0] - v0[1] * cs0[1]; o0[1] = v0[0] * cs0[1] + v0[1] * cs0[0];
                        o0[2] = v0[2] * cs0[2] - v0[3] * cs0[3]; o0[3] = v0[2] * cs0[3] + v0[3] * cs0[2];
                        o1[0] = v1[0] * cs1[0] - v1[1] * cs1[1]; o1[1] = v1[0] * cs1[1] + v1[1] * cs1[0];
                        o1[2] = v1[2] * cs1[2] - v1[3] * cs1[3]; o1[3] = v1[2] * cs1[3] + v1[3] * cs1[2];
                        v0 = o0 * sc; v1 = o1 * sc;
                    }
                    pw[bj] = pack8(v0, v1); }
#pragma unroll
                for (int s = 0; s < 2; ++s) { const int rr = 8 * s + (ln >> 3), pp = ln & 7; const int srcl = (pp & 3) * 16 + rr;
                    const u32x4 a0 = xp16(pw[0], srcl), a1 = xp16(pw[1], srcl); const u32x4 ow = (pp >> 2) ? a1 : a0;
                    if (!(MK_DRYMODE == 1 && dry) || ow.x == 0x7fc12345u) __builtin_nontemporal_store(ow, (u32x4*)(zt + (unsigned)(((rt - fr + rr) * ldz + wc * 64 + 8 * pp) * 2))); }
                asm volatile("" ::: "memory"); }
    }
};
struct EpiT1 {
    static constexpr bool PERM = true; static constexpr bool MID = false;
    const bf16* Z; bf16* T1;
    __device__ __forceinline__ void operator()(const f32x4 (&acc)[2][2][4][2], const Unit& u, int wr, int wc, int fr, int fq) const {
        const char* zt = (const char*)(Z + (size_t)u.pm * 256 * ZLD + C_GA + u.pn * 256); char* tt = (char*)(T1 + (size_t)u.pm * 256 * D + u.pn * 256);
        int ldz = ZLD, ldt = D; asm volatile("" : "+s"(ldz), "+s"(ldt));
        const int ln = fq * 16 + fr, xs = (ln & 3) * 16 + (ln >> 2), dr = (ln >> 2) - fr, dc = 8 * ((ln & 3) - fq);
        epi_perm_pipe<u32x4>(acc, wr, wc, fr, fq, [&](int rt, int ct) { return *(const u32x4*)(zt + (unsigned)((rt * ldz + ct) * 2)); },
            [&](int rt, int ct, f32x4 v0, f32x4 v1, u32x4 gw) { float gte[8]; unpack8(gw, gte);
            for (int j = 0; j < 4; ++j) { v0[j] *= sigmoidf_(gte[j]); v1[j] *= sigmoidf_(gte[4 + j]); }
            *(u32x4*)(tt + (unsigned)(((rt + dr) * ldt + ct + dc) * 2)) = xp16(pack8(v0, v1), xs); });
    }
};
struct EpiMg {
    static constexpr bool PERM = true; static constexpr bool MID = false;
    const bf16* Z; const bf16* T1; bf16* MG;
    __device__ __forceinline__ void operator()(const f32x4 (&acc)[2][2][4][2], const Unit& u, int wr, int wc, int fr, int fq) const {
        const char* zt = (const char*)(Z + (size_t)u.pm * 256 * ZLD + C_GB + u.pn * 256); const char* tt = (const char*)(T1 + (size_t)u.pm * 256 * D + u.pn * 256); char* mt = (char*)(MG + (size_t)u.pm * 256 * D + u.pn * 256);
        int ldz = ZLD, ldt = D; asm volatile("" : "+s"(ldz), "+s"(ldt));
        const int ln = fq * 16 + fr, xs = (ln & 3) * 16 + (ln >> 2), dr = (ln >> 2) - fr, dc = 8 * ((ln & 3) - fq);
        struct D2 { u32x4 a, b; };
        epi_perm_pipe<D2>(acc, wr, wc, fr, fq, [&](int rt, int ct) { D2 d; d.a = *(const u32x4*)(zt + (unsigned)((rt * ldz + ct) * 2)); d.b = *(const u32x4*)(tt + (unsigned)((rt * ldt + ct) * 2)); return d; },
            [&](int rt, int ct, f32x4 v0, f32x4 v1, D2 dd) { float gte[8], t1v[8]; unpack8(dd.a, gte); unpack8(dd.b, t1v);
            for (int j = 0; j < 4; ++j) { v0[j] = t1v[j] + v0[j] * sigmoidf_(gte[j]); v1[j] = t1v[4 + j] + v1[j] * sigmoidf_(gte[4 + j]); }
            *(u32x4*)(mt + (unsigned)(((rt + dr) * ldt + ct + dc) * 2)) = xp16(pack8(v0, v1), xs); });
    }
};
struct EpiF {
    static constexpr bool PERM = true; static constexpr bool MID = true;
    const bf16* Z; bf16* MG; int dry;
    __device__ __forceinline__ bool is_mid(const Unit& u) const { return u.koff == 0; }
    __device__ __forceinline__ void mid(f32x4 (&acc)[2][2][4][2], const Unit& u, int wr, int wc, int fr, int fq) const {
        if (MK_DRYMODE == 2 && dry) return;
        const char* za = (const char*)(Z + (size_t)u.pm * 256 * ZLD + C_GA + u.pn * 256); const char* zb = za + (C_GB - C_GA) * 2;
        int ldz = ZLD; asm volatile("" : "+s"(ldz));
        auto off = [&](int it) { const int ai = it >> 3, m = (it >> 1) & 3, bj = it & 1; return (unsigned)(((ai * 128 + wr * 64 + m * 16 + fr) * ldz + wc * 64 + bj * 32 + 8 * fq) * 2); };
        u32x4 qa[3], qb[3];
        qa[0] = *(const u32x4*)(za + off(0)); qb[0] = *(const u32x4*)(zb + off(0)); qa[1] = *(const u32x4*)(za + off(1)); qb[1] = *(const u32x4*)(zb + off(1));
#pragma unroll
        for (int it = 0; it < 16; ++it) { const int ai = it >> 3, m = (it >> 1) & 3, bj = it & 1;
            if (it + 2 < 16) { qa[(it + 2) % 3] = *(const u32x4*)(za + off(it + 2)); qb[(it + 2) % 3] = *(const u32x4*)(zb + off(it + 2)); }
            asm volatile("" ::: "memory");
            float ga[8], gb[8]; unpack8(qa[it % 3], ga); unpack8(qb[it % 3], gb);
#pragma unroll
            for (int j = 0; j < 4; ++j) {
                acc[ai][bj][m][0][j] *= (1.0f + fminf(__expf(-gb[j]), 1e30f)) * __builtin_amdgcn_rcpf(1.0f + __expf(-ga[j]));
                acc[ai][bj][m][1][j] *= (1.0f + fminf(__expf(-gb[4 + j]), 1e30f)) * __builtin_amdgcn_rcpf(1.0f + __expf(-ga[4 + j])); } }
    }
    __device__ __forceinline__ void operator()(const f32x4 (&acc)[2][2][4][2], const Unit& u, int wr, int wc, int fr, int fq) const {
        if (MK_DRYMODE == 2 && dry) return;
        const char* zb = (const char*)(Z + (size_t)u.pm * 256 * ZLD + C_GB + u.pn * 256); char* mt = (char*)(MG + (size_t)u.pm * 256 * D + u.pn * 256);
        int ldz = ZLD, ldt = D; asm volatile("" : "+s"(ldz), "+s"(ldt));
        const int ln = fq * 16 + fr, xs = (ln & 3) * 16 + (ln >> 2), dr = (ln >> 2) - fr, dc = 8 * ((ln & 3) - fq);
        auto off = [&](int it) { const int ai = it >> 3, m = (it >> 1) & 3, bj = it & 1; return (unsigned)(((ai * 128 + wr * 64 + m * 16 + fr) * ldz + wc * 64 + bj * 32 + 8 * fq) * 2); };
        u32x4 qb[4]; qb[0] = *(const u32x4*)(zb + off(0)); qb[1] = *(const u32x4*)(zb + off(1)); qb[2] = *(const u32x4*)(zb + off(2));
#pragma unroll
        for (int it = 0; it < 16; ++it) { const int ai = it >> 3, m = (it >> 1) & 3, bj = it & 1; const int rt = ai * 128 + wr * 64 + m * 16 + fr, ct = wc * 64 + bj * 32 + 8 * fq;
            if (it + 3 < 16) qb[(it + 3) & 3] = *(const u32x4*)(zb + off(it + 3));
            asm volatile("" ::: "memory");
            float gb[8]; unpack8(qb[it & 3], gb); f32x4 v0 = acc[ai][bj][m][0], v1 = acc[ai][bj][m][1];
#pragma unroll
            for (int j = 0; j < 4; ++j) { v0[j] *= __builtin_amdgcn_rcpf(1.0f + fminf(__expf(-gb[j]), 1e30f)); v1[j] *= __builtin_amdgcn_rcpf(1.0f + fminf(__expf(-gb[4 + j]), 1e30f)); }
            *(u32x4*)(mt + (unsigned)(((rt + dr) * ldt + ct + dc) * 2)) = xp16(pack8(v0, v1), xs); }
    }
};
struct EpiX1 {
    static constexpr bool PERM = false; static constexpr bool MID = false;
    const float* X; float* O; const float* mod; int grow0;
    __device__ __forceinline__ void operator()(const f32x4 (&acc)[2][2][4][2], const Unit& u, int wr, int wc, int fr, int fq) const {
        const int trow = grow0 + u.pm * 256; const int b = trow >> 13;
        const char* xt = (const char*)(X + (size_t)trow * D + u.pn * 256); char* ot = (char*)(O + (size_t)trow * D + u.pn * 256); const float* g1 = mod + b * 6144 + 2048 + u.pn * 256;
        int ldx = D; asm volatile("" : "+s"(ldx));
        const int ln = fq * 16 + fr, xs = (ln & 3) * 16 + (ln >> 2);
        const int r0 = wr * 64 + (ln >> 2), c0 = wc * 64 + 4 * (ln & 3), c0g = wc * 64 + 4 * fq;
        f32x4 gv[2][2];
#pragma unroll
        for (int bj = 0; bj < 2; ++bj)
#pragma unroll
            for (int n = 0; n < 2; ++n) gv[bj][n] = *(const f32x4*)(g1 + c0g + bj * 32 + n * 16);
        auto xoff = [&](int it) { const int bj = it >> 4, n = (it >> 3) & 1, ai = (it >> 2) & 1, m = it & 3; return (unsigned)(((r0 + ai * 128 + m * 16) * ldx + c0 + bj * 32 + n * 16) * 4); };
        f32x4 xq[3]; xq[0] = *(const f32x4*)(xt + xoff(0)); xq[1] = *(const f32x4*)(xt + xoff(1));
#pragma unroll
        for (int it = 0; it < 32; ++it) { const int bj = it >> 4, n = (it >> 3) & 1, ai = (it >> 2) & 1, m = it & 3;
            if (it + 2 < 32) xq[(it + 2) % 3] = *(const f32x4*)(xt + xoff(it + 2));
            asm volatile("" ::: "memory");
            const f32x4 pr = gv[bj][n] * acc[ai][bj][m][n]; const u32x4 ps = xp16(__builtin_bit_cast(u32x4, pr), xs);
            *(f32x4*)(ot + xoff(it)) = xq[it % 3] + __builtin_bit_cast(f32x4, ps); }
    }
};
__device__ __forceinline__ float swiglu1(float g, float l) { const float gl = fminf(g, 7.0f), li = fminf(fmaxf(l, -7.0f), 7.0f); return gl * sigmoidf_(1.702f * gl) * (li + 1.0f); }
struct EpiHid {
    static constexpr bool PERM = true; static constexpr bool MID = false;
    unsigned char* HID; const float* b1;
    __device__ __forceinline__ void operator()(const f32x4 (&acc)[2][2][4][2], const Unit& u, int wr, int wc, int fr, int fq) const {
        const int e = u.pn >> 3, pl = u.pn & 7; const float* bb = b1 + e * 2048 + pl * 256; char* ht = (char*)(HID + (size_t)u.pm * 256 * DEXP + pl * 128);
        int ldh = DEXP; asm volatile("" : "+s"(ldh));
        const int ln = fq * 16 + fr, xs = (ln & 3) * 16 + (ln >> 2), dr = (ln >> 2) - fr, dc = 8 * ((ln & 3) - fq);
        f32x4 bq[2][2];
#pragma unroll
        for (int bj = 0; bj < 2; ++bj) { bq[bj][0] = *(const f32x4*)(bb + wc * 64 + bj * 32 + 8 * fq); bq[bj][1] = *(const f32x4*)(bb + wc * 64 + bj * 32 + 8 * fq + 4); }
        epi_perm_loop(acc, wr, wc, fr, fq, [&](int rt, int ct, f32x4 v0, f32x4 v1) { v0 += bq[(ct >> 5) & 1][0]; v1 += bq[(ct >> 5) & 1][1];
            const unsigned w = pk4_fp8(swiglu1(v0[0], v0[1]), swiglu1(v0[2], v0[3]), swiglu1(v1[0], v1[1]), swiglu1(v1[2], v1[3]));
            *(unsigned*)(ht + (unsigned)((rt + dr) * ldh + ((ct + dc) >> 1))) = (unsigned)__shfl((int)w, xs); });
    }
};
struct EpiY {
    static constexpr bool PERM = true; static constexpr bool MID = false;
    unsigned char* Y; const float* b2;
    __device__ __forceinline__ void operator()(const f32x4 (&acc)[2][2][4][2], const Unit& u, int wr, int wc, int fr, int fq) const {
        const int e = u.pn >> 2, pl = u.pn & 3; const float* bb = b2 + e * 1024 + pl * 256; char* yt = (char*)(Y + (size_t)u.pm * 256 * D + pl * 256);
        int ldy = D; asm volatile("" : "+s"(ldy));
        const int ln = fq * 16 + fr, xs = (ln & 3) * 16 + (ln >> 2), dr = (ln >> 2) - fr, dc = 8 * ((ln & 3) - fq);
        f32x4 bq[2][2];
#pragma unroll
        for (int bj = 0; bj < 2; ++bj) { bq[bj][0] = *(const f32x4*)(bb + wc * 64 + bj * 32 + 8 * fq); bq[bj][1] = *(const f32x4*)(bb + wc * 64 + bj * 32 + 8 * fq + 4); }
        epi_perm_loop(acc, wr, wc, fr, fq, [&](int rt, int ct, f32x4 v0, f32x4 v1) { v0 += bq[(ct >> 5) & 1][0]; v1 += bq[(ct >> 5) & 1][1];
            u32x2 w8; w8.x = pk4_fp8(v0[0], v0[1], v0[2], v0[3]); w8.y = pk4_fp8(v1[0], v1[1], v1[2], v1[3]);
            *(u32x2*)(yt + (unsigned)((rt + dr) * ldy + ct + dc)) = xp8(w8, xs); });
    }
};

#define XB_TMO      128
#define XB_XCNT(j)  (256  + 64 * (j))
#define XB_XSUB(j)  (1280 + 64 * (j))
#define XB_XGEN(j)  (2304 + 64 * (j))
#define XB_TOP      3328
#define XB_TOPGEN   3392
#define XCD_BAR_WORDS 3456
#define XB_SPIN_CAP (1u << 22)
__device__ __forceinline__ unsigned xb_ld(unsigned* p)              { return __hip_atomic_load(p, __ATOMIC_RELAXED, __HIP_MEMORY_SCOPE_AGENT); }
__device__ __forceinline__ unsigned xb_add(unsigned* p, unsigned v) { return __hip_atomic_fetch_add(p, v, __ATOMIC_RELAXED, __HIP_MEMORY_SCOPE_AGENT); }
__device__ __forceinline__ unsigned xb_xcc_id() { return (unsigned)__builtin_amdgcn_s_getreg((3 << 11) | 20) & 0xFu; }
#define XB_SPIN(cond, bar) do { unsigned _sp = 0; while (cond) { __builtin_amdgcn_s_sleep(1); \
    if ((++_sp & 255u) == 0u) { if (xb_ld(&(bar)[XB_TMO])) break; if (_sp > XB_SPIN_CAP) { atomicAdd(&(bar)[XB_TMO], 1u); break; } } } } while (0)
struct XcdBarrier { unsigned* bar; unsigned x; volatile LAS unsigned* st; };
__device__ __forceinline__ XcdBarrier xcd_barrier_post(unsigned* bar, volatile LAS unsigned* st) {
    XcdBarrier b; b.bar = bar; b.x = xb_xcc_id(); b.st = st;
    if (threadIdx.x == 0) (void)xb_add(&bar[XB_XCNT(b.x)], 1u);
    return b;
}
__device__ __forceinline__ void xcd_barrier_complete(unsigned* bar, unsigned x, unsigned& nloc, unsigned& nx) {
    const unsigned G = gridDim.x * gridDim.y * gridDim.z;
    unsigned sum, cnt, mine, sp = 0u;
    for (;;) {
        sum = 0u; cnt = 0u; mine = 0u;
#pragma unroll
        for (unsigned j = 0; j < 16; ++j) { const unsigned c = xb_ld(&bar[XB_XCNT(j)]); sum += c; cnt += (c > 0u) ? 1u : 0u; mine = (j == x) ? c : mine; }
        if (sum == G) break;
        __builtin_amdgcn_s_sleep(1);
        if ((++sp & 255u) == 0u) { if (xb_ld(&bar[XB_TMO])) break; if (sp > XB_SPIN_CAP) { atomicAdd(&bar[XB_TMO], 1u); break; } }
    }
    nloc = mine > 0u ? mine : 1u; nx = cnt > 0u ? cnt : 1u;
}
__device__ __forceinline__ void xcd_barrier(const XcdBarrier& b) {
    asm volatile("s_waitcnt vmcnt(0)" ::: "memory");
    __syncthreads();
    if (threadIdx.x == 0) {
        unsigned* bar = b.bar;
        __builtin_amdgcn_s_waitcnt(0);
        unsigned nloc = b.st[0], nx = b.st[1];
        if (nloc == 0u) { xcd_barrier_complete(bar, b.x, nloc, nx); b.st[0] = nloc; b.st[1] = nx; }
        const unsigned old = xb_add(&bar[XB_XSUB(b.x)], 1u);
        const unsigned gen = old / nloc;
        if (old + 1u == (gen + 1u) * nloc) {
            __builtin_amdgcn_fence(__ATOMIC_RELEASE, "agent");
            asm volatile("s_waitcnt vmcnt(0)" ::: "memory");
            const unsigned og = xb_add(&bar[XB_TOP], 1u);
            const unsigned tg = og / nx;
            if (og + 1u == (tg + 1u) * nx) xb_add(&bar[XB_TOPGEN], 1u);
            else XB_SPIN(xb_ld(&bar[XB_TOPGEN]) == tg, bar);
            __builtin_amdgcn_fence(__ATOMIC_ACQUIRE, "agent");
            xb_add(&bar[XB_XGEN(b.x)], 1u);
            asm volatile("s_waitcnt vmcnt(0)" ::: "memory");
        } else {
            XB_SPIN(xb_ld(&bar[XB_XGEN(b.x)]) == gen, bar);
            __builtin_amdgcn_fence(__ATOMIC_ACQUIRE, "agent");
            asm volatile("s_waitcnt vmcnt(0)" ::: "memory");
        }
    }
    __syncthreads();
}

__device__ __forceinline__ void transpose_item(const float* W, int ldw, int K, int N, bf16* WT, LAS float* scr, int item, int lane) {
    const int nblk = N / 32, kb = item / nblk, nb = item % nblk, k0 = 64 * kb, n0 = 32 * nb;
#pragma unroll 8
    for (int i = 0; i < 32; ++i) { const int kk = 2 * i + (lane >> 5); scr[kk * 33 + (lane & 31)] = W[(size_t)(k0 + kk) * ldw + n0 + (lane & 31)]; }
    LDS_WAIT(); asm volatile("" ::: "memory");
    const int c = lane & 7;
#pragma unroll
    for (int j = 0; j < 4; ++j) { const int n = (lane >> 3) + 8 * j; const LAS float* s = scr + (8 * c) * 33 + n;
        u32x4 o; o.x = pk2(s[0 * 33], s[1 * 33]); o.y = pk2(s[2 * 33], s[3 * 33]); o.z = pk2(s[4 * 33], s[5 * 33]); o.w = pk2(s[6 * 33], s[7 * 33]);
        *(u32x4*)(WT + (size_t)(n0 + n) * K + k0 + 8 * c) = o; }
    LDS_WAIT(); asm volatile("" ::: "memory");
}
struct TrTile { const float* src; bf16* dst; int ldw, ldt; };
__device__ __forceinline__ void tr_load(const TrTile& t, int tid, f32x4 (&v)[8]) {
#pragma unroll
    for (int i = 0; i < 8; ++i) { const int id = tid + 512 * i, k = id >> 5, c4 = id & 31; v[i] = *(const f32x4*)(t.src + (size_t)k * t.ldw + 4 * c4); }
}
__device__ __forceinline__ void tr_store(const TrTile& t, int tid, const f32x4 (&v)[8], LAS float* L) {
#pragma unroll
    for (int i = 0; i < 8; ++i) { const int id = tid + 512 * i, k = id >> 5, c4 = id & 31;
        L[(4 * c4 + 0) * 129 + k] = v[i][0]; L[(4 * c4 + 1) * 129 + k] = v[i][1]; L[(4 * c4 + 2) * 129 + k] = v[i][2]; L[(4 * c4 + 3) * 129 + k] = v[i][3]; }
    __syncthreads();
#pragma unroll
    for (int i = 0; i < 4; ++i) { const int id = tid + 512 * i, kc = id & 15, n = id >> 4; const LAS float* s = L + n * 129 + 8 * kc;
        u32x4 o; o.x = pk2(s[0], s[1]); o.y = pk2(s[2], s[3]); o.z = pk2(s[4], s[5]); o.w = pk2(s[6], s[7]);
        *(u32x4*)(t.dst + (size_t)n * t.ldt + 8 * kc) = o; }
    __syncthreads();
}
template <bool FP8 = false>
__device__ __forceinline__ void tr_strip_i8(const float* src, int ldw, int K, signed char* dst, int ldt, float* scales, int tid, LAS unsigned* TL, LAS unsigned* CM) {
    constexpr float QMAX = FP8 ? 448.0f : 127.0f;
    const int c4 = tid & 31, g = tid >> 5, nk = K / 128;
    const float* p = src + (size_t)(4 * g) * ldw + 4 * c4;
    auto ld8 = [&](int kt, f32x4 (&v)[8]) {
#pragma unroll
        for (int h = 0; h < 2; ++h)
#pragma unroll
            for (int r = 0; r < 4; ++r) v[4 * h + r] = *(const f32x4*)(p + (size_t)(kt * 128 + 64 * h + r) * ldw); };
    float mx[4] = {0.f, 0.f, 0.f, 0.f};
    auto red = [&](const f32x4 (&v)[8]) {
#pragma unroll
        for (int i = 0; i < 8; ++i)
#pragma unroll
            for (int j = 0; j < 4; ++j) mx[j] = fmaxf(mx[j], fabsf(v[i][j])); };
    {   f32x4 va[8], vb[8]; ld8(0, va);
#pragma unroll 1
        for (int kt = 0; kt < nk; kt += 2) { ld8(kt + 1, vb); red(va); if (kt + 2 < nk) ld8(kt + 2, va); red(vb); } }
    f32x4 v[8]; ld8(0, v);
    if (tid < 128) CM[tid] = 0u;
    __syncthreads();
#pragma unroll
    for (int j = 0; j < 4; ++j) __hip_atomic_fetch_max(&CM[4 * c4 + j], __builtin_bit_cast(unsigned, mx[j]), __ATOMIC_RELAXED, __HIP_MEMORY_SCOPE_WORKGROUP);
    __syncthreads();
    if (tid < 128) { const float m = __builtin_bit_cast(float, CM[tid]); scales[tid] = m > 0.f ? m * (1.0f / QMAX) : 1.0f; }
    float inv[4];
#pragma unroll
    for (int j = 0; j < 4; ++j) { const float m = __builtin_bit_cast(float, CM[4 * c4 + j]); inv[j] = m > 0.f ? QMAX / m : 0.f; }
#pragma unroll 1
    for (int kt = 0; kt < nk; ++kt) {
        f32x4 w[8];
#pragma unroll
        for (int i = 0; i < 8; ++i) w[i] = v[i];
        if (kt + 1 < nk) ld8(kt + 1, v);
        LAS unsigned* T = TL + (kt & 1) * 4352;
#pragma unroll
        for (int h = 0; h < 2; ++h)
#pragma unroll
            for (int j = 0; j < 4; ++j) { unsigned pk;
                if constexpr (FP8) pk = pk4_fp8(w[4 * h][j] * inv[j], w[4 * h + 1][j] * inv[j], w[4 * h + 2][j] * inv[j], w[4 * h + 3][j] * inv[j]);
                else pk = q8x4((f32x4){w[4 * h][j], w[4 * h + 1][j], w[4 * h + 2][j], w[4 * h + 3][j]}, inv[j]);
                T[c4 * 133 + j * 33 + 16 * h + g] = pk; }
        __syncthreads();
#pragma unroll
        for (int i = 0; i < 2; ++i) { const int id = tid + 512 * i, kc = id & 7, n = id >> 3; const LAS unsigned* s = T + (n >> 2) * 133 + (n & 3) * 33 + 4 * kc;
            *(u32x4*)(dst + (size_t)n * ldt + kt * 128 + 16 * kc) = (u32x4){s[0], s[1], s[2], s[3]}; }
    }
    __syncthreads();
}
__device__ __forceinline__ unsigned offb(unsigned row, unsigned ch) { return 256u * row + 16u * (ch ^ (((row & 3u) << 2) | ((row >> 2) & 3u))); }
typedef short v4i16_t __attribute__((ext_vector_type(4)));
__device__ __forceinline__ s16x4 trd(const LAS unsigned char* p) { return __builtin_bit_cast(s16x4, __builtin_amdgcn_ds_read_tr16_b64_v4i16((LAS v4i16_t*)p)); }
#define MFMA32(a, b, c) __builtin_amdgcn_mfma_f32_32x32x16_bf16((a), (b), (c), 0, 0, 0)
#define MFMA16(a, b, c) __builtin_amdgcn_mfma_f32_16x16x32_bf16((a), (b), (c), 0, 0, 0)
__device__ __forceinline__ int crow(int reg, int h) { return (reg & 3) + 8 * (reg >> 2) + 4 * h; }

struct LruP { const float *conv_w, *conv_b, *ba, *bx, *lam; const bf16* wg; f32x2* carry; };
template <int PASS, int DIR>
__device__ __forceinline__ void lru_dir(LAS unsigned char* XC, LAS unsigned char* RN, const LruP& P, int b, int cp, int n, int w, int col, int g4) {
    const int ch = 128 * n + 16 * w + col;
    const float bav = P.ba[DIR * 1024 + ch], bxv = P.bx[DIR * 1024 + ch];
    const float c8 = 8.0f * log1pf(expf(-P.lam[DIR * 1024 + ch]));
    bf16x8 Ba[4], Bx[4];
    { const bf16* wa = P.wg + ((size_t)((n * 4 + DIR * 2 + 0) * 128 + 16 * w + col)) * 128 + 8 * g4; const bf16* wx = wa + 128 * 128;
#pragma unroll
      for (int ks = 0; ks < 4; ++ks) { Ba[ks] = *(const bf16x8*)(wa + 32 * ks); Bx[ks] = *(const bf16x8*)(wx + 32 * ks); } }
    float hrun = 0.f, atot = 1.f;
    if (PASS == 1) {
        const int Pn = DIR == 0 ? cp : 33 - cp; float Al = 1.f, Ul = 0.f;
#pragma unroll
        for (int k = 0; k < 9; ++k) { const int p = 9 * g4 + k;
            if (p < Pn) { const int cq = DIR == 0 ? p : (p == 0 ? 0 : 33 - p); const f32x2 ah = P.carry[((size_t)(b * 2 + DIR) * 33 + cq) * 1024 + ch]; Ul = ah.x * Ul + ah.y; Al = ah.x * Al; } }
#pragma unroll
        for (int gq = 0; gq < 4; ++gq) { const float Ag = __shfl(Al, col + 16 * gq), Ug = __shfl(Ul, col + 16 * gq); hrun = Ag * hrun + Ug; }
    }
#pragma unroll 4
    for (int mi = 0; mi < 16; ++mi) {
        const int m = DIR == 0 ? mi : 15 - mi;
        f32x4 ar = {0.f, 0.f, 0.f, 0.f}, ai = {0.f, 0.f, 0.f, 0.f};
        const LAS unsigned char* xrow = XC + (16 * m + col) * 272 + 16 * g4;
#pragma unroll
        for (int ks = 0; ks < 4; ++ks) { const bf16x8 af = *(const LAS bf16x8*)(xrow + 64 * ks); ar = MFMA16(af, Ba[ks], ar); ai = MFMA16(af, Bx[ks], ai); }
        float av[4], uv[4];
#pragma unroll
        for (int r = 0; r < 4; ++r) { const int t = 16 * m + 4 * g4 + r; const float xc = bf2f(*(const LAS unsigned short*)(XC + t * 272 + (16 * w + col) * 2));
            const float er = __expf(fminf(-(ar[r] + bav), 40.f)) + 1.0f, ei = __expf(fminf(-(ai[r] + bxv), 40.f)) + 1.0f; const float inv = __builtin_amdgcn_rcpf(er * ei);
            const float rg = inv * ei, ig = inv * er; const float a = __expf(-c8 * rg);
            av[r] = a; uv[r] = __builtin_amdgcn_sqrtf(fmaxf(1.0f - a * a, 0.f)) * ig * xc; }
        float Al = 1.f, Ul = 0.f;
#pragma unroll
        for (int rr = 0; rr < 4; ++rr) { const int r = DIR == 0 ? rr : 3 - rr; Ul = av[r] * Ul + uv[r]; Al = av[r] * Al; }
        float Ag[4], Ug[4];
#pragma unroll
        for (int gq = 0; gq < 4; ++gq) { Ag[gq] = __shfl(Al, col + 16 * gq); Ug[gq] = __shfl(Ul, col + 16 * gq); }
        float h = hrun, hin = hrun;
#pragma unroll
        for (int gi = 0; gi < 4; ++gi) { const int gq = DIR == 0 ? gi : 3 - gi; if (gq == g4) hin = h; h = Ag[gq] * h + Ug[gq]; atot *= Ag[gq]; }
        hrun = h;
        if (PASS == 1) {
            float hh = hin;
#pragma unroll
            for (int rr = 0; rr < 4; ++rr) { const int r = DIR == 0 ? rr : 3 - rr; hh = av[r] * hh + uv[r];
                LAS unsigned short* rp = (LAS unsigned short*)(RN + (16 * m + 4 * g4 + r) * 272 + (16 * w + col) * 2);
                if (DIR == 0) *rp = (unsigned short)f2bf(hh); else *rp = (unsigned short)f2bf(bf2f(*rp) + hh); }
        }
    }
    if (PASS == 0) { if (g4 == 0) P.carry[((size_t)(b * 2 + DIR) * 33 + cp) * 1024 + ch] = (f32x2){atot, hrun}; }
}
template <int PASS>
__device__ __forceinline__ void lru_unit(LAS unsigned char* lds, const LruP& P, int b, int cp, int n, const bf16* xsrc, int ldx, int seqlen, const bf16* grp, bf16* gout) {
    const int tid = opaque_tid(), lane = tid & 63, w = __builtin_amdgcn_readfirstlane(tid >> 6), col = lane & 15, g4 = lane >> 4;
    const int t0 = cp == 0 ? 0 : (cp - 1) * 256;
    LAS unsigned char* XC = lds;
    LAS unsigned char* RN = lds + 69632;
    __syncthreads();
    {
        const int j8 = tid & 15, ch0 = 128 * n + 8 * j8;
        float cw[4][8], cb[8];
#pragma unroll
        for (int k = 0; k < 4; ++k) { const f32x4 a = *(const f32x4*)(P.conv_w + k * 1024 + ch0), c = *(const f32x4*)(P.conv_w + k * 1024 + ch0 + 4);
            cw[k][0] = a[0]; cw[k][1] = a[1]; cw[k][2] = a[2]; cw[k][3] = a[3]; cw[k][4] = c[0]; cw[k][5] = c[1]; cw[k][6] = c[2]; cw[k][7] = c[3]; }
        { const f32x4 a = *(const f32x4*)(P.conv_b + ch0), c = *(const f32x4*)(P.conv_b + ch0 + 4); cb[0] = a[0]; cb[1] = a[1]; cb[2] = a[2]; cb[3] = a[3]; cb[4] = c[0]; cb[5] = c[1]; cb[6] = c[2]; cb[7] = c[3]; }
#pragma unroll 4
        for (int i = 0; i < 8; ++i) {
            const int t = (tid >> 4) + 32 * i; float a[8];
#pragma unroll
            for (int j = 0; j < 8; ++j) a[j] = cb[j];
#pragma unroll
            for (int k = 0; k < 4; ++k) { const int row = t0 + t + k - 2;
                if (row >= 0 && row < seqlen) { float xv[8]; unpack8(*(const u32x4*)(xsrc + (size_t)row * ldx + ch0), xv);
#pragma unroll
                    for (int j = 0; j < 8; ++j) a[j] += cw[k][j] * xv[j]; } }
            u32x4 o; o.x = pk2(a[0], a[1]); o.y = pk2(a[2], a[3]); o.z = pk2(a[4], a[5]); o.w = pk2(a[6], a[7]);
            *(LAS u32x4*)(XC + t * 272 + j8 * 16) = o;
        }
    }
    __syncthreads();
    lru_dir<PASS, 0>(XC, RN, P, b, cp, n, w, col, g4);
    lru_dir<PASS, 1>(XC, RN, P, b, cp, n, w, col, g4);
    if (PASS == 1) {
        __syncthreads();
        const int j8 = tid & 15, ch0 = 128 * n + 8 * j8;
#pragma unroll 4
        for (int i = 0; i < 8; ++i) { const int t = (tid >> 4) + 32 * i; float rv[8], gv[8];
            unpack8(*(const LAS u32x4*)(RN + t * 272 + j8 * 16), rv); const bf16* gp_in = grp + (size_t)(t0 + t) * ZLD + C_GR + ch0; unpack8(*(const u32x4*)gp_in, gv); bf16* gp = gout + (size_t)(t0 + t) * D + ch0;
            for (int j = 0; j < 8; ++j) gv[j] = gelu_tanh(gv[j]);
            u32x4 o; o.x = pk2(rv[0] * gv[0], rv[1] * gv[1]); o.y = pk2(rv[2] * gv[2], rv[3] * gv[3]); o.z = pk2(rv[4] * gv[4], rv[5] * gv[5]); o.w = pk2(rv[6] * gv[6], rv[7] * gv[7]);
            *(u32x4*)gp = o; }
    }
}

__device__ __forceinline__ void kv_unit(LAS unsigned char* lds, const bf16* ksrc, const bf16* vsrc, int ld, float l2g, bf16* out) {
    const int tid = opaque_tid(), lane = tid & 63, w = __builtin_amdgcn_readfirstlane(tid >> 6);
    LAS unsigned char* KF = lds; LAS unsigned char* KB = lds + 32768; LAS unsigned char* VI = lds + 65536;
    __syncthreads();
#pragma unroll
    for (int i = 0; i < 4; ++i) { const int idx = tid + 512 * i, j = idx >> 4, chn = idx & 15; float kv[8]; unpack8(*(const u32x4*)(ksrc + (size_t)j * ld + 8 * chn), kv);
        const float wf = exp2f(l2g * (float)(127 - j)), wb = exp2f(l2g * (float)j);
        u32x4 of, ob; of.x = pk2(kv[0] * wf, kv[1] * wf); of.y = pk2(kv[2] * wf, kv[3] * wf); of.z = pk2(kv[4] * wf, kv[5] * wf); of.w = pk2(kv[6] * wf, kv[7] * wf);
        ob.x = pk2(kv[0] * wb, kv[1] * wb); ob.y = pk2(kv[2] * wb, kv[3] * wb); ob.z = pk2(kv[4] * wb, kv[5] * wb); ob.w = pk2(kv[6] * wb, kv[7] * wb);
        *(LAS u32x4*)(KF + offb(j, chn)) = of; *(LAS u32x4*)(KB + offb(j, chn)) = ob; }
#pragma unroll
    for (int i = 0; i < 8; ++i) { const int idx = tid + 512 * i, j = idx >> 5, chn = idx & 31;
        *(LAS u32x4*)(VI + (chn >> 4) * 32768 + offb(j, chn & 15)) = *(const u32x4*)(vsrc + (size_t)j * ld + 8 * chn); }
    __syncthreads();
    const int h = lane >> 5, blk = (lane >> 4) & 1, q = (lane & 15) >> 2, p = lane & 3;
    f32x16 accF[4], accB[4];
#pragma unroll
    for (int dt = 0; dt < 4; ++dt)
#pragma unroll
        for (int r = 0; r < 16; ++r) { accF[dt][r] = 0.f; accB[dt][r] = 0.f; }
    const LAS unsigned char* Vimg = VI + (w >> 2) * 32768; const int cv = w & 3;
#pragma unroll 1
    for (int ks = 0; ks < 8; ++ks) {
        const unsigned r0 = 16 * ks + 8 * h + q, r1 = r0 + 4;
        const s16x4 v0 = trd(Vimg + offb(r0, 4 * cv + 2 * blk + (p >> 1)) + 8 * (p & 1)), v1 = trd(Vimg + offb(r1, 4 * cv + 2 * blk + (p >> 1)) + 8 * (p & 1));
        const bf16x8 bv = __builtin_shufflevector(v0, v1, 0, 1, 2, 3, 4, 5, 6, 7);
#pragma unroll
        for (int dt = 0; dt < 4; ++dt) {
            const unsigned o0 = offb(r0, 4 * dt + 2 * blk + (p >> 1)) + 8 * (p & 1), o1 = offb(r1, 4 * dt + 2 * blk + (p >> 1)) + 8 * (p & 1);
            const bf16x8 af = __builtin_shufflevector(trd(KF + o0), trd(KF + o1), 0, 1, 2, 3, 4, 5, 6, 7);
            const bf16x8 ab = __builtin_shufflevector(trd(KB + o0), trd(KB + o1), 0, 1, 2, 3, 4, 5, 6, 7);
            accF[dt] = MFMA32(af, bv, accF[dt]); accB[dt] = MFMA32(ab, bv, accB[dt]);
        }
    }
    __syncthreads();
    { const int v = 32 * w + (lane & 31);
#pragma unroll
      for (int dt = 0; dt < 4; ++dt)
#pragma unroll
        for (int rg = 0; rg < 4; ++rg) { const int d = 32 * dt + 8 * rg + 4 * h;
            u32x2 of, ob; of.x = pk2(accF[dt][4 * rg], accF[dt][4 * rg + 1]); of.y = pk2(accF[dt][4 * rg + 2], accF[dt][4 * rg + 3]);
            ob.x = pk2(accB[dt][4 * rg], accB[dt][4 * rg + 1]); ob.y = pk2(accB[dt][4 * rg + 2], accB[dt][4 * rg + 3]);
            *(LAS u32x2*)(lds + v * 272 + d * 2) = of; *(LAS u32x2*)(lds + 69632 + v * 272 + d * 2) = ob; } }
    __syncthreads();
#pragma unroll
    for (int i = 0; i < 16; ++i) { const int idx = tid + 512 * i, dir = idx >> 12, v = (idx >> 4) & 255, chn = idx & 15;
        *(u32x4*)(out + (size_t)dir * 32768 + v * 128 + 8 * chn) = *(const LAS u32x4*)(lds + dir * 69632 + v * 272 + chn * 16); }
}

__device__ __forceinline__ void xc_rows(const LruP& P, const bf16* xsrc, int ldx, int lgseq  , int nrows, bf16* dst, int gthread, int nthreads) {
    const int c8 = gthread & 127, ch0 = 8 * c8;
    float cw[4][8], cb[8];
#pragma unroll
    for (int k = 0; k < 4; ++k) { const f32x4 a = *(const f32x4*)(P.conv_w + k * 1024 + ch0), c = *(const f32x4*)(P.conv_w + k * 1024 + ch0 + 4);
        cw[k][0] = a[0]; cw[k][1] = a[1]; cw[k][2] = a[2]; cw[k][3] = a[3]; cw[k][4] = c[0]; cw[k][5] = c[1]; cw[k][6] = c[2]; cw[k][7] = c[3]; }
    { const f32x4 a = *(const f32x4*)(P.conv_b + ch0), c = *(const f32x4*)(P.conv_b + ch0 + 4); cb[0] = a[0]; cb[1] = a[1]; cb[2] = a[2]; cb[3] = a[3]; cb[4] = c[0]; cb[5] = c[1]; cb[6] = c[2]; cb[7] = c[3]; }
    const int seqmask = (1 << lgseq) - 1;
    for (int run = gthread >> 7; run < nrows / 16; run += nthreads >> 7) {
        const int row0 = run * 16, t0 = row0 & seqmask;
        u32x4 xw[19];
#pragma unroll
        for (int k = 0; k < 19; ++k) { const int tt = t0 + k - 2; xw[k] = (tt >= 0 && tt <= seqmask) ? *(const u32x4*)(xsrc + (size_t)(row0 + k - 2) * ldx + ch0) : (u32x4){0u, 0u, 0u, 0u}; }
#pragma unroll
        for (int r = 0; r < 16; ++r) { float a[8];
#pragma unroll
            for (int j = 0; j < 8; ++j) a[j] = cb[j];
#pragma unroll
            for (int k = 0; k < 4; ++k) { float xv[8]; unpack8(xw[r + k], xv);
#pragma unroll
                for (int j = 0; j < 8; ++j) a[j] += cw[k][j] * xv[j]; }
            u32x4 o; o.x = pk2(a[0], a[1]); o.y = pk2(a[2], a[3]); o.z = pk2(a[4], a[5]); o.w = pk2(a[6], a[7]);
            *(u32x4*)(dst + (size_t)(row0 + r) * 1024 + ch0) = o; }
    }
}
__device__ __forceinline__ void lru_sweep(LAS unsigned char* lds, const LruP& P, int n, int sub, int dir, const bf16* xcl, const bf16* xcc, bf16* hout) {
    const int tid = opaque_tid(), lane = tid & 63, w = __builtin_amdgcn_readfirstlane(tid >> 6), col = lane & 15, g4 = lane >> 4;
    LAS unsigned char* XC = lds;
    LAS f32x2* AGG = (LAS f32x2*)(lds + 69632);
    LAS unsigned char* OUT = lds + 69632 + 1024;
    const int chl = 16 * sub + col, ch = 128 * n + chl;
    const float bav = P.ba[dir * 1024 + ch], bxv = P.bx[dir * 1024 + ch];
    const float c8 = 8.0f * log1pf(expf(-P.lam[dir * 1024 + ch]));
    bf16x8 Ba[4], Bx[4];
    { const bf16* wa = P.wg + ((size_t)((n * 4 + dir * 2 + 0) * 128 + chl)) * 128 + 8 * g4; const bf16* wx = wa + 128 * 128;
#pragma unroll
      for (int ks = 0; ks < 4; ++ks) { Ba[ks] = *(const bf16x8*)(wa + 32 * ks); Bx[ks] = *(const bf16x8*)(wx + 32 * ks); } }
    u32x4 xq[8];
    auto gload = [&](int s) { const bf16* srcp = s == 0 ? xcc : xcl + (size_t)(dir ? 32 - s : s - 1) * 256 * 1024;
#pragma unroll
        for (int i = 0; i < 8; ++i) { const int it = tid + 512 * i; xq[i] = *(const u32x4*)(srcp + (size_t)(it >> 4) * 1024 + 128 * n + 8 * (it & 15)); } };
    auto lstore = [&]() {
#pragma unroll
        for (int i = 0; i < 8; ++i) { const int it = tid + 512 * i; *(LAS u32x4*)(XC + (it >> 4) * 272 + (it & 15) * 16) = xq[i]; } };
    float hchunk = 0.f;
    __syncthreads();
    gload(0); lstore();
#pragma unroll 1
    for (int s = 0; s < 33; ++s) {
        __syncthreads();
        if (s + 1 < 33) gload(s + 1);
        if (s >= 2) { const int cprev = dir ? 33 - s : s - 2; *(u32x4*)(hout + (size_t)cprev * 4096 + tid * 8) = *(const LAS u32x4*)(OUT + tid * 16); }
        float av[2][4], uv[2][4], Ag[2][4], Ug[2][4], Am[2], Um[2];
#pragma unroll
        for (int q2 = 0; q2 < 2; ++q2) {
            const int m = dir ? 2 * w + 1 - q2 : 2 * w + q2;
            f32x4 ar = {0.f, 0.f, 0.f, 0.f}, ai = {0.f, 0.f, 0.f, 0.f};
            const LAS unsigned char* xrow = XC + (16 * m + col) * 272 + 16 * g4;
#pragma unroll
            for (int ks = 0; ks < 4; ++ks) { const bf16x8 af = *(const LAS bf16x8*)(xrow + 64 * ks); ar = MFMA16(af, Ba[ks], ar); ai = MFMA16(af, Bx[ks], ai); }
#pragma unroll
            for (int r = 0; r < 4; ++r) { const int t = 16 * m + 4 * g4 + r; const float xc = bf2f(*(const LAS unsigned short*)(XC + t * 272 + chl * 2));
                const float er = __expf(fminf(-(ar[r] + bav), 40.f)) + 1.0f, ei = __expf(fminf(-(ai[r] + bxv), 40.f)) + 1.0f; const float inv = __builtin_amdgcn_rcpf(er * ei);
                const float rg = inv * ei, ig = inv * er; const float a = __expf(-c8 * rg);
                av[q2][r] = a; uv[q2][r] = __builtin_amdgcn_sqrtf(fmaxf(1.0f - a * a, 0.f)) * ig * xc; }
            float Al = 1.f, Ul = 0.f;
#pragma unroll
            for (int rr = 0; rr < 4; ++rr) { const int r = dir ? 3 - rr : rr; Ul = av[q2][r] * Ul + uv[q2][r]; Al = av[q2][r] * Al; }
            float am = 1.f, um = 0.f;
#pragma unroll
            for (int gq = 0; gq < 4; ++gq) { Ag[q2][gq] = __shfl(Al, col + 16 * gq); Ug[q2][gq] = __shfl(Ul, col + 16 * gq); }
#pragma unroll
            for (int gi = 0; gi < 4; ++gi) { const int gq = dir ? 3 - gi : gi; um = Ag[q2][gq] * um + Ug[q2][gq]; am = Ag[q2][gq] * am; }
            Am[q2] = am; Um[q2] = um;
        }
        if (g4 == 0) AGG[w * 16 + col] = (f32x2){Am[0] * Am[1], Am[1] * Um[0] + Um[1]};
        __syncthreads();
        float h = hchunk, hin = hchunk;
#pragma unroll
        for (int wi = 0; wi < 8; ++wi) { const int ww = dir ? 7 - wi : wi; const f32x2 au = AGG[ww * 16 + col]; if (ww == w) hin = h; h = au.x * h + au.y; }
        hchunk = h;
        float hrun = hin;
#pragma unroll
        for (int q2 = 0; q2 < 2; ++q2) {
            const int m = dir ? 2 * w + 1 - q2 : 2 * w + q2;
            float hg = hrun, hmy = hrun;
#pragma unroll
            for (int gi = 0; gi < 4; ++gi) { const int gq = dir ? 3 - gi : gi; if (gq == g4) hmy = hg; hg = Ag[q2][gq] * hg + Ug[q2][gq]; }
            hrun = hg;
            float hh = hmy;
#pragma unroll
            for (int rr = 0; rr < 4; ++rr) { const int r = dir ? 3 - rr : rr; hh = av[q2][r] * hh + uv[q2][r];
                *(LAS unsigned short*)(OUT + (16 * m + 4 * g4 + r) * 32 + col * 2) = (unsigned short)f2bf(hh); }
        }
        if (s + 1 < 33) lstore();
    }
    __syncthreads();
    { const int cprev = dir ? 0 : 31; *(u32x4*)(hout + (size_t)cprev * 4096 + tid * 8) = *(const LAS u32x4*)(OUT + tid * 16); }
}
__device__ __forceinline__ void lru_combine(const bf16* hf, const bf16* hb  , int c, const bf16* grp  , bf16* ar  , int tid) {
#pragma unroll
    for (int i = 0; i < 8; ++i) { const int it = tid + 512 * i, t = it >> 4, j8 = it & 15; const size_t ho = (size_t)(j8 >> 1) * (32 * 4096) + (size_t)c * 4096 + t * 16 + (j8 & 1) * 8;
        float a[8], b[8], g[8]; unpack8(__builtin_nontemporal_load((const u32x4*)(hf + ho)), a); unpack8(__builtin_nontemporal_load((const u32x4*)(hb + ho)), b); unpack8(*(const u32x4*)(grp + (size_t)t * ZLD + 8 * j8), g);
        u32x4 o; o.x = pk2((a[0] + b[0]) * gelu_tanh(g[0]), (a[1] + b[1]) * gelu_tanh(g[1])); o.y = pk2((a[2] + b[2]) * gelu_tanh(g[2]), (a[3] + b[3]) * gelu_tanh(g[3]));
        o.z = pk2((a[4] + b[4]) * gelu_tanh(g[4]), (a[5] + b[5]) * gelu_tanh(g[5])); o.w = pk2((a[6] + b[6]) * gelu_tanh(g[6]), (a[7] + b[7]) * gelu_tanh(g[7]));
        *(u32x4*)(ar + (size_t)t * 3072 + 8 * j8) = o; }
}

__device__ __forceinline__ void kvs_unit(LAS unsigned char* lds, const bf16* kctx, const bf16* vctx, const bf16* klat, const bf16* vlat, int dir, int part, float lg, bf16* st) {
    const int tid = opaque_tid(), lane = tid & 63, w = __builtin_amdgcn_readfirstlane(tid >> 6);
    const float l2g = lg * 1.4426950408889634f, cdec = __expf(128.0f * lg);
    const int h = lane >> 5, blk = (lane >> 4) & 1, q = (lane & 15) >> 2, p = lane & 3;
    float wj[4];
#pragma unroll
    for (int i = 0; i < 4; ++i) { const int j = (tid + 512 * i) >> 4; wj[i] = exp2f(l2g * (float)(dir ? j : 127 - j)); }
    f32x16 acc;
#pragma unroll
    for (int r = 0; r < 16; ++r) acc[r] = 0.f;
    u32x4 kq[4][4], vq[4];
    LAS unsigned char* SX = lds + 131072;
    auto src = [&](int s, const bf16*& kp, const bf16*& vp, int& ld) {
        if (s < 2) { const int cc = dir ? 1 - s : s; kp = kctx + (size_t)cc * 128 * ZC_LD; vp = vctx + (size_t)cc * 128 * ZC_LD; ld = ZC_LD; }
        else { const int c = dir ? 65 - s : s - 2; kp = klat + (size_t)c * 128 * ZLD; vp = vlat + (size_t)c * 128 * ZLD; ld = ZLD; } };
    auto gload = [&](int s, u32x4 (&kk)[4], u32x4& vv) { const bf16* kp; const bf16* vp; int ld; src(s, kp, vp, ld);
#pragma unroll
        for (int i = 0; i < 4; ++i) { const int idx = tid + 512 * i, j = idx >> 4, chn = idx & 15; kk[i] = *(const u32x4*)(kp + (size_t)j * ld + 8 * chn); }
        vv = *(const u32x4*)(vp + (size_t)(tid >> 2) * ld + 32 * part + 8 * (tid & 3)); };
    auto lstore = [&](int buf, const u32x4 (&kk)[4], const u32x4& vv) { LAS unsigned char* KB = lds + buf * 65536; LAS unsigned char* VB = KB + 32768;
#pragma unroll
        for (int i = 0; i < 4; ++i) { const int idx = tid + 512 * i, j = idx >> 4, chn = idx & 15; float kv[8]; unpack8(kk[i], kv); const float ww = wj[i];
            u32x4 o; o.x = pk2(kv[0] * ww, kv[1] * ww); o.y = pk2(kv[2] * ww, kv[3] * ww); o.z = pk2(kv[4] * ww, kv[5] * ww); o.w = pk2(kv[6] * ww, kv[7] * ww);
            *(LAS u32x4*)(KB + offb(j, chn)) = o; }
        *(LAS u32x4*)(VB + offb(tid >> 2, tid & 3)) = vv; };
    auto copyout = [&](int sprev) { const int c = dir ? 65 - sprev : sprev - 2;
        const u32x4 o = *(const LAS u32x4*)(SX + (sprev & 1) * 8704 + (tid >> 4) * 272 + (tid & 15) * 16);
        *(u32x4*)(st + (size_t)(c * 2 + dir) * 32768 + (size_t)(32 * part) * 128 + tid * 8) = o; };
    auto step = [&](int s, auto SETC, auto LOADC, auto STAGEC, auto COPYC) {
        constexpr int sp = decltype(SETC)::value;
        if constexpr (decltype(LOADC)::value) gload(s + 3, kq[(sp + 3) & 3], vq[(sp + 3) & 3]);
        if constexpr (decltype(COPYC)::value) copyout(s - 1);
        if (w < 4) {
            if constexpr (decltype(STAGEC)::value) { LAS unsigned char* sx = SX + (s & 1) * 8704 + (lane & 31) * 272 + (32 * w + 4 * h) * 2;
#pragma unroll
                for (int rg = 0; rg < 4; ++rg) { u32x2 o; o.x = pk2(acc[4 * rg], acc[4 * rg + 1]); o.y = pk2(acc[4 * rg + 2], acc[4 * rg + 3]); *(LAS u32x2*)(sx + 16 * rg) = o; } }
#pragma unroll
            for (int r = 0; r < 16; ++r) acc[r] *= cdec;
            const LAS unsigned char* KB = lds + (s & 1) * 65536; const LAS unsigned char* VB = KB + 32768;
#pragma unroll
            for (int ks = 0; ks < 8; ++ks) {
                const unsigned r0 = 16 * ks + 8 * h + q, r1 = r0 + 4;
                const bf16x8 bv = __builtin_shufflevector(trd(VB + offb(r0, 2 * blk + (p >> 1)) + 8 * (p & 1)), trd(VB + offb(r1, 2 * blk + (p >> 1)) + 8 * (p & 1)), 0, 1, 2, 3, 4, 5, 6, 7);
                const bf16x8 ak = __builtin_shufflevector(trd(KB + offb(r0, 4 * w + 2 * blk + (p >> 1)) + 8 * (p & 1)), trd(KB + offb(r1, 4 * w + 2 * blk + (p >> 1)) + 8 * (p & 1)), 0, 1, 2, 3, 4, 5, 6, 7);
                acc = MFMA32(ak, bv, acc);
            }
        }
        if (s + 1 < 66) lstore((s + 1) & 1, kq[(sp + 1) & 3], vq[(sp + 1) & 3]);
        __syncthreads();
    };
    using std::integral_constant; typedef integral_constant<bool, true> T_; typedef integral_constant<bool, false> F_;
    __syncthreads();
    gload(0, kq[0], vq[0]); gload(1, kq[1], vq[1]); gload(2, kq[2], vq[2]); lstore(0, kq[0], vq[0]);
    __syncthreads();
    step(0, integral_constant<int, 0>{}, T_{}, F_{}, F_{});
    step(1, integral_constant<int, 1>{}, T_{}, F_{}, F_{});
    step(2, integral_constant<int, 2>{}, T_{}, T_{}, F_{});
#pragma unroll 1
    for (int s4 = 3; s4 < 63; s4 += 4) {
        step(s4 + 0, integral_constant<int, 3>{}, T_{}, T_{}, T_{});
        step(s4 + 1, integral_constant<int, 0>{}, T_{}, T_{}, T_{});
        step(s4 + 2, integral_constant<int, 1>{}, T_{}, T_{}, T_{});
        step(s4 + 3, integral_constant<int, 2>{}, T_{}, T_{}, T_{});
    }
    step(63, integral_constant<int, 3>{}, F_{}, T_{}, T_{});
    step(64, integral_constant<int, 0>{}, F_{}, T_{}, T_{});
    step(65, integral_constant<int, 1>{}, F_{}, T_{}, T_{});
    copyout(65);
}

__device__ __forceinline__ void ro_unit(LAS unsigned char* lds, const bf16* qsrc, const bf16* ksrc, const bf16* vsrc, const bf16* gsp, bf16* gout, const bf16* Sf, const bf16* Sb, float l2g, int skip = 0) {
    const int tid = opaque_tid(), lane = tid & 63, w = __builtin_amdgcn_readfirstlane(tid >> 6), wi = w & 3, wv = w >> 2;
    LAS unsigned char* SF = lds; LAS unsigned char* SB = lds + 65536;
    LAS unsigned char* KI = lds; LAS unsigned char* VI = lds + 32768; LAS float* STATS = (LAS float*)(lds + 135168);
    const int h = lane >> 5, l31 = lane & 31, blk = (lane >> 4) & 1, q = (lane & 15) >> 2, p = lane & 3;
    __syncthreads();
    if (!(skip & 1)) {   u32x4 sf[8], sb[8];
#pragma unroll
        for (int i = 0; i < 8; ++i) { const int idx = tid + 512 * i; sf[i] = __builtin_nontemporal_load((const u32x4*)(Sf + (size_t)idx * 8)); sb[i] = __builtin_nontemporal_load((const u32x4*)(Sb + (size_t)idx * 8)); }
#pragma unroll
        for (int i = 0; i < 8; ++i) { const int idx = tid + 512 * i, v = idx >> 4, chn = idx & 15; *(LAS u32x4*)(SF + offb(v, chn)) = sf[i]; *(LAS u32x4*)(SB + offb(v, chn)) = sb[i]; }
    }
    bf16x8 qf[8];
#pragma unroll
    for (int s = 0; s < 8; ++s) qf[s] = *(const bf16x8*)(qsrc + (size_t)(32 * wi + l31) * ZLD + 16 * s + 8 * h);
    u32x4 kreg[4], vreg[8];
#pragma unroll
    for (int i = 0; i < 4; ++i) { const int idx = tid + 512 * i, j = idx >> 4, chn = idx & 15; kreg[i] = __builtin_nontemporal_load((const u32x4*)(ksrc + (size_t)j * ZLD + 8 * chn)); }
#pragma unroll
    for (int i = 0; i < 8; ++i) { const int idx = tid + 512 * i, j = idx >> 5, chn = idx & 31; vreg[i] = __builtin_nontemporal_load((const u32x4*)(vsrc + (size_t)j * ZLD + 8 * chn)); }
    __syncthreads();
    f32x16 z[4];
#pragma unroll
    for (int c = 0; c < 4; ++c)
#pragma unroll
        for (int r = 0; r < 16; ++r) z[c][r] = 0.f;
    if (!(skip & 1)) {
#pragma unroll
    for (int s = 0; s < 8; ++s)
#pragma unroll
        for (int c = 0; c < 4; ++c) { const bf16x8 bs = *(const LAS bf16x8*)(SF + offb(128 * wv + 32 * c + l31, 2 * s + h)); z[c] = MFMA32(qf[s], bs, z[c]); }
#pragma unroll
    for (int r = 0; r < 16; ++r) { const int i = 32 * wi + crow(r, h); const float f = exp2f(l2g * (float)(2 * i - 127));
#pragma unroll
        for (int c = 0; c < 4; ++c) z[c][r] *= f; }
#pragma unroll
    for (int s = 0; s < 8; ++s)
#pragma unroll
        for (int c = 0; c < 4; ++c) { const bf16x8 bs = *(const LAS bf16x8*)(SB + offb(128 * wv + 32 * c + l31, 2 * s + h)); z[c] = MFMA32(qf[s], bs, z[c]); }
#pragma unroll
    for (int r = 0; r < 16; ++r) { const int i = 32 * wi + crow(r, h); const float f = exp2f(l2g * (float)(128 - i));
#pragma unroll
        for (int c = 0; c < 4; ++c) z[c][r] *= f; }
    }
    __syncthreads();
#pragma unroll
    for (int i = 0; i < 4; ++i) { const int idx = tid + 512 * i, j = idx >> 4, chn = idx & 15; *(LAS u32x4*)(KI + offb(j, chn)) = kreg[i]; }
#pragma unroll
    for (int i = 0; i < 8; ++i) { const int idx = tid + 512 * i, j = idx >> 5, chn = idx & 31; *(LAS u32x4*)(VI + (chn >> 4) * 32768 + offb(j, chn & 15)) = vreg[i]; }
    __syncthreads();
    const LAS unsigned char* Vimg = VI + wv * 32768;
    u32x4 gsq[8];
#pragma unroll
    for (int i = 0; i < 8; ++i) { const int idx = tid + 512 * i, r = idx >> 5, chn = idx & 31; gsq[i] = __builtin_nontemporal_load((const u32x4*)(gsp + (size_t)r * ZLD + 8 * chn)); }
    if (!(skip & 2))
#pragma unroll
    for (int jt = 0; jt < 4; ++jt) {
        f32x16 x;
#pragma unroll
        for (int r = 0; r < 16; ++r) x[r] = 0.f;
#pragma unroll
        for (int s = 0; s < 8; ++s) { const bf16x8 ak = *(const LAS bf16x8*)(KI + offb(32 * jt + l31, 2 * s + h)); x = MFMA32(ak, qf[s], x); }
        const int ii = 32 * wi + l31;
#pragma unroll
        for (int r = 0; r < 16; ++r) { const int jj = 32 * jt + crow(r, h); const int dd = ii > jj ? ii - jj : jj - ii; x[r] *= exp2f(l2g * (float)dd); }
#pragma unroll
        for (int s2 = 0; s2 < 2; ++s2) {
            u32x4 pw; pw.x = pk2(x[8 * s2], x[8 * s2 + 1]); pw.y = pk2(x[8 * s2 + 2], x[8 * s2 + 3]); pw.z = pk2(x[8 * s2 + 4], x[8 * s2 + 5]); pw.w = pk2(x[8 * s2 + 6], x[8 * s2 + 7]);
            const bf16x8 xs = __builtin_bit_cast(bf16x8, pw);
            const unsigned r0 = 32 * jt + 16 * s2 + 4 * h + q, r1 = r0 + 8;
#pragma unroll
            for (int c = 0; c < 4; ++c) {
                const s16x4 v0 = trd(Vimg + offb(r0, 4 * c + 2 * blk + (p >> 1)) + 8 * (p & 1)), v1 = trd(Vimg + offb(r1, 4 * c + 2 * blk + (p >> 1)) + 8 * (p & 1));
                const bf16x8 pb = __builtin_shufflevector(v0, v1, 0, 1, 2, 3, 4, 5, 6, 7);
                z[c] = MFMA32(xs, pb, z[c]);
            }
        }
#pragma unroll
        for (int i2 = 0; i2 < 2; ++i2) { const int i = 2 * jt + i2; float gv[8]; unpack8(gsq[i], gv);
#pragma unroll
            for (int j = 0; j < 8; ++j) gv[j] = gv[j] * sigmoidf_(gv[j]);
            gsq[i].x = pk2(gv[0], gv[1]); gsq[i].y = pk2(gv[2], gv[3]); gsq[i].z = pk2(gv[4], gv[5]); gsq[i].w = pk2(gv[6], gv[7]); }
    }
#pragma unroll
    for (int r = 0; r < 16; ++r) { float s1 = (z[0][r] + z[1][r]) + (z[2][r] + z[3][r]); float s2 = (z[0][r] * z[0][r] + z[1][r] * z[1][r]) + (z[2][r] * z[2][r] + z[3][r] * z[3][r]);
        s1 = row16_sum(s1); s2 = row16_sum(s2);
        s1 += __shfl_xor(s1, 16); s2 += __shfl_xor(s2, 16);
        if (l31 == 0) { STATS[((wi * 2 + wv) * 32 + crow(r, h)) * 2] = s1; STATS[((wi * 2 + wv) * 32 + crow(r, h)) * 2 + 1] = s2; } }
    __syncthreads();
#pragma unroll
    for (int r = 0; r < 16; ++r) { const int il = crow(r, h);
        const float s1 = STATS[((wi * 2 + 0) * 32 + il) * 2] + STATS[((wi * 2 + 1) * 32 + il) * 2], s2 = STATS[((wi * 2 + 0) * 32 + il) * 2 + 1] + STATS[((wi * 2 + 1) * 32 + il) * 2 + 1];
        const float mean = s1 * (1.0f / 256.0f); const float var = fmaxf(s2 * (1.0f / 256.0f) - mean * mean, 0.f); const float rstd = __builtin_amdgcn_rsqf(var + EPS);
#pragma unroll
        for (int c = 0; c < 4; ++c) *(LAS unsigned short*)(lds + (32 * wi + il) * 528 + (128 * wv + 32 * c + l31) * 2) = (unsigned short)f2bf((z[c][r] - mean) * rstd); }
    __syncthreads();
    if (!(skip & 4))
#pragma unroll
    for (int i = 0; i < 8; ++i) { const int idx = tid + 512 * i, r = idx >> 5, chn = idx & 31; float ov[8], gv[8];
        unpack8(*(const LAS u32x4*)(lds + r * 528 + chn * 16), ov); unpack8(gsq[i], gv); bf16* gp = gout + (size_t)r * 3072 + 8 * chn;
        u32x4 o; o.x = pk2(ov[0] * gv[0], ov[1] * gv[1]); o.y = pk2(ov[2] * gv[2], ov[3] * gv[3]); o.z = pk2(ov[4] * gv[4], ov[5] * gv[5]); o.w = pk2(ov[6] * gv[6], ov[7] * gv[7]);
        *(u32x4*)gp = o; }
}

struct Args { const float* in[26]; float* out; unsigned char* ws; int lo, hi; };
enum { I_X = 0, I_C, I_CTX, I_CCTX, I_ADAW, I_ADAB, I_N1G, I_WIN, I_CONVW, I_CONVB, I_WA, I_BA, I_WX, I_BX, I_LAM, I_WRNN, I_WRET, I_WOUT, I_N2G, I_RW, I_RB, I_W1, I_B1, I_W2, I_B2, I_FG };
constexpr int ST_GRP = 3, ST_M0 = 27, ST_M1 = 28, ST_RNG = 29, ST_END = ST_RNG + 3 * NRANGE;

__global__ void __launch_bounds__(NTHR, 2) fwd_kernel(Args args) {
    extern __shared__ __attribute__((aligned(16))) unsigned char lds_raw[];
    LAS unsigned char* lds = (LAS unsigned char*)lds_raw;
    const int tid = threadIdx.x, lane = tid & 63, wave = __builtin_amdgcn_readfirstlane(tid >> 6);
    const int G = gridDim.x, bid = blockIdx.x;
    const int gw = bid * NWAVES + wave, NGW = G * NWAVES;
    unsigned char* ws = args.ws;
    volatile LAS unsigned* MISC = (volatile LAS unsigned*)(lds + MISC_OFF);
    if (tid < 64) MISC[tid] = 0u;
    __syncthreads();
    const int lo = args.lo, hi = args.hi;
    XcdBarrier bar; bar.bar = (unsigned*)(ws + WS_CTL) + CW_BAR; bar.x = 0; bar.st = nullptr;
    if (!MK_PER_PHASE) bar = xcd_barrier_post((unsigned*)(ws + WS_CTL) + CW_BAR, MISC);
#define IN(k) (lo <= (k) && (k) < hi)
#define SEAM(k) do { if (IN(k) && IN((k) + 1)) xcd_barrier(bar); } while (0)
#if MK_PROBE
    unsigned long long t_last = wall_clock64();
#define STAMP(kind) do { if (bid == 0 && threadIdx.x == 0) { const unsigned long long t_ = wall_clock64(); MISC[16 + (kind)] += (unsigned)(t_ - t_last); t_last = t_; } } while (0)
#else
#define STAMP(kind) do { } while (0)
#endif

    float* mod = (float*)(ws + WS_MOD);
    f32x2* rope = (f32x2*)(ws + WS_ROPE);
    f32x2* carry = (f32x2*)(ws + WS_CARRY); bf16* RWB = (bf16*)(ws + WS_RWB);
    bf16* WG = (bf16*)(ws + WS_WG); bf16* WRNN = (bf16*)(ws + WS_WRNN); bf16* WOUT = (bf16*)(ws + WS_WOUT); bf16* WRET = WRNN + 1024; bf16* WIN = (bf16*)(ws + WS_WIN);
    bf16* HL = (bf16*)(ws + WS_HL); bf16* ZC = (bf16*)(ws + WS_ZC); bf16* CTXU = (bf16*)(ws + WS_CTXU); bf16* Z = (bf16*)(ws + WS_Z); bf16* STB = (bf16*)(ws + WS_ST);
    bf16* T1 = (bf16*)(ws + WS_T1); bf16* MG = (bf16*)(ws + WS_MG);
    bf16* W1T = (bf16*)(ws + WS_W1T); bf16* W2T = (bf16*)(ws + WS_W2T); bf16* HPAD = (bf16*)(ws + WS_HPAD); bf16* HID = (bf16*)(ws + WS_HID); bf16* YPAD = (bf16*)(ws + WS_YPAD);
    float* WRNNS = (float*)(ws + WS_WFS); float* WRETS = WRNNS + 1024; float* WOUTS = WRNNS + 2048; float* W2S = WRNNS + 4096;
    bf16* AR = (bf16*)(ws + WS_AR); bf16* AT = (bf16*)(ws + WS_AT);
    bf16* XCB = T1; bf16* XCC = CTXU;
    bf16* HDF = MG; bf16* HDB = (bf16*)(ws + 880 * MiB);
    float* HLS = (float*)(ws + WS_HLS); float* WINS = (float*)(ws + WS_WINS); float* W1S = (float*)(ws + WS_W1S); float* HPS = (float*)(ws + WS_HPS);
    int* ROWTOK = (int*)(ws + WS_HPAD);
    int* EIDX = (int*)(ws + WS_EIDX); float* GATE = (float*)(ws + WS_GATE); int* LPOS = (int*)(ws + WS_LPOS); int* AROW = (int*)(ws + WS_AROW);
    int* BCNT = (int*)(ws + WS_BCNT); int* BBASE = (int*)(ws + WS_BBASE); int* TILEE = (int*)(ws + WS_TILEE); int* NTILE = (int*)(ws + WS_NTILE);

    if (PH_EN(0) && IN(0)) for (int rep = 0; rep < DUP_N(0); ++rep) {
        const int tid = opaque_tid(), lane = tid & 63, wave = __builtin_amdgcn_readfirstlane(tid >> 6), gw = bid * NWAVES + wave; (void)lane; (void)gw; (void)rep;
        if (bid < 96) {
            LAS float* sc = (LAS float*)lds;
            LAS float* red = (LAS float*)(lds + 40960);
            for (int i = tid; i < 9 * 1024; i += NTHR) { const int r = i >> 10, k = i & 1023; const float v = r < 8 ? args.in[I_C][r * 1024 + k] : args.in[I_CCTX][k]; sc[i] = v * sigmoidf_(v); }
            __syncthreads();
            const int n0 = bid * 64; float a9[9];
#pragma unroll
            for (int r = 0; r < 9; ++r) a9[r] = 0.f;
            for (int k = wave * 128; k < wave * 128 + 128; ++k) { const float wv = args.in[I_ADAW][(size_t)k * 6144 + n0 + lane];
#pragma unroll
                for (int r = 0; r < 9; ++r) a9[r] += sc[r * 1024 + k] * wv; }
#pragma unroll
            for (int r = 0; r < 9; ++r) red[(wave * 9 + r) * 64 + lane] = a9[r];
            __syncthreads();
            for (int i = tid; i < 9 * 64; i += NTHR) { const int r = i >> 6, l = i & 63; float s = 0.f;
#pragma unroll
                for (int w8 = 0; w8 < 8; ++w8) s += red[(w8 * 9 + r) * 64 + l];
                mod[r * 6144 + n0 + l] = s + args.in[I_ADAB][n0 + l]; }
            __syncthreads();
        }
        if (bid == 97 % G) {
            for (int i = tid; i < 32 * 1024; i += NTHR) { const int d = i >> 5, e = i & 31; const float wv = args.in[I_RW][i]; const unsigned hi = f2bf(wv); const float rem = wv - bf2f((unsigned short)hi);
                RWB[e * 1024 + d] = (bf16)hi; RWB[32 * 1024 + e * 1024 + d] = (bf16)f2bf(rem); }
        }
        if (bid == 96) {
            for (int i = tid; i < 128 * 32; i += NTHR) { const int pos = i >> 5, f = i & 31; const float inv = powf(10000.0f, -(float)f / 32.0f); const float ang = (float)pos * inv; float s, c; sincosf(ang, &s, &c); rope[i] = (f32x2){c, s}; }
        }
        {
            LAS float* L = (LAS float*)(lds + 65536); LAS unsigned* CM = (LAS unsigned*)(lds + 65536 + 66048); LAS unsigned* TL = (LAS unsigned*)lds;
            for (int it = bid; it < 848; it += G) {
                if (it < 80) tr_strip_i8<false>(args.in[I_WIN] + it * 128, DIN, 1024, (signed char*)WIN + (size_t)it * 128 * 1024, 1024, WINS + it * 128, tid, TL, CM);
                else if (it < 592) { const int s = it - 80, e = s >> 4, nt = s & 15; tr_strip_i8<false>(args.in[I_W1] + (size_t)e * 1024 * 2048 + nt * 128, 2048, 1024, (signed char*)W1T + ((size_t)e * 2048 + nt * 128) * 1024, 1024, W1S + e * 2048 + nt * 128, tid, TL, CM); }
                else { const int s = it - 592, e = s >> 3, nt = s & 7; tr_strip_i8<true>(args.in[I_W2] + (size_t)e * 1024 * 1024 + nt * 128, 1024, 1024, (signed char*)W2T + ((size_t)e * 1024 + nt * 128) * 1024, 1024, W2S + e * 1024 + nt * 128, tid, TL, CM); }
            }
            constexpr int NT_ALL = 64 + 128 + 64 + 32;
            auto desc = [&](int it) -> TrTile { TrTile t;
                if (it < 64) { const int kt = it >> 3, nt = it & 7; t.src = args.in[I_WRNN] + (size_t)kt * 128 * 1024 + nt * 128; t.ldw = 1024; t.dst = WRNN + (size_t)nt * 128 * 3072 + kt * 128; t.ldt = 3072; return t; }
                it -= 64;
                if (it < 128) { const int kt = it >> 3, nt = it & 7; t.src = args.in[I_WRET] + (size_t)kt * 128 * 1024 + nt * 128; t.ldw = 1024; t.dst = WRET + (size_t)nt * 128 * 3072 + kt * 128; t.ldt = 3072; return t; }
                it -= 128;
                if (it < 64) { const int kt = it >> 3, nt = it & 7; t.src = args.in[I_WOUT] + (size_t)kt * 128 * 1024 + nt * 128; t.ldw = 1024; t.dst = WOUT + (size_t)nt * 128 * 1024 + kt * 128; t.ldt = 1024; return t; }
                it -= 64;
                { const int q = it & 3, n = it >> 2; const int dir = q >> 1, typ = q & 1;
                  t.src = (typ ? args.in[I_WX] : args.in[I_WA]) + (size_t)(dir * 8 + n) * 128 * 128; t.ldw = 128; t.dst = WG + (size_t)(n * 4 + q) * 128 * 128; t.ldt = 128; return t; } };
            f32x4 v[8];
            int it = NT_ALL - 1 - ((bid + 80) % G);
            if (it >= 0) { const TrTile t0 = desc(it); tr_load(t0, tid, v); }
            while (it >= 0) {
                const TrTile tc = desc(it); const int nx = it - G;
                f32x4 w[8];
#pragma unroll
                for (int i = 0; i < 8; ++i) w[i] = v[i];
                if (nx >= 0) { const TrTile tn = desc(nx); tr_load(tn, tid, v); }
                tr_store(tc, tid, w, L);
                it = nx;
            }
        }
    }
    SEAM(0); STAMP(0);
    if (PH_EN(1) && IN(1)) for (int rep = 0; rep < DUP_N(1); ++rep) {
        const int tid = opaque_tid(), lane = tid & 63, wave = __builtin_amdgcn_readfirstlane(tid >> 6), gw = bid * NWAVES + wave; (void)lane; (void)gw; (void)rep;
        auto rowsrc = [&](int m) { return (const f32x4*)(m < NTOK ? args.in[I_X] + (size_t)m * D : args.in[I_CTX] + (size_t)(m - NTOK) * D) + lane; };
        f32x4 nx[4];
        if (gw < NROWS_HL) { const f32x4* xr = rowsrc(gw);
#pragma unroll
            for (int j = 0; j < 4; ++j) nx[j] = xr[64 * j]; }
#pragma unroll 1
        for (int m = gw; m < NROWS_HL; m += NGW) {
            const int r = m < NTOK ? (m >> 13) : 8;
            f32x4 v[4]; float ss = 0.f;
#pragma unroll
            for (int j = 0; j < 4; ++j) v[j] = nx[j];
            if (m + NGW < NROWS_HL) { const f32x4* xr = rowsrc(m + NGW);
#pragma unroll
                for (int j = 0; j < 4; ++j) nx[j] = xr[64 * j]; }
#pragma unroll
            for (int j = 0; j < 4; ++j) ss += (v[j].x * v[j].x + v[j].y * v[j].y) + (v[j].z * v[j].z + v[j].w * v[j].w);
            const float rstd = 1.0f / sqrtf(wave_sum(ss) * (1.0f / D) + EPS);
            float am = 0.f;
#pragma unroll
            for (int j = 0; j < 4; ++j) { const int c0 = 4 * lane + 256 * j; const f32x4 gn = *(const f32x4*)(args.in[I_N1G] + c0), sh = *(const f32x4*)(mod + r * 6144 + c0), sc = *(const f32x4*)(mod + r * 6144 + 1024 + c0);
                v[j] = (v[j] * rstd * gn) * (sc + 1.0f) + sh; am = fmaxf(fmaxf(am, fmaxf(fabsf(v[j].x), fabsf(v[j].y))), fmaxf(fabsf(v[j].z), fabsf(v[j].w))); }
            am = wave_max(am); const float inv = am > 0.f ? 127.0f / am : 0.f;
            if (lane == 0) HLS[m] = am > 0.f ? am * (1.0f / 127.0f) : 1.0f;
            unsigned* o4 = (unsigned*)((signed char*)HL + (size_t)m * D) + lane;
#pragma unroll
            for (int j = 0; j < 4; ++j) o4[64 * j] = q8x4(v[j], inv);
        }
    }
    SEAM(1); STAMP(1);
    if (PH_EN(2) && IN(2)) for (int rep = 0; rep < DUP_N(2); ++rep) {
        const int tid = opaque_tid(), lane = tid & 63, wave = __builtin_amdgcn_readfirstlane(tid >> 6), gw = bid * NWAVES + wave; (void)lane; (void)gw; (void)rep;
        pg8::Gemm g{HL, WIN, 512, 512, 512, HLS, WINS, nullptr}; pg8::CtxOrder S{G, bid}; EpiCtx E{ZC};
        pg8::gemm_phase<EpiCtx, pg8::CtxOrder, 1>(lds, g, S, E);
    }
    SEAM(2); STAMP(2);
    for (int grp = 0; grp < NGRP; ++grp) {
        const int s0 = ST_GRP + 6 * grp;
        if (PH_EN(3) && IN(s0 + 0)) for (int rep = 0; rep < DUP_N(3); ++rep) {
        const int tid = opaque_tid(), lane = tid & 63, wave = __builtin_amdgcn_readfirstlane(tid >> 6), gw = bid * NWAVES + wave; (void)lane; (void)gw; (void)rep;
            pg8::Gemm g{HL + (size_t)grp * GROWS * 512, WIN, 512, 512, 512, HLS + grp * GROWS, WINS, nullptr}; pg8::StaticOrder S; S.init(GROWS / 256, DIN / 256, G, bid); EpiIn E{Z, rope, DRY(3) ? 1 : 0};
            STAGGER(STAG_B); pg8::gemm_phase<EpiIn, pg8::StaticOrder, 1>(lds, g, S, E);
        }
        SEAM(s0 + 0); STAMP(3);
        if (PH_EN(4) && IN(s0 + 1)) for (int rep = 0; rep < DUP_N(4); ++rep) {
        const int tid = opaque_tid(), lane = tid & 63, wave = __builtin_amdgcn_readfirstlane(tid >> 6), gw = bid * NWAVES + wave; (void)lane; (void)gw; (void)rep;
            for (int u = bid; u < GB * 8 * 2 * 8; u += G) { const int hd = u & 7, y = u >> 3, bl = y >> 4, dir = (y >> 3) & 1, part = y & 7; const int b = grp * GB + bl;
                const float lg = log1pf(-exp2f(-5.0f - (float)hd));
                const bf16* zc = ZC + (size_t)(b * CTXL) * ZC_LD; const bf16* zl = Z + (size_t)(bl * SEQ) * ZLD;
                kvs_unit(lds, zc + ZC_K + hd * 128, zc + ZC_V + hd * 256, zl + C_K + hd * 128, zl + C_V + hd * 256, dir, part, lg, STB + (size_t)((bl * 8 + hd) * 64) * 2 * 32768); }
            LruP LP{args.in[I_CONVW], args.in[I_CONVB], args.in[I_BA], args.in[I_BX], args.in[I_LAM], WG, carry};
            xc_rows(LP, Z + C_XR, ZLD, 13, GROWS, XCB, bid * NTHR + tid, G * NTHR);
            if (grp == 0) xc_rows(LP, ZC + ZC_XR, ZC_LD, 8, NCTX, XCC, bid * NTHR + tid, G * NTHR);
        }
        SEAM(s0 + 1); STAMP(4);
        if (PH_EN(5) && IN(s0 + 2)) for (int rep = 0; rep < DUP_N(5); ++rep) {
        const int tid = opaque_tid(), lane = tid & 63, wave = __builtin_amdgcn_readfirstlane(tid >> 6), gw = bid * NWAVES + wave; (void)lane; (void)gw; (void)rep;
            LruP LP{args.in[I_CONVW], args.in[I_CONVB], args.in[I_BA], args.in[I_BX], args.in[I_LAM], WG, carry};
            for (int u = bid; u < GB * 8 * 8 * 2; u += G) { const int n = u & 7, bl = (u >> 3) & 1, y = u >> 4, dir = y & 1, sub = y >> 1;
                bf16* hb_ = (dir ? HDB : HDF) + (size_t)((bl * 8 + n) * 8 + sub) * (32 * 4096);
                lru_sweep(lds, LP, n, sub, dir, XCB + (size_t)(bl * SEQ) * 1024, XCC + (size_t)((grp * GB + bl) * CTXL) * 1024, hb_); }
        }
        SEAM(s0 + 2); STAMP(5);
        if (PH_EN(6) && IN(s0 + 3)) for (int rep = 0; rep < DUP_N(6); ++rep) {
        const int tid = opaque_tid(), lane = tid & 63, wave = __builtin_amdgcn_readfirstlane(tid >> 6), gw = bid * NWAVES + wave; (void)lane; (void)gw; (void)rep;
            for (int u = bid; u < GB * 64 * 8; u += G) { const int hd = u & 7, c = (u >> 3) & 63, bl = u >> 9; const float l2g = log1pf(-exp2f(-5.0f - (float)hd)) * 1.4426950408889634f;
                bf16* zr = Z + (size_t)(bl * SEQ + c * 128) * ZLD; const bf16* sp = STB + (size_t)(((bl * 8 + hd) * 64 + c) * 2) * 32768;
                ro_unit(lds, zr + C_Q + hd * 128, zr + C_K + hd * 128, zr + C_V + hd * 256, zr + C_GS + hd * 256, AR + (size_t)(bl * SEQ + c * 128) * 3072 + 1024 + hd * 256, sp, sp + 32768, l2g, DRY(6) ? (MK_DRYMODE >= 8 ? MK_DRYMODE - 8 : 0) : 0); }
            if (!(DRY(6) && MK_DRYMODE >= 8))
            for (int u = bid; u < GB * 32 * 8; u += G) { const int n = u & 7, c = (u >> 3) & 31, bl = u >> 8; const size_t ub = (size_t)((bl * 8 + n) * 8) * (32 * 4096);
                lru_combine(HDF + ub, HDB + ub, c, Z + (size_t)(bl * SEQ + c * 256) * ZLD + C_GR + 128 * n, AR + (size_t)(bl * SEQ + c * 256) * 3072 + 128 * n, tid); }
        }
        SEAM(s0 + 3); STAMP(6);
        if (PH_EN(7) && IN(s0 + 4)) for (int rep = 0; rep < DUP_N(7); ++rep) {
        const int tid = opaque_tid(), lane = tid & 63, wave = __builtin_amdgcn_readfirstlane(tid >> 6), gw = bid * NWAVES + wave; (void)lane; (void)gw; (void)rep;
            { pg8::Gemm g{AR, WRNN, 3072, 3072, 3072, nullptr, nullptr, nullptr}; pg8::FOrder S; S.so.init(GROWS / 256, 4, G, bid); EpiF E{Z, MG, DRY(7) ? 1 : 0};
              pg8::gemm_phase<EpiF, pg8::FOrder>(lds, g, S, E); }
        }
        SEAM(s0 + 4); STAMP(7);
        if (PH_EN(8) && IN(s0 + 5)) for (int rep = 0; rep < DUP_N(8); ++rep) {
        const int tid = opaque_tid(), lane = tid & 63, wave = __builtin_amdgcn_readfirstlane(tid >> 6), gw = bid * NWAVES + wave; (void)lane; (void)gw; (void)rep;
            pg8::Gemm g{MG, WOUT, D, D, D, nullptr, nullptr, nullptr}; pg8::StaticOrder S; S.init(GROWS / 256, 4, G, bid); EpiX1 E{args.in[I_X], args.out, mod, grp * GROWS};
            pg8::gemm_phase<EpiX1, pg8::StaticOrder>(lds, g, S, E);
        }
        if (grp == NGRP - 1) SEAM(s0 + 5);
        STAMP(8);
    }
    if (PH_EN(9) && IN(ST_M0)) for (int rep = 0; rep < DUP_N(9); ++rep) {
        const int tid = opaque_tid(), lane = tid & 63, wave = __builtin_amdgcn_readfirstlane(tid >> 6), gw = bid * NWAVES + wave; (void)lane; (void)gw; (void)rep;
        LAS unsigned char* AH = lds;
        LAS unsigned char* AL = lds + 66048;
        LAS float* RED = (LAS float*)lds;
        LAS float* LOG = (LAS float*)(lds + 32768);
        LAS int* CNT = (LAS int*)(lds + 132096 + 512);
        const int h5 = lane >> 5, l31 = lane & 31;
        bf16x8 bh[8], bl[8];
#pragma unroll
        for (int s = 0; s < 8; ++s) { bh[s] = *(const bf16x8*)(RWB + (size_t)l31 * 1024 + 128 * wave + 16 * s + 8 * h5); bl[s] = *(const bf16x8*)(RWB + 32 * 1024 + (size_t)l31 * 1024 + 128 * wave + 16 * s + 8 * h5); }
        f32x4 xv[4][4];
        auto ldtile = [&](int blk, int tile) { const int m0 = blk * 256 + tile * 32 + wave * 4;
#pragma unroll
            for (int r4 = 0; r4 < 4; ++r4)
#pragma unroll
                for (int j = 0; j < 4; ++j) xv[r4][j] = __builtin_nontemporal_load((const f32x4*)(args.out + (size_t)(m0 + r4) * D) + lane + 64 * j); };
        for (int blk = bid; blk < NTOK / 256; blk += G) {
            __syncthreads();
            if (tid < 32) CNT[tid] = 0;
            ldtile(blk, 0);
#pragma unroll 1
            for (int tile = 0; tile < 8; ++tile) {
                __syncthreads();
                const int m0 = blk * 256 + tile * 32 + wave * 4; const int b = m0 >> 13;
#pragma unroll
                for (int r4 = 0; r4 < 4; ++r4) {
                    const int m = m0 + r4; f32x4 v[4]; float ss = 0.f;
#pragma unroll
                    for (int j = 0; j < 4; ++j) { v[j] = xv[r4][j]; ss += (v[j].x * v[j].x + v[j].y * v[j].y) + (v[j].z * v[j].z + v[j].w * v[j].w); }
                    const float rstd = 1.0f / sqrtf(wave_sum(ss) * (1.0f / D) + EPS);
                    float am = 0.f;
#pragma unroll
                    for (int j = 0; j < 4; ++j) { const int c0 = 4 * lane + 256 * j; const f32x4 gn = *(const f32x4*)(args.in[I_N2G] + c0), sh = *(const f32x4*)(mod + b * 6144 + 3072 + c0), sc = *(const f32x4*)(mod + b * 6144 + 4096 + c0);
                        v[j] = (v[j] * rstd * gn) * (sc + 1.0f) + sh; am = fmaxf(fmaxf(am, fmaxf(fabsf(v[j].x), fabsf(v[j].y))), fmaxf(fabsf(v[j].z), fabsf(v[j].w))); }
                    am = wave_max(am); const float inv = am > 0.f ? 127.0f / am : 0.f;
                    if (lane == 0) HLS[m] = am > 0.f ? am * (1.0f / 127.0f) : 1.0f;
                    unsigned* o4 = (unsigned*)((signed char*)HL + (size_t)m * D) + lane;
                    const int rowl = wave * 4 + r4;
#pragma unroll
                    for (int j = 0; j < 4; ++j) { o4[64 * j] = q8x4(v[j], inv);
                        u32x2 hi; hi.x = pk2(v[j].x, v[j].y); hi.y = pk2(v[j].z, v[j].w);
                        u32x2 lo; lo.x = pk2(v[j].x - bflo(hi.x), v[j].y - bfhi(hi.x)); lo.y = pk2(v[j].z - bflo(hi.y), v[j].w - bfhi(hi.y));
                        *(LAS u32x2*)(AH + rowl * 2064 + (4 * lane + 256 * j) * 2) = hi; *(LAS u32x2*)(AL + rowl * 2064 + (4 * lane + 256 * j) * 2) = lo; }
                }
                if (tile + 1 < 8) ldtile(blk, tile + 1);
                __syncthreads();
                f32x16 acc;
#pragma unroll
                for (int r = 0; r < 16; ++r) acc[r] = 0.f;
#pragma unroll
                for (int s = 0; s < 8; ++s) { const int ko = (128 * wave + 16 * s + 8 * h5) * 2;
                    const bf16x8 ah = *(const LAS bf16x8*)(AH + l31 * 2064 + ko), al = *(const LAS bf16x8*)(AL + l31 * 2064 + ko);
                    acc = MFMA32(ah, bh[s], acc); acc = MFMA32(ah, bl[s], acc); acc = MFMA32(al, bh[s], acc); }
                __syncthreads();
#pragma unroll
                for (int r = 0; r < 16; ++r) RED[(wave * 32 + crow(r, h5)) * 32 + l31] = acc[r];
                __syncthreads();
#pragma unroll
                for (int i = 0; i < 2; ++i) { const int idx = tid + 512 * i, t = idx >> 5, e = idx & 31; float sum = args.in[I_RB][e];
#pragma unroll
                    for (int w8 = 0; w8 < 8; ++w8) sum += RED[(w8 * 32 + t) * 32 + e];
                    LOG[t * 33 + e] = sum; }
                __syncthreads();
#pragma unroll
                for (int r4 = 0; r4 < 4; ++r4) {
                    const int m = m0 + r4; float tv[4]; int ti[4]; float cur = lane < 32 ? LOG[(wave * 4 + r4) * 33 + lane] : -3.0e38f;
#pragma unroll
                    for (int k = 0; k < 4; ++k) { float mx = cur;
#pragma unroll
                        for (int o = 1; o < 64; o <<= 1) mx = fmaxf(mx, __shfl_xor(mx, o));
                        const unsigned long long msk = __ballot(cur == mx && lane < 32); const int sel = __ffsll((long long)msk) - 1; tv[k] = mx; ti[k] = sel; if (lane == sel) cur = -3.0e38f; }
                    const float e1 = __expf(tv[1] - tv[0]), e2 = __expf(tv[2] - tv[0]), e3 = __expf(tv[3] - tv[0]); const float inv = 1.0f / (1.0f + e1 + e2 + e3);
                    if (lane < 4) { const int k = lane; const int ee = k == 0 ? ti[0] : k == 1 ? ti[1] : k == 2 ? ti[2] : ti[3]; const float gg = (k == 0 ? 1.0f : k == 1 ? e1 : k == 2 ? e2 : e3) * inv;
                        const int lp = __hip_atomic_fetch_add(&CNT[ee], 1, __ATOMIC_RELAXED, __HIP_MEMORY_SCOPE_WORKGROUP);
                        EIDX[m * 4 + k] = ee; GATE[m * 4 + k] = gg; LPOS[m * 4 + k] = lp; }
                }
            }
            __syncthreads();
            if (tid < 32) BCNT[blk * 32 + tid] = CNT[tid];
        }
    }
    SEAM(ST_M0); STAMP(9);
#define MOE_TABLES() do { \
        LAS int* TB = (LAS int*)lds;                   \
        LAS int* EB = (LAS int*)(lds + 32768);         \
        __syncthreads(); \
        for (int i = tid; i < NRANGE * WBR * 32; i += NTHR) TB[i] = BCNT[i]; \
        __syncthreads(); \
        if (tid < NRANGE * 32) { const int r = tid >> 5, e = tid & 31; int run = 0; _Pragma("unroll 4") for (int wb = 0; wb < WBR; ++wb) { const int c_ = TB[(r * WBR + wb) * 32 + e]; TB[(r * WBR + wb) * 32 + e] = run; run += c_; } EB[128 + tid] = run; } \
        __syncthreads(); \
        if (tid < NRANGE) { int run = 0; _Pragma("unroll 1") for (int e = 0; e < 32; ++e) { EB[tid * 32 + e] = run; run += (EB[128 + tid * 32 + e] + 255) & ~255; } EB[256 + tid] = run >> 8; } \
        __syncthreads(); \
        for (int i = tid; i < NRANGE * WBR * 32; i += NTHR) { const int r = i / (WBR * 32), e = i & 31; TB[i] += EB[r * 32 + e]; } \
        __syncthreads(); } while (0)
#define MOE_SCATTER(r) do { \
        LAS int* TB = (LAS int*)lds; LAS int* EB = (LAS int*)(lds + 32768); \
        for (int idx = bid * NTHR + tid; idx < RTOK * 4; idx += G * NTHR) { const int m = (r) * RTOK + (idx >> 2), k = idx & 3; const int wb = (idx >> 2) >> 8; \
            const int e = EIDX[m * 4 + k]; const int row = TB[((r) * WBR + wb) * 32 + e] + LPOS[m * 4 + k]; AROW[m * 4 + k] = row; HPS[row] = HLS[m]; ROWTOK[row] = m; } \
        for (int e = bid; e < 32; e += G) { const int tot = EB[128 + (r) * 32 + e], base = EB[(r) * 32 + e]; const int npad = ((tot + 255) & ~255) - tot; \
            for (int i = tid; i < npad; i += NTHR) { HPS[base + tot + i] = 0.f; ROWTOK[base + tot + i] = -1; } } } while (0)
    if (PH_EN(10) && IN(ST_M1)) for (int rep = 0; rep < DUP_N(10); ++rep) {
        const int tid = opaque_tid(), lane = tid & 63, wave = __builtin_amdgcn_readfirstlane(tid >> 6), gw = bid * NWAVES + wave; (void)lane; (void)gw; (void)rep;
        MOE_TABLES();
        if (bid == 0) {
            LAS int* TB = (LAS int*)lds; LAS int* EB = (LAS int*)(lds + 32768);
            for (int i = tid; i < NRANGE * WBR * 32; i += NTHR) BBASE[i] = TB[i];
            if (tid < NRANGE) NTILE[tid] = EB[256 + tid];
            for (int i = tid; i < NRANGE * 32; i += NTHR) { const int r = i >> 5, e = i & 31; const int base = EB[r * 32 + e], nt = (EB[128 + i] + 255) >> 8; for (int t = 0; t < nt; ++t) TILEE[r * TILE_LD + (base >> 8) + t] = e; }
        }
        MOE_SCATTER(0);
    }
    SEAM(ST_M1); STAMP(10);
    for (int r = 0; r < NRANGE; ++r) {
        const int s0 = ST_RNG + 3 * r;
        if (PH_EN(11) && IN(s0 + 0)) for (int rep = 0; rep < DUP_N(11); ++rep) {
        const int tid = opaque_tid(), lane = tid & 63, wave = __builtin_amdgcn_readfirstlane(tid >> 6), gw = bid * NWAVES + wave; (void)lane; (void)gw; (void)rep;
            pg8::Gemm g{HL, W1T, 512, 512, 512, HPS, W1S, ROWTOK}; pg8::MoeOrder S{TILEE + r * TILE_LD, NTILE[r], 8, G, bid}; EpiHid E{(unsigned char*)HID, args.in[I_B1]};
            STAGGER(STAG_M2); pg8::gemm_phase<EpiHid, pg8::MoeOrder, 1, true>(lds, g, S, E);
        }
        SEAM(s0 + 0); STAMP(11);
        if (PH_EN(12) && IN(s0 + 1)) for (int rep = 0; rep < DUP_N(12); ++rep) {
        const int tid = opaque_tid(), lane = tid & 63, wave = __builtin_amdgcn_readfirstlane(tid >> 6), gw = bid * NWAVES + wave; (void)lane; (void)gw; (void)rep;
            pg8::Gemm g{HID, W2T, 512, 512, 512, nullptr, W2S, nullptr}; pg8::MoeOrder S{TILEE + r * TILE_LD, NTILE[r], 4, G, bid}; EpiY E{(unsigned char*)YPAD, args.in[I_B2]};
            STAGGER(STAG_M3); pg8::gemm_phase<EpiY, pg8::MoeOrder, 2>(lds, g, S, E);
        }
        SEAM(s0 + 1); STAMP(12);
        if (PH_EN(13) && IN(s0 + 2)) for (int rep = 0; rep < DUP_N(13); ++rep) {
        const int tid = opaque_tid(), lane = tid & 63, wave = __builtin_amdgcn_readfirstlane(tid >> 6), gw = bid * NWAVES + wave; (void)lane; (void)gw; (void)rep;
            for (int mb = r * RTOK + gw * 16; mb < (r + 1) * RTOK; mb += NGW * 16) {
                const int arow_l = AROW[mb * 4 + lane]; const float gate_l = GATE[mb * 4 + lane];
                const int b = mb >> 13;
                f32x4 g2v[4], fgv[4];
#pragma unroll
                for (int j = 0; j < 4; ++j) { g2v[j] = *(const f32x4*)(mod + b * 6144 + 5120 + 4 * lane + 256 * j); fgv[j] = *(const f32x4*)(args.in[I_FG] + 4 * lane + 256 * j); }
                f32x4 xv[2][4]; unsigned yw[2][4][4];
                auto issue = [&](int i, f32x4 (&xx)[4], unsigned (&yy)[4][4]) { const int m = mb + i;
#pragma unroll
                    for (int j = 0; j < 4; ++j) xx[j] = __builtin_nontemporal_load((const f32x4*)(args.out + (size_t)m * D) + lane + 64 * j);
#pragma unroll
                    for (int k = 0; k < 4; ++k) { const int row = __shfl(arow_l, 4 * i + k); const unsigned* yp = (const unsigned*)((const unsigned char*)YPAD + (size_t)row * D) + lane;
#pragma unroll
                        for (int j = 0; j < 4; ++j) yy[k][j] = __builtin_nontemporal_load(yp + 64 * j); } };
                auto finish = [&](int i, const f32x4 (&xx)[4], const unsigned (&yy)[4][4]) { const int m = mb + i; f32x4 v[4]; float ss = 0.f;
#pragma unroll
                    for (int j = 0; j < 4; ++j) { f32x4 y = {0.f, 0.f, 0.f, 0.f};
#pragma unroll
                        for (int k = 0; k < 4; ++k) { const float gk = __shfl(gate_l, 4 * i + k); const int w = (int)yy[k][j]; const f32x2 lo = __builtin_amdgcn_cvt_pk_f32_fp8(w, false), hi = __builtin_amdgcn_cvt_pk_f32_fp8(w, true);
                            y.x += gk * lo.x; y.y += gk * lo.y; y.z += gk * hi.x; y.w += gk * hi.y; }
                        v[j] = xx[j] + g2v[j] * y; ss += (v[j].x * v[j].x + v[j].y * v[j].y) + (v[j].z * v[j].z + v[j].w * v[j].w); }
                    const float rstd = 1.0f / sqrtf(wave_sum(ss) * (1.0f / D) + EPS);
#pragma unroll
                    for (int j = 0; j < 4; ++j) ((f32x4*)((DRY(13) ? (float*)(ws + WS_DUMMY) + (size_t)((m - r * RTOK) & 16383) * D : args.out + (size_t)m * D)) + lane)[64 * j] = v[j] * rstd * fgv[j]; };
                issue(0, xv[0], yw[0]);
#pragma unroll 1
                for (int i = 0; i < 16; i += 2) {
                    issue(i + 1, xv[1], yw[1]);
                    finish(i, xv[0], yw[0]);
                    if (i + 2 < 16) issue(i + 2, xv[0], yw[0]);
                    finish(i + 1, xv[1], yw[1]);
                }
            }
            if (r + 1 < NRANGE) { MOE_TABLES(); MOE_SCATTER(r + 1); }
        }
        if (r + 1 < NRANGE) SEAM(s0 + 2);
        STAMP(13);
    }
#if MK_PROBE
    {
        unsigned* PR = (unsigned*)(ws + WS_CTL) + 8192;
        xcd_barrier(bar);
        if (bid == 0 && threadIdx.x == 0) { PR[0] = MISC[16 + PROBE_SEL1]; PR[1] = MISC[16 + PROBE_SEL2]; }
        xcd_barrier(bar);
        const float d1 = (float)__hip_atomic_load(PR, __ATOMIC_RELAXED, __HIP_MEMORY_SCOPE_AGENT) * 0.01f, d2 = (float)__hip_atomic_load(PR + 1, __ATOMIC_RELAXED, __HIP_MEMORY_SCOPE_AGENT) * 0.01f;
        const float sc = 1.0f + sqrtf(d1 * 1e-4f);
        for (size_t i = (size_t)bid * NTHR + threadIdx.x; i < (size_t)NTOK * D / 4; i += (size_t)G * NTHR) { f32x4 v = ((f32x4*)args.out)[i]; v *= sc; if (i == 0) v.x += d2 * 0.25f; ((f32x4*)args.out)[i] = v; }
    }
#endif
#undef IN
#undef SEAM
}

extern "C" void kernel_launch(void* const* d_in, const int* in_sizes, int n_in, void* d_out, int out_size, void* d_ws, size_t ws_size, hipStream_t stream) {
    static int grid = 0;
    if (grid == 0) {
        if (n_in != 26 || in_sizes[0] != NTOK * D || out_size != NTOK * D || ws_size < WS_END) { fprintf(stderr, "kernel_launch: unexpected shapes (n_in %d, in0 %d, out %d, ws %zu); nothing launched\n", n_in, n_in > 0 ? in_sizes[0] : -1, out_size, ws_size); grid = -1; return; }
        int dev = 0, cus = 0, per_cu = 0;
        if (hipGetDevice(&dev) != hipSuccess || hipDeviceGetAttribute(&cus, hipDeviceAttributeMultiprocessorCount, dev) != hipSuccess) { grid = -1; return; }
        if (hipFuncSetAttribute((const void*)fwd_kernel, hipFuncAttributeMaxDynamicSharedMemorySize, LDS_BYTES) != hipSuccess) { fprintf(stderr, "kernel_launch: hipFuncSetAttribute failed\n"); grid = -1; return; }
        if (hipOccupancyMaxActiveBlocksPerMultiprocessor(&per_cu, (const void*)fwd_kernel, NTHR, LDS_BYTES) != hipSuccess || per_cu < 1) fprintf(stderr, "kernel_launch: occupancy query reports %d\n", per_cu);
        (void)hipGetLastError();
        grid = cus;
    }
    if (grid < 0) return;
    if (hipMemsetAsync((char*)d_ws + WS_CTL, 0, CTL_ZERO_BYTES, stream) != hipSuccess) return;
    Args a{};
    for (int i = 0; i < 26; ++i) a.in[i] = (const float*)d_in[i];
    a.out = (float*)d_out; a.ws = (unsigned char*)d_ws;
#if MK_PER_PHASE
    for (int s = 0; s < ST_END; ++s) { a.lo = s; a.hi = s + 1; hipLaunchKernelGGL(fwd_kernel, dim3(grid), dim3(NTHR), LDS_BYTES, stream, a); }
#else
    a.lo = 0; a.hi = ST_END;
    hipLaunchKernelGGL(fwd_kernel, dim3(grid), dim3(NTHR), LDS_BYTES, stream, a);
#endif
    const hipError_t le = hipPeekAtLastError();
    if (le != hipSuccess) fprintf(stderr, "kernel_launch: launch failed: %s\n", hipGetErrorName(le));
}
```

```cpp
#include <hip/hip_runtime.h>
#include <type_traits>
#include <cstdio>
#include <cstdint>

#ifndef MK_PER_PHASE
#define MK_PER_PHASE 0
#endif

#ifndef MK_PROBE
#define MK_PROBE 0
#endif
#ifndef PROBE_SEL1
#define PROBE_SEL1 3
#endif
#ifndef PROBE_SEL2
#define PROBE_SEL2 4
#endif
#ifndef MK_DUP
#define MK_DUP 0u
#endif
#define DUP_N(k) ((((MK_DUP) >> (k)) & 1u) ? 2 : 1)
#define DRY(k) ((((MK_DUP) >> (k)) & 1u) && rep == 0)
#ifndef MK_DRYMODE
#define MK_DRYMODE 0
#endif
#ifndef STAG_B
#define STAG_B 0
#endif
#ifndef STAG_M2
#define STAG_M2 0
#endif
#ifndef STAG_M3
#define STAG_M3 0
#endif
#define STAGGER(n) do { const int slot_ = (bid >> 3) & 3; for (int i_ = 0; i_ < slot_ * (n); ++i_) __builtin_amdgcn_s_sleep(127); } while (0)
#ifndef MK_PHASES
#define MK_PHASES 0xFFFFu
#endif
#define PH_EN(k) (((MK_PHASES) >> (k)) & 1u)
#define LAS __attribute__((address_space(3)))
#define GAS __attribute__((address_space(1)))
typedef unsigned short bf16;
typedef short bf16x8 __attribute__((ext_vector_type(8)));
typedef short s16x4 __attribute__((ext_vector_type(4)));
typedef float f32x2 __attribute__((ext_vector_type(2)));
typedef float f32x4 __attribute__((ext_vector_type(4)));
typedef float f32x16 __attribute__((ext_vector_type(16)));
typedef unsigned u32x2 __attribute__((ext_vector_type(2)));
typedef unsigned u32x4 __attribute__((ext_vector_type(4)));

constexpr int D = 1024, NB = 8, SEQ = 8192, NTOK = NB * SEQ, CTXL = 256, NCTX = NB * CTXL, DIN = 10240, ZLD = 10240 + 128;
constexpr int NROWS_HL = NTOK + NCTX;
constexpr int GB = 2, NGRP = NB / GB, GROWS = GB * SEQ;
constexpr int NEXP = 32, TOPK = 4, DEXP = 1024;
constexpr int NRANGE = 1, RTOK = NTOK / NRANGE, WBR = RTOK / 256;
constexpr int RROWS = 4 * RTOK + 32 * 256, RTILES = RROWS / 256, TILE_LD = RTILES + 32;
constexpr float EPS = 1e-6f;
constexpr float K_SCALE = 0.08838834764831845f;
constexpr int C_XR = 0, C_GR = 1024, C_Q = 2048, C_K = 3072, C_V = 4096, C_GS = 6144, C_GA = 8192, C_GB = 9216;
constexpr int ZC_LD = 4096, ZC_XR = 0, ZC_K = 1024, ZC_V = 2048;

constexpr size_t MiB = 1u << 20;
constexpr size_t WS_CTL = 0, CTL_ZERO_BYTES = 1 * MiB;
constexpr size_t WS_MOD = 1 * MiB;
constexpr size_t WS_ROPE = 1 * MiB + 256 * 1024;
constexpr size_t WS_RWB = 1 * MiB + 512 * 1024;
constexpr size_t WS_CARRY = 2 * MiB;
constexpr size_t WS_HLS = 7 * MiB;
constexpr size_t WS_WINS = 7 * MiB + 320 * 1024;
constexpr size_t WS_W1S = 7 * MiB + 384 * 1024;
constexpr size_t WS_HPS = 880 * MiB;
constexpr size_t WS_WFS = 7 * MiB + 640 * 1024;
constexpr size_t WS_EIDX = 8 * MiB, WS_GATE = 9 * MiB, WS_LPOS = 10 * MiB, WS_AROW = 11 * MiB;
constexpr size_t WS_BCNT = 12 * MiB;
constexpr size_t WS_BBASE = 12 * MiB + 64 * 1024;
constexpr size_t WS_TILEE = 12 * MiB + 128 * 1024;
constexpr size_t WS_NTILE = 12 * MiB + 192 * 1024;
constexpr size_t WS_WG = 14 * MiB;
constexpr size_t WS_WRNN = 16 * MiB, WS_WOUT = 22 * MiB, WS_WIN = 24 * MiB;
constexpr size_t WS_HL = 44 * MiB;
constexpr size_t WS_ZC = 176 * MiB;
constexpr size_t WS_CTXU = 192 * MiB;
constexpr size_t WS_Z = 208 * MiB;
constexpr size_t WS_ST = 536 * MiB;
constexpr size_t WS_T1 = 664 * MiB, WS_MG = 696 * MiB;
constexpr size_t WS_W1T = 736 * MiB;
constexpr size_t WS_W2T = 848 * MiB;
constexpr size_t WS_HPAD = 208 * MiB, WS_HID = 210 * MiB, WS_YPAD = 474 * MiB;
constexpr size_t WS_AR = 912 * MiB, WS_AT = 944 * MiB;
constexpr size_t WS_DUMMY = 912 * MiB;
constexpr size_t WS_END = 1024 * MiB;
constexpr int CW_BAR = 4096;

constexpr int LDS_BYTES = 149504;
constexpr int MISC_OFF = LDS_BYTES - 256;
constexpr int NWAVES = 8, NTHR = 512;

__device__ __forceinline__ unsigned f2bf(float f) { unsigned u = __builtin_bit_cast(unsigned, f); return (u + 0x7fffu + ((u >> 16) & 1u)) >> 16; }
typedef __bf16 hwbf16x2 __attribute__((ext_vector_type(2)));
__device__ __forceinline__ unsigned pk2(float lo, float hi) { const f32x2 v = {lo, hi}; return __builtin_bit_cast(unsigned, __builtin_convertvector(v, hwbf16x2)); }
__device__ __forceinline__ float bflo(unsigned w) { return __builtin_bit_cast(float, w << 16); }
__device__ __forceinline__ float bfhi(unsigned w) { return __builtin_bit_cast(float, w & 0xffff0000u); }
__device__ __forceinline__ float bf2f(unsigned short h) { return __builtin_bit_cast(float, ((unsigned)h) << 16); }
__device__ __forceinline__ float sigmoidf_(float x) { return __builtin_amdgcn_rcpf(1.0f + __expf(-x)); }
__device__ __forceinline__ float wave_sum(float v) {
#pragma unroll
    for (int o = 1; o < 64; o <<= 1) v += __shfl_xor(v, o);
    return v;
}
template <int CTRL> __device__ __forceinline__ float dpp_f(float v) { return __builtin_bit_cast(float, __builtin_amdgcn_update_dpp(0, __builtin_bit_cast(int, v), CTRL, 0xF, 0xF, true)); }
__device__ __forceinline__ float row16_sum(float v) { v += dpp_f<0xB1>(v); v += dpp_f<0x4E>(v); v += dpp_f<0x141>(v); v += dpp_f<0x140>(v); return v; }
__device__ __forceinline__ float wave_max(float v) {
#pragma unroll
    for (int o = 1; o < 64; o <<= 1) v = fmaxf(v, __shfl_xor(v, o));
    return v;
}
__device__ __forceinline__ unsigned q8x4(f32x4 v, float inv) {
    const int a = (int)rintf(v.x * inv), b = (int)rintf(v.y * inv), c = (int)rintf(v.z * inv), d = (int)rintf(v.w * inv);
    return ((unsigned)a & 0xffu) | (((unsigned)b & 0xffu) << 8) | (((unsigned)c & 0xffu) << 16) | (((unsigned)d & 0xffu) << 24);
}
#define LDS_WAIT() asm volatile("s_waitcnt lgkmcnt(0)" ::: "memory")
__device__ __forceinline__ int opaque_tid() { int t = threadIdx.x; asm volatile("" : "+v"(t)); return t; }
template <class T> __device__ __forceinline__ T* opaque_ptr(T* p) { unsigned long long u = (unsigned long long)p; asm volatile("" : "+s"(u)); return (T*)u; }

namespace pg8 {
constexpr int BM = 256, BK = 64, HALF = 128, HTB = HALF * BK * 2, STAGE_BYTES = 8 * HTB, NXCD = 8, WGM = 8;
__host__ __device__ __forceinline__ int lds_byte(int r, int c) { const int st = (r >> 4) * 2 + (c >> 5), rr = r & 15, cc = c & 31, ob = rr * 64 + cc * 2; return st * 1024 + (ob ^ (((ob >> 9) & 1) << 5)); }
__host__ __device__ __forceinline__ void stage_rc(int b, int& R, int& C) { const int st = b / 1024, sb = b % 1024, swz = sb ^ (((sb >> 9) & 1) << 5); R = (st >> 1) * 16 + swz / 64; C = (st & 1) * 32 + (swz % 64) / 2; }
__host__ __device__ __forceinline__ int perm32(int rho) { const int n = rho >> 4, i = rho & 15; return 8 * (i >> 2) + 4 * n + (i & 3); }
struct Unit { int pm, pn; int koff = 0, nt = 0; };
struct Gemm { const bf16* A; const bf16* Bt; int lda, ldb, K; const float* SA; const float* SB; const int* RT; };
struct StaticOrder {
    int nM, nN, nwg, G, c;
    __device__ void init(int nM_, int nN_, int G_, int c_) { nM = nM_; nN = nN_; nwg = nM * nN; G = G_; c = c_; }
    __device__ bool next(int i, Unit& u) const {
        const long L = (long)i * G + c; if (L >= nwg) return false;
        int wgid = (int)L; { const int q = nwg / NXCD, r = nwg % NXCD, xcd = wgid % NXCD, off = wgid / NXCD; wgid = (xcd < r ? xcd * (q + 1) : r * (q + 1) + (xcd - r) * q) + off; }
        const int nig = WGM * nN, gid = wgid / nig, fm = gid * WGM, gsz = (nM - fm) < WGM ? (nM - fm) : WGM;
        u.pm = fm + ((wgid % nig) % gsz); u.pn = (wgid % nig) / gsz; return true;
    }
};
struct CtxOrder {
    int G, c;
    __device__ bool next(int i, Unit& u) const { const int L = i * G + c; if (L >= 128) return false; const int j = L >> 3; u.pm = 256 + (L & 7); u.pn = j < 4 ? j : j + 8; return true; }
};
struct FOrder {
    StaticOrder so;
    __device__ bool next(int i, Unit& u) const { Unit t; if (!so.next(i >> 1, t)) return false; u.pm = t.pm; u.pn = t.pn; u.koff = (i & 1) ? 1024 : 0; u.nt = (i & 1) ? 32 : 16; return true; }
};
struct MoeOrder {
    const int* tile_e; int ntiles, npn, G, c;
    __device__ bool next_pm(int i, Unit& u) const {
        if ((G & 7) == 0 && ((G >> 3) % npn) == 0) { const int x = c & 7, y = c >> 3, T = (G >> 3) / npn; const int ti = (i * 8 + x) * T + y / npn, pl = y % npn;
            if (ti >= ntiles) return false; u.pm = ti; u.pn = pl; return true; }
        const long L = (long)i * G + c; if (L >= (long)ntiles * npn) return false; const int ti = (int)(L / npn), pl = (int)(L % npn);
        u.pm = ti; u.pn = pl; return true; }
    __device__ int expert(const Unit& u) const { return tile_e[u.pm]; }
    __device__ bool next(int i, Unit& u) const { if (!next_pm(i, u)) return false; u.pn += expert(u) * npn; return true; }
};

typedef int i32x4 __attribute__((ext_vector_type(4)));
typedef int i32x8 __attribute__((ext_vector_type(8)));
template <int MODE> struct Frag { bf16x8 v[2]; };
template <> struct Frag<2> { i32x8 w; };
template <class Epi, class Sched, int MODE = 0, bool GATHER = false>
__device__ __forceinline__ void gemm_phase(LAS unsigned char* lds, const Gemm g, const Sched& S, const Epi& E) {
    const int tid = opaque_tid(), wid = __builtin_amdgcn_readfirstlane(tid >> 6), lane = tid & 63, wr = wid >> 2, wc = wid & 3, fr = lane & 15, fq = lane >> 4;
    const int K = g.K, nt = K / BK;
    const bf16* gA = opaque_ptr(g.A); const bf16* gBt = opaque_ptr(g.Bt);
    unsigned voffA[2], voffB[2]; int RA[2]; unsigned CA[2];
#pragma unroll
    for (int i = 0; i < 2; ++i) { int R, C; stage_rc(tid * 16 + i * 8192, R, C); const int Rb = 64 * (R >> 5) + (Epi::PERM ? perm32(R & 31) : (R & 31));
        voffA[i] = (unsigned)(R * g.lda + C) * 2u; voffB[i] = (unsigned)(Rb * g.ldb + C) * 2u; RA[i] = R; CA[i] = (unsigned)C * 2u; }
    (void)RA; (void)CA;
    const size_t kstep = (size_t)(BK * 2);
    const size_t hstepA = GATHER ? (size_t)0 : (size_t)HALF * g.lda * 2, hstepB = (size_t)32 * g.ldb * 2;
    unsigned vC[2][2], vN[2][2];
    auto gather_offs = [&](int pm, unsigned (&v)[2][2]) {
        int t00 = g.RT[pm * 256 + RA[0]], t01 = g.RT[pm * 256 + RA[1]], t10 = g.RT[pm * 256 + 128 + RA[0]], t11 = g.RT[pm * 256 + 128 + RA[1]];
        asm volatile("" : "+v"(t00), "+v"(t01), "+v"(t10), "+v"(t11));
        t00 = t00 < 0 ? 0 : t00; t01 = t01 < 0 ? 0 : t01; t10 = t10 < 0 ? 0 : t10; t11 = t11 < 0 ? 0 : t11;
        v[0][0] = (unsigned)t00 * (unsigned)(g.lda * 2) + CA[0]; v[0][1] = (unsigned)t01 * (unsigned)(g.lda * 2) + CA[1];
        v[1][0] = (unsigned)t10 * (unsigned)(g.lda * 2) + CA[0]; v[1][1] = (unsigned)t11 * (unsigned)(g.lda * 2) + CA[1]; };
    const size_t tstepA = (size_t)BM * g.lda * 2, tstepB = (size_t)BM * g.ldb * 2;
    const unsigned ldsw = (unsigned)wid * 1024u;
    const int aoff = lds_byte(wr * 64 + fr, fq * 8), boff = lds_byte(wc * 32 + fr, fq * 8);
#define PG8_SA(b, h) (((b) * 2 + (h)) * HTB)
#define PG8_SB(b, h) ((4 + (b) * 2 + (h)) * HTB)
#define PG8_STAGE(bufoff, gbase, voff) do { _Pragma("unroll") for (int _i = 0; _i < 2; ++_i) \
        __builtin_amdgcn_global_load_lds((const unsigned*)((const char*)(gbase) + (voff)[_i]), (LAS unsigned*)(lds + (bufoff) + ldsw + _i * 8192), 16, 0, 0); } while (0)
#define PG8_STAGE_A(bufoff, gbase, hh, nx) do { if constexpr (GATHER) { _Pragma("unroll") for (int _i = 0; _i < 2; ++_i) { const unsigned _o = (nx) ? vN[hh][_i] : vC[hh][_i]; \
        __builtin_amdgcn_global_load_lds((const unsigned*)((const char*)(gbase) + _o), (LAS unsigned*)(lds + (bufoff) + ldsw + _i * 8192), 16, 0, 0); } } else PG8_STAGE(bufoff, gbase, voffA); } while (0)
#define PG8_LD1(dst, p) do { if constexpr (MODE == 2) (dst).w = __builtin_shufflevector(*(const LAS i32x4*)(p), *(const LAS i32x4*)((p) + 1024), 0, 1, 2, 3, 4, 5, 6, 7); \
        else { (dst).v[0] = *(const LAS bf16x8*)(p); (dst).v[1] = *(const LAS bf16x8*)((p) + 1024); } } while (0)
#define PG8_LDA(dst, b, h) do { _Pragma("unroll") for (int m = 0; m < 4; ++m) PG8_LD1(dst[m], lds + PG8_SA(b, h) + aoff + m * 2048); } while (0)
#define PG8_LDB(dst, b, h) do { _Pragma("unroll") for (int n = 0; n < 2; ++n) PG8_LD1(dst[n], lds + PG8_SB(b, h) + boff + n * 2048); } while (0)
#define PG8_MMA(ai, bj, At, Bt) do { __builtin_amdgcn_s_setprio(1); _Pragma("unroll") for (int m = 0; m < 4; ++m) _Pragma("unroll") for (int n = 0; n < 2; ++n) { \
        if constexpr (MODE == 2) {   \
              \
            asm volatile("v_mfma_scale_f32_16x16x128_f8f6f4 %0, %1, %2, %0, %3, %3 op_sel_hi:[0,0,0]" : "+v"(acc[ai][bj][m][n]) : "v"(Bt[n].w), "v"(At[m].w), "v"(sc1)); \
        } else { _Pragma("unroll") for (int k = 0; k < 2; ++k) \
        { if constexpr (MODE == 1) acc[ai][bj][m][n] = __builtin_bit_cast(f32x4, __builtin_amdgcn_mfma_i32_16x16x64_i8(__builtin_bit_cast(i32x4, Bt[n].v[k]), __builtin_bit_cast(i32x4, At[m].v[k]), __builtin_bit_cast(i32x4, acc[ai][bj][m][n]), 0, 0, 0)); \
          else acc[ai][bj][m][n] = __builtin_amdgcn_mfma_f32_16x16x32_bf16(Bt[n].v[k], At[m].v[k], acc[ai][bj][m][n], 0, 0, 0); } } } __builtin_amdgcn_s_setprio(0); } while (0)
#define PG8_WAIT_V(n) asm volatile("s_waitcnt vmcnt(" #n ")" ::: "memory")
#define PG8_WAIT_VN(n) asm volatile("s_waitcnt vmcnt(%0)" :: "n"(n) : "memory")
#define PG8_WAIT_L(n) asm volatile("s_waitcnt lgkmcnt(" #n ")" ::: "memory")
#define PG8_BAR __builtin_amdgcn_s_barrier()
#define PG8_SCHED __builtin_amdgcn_sched_barrier(0)
    Unit cur, nxt; int ui = 0;
    if (!S.next(0, cur)) return;
    constexpr int FIRST_NST = (MK_DRYMODE != 0 || MK_DUP != 0u) ? 0 : Epi::NST;
    constexpr int SC_OFF = 8 * HTB;
    auto stage_scales = [&](const Unit& u, int par) {
        if constexpr (MODE != 0) { if (MODE == 1 || wid >= 4) { const float* sp = wid < 4 ? g.SA + u.pm * 256 + tid : g.SB + u.pn * 256 + (tid - 256);
            __builtin_amdgcn_global_load_lds((const unsigned*)sp, (LAS unsigned*)(lds + SC_OFF + par * 2048 + wid * 256), 4, 0, 0); } } };
    stage_scales(cur, 0);
    f32x4 acc[2][2][4][2];
#pragma unroll
    for (int a = 0; a < 2; ++a)
#pragma unroll
        for (int b = 0; b < 2; ++b)
#pragma unroll
            for (int m = 0; m < 4; ++m)
#pragma unroll
                for (int n = 0; n < 2; ++n) acc[a][b][m][n] = (f32x4){0.f, 0.f, 0.f, 0.f};
    Frag<MODE> At[4], B0[2], B1[2]; const int sc1 = 0x7f7f7f7f; (void)sc1;
    const char* cA = GATHER ? (const char*)gA : (const char*)gA + (size_t)cur.pm * tstepA + (size_t)cur.koff * 2; const char* cB = (const char*)gBt + (size_t)cur.pn * tstepB + (size_t)cur.koff * 2;
    if constexpr (GATHER) gather_offs(cur.pm, vC);
    PG8_STAGE(PG8_SB(0, 0), cB, voffB); PG8_STAGE(PG8_SB(0, 1), cB + hstepB, voffB); PG8_STAGE_A(PG8_SA(0, 0), cA, 0, false); PG8_STAGE_A(PG8_SA(0, 1), cA + hstepA, 1, false);
    if (wr == 1) PG8_BAR;
    PG8_WAIT_V(2); PG8_BAR;
    PG8_STAGE(PG8_SB(1, 0), cB + kstep, voffB); PG8_STAGE_A(PG8_SA(1, 0), cA + kstep, 0, false); PG8_STAGE(PG8_SB(1, 1), cB + hstepB + kstep, voffB);
    PG8_WAIT_V(6); PG8_BAR;
    for (;;) {
        bool has_next;
        if constexpr (GATHER) {
            has_next = S.next_pm(ui + 1, nxt);
            if (has_next) { int t00 = g.RT[nxt.pm * 256 + RA[0]], t01 = g.RT[nxt.pm * 256 + RA[1]], t10 = g.RT[nxt.pm * 256 + 128 + RA[0]], t11 = g.RT[nxt.pm * 256 + 128 + RA[1]]; int ex = S.expert(nxt);
                asm volatile("" : "+v"(t00), "+v"(t01), "+v"(t10), "+v"(t11), "+v"(ex));
                nxt.pn += __builtin_amdgcn_readfirstlane(ex) * S.npn;
                t00 = t00 < 0 ? 0 : t00; t01 = t01 < 0 ? 0 : t01; t10 = t10 < 0 ? 0 : t10; t11 = t11 < 0 ? 0 : t11;
                vN[0][0] = (unsigned)t00 * (unsigned)(g.lda * 2) + CA[0]; vN[0][1] = (unsigned)t01 * (unsigned)(g.lda * 2) + CA[1];
                vN[1][0] = (unsigned)t10 * (unsigned)(g.lda * 2) + CA[0]; vN[1][1] = (unsigned)t11 * (unsigned)(g.lda * 2) + CA[1]; }
            else {
#pragma unroll
                for (int hh = 0; hh < 2; ++hh)
#pragma unroll
                    for (int i = 0; i < 2; ++i) vN[hh][i] = vC[hh][i]; }
        } else has_next = S.next(ui + 1, nxt);
        const char* nA = (has_next && !GATHER) ? (const char*)gA + (size_t)nxt.pm * tstepA + (size_t)nxt.koff * 2 : cA; const char* nB = has_next ? (const char*)gBt + (size_t)nxt.pn * tstepB + (size_t)nxt.koff * 2 : cB;
        const int ntc = cur.nt ? cur.nt : nt;
#pragma unroll 1
        for (int t = 0; t < ntc; t += 2) {
            const bool last = (t == ntc - 2);
            const char* a1 = cA + (size_t)(t + 1) * kstep;
            const char* a2 = last ? nA : cA + (size_t)(t + 2) * kstep; const char* b2 = last ? nB : cB + (size_t)(t + 2) * kstep;
            const char* a3 = a2 + kstep; const char* b3 = b2 + kstep;
            PG8_LDB(B0, 0, 0); PG8_LDB(B1, 0, 1); PG8_SCHED; PG8_LDA(At, 0, 0); PG8_STAGE_A(PG8_SA(1, 1), a1 + hstepA, 1, false);
            if (t == 0 && ui > 0) PG8_WAIT_VN(8 + FIRST_NST); else PG8_WAIT_V(8);
            PG8_WAIT_L(0); PG8_BAR; PG8_MMA(0, 0, At, B0); PG8_MMA(0, 1, At, B1); PG8_SCHED; PG8_BAR; PG8_SCHED;
            PG8_LDA(At, 0, 1); PG8_STAGE(PG8_SB(0, 0), b2, voffB); PG8_STAGE(PG8_SB(0, 1), b2 + hstepB, voffB); PG8_STAGE_A(PG8_SA(0, 0), a2, 0, last);
            if (t == 0 && ui > 0) PG8_WAIT_VN(8 + FIRST_NST); else PG8_WAIT_V(8);
            PG8_WAIT_L(0); PG8_BAR; PG8_MMA(1, 0, At, B0); PG8_MMA(1, 1, At, B1); PG8_SCHED; PG8_BAR; PG8_SCHED;
            PG8_LDB(B0, 1, 0); PG8_LDB(B1, 1, 1); PG8_SCHED; PG8_LDA(At, 1, 0); PG8_STAGE_A(PG8_SA(0, 1), a2 + hstepA, 1, last);
            PG8_WAIT_V(8); PG8_WAIT_L(0); PG8_BAR; PG8_MMA(0, 0, At, B0); PG8_MMA(0, 1, At, B1); PG8_SCHED; PG8_BAR; PG8_SCHED;
            PG8_LDA(At, 1, 1); PG8_STAGE(PG8_SB(1, 0), b3, voffB); PG8_STAGE(PG8_SB(1, 1), b3 + hstepB, voffB); PG8_STAGE_A(PG8_SA(1, 0), a3, 0, last);
            PG8_WAIT_V(8); PG8_WAIT_L(0); PG8_BAR; PG8_MMA(1, 0, At, B0); PG8_MMA(1, 1, At, B1); PG8_SCHED; PG8_BAR; PG8_SCHED;
        }
        if (wr == 0) PG8_BAR;
        if constexpr (MODE == 2) {
            int fq_ = fq; asm volatile("" : "+v"(fq_));
            const LAS float* sb = (const LAS float*)(lds + SC_OFF + (ui & 1) * 2048) + 256 + wc * 64 + (Epi::PERM ? 8 : 4) * fq_;
            f32x4 cs[2][2];
#pragma unroll
            for (int b = 0; b < 2; ++b)
#pragma unroll
                for (int n = 0; n < 2; ++n) cs[b][n] = *(const LAS f32x4*)(sb + b * 32 + (Epi::PERM ? 4 : 16) * n);
#pragma unroll
            for (int a = 0; a < 2; ++a)
#pragma unroll
                for (int b = 0; b < 2; ++b)
#pragma unroll
                    for (int m = 0; m < 4; ++m)
#pragma unroll
                        for (int n = 0; n < 2; ++n) acc[a][b][m][n] *= cs[b][n];
        }
        if constexpr (MODE == 1) {
            static_assert(Epi::PERM, "int8 path is written for the PERM layout");
            int fr_ = fr, fq_ = fq; asm volatile("" : "+v"(fr_), "+v"(fq_));
            const LAS float* sa = (const LAS float*)(lds + SC_OFF + (ui & 1) * 2048) + wr * 64 + fr_; const LAS float* sb = (const LAS float*)(lds + SC_OFF + (ui & 1) * 2048) + 256 + wc * 64 + 8 * fq_;
            float rs[2][4]; f32x4 cs[2][2];
#pragma unroll
            for (int a = 0; a < 2; ++a)
#pragma unroll
                for (int m = 0; m < 4; ++m) rs[a][m] = sa[a * 128 + m * 16];
#pragma unroll
            for (int b = 0; b < 2; ++b)
#pragma unroll
                for (int n = 0; n < 2; ++n) cs[b][n] = *(const LAS f32x4*)(sb + b * 32 + 4 * n);
#pragma unroll
            for (int a = 0; a < 2; ++a)
#pragma unroll
                for (int b = 0; b < 2; ++b)
#pragma unroll
                    for (int m = 0; m < 4; ++m)
#pragma unroll
                        for (int n = 0; n < 2; ++n) { const i32x4 iv = __builtin_bit_cast(i32x4, acc[a][b][m][n]); acc[a][b][m][n] = __builtin_convertvector(iv, f32x4) * cs[b][n] * rs[a][m]; }
        }
        bool keep = false;
        { int fr_ = fr, fq_ = fq; asm volatile("" : "+v"(fr_), "+v"(fq_));
          if constexpr (Epi::MID) { if (E.is_mid(cur)) { E.mid(acc, cur, wr, wc, fr_, fq_); keep = true; } else E(acc, cur, wr, wc, fr_, fq_); } else E(acc, cur, wr, wc, fr_, fq_); }
        if (!has_next) break;
        if (!keep) {
#pragma unroll
        for (int a = 0; a < 2; ++a)
#pragma unroll
            for (int b = 0; b < 2; ++b)
#pragma unroll
                for (int m = 0; m < 4; ++m)
#pragma unroll
                    for (int n = 0; n < 2; ++n) acc[a][b][m][n] = (f32x4){0.f, 0.f, 0.f, 0.f}; }
        cur = nxt; cA = nA; cB = nB; ++ui;
        stage_scales(cur, ui & 1);
        if constexpr (GATHER) {
#pragma unroll
            for (int hh = 0; hh < 2; ++hh)
#pragma unroll
                for (int i = 0; i < 2; ++i) vC[hh][i] = vN[hh][i]; }
        if (wr == 1) PG8_BAR;
    }
    PG8_WAIT_V(0);
    PG8_BAR;
#undef PG8_SA
#undef PG8_SB
#undef PG8_STAGE
#undef PG8_STAGE_A
#undef PG8_LDA
#undef PG8_LD1
#undef PG8_LDB
#undef PG8_MMA
#undef PG8_WAIT_V
#undef PG8_WAIT_VN
#undef PG8_WAIT_L
#undef PG8_BAR
#undef PG8_SCHED
}
}
using pg8::Unit;

template <class F>
__device__ __forceinline__ void epi_perm_loop(const f32x4 (&acc)[2][2][4][2], int wr, int wc, int fr, int fq, F&& f) {
#pragma unroll
    for (int ai = 0; ai < 2; ++ai)
#pragma unroll
        for (int m = 0; m < 4; ++m) { const int rt = ai * 128 + wr * 64 + m * 16 + fr;
#pragma unroll
            for (int bj = 0; bj < 2; ++bj) { const int ct = wc * 64 + bj * 32 + 8 * fq; f(rt, ct, acc[ai][bj][m][0], acc[ai][bj][m][1]); }
            asm volatile("" ::: "memory"); }
}
__device__ __forceinline__ unsigned pk4_fp8(float a, float b, float c, float d) { int w = 0; w = __builtin_amdgcn_cvt_pk_fp8_f32(a, b, w, false); w = __builtin_amdgcn_cvt_pk_fp8_f32(c, d, w, true); return (unsigned)w; }
__device__ __forceinline__ u32x4 xp16(u32x4 w, int src) { u32x4 r; r.x = __shfl(w.x, src); r.y = __shfl(w.y, src); r.z = __shfl(w.z, src); r.w = __shfl(w.w, src); return r; }
__device__ __forceinline__ u32x2 xp8(u32x2 w, int src) { u32x2 r; r.x = __shfl(w.x, src); r.y = __shfl(w.y, src); return r; }
template <class DT, class LD, class F>
__device__ __forceinline__ void epi_perm_pipe(const f32x4 (&acc)[2][2][4][2], int wr, int wc, int fr, int fq, LD&& ld, F&& f) {
    DT cur = ld(wr * 64 + fr, wc * 64 + 8 * fq);
#pragma unroll
    for (int it = 0; it < 16; ++it) { const int ai = it >> 3, m = (it >> 1) & 3, bj = it & 1; const int rt = ai * 128 + wr * 64 + m * 16 + fr, ct = wc * 64 + bj * 32 + 8 * fq;
        DT nxt = cur;
        if (it + 1 < 16) { const int i2 = it + 1, a2 = i2 >> 3, m2 = (i2 >> 1) & 3, b2 = i2 & 1; nxt = ld(a2 * 128 + wr * 64 + m2 * 16 + fr, wc * 64 + b2 * 32 + 8 * fq); }
        asm volatile("" ::: "memory");
        f(rt, ct, acc[ai][bj][m][0], acc[ai][bj][m][1], cur);
        cur = nxt; }
}
__device__ __forceinline__ u32x4 pack8(f32x4 v0, f32x4 v1) { u32x4 w; w.x = pk2(v0[0], v0[1]); w.y = pk2(v0[2], v0[3]); w.z = pk2(v1[0], v1[1]); w.w = pk2(v1[2], v1[3]); return w; }
__device__ __forceinline__ float gelu_tanh(float x) { const float u = 1.5957691216057308f * (x + 0.044715f * x * x * x); return x * sigmoidf_(u); }
__device__ __forceinline__ void unpack8(u32x4 w, float (&f)[8]) { f[0] = bflo(w.x); f[1] = bfhi(w.x); f[2] = bflo(w.y); f[3] = bfhi(w.y); f[4] = bflo(w.z); f[5] = bfhi(w.z); f[6] = bflo(w.w); f[7] = bfhi(w.w); }

struct EpiCtx {
    static constexpr bool PERM = true; static constexpr bool MID = false; static constexpr int NST = 16;
    bf16* ZC;
    __device__ __forceinline__ void operator()(const f32x4 (&acc)[2][2][4][2], const Unit& u, int wr, int wc, int fr, int fq) const {
        const int pn = u.pn; const int ctile = pn < 4 ? pn : pn - 8;
        const float sc = (pn >= 12 && pn < 16) ? K_SCALE : 1.0f;
        char* zc = (char*)(ZC + (size_t)(u.pm - 256) * 256 * ZC_LD + ctile * 256); int ldz = ZC_LD; asm volatile("" : "+s"(ldz));
        const int ln = fq * 16 + fr, xs = (ln & 3) * 16 + (ln >> 2), dr = (ln >> 2) - fr, dc = 8 * ((ln & 3) - fq);
        epi_perm_loop(acc, wr, wc, fr, fq, [&](int rt, int ct, f32x4 v0, f32x4 v1) { v0 *= sc; v1 *= sc; *(u32x4*)(zc + (unsigned)(((rt + dr) * ldz + ct + dc) * 2)) = xp16(pack8(v0, v1), xs); });
    }
};
struct EpiIn {
    static constexpr bool PERM = true; static constexpr bool MID = false; static constexpr int NST = 16;
    bf16* Z; const f32x2* rope; int dry;
    template <bool ROPE>
    __device__ __forceinline__ void run(const f32x4 (&acc)[2][2][4][2], const Unit& u, int wr, int wc, int fr, int fq, float sc) const {
        const int pn = u.pn; const int row0 = u.pm * 256, col0 = pn * 256; const f32x2* rp_ = rope;
        char* zt = (char*)(Z + (size_t)row0 * ZLD + col0); int ldz = ZLD; asm volatile("" : "+s"(ldz));
        const int ln = fq * 16 + fr;
        f32x4 cq[2][2], nq[2][2];
        auto ldrope = [&](int g, f32x4 (&q)[2][2]) { const int ai = g >> 2, m = g & 3; const int rt = ai * 128 + wr * 64 + m * 16 + fr; const int t = (row0 + rt) & (SEQ - 1);
#pragma unroll
            for (int bj = 0; bj < 2; ++bj) { const int ct = wc * 64 + bj * 32 + 8 * fq; const int e0 = (col0 + ct) & 127; const int p0 = e0 >> 1;
                const int pos = p0 < 32 ? (t >> 6) : (t & 63); const int f0 = p0 & 31; const f32x4* rp = (const f32x4*)(rp_ + pos * 32 + f0);
                q[bj][0] = rp[0]; q[bj][1] = rp[1]; } };
        if constexpr (ROPE) ldrope(0, cq);
#pragma unroll
        for (int g = 0; g < 8; ++g) { const int ai = g >> 2, m = g & 3; const int rt = ai * 128 + wr * 64 + m * 16 + fr; u32x4 pw[2];
            if constexpr (ROPE) { if (g + 1 < 8) ldrope(g + 1, nq); }
            asm volatile("" ::: "memory");
#pragma unroll
            for (int bj = 0; bj < 2; ++bj) { f32x4 v0 = acc[ai][bj][m][0], v1 = acc[ai][bj][m][1];
                if constexpr (ROPE) { const f32x4 cs0 = cq[bj][0], cs1 = cq[bj][1]; f32x4 o0, o1;
                    o0[0] = v0[0] * cs0[0] - v0[1] * cs0[1]; o0[1] = v0[0] * cs0[1] + v0[1] * cs0[0];
                    o0[2] = v0[2] * cs0[2] - v0[3] * cs0[3]; o0[3] = v0[2] * cs0[3] + v0[3] * cs0[2];
                    o1[0] = v1[0] * cs1[0] - v1[1] * cs1[1]; o1[1] = v1[0] * cs1[1] + v1[1] * cs1[0];
                    o1[2] = v1[2] * cs1[2] - v1[3] * cs1[3]; o1[3] = v1[2] * cs1[3] + v1[3] * cs1[2];
                    v0 = o0 * sc; v1 = o1 * sc; }
                pw[bj] = pack8(v0, v1); }
#pragma unroll
            for (int s = 0; s < 2; ++s) { const int rr = 8 * s + (ln >> 3), pp = ln & 7; const int srcl = (pp & 3) * 16 + rr;
                const u32x4 a0 = xp16(pw[0], srcl), a1 = xp16(pw[1], srcl); const u32x4 ow = (pp >> 2) ? a1 : a0;
                if (!(MK_DRYMODE == 1 && dry) || ow.x == 0x7fc12345u) __builtin_nontemporal_store(ow, (u32x4*)(zt + (unsigned)(((rt - fr + rr) * ldz + wc * 64 + 8 * pp) * 2))); }
            if constexpr (ROPE) {
#pragma unroll
                for (int bj = 0; bj < 2; ++bj) { cq[bj][0] = nq[bj][0]; cq[bj][1] = nq[bj][1]; } }
            asm volatile("" ::: "memory"); }
    }
    __device__ __forceinline__ void operator()(const f32x4 (&acc)[2][2][4][2], const Unit& u, int wr, int wc, int fr, int fq) const {
        if (MK_DRYMODE >= 2 && dry) return;
        const int pn = u.pn;
        if (pn >= 8 && pn < 16) run<true>(acc, u, wr, wc, fr, fq, pn >= 12 ? K_SCALE : 1.0f); else run<false>(acc, u, wr, wc, fr, fq, 1.0f);
    }
};
struct EpiT1 {
    static constexpr bool PERM = true; static constexpr bool MID = false; static constexpr int NST = 16;
    const bf16* Z; bf16* T1;
    __device__ __forceinline__ void operator()(const f32x4 (&acc)[2][2][4][2], const Unit& u, int wr, int wc, int fr, int fq) const {
        const char* zt = (const char*)(Z + (size_t)u.pm * 256 * ZLD + C_GA + u.pn * 256); char* tt = (char*)(T1 + (size_t)u.pm * 256 * D + u.pn * 256);
        int ldz = ZLD, ldt = D; asm volatile("" : "+s"(ldz), "+s"(ldt));
        const int ln = fq * 16 + fr, xs = (ln & 3) * 16 + (ln >> 2), dr = (ln >> 2) - fr, dc = 8 * ((ln & 3) - fq);
        epi_perm_pipe<u32x4>(acc, wr, wc, fr, fq, [&](int rt, int ct) { return *(const u32x4*)(zt + (unsigned)((rt * ldz + ct) * 2)); },
            [&](int rt, int ct, f32x4 v0, f32x4 v1, u32x4 gw) { float gte[8]; unpack8(gw, gte);
            for (int j = 0; j < 4; ++j) { v0[j] *= sigmoidf_(gte[j]); v1[j] *= sigmoidf_(gte[4 + j]); }
            *(u32x4*)(tt + (unsigned)(((rt + dr) * ldt + ct + dc) * 2)) = xp16(pack8(v0, v1), xs); });
    }
};
struct EpiMg {
    static constexpr bool PERM = true; static constexpr bool MID = false; static constexpr int NST = 16;
    const bf16* Z; const bf16* T1; bf16* MG;
    __device__ __forceinline__ void operator()(const f32x4 (&acc)[2][2][4][2], const Unit& u, int wr, int wc, int fr, int fq) const {
        const char* zt = (const char*)(Z + (size_t)u.pm * 256 * ZLD + C_GB + u.pn * 256); const char* tt = (const char*)(T1 + (size_t)u.pm * 256 * D + u.pn * 256); char* mt = (char*)(MG + (size_t)u.pm * 256 * D + u.pn * 256);
        int ldz = ZLD, ldt = D; asm volatile("" : "+s"(ldz), "+s"(ldt));
        const int ln = fq * 16 + fr, xs = (ln & 3) * 16 + (ln >> 2), dr = (ln >> 2) - fr, dc = 8 * ((ln & 3) - fq);
        struct D2 { u32x4 a, b; };
        epi_perm_pipe<D2>(acc, wr, wc, fr, fq, [&](int rt, int ct) { D2 d; d.a = *(const u32x4*)(zt + (unsigned)((rt * ldz + ct) * 2)); d.b = *(const u32x4*)(tt + (unsigned)((rt * ldt + ct) * 2)); return d; },
            [&](int rt, int ct, f32x4 v0, f32x4 v1, D2 dd) { float gte[8], t1v[8]; unpack8(dd.a, gte); unpack8(dd.b, t1v);
            for (int j = 0; j < 4; ++j) { v0[j] = t1v[j] + v0[j] * sigmoidf_(gte[j]); v1[j] = t1v[4 + j] + v1[j] * sigmoidf_(gte[4 + j]); }
            *(u32x4*)(mt + (unsigned)(((rt + dr) * ldt + ct + dc) * 2)) = xp16(pack8(v0, v1), xs); });
    }
};
struct EpiF {
    static constexpr bool PERM = true; static constexpr bool MID = true; static constexpr int NST = 16;
    const bf16* Z; bf16* MG; int dry;
    __device__ __forceinline__ bool is_mid(const Unit& u) const { return u.koff == 0; }
    __device__ __forceinline__ void mid(f32x4 (&acc)[2][2][4][2], const Unit& u, int wr, int wc, int fr, int fq) const {
        if (MK_DRYMODE == 2 && dry) return;
        const char* za = (const char*)(Z + (size_t)u.pm * 256 * ZLD + C_GA + u.pn * 256); const char* zb = za + (C_GB - C_GA) * 2;
        int ldz = ZLD; asm volatile("" : "+s"(ldz));
        auto off = [&](int it) { const int ai = it >> 3, m = (it >> 1) & 3, bj = it & 1; return (unsigned)(((ai * 128 + wr * 64 + m * 16 + fr) * ldz + wc * 64 + bj * 32 + 8 * fq) * 2); };
        u32x4 qa[3], qb[3];
        qa[0] = *(const u32x4*)(za + off(0)); qb[0] = *(const u32x4*)(zb + off(0)); qa[1] = *(const u32x4*)(za + off(1)); qb[1] = *(const u32x4*)(zb + off(1));
#pragma unroll
        for (int it = 0; it < 16; ++it) { const int ai = it >> 3, m = (it >> 1) & 3, bj = it & 1;
            if (it + 2 < 16) { qa[(it + 2) % 3] = *(const u32x4*)(za + off(it + 2)); qb[(it + 2) % 3] = *(const u32x4*)(zb + off(it + 2)); }
            asm volatile("" ::: "memory");
            float ga[8], gb[8]; unpack8(qa[it % 3], ga); unpack8(qb[it % 3], gb);
#pragma unroll
            for (int j = 0; j < 4; ++j) {
                acc[ai][bj][m][0][j] *= (1.0f + fminf(__expf(-gb[j]), 1e30f)) * __builtin_amdgcn_rcpf(1.0f + __expf(-ga[j]));
                acc[ai][bj][m][1][j] *= (1.0f + fminf(__expf(-gb[4 + j]), 1e30f)) * __builtin_amdgcn_rcpf(1.0f + __expf(-ga[4 + j])); } }
    }
    __device__ __forceinline__ void operator()(const f32x4 (&acc)[2][2][4][2], const Unit& u, int wr, int wc, int fr, int fq) const {
        if (MK_DRYMODE == 2 && dry) return;
        const char* zb = (const char*)(Z + (size_t)u.pm * 256 * ZLD + C_GB + u.pn * 256); char* mt = (char*)(MG + (size_t)u.pm * 256 * D + u.pn * 256);
        int ldz = ZLD, ldt = D; asm volatile("" : "+s"(ldz), "+s"(ldt));
        const int ln = fq * 16 + fr, xs = (ln & 3) * 16 + (ln >> 2), dr = (ln >> 2) - fr, dc = 8 * ((ln & 3) - fq);
        auto off = [&](int it) { const int ai = it >> 3, m = (it >> 1) & 3, bj = it & 1; return (unsigned)(((ai * 128 + wr * 64 + m * 16 + fr) * ldz + wc * 64 + bj * 32 + 8 * fq) * 2); };
        u32x4 qb[4]; qb[0] = *(const u32x4*)(zb + off(0)); qb[1] = *(const u32x4*)(zb + off(1)); qb[2] = *(const u32x4*)(zb + off(2));
#pragma unroll
        for (int it = 0; it < 16; ++it) { const int ai = it >> 3, m = (it >> 1) & 3, bj = it & 1; const int rt = ai * 128 + wr * 64 + m * 16 + fr, ct = wc * 64 + bj * 32 + 8 * fq;
            if (it + 3 < 16) qb[(it + 3) & 3] = *(const u32x4*)(zb + off(it + 3));
            asm volatile("" ::: "memory");
            float gb[8]; unpack8(qb[it & 3], gb); f32x4 v0 = acc[ai][bj][m][0], v1 = acc[ai][bj][m][1];
#pragma unroll
            for (int j = 0; j < 4; ++j) { v0[j] *= __builtin_amdgcn_rcpf(1.0f + fminf(__expf(-gb[j]), 1e30f)); v1[j] *= __builtin_amdgcn_rcpf(1.0f + fminf(__expf(-gb[4 + j]), 1e30f)); }
            *(u32x4*)(mt + (unsigned)(((rt + dr) * ldt + ct + dc) * 2)) = xp16(pack8(v0, v1), xs); }
    }
};
struct EpiX1 {
    static constexpr bool PERM = false; static constexpr bool MID = false; static constexpr int NST = 32;
    const float* X; float* O; const float* mod; int grow0;
    __device__ __forceinline__ void operator()(const f32x4 (&acc)[2][2][4][2], const Unit& u, int wr, int wc, int fr, int fq) const {
        const int trow = grow0 + u.pm * 256; const int b = trow >> 13;
        const char* xt = (const char*)(X + (size_t)trow * D + u.pn * 256); char* ot = (char*)(O + (size_t)trow * D + u.pn * 256); const float* g1 = mod + b * 6144 + 2048 + u.pn * 256;
        int ldx = D; asm volatile("" : "+s"(ldx));
        const int ln = fq * 16 + fr, xs = (ln & 3) * 16 + (ln >> 2);
        const int r0 = wr * 64 + (ln >> 2), c0 = wc * 64 + 4 * (ln & 3), c0g = wc * 64 + 4 * fq;
        f32x4 gv[2][2];
#pragma unroll
        for (int bj = 0; bj < 2; ++bj)
#pragma unroll
            for (int n = 0; n < 2; ++n) gv[bj][n] = *(const f32x4*)(g1 + c0g + bj * 32 + n * 16);
        auto xoff = [&](int it) { const int bj = it >> 4, n = (it >> 3) & 1, ai = (it >> 2) & 1, m = it & 3; return (unsigned)(((r0 + ai * 128 + m * 16) * ldx + c0 + bj * 32 + n * 16) * 4); };
        f32x4 xq[3]; xq[0] = *(const f32x4*)(xt + xoff(0)); xq[1] = *(const f32x4*)(xt + xoff(1));
#pragma unroll
        for (int it = 0; it < 32; ++it) { const int bj = it >> 4, n = (it >> 3) & 1, ai = (it >> 2) & 1, m = it & 3;
            if (it + 2 < 32) xq[(it + 2) % 3] = *(const f32x4*)(xt + xoff(it + 2));
            asm volatile("" ::: "memory");
            const f32x4 pr = gv[bj][n] * acc[ai][bj][m][n]; const u32x4 ps = xp16(__builtin_bit_cast(u32x4, pr), xs);
            *(f32x4*)(ot + xoff(it)) = xq[it % 3] + __builtin_bit_cast(f32x4, ps); }
    }
};
__device__ __forceinline__ float swiglu1(float g, float l) { const float gl = fminf(g, 7.0f), li = fminf(fmaxf(l, -7.0f), 7.0f); return gl * sigmoidf_(1.702f * gl) * (li + 1.0f); }
struct EpiHid {
    static constexpr bool PERM = true; static constexpr bool MID = false; static constexpr int NST = 16;
    unsigned char* HID; const float* b1;
    __device__ __forceinline__ void operator()(const f32x4 (&acc)[2][2][4][2], const Unit& u, int wr, int wc, int fr, int fq) const {
        const int e = u.pn >> 3, pl = u.pn & 7; const float* bb = b1 + e * 2048 + pl * 256; char* ht = (char*)(HID + (size_t)u.pm * 256 * DEXP + pl * 128);
        int ldh = DEXP; asm volatile("" : "+s"(ldh));
        const int ln = fq * 16 + fr, xs = (ln & 3) * 16 + (ln >> 2), dr = (ln >> 2) - fr, dc = 8 * ((ln & 3) - fq);
        f32x4 bq[2][2];
#pragma unroll
        for (int bj = 0; bj < 2; ++bj) { bq[bj][0] = *(const f32x4*)(bb + wc * 64 + bj * 32 + 8 * fq); bq[bj][1] = *(const f32x4*)(bb + wc * 64 + bj * 32 + 8 * fq + 4); }
        epi_perm_loop(acc, wr, wc, fr, fq, [&](int rt, int ct, f32x4 v0, f32x4 v1) { v0 += bq[(ct >> 5) & 1][0]; v1 += bq[(ct >> 5) & 1][1];
            const unsigned w = pk4_fp8(swiglu1(v0[0], v0[1]), swiglu1(v0[2], v0[3]), swiglu1(v1[0], v1[1]), swiglu1(v1[2], v1[3]));
            *(unsigned*)(ht + (unsigned)((rt + dr) * ldh + ((ct + dc) >> 1))) = (unsigned)__shfl((int)w, xs); });
    }
};
struct EpiY {
    static constexpr bool PERM = true; static constexpr bool MID = false; static constexpr int NST = 16;
    unsigned char* Y; const float* b2;
    __device__ __forceinline__ void operator()(const f32x4 (&acc)[2][2][4][2], const Unit& u, int wr, int wc, int fr, int fq) const {
        const int e = u.pn >> 2, pl = u.pn & 3; const float* bb = b2 + e * 1024 + pl * 256; char* yt = (char*)(Y + (size_t)u.pm * 256 * D + pl * 256);
        int ldy = D; asm volatile("" : "+s"(ldy));
        const int ln = fq * 16 + fr, xs = (ln & 3) * 16 + (ln >> 2), dr = (ln >> 2) - fr, dc = 8 * ((ln & 3) - fq);
        f32x4 bq[2][2];
#pragma unroll
        for (int bj = 0; bj < 2; ++bj) { bq[bj][0] = *(const f32x4*)(bb + wc * 64 + bj * 32 + 8 * fq); bq[bj][1] = *(const f32x4*)(bb + wc * 64 + bj * 32 + 8 * fq + 4); }
        epi_perm_loop(acc, wr, wc, fr, fq, [&](int rt, int ct, f32x4 v0, f32x4 v1) { v0 += bq[(ct >> 5) & 1][0]; v1 += bq[(ct >> 5) & 1][1];
            u32x2 w8; w8.x = pk4_fp8(v0[0], v0[1], v0[2], v0[3]); w8.y = pk4_fp8(v1[0], v1[1], v1[2], v1[3]);
            *(u32x2*)(yt + (unsigned)((rt + dr) * ldy + ct + dc)) = xp8(w8, xs); });
    }
};

#define XB_TMO      128
#define XB_XCNT(j)  (256  + 64 * (j))
#define XB_XSUB(j)  (1280 + 64 * (j))
#define XB_XGEN(j)  (2304 + 64 * (j))
#define XB_TOP      3328
#define XB_TOPGEN   3392
#define XCD_BAR_WORDS 3456
#define XB_SPIN_CAP (1u << 22)
__device__ __forceinline__ unsigned xb_ld(unsigned* p)              { return __hip_atomic_load(p, __ATOMIC_RELAXED, __HIP_MEMORY_SCOPE_AGENT); }
__device__ __forceinline__ unsigned xb_add(unsigned* p, unsigned v) { return __hip_atomic_fetch_add(p, v, __ATOMIC_RELAXED, __HIP_MEMORY_SCOPE_AGENT); }
__device__ __forceinline__ unsigned xb_xcc_id() { return (unsigned)__builtin_amdgcn_s_getreg((3 << 11) | 20) & 0xFu; }
#define XB_SPIN(cond, bar) do { unsigned _sp = 0; while (cond) { __builtin_amdgcn_s_sleep(1); \
    if ((++_sp & 255u) == 0u) { if (xb_ld(&(bar)[XB_TMO])) break; if (_sp > XB_SPIN_CAP) { atomicAdd(&(bar)[XB_TMO], 1u); break; } } } } while (0)
struct XcdBarrier { unsigned* bar; unsigned x; volatile LAS unsigned* st; };
__device__ __forceinline__ XcdBarrier xcd_barrier_post(unsigned* bar, volatile LAS unsigned* st) {
    XcdBarrier b; b.bar = bar; b.x = xb_xcc_id(); b.st = st;
    if (threadIdx.x == 0) (void)xb_add(&bar[XB_XCNT(b.x)], 1u);
    return b;
}
__device__ __forceinline__ void xcd_barrier_complete(unsigned* bar, unsigned x, unsigned& nloc, unsigned& nx) {
    const unsigned G = gridDim.x * gridDim.y * gridDim.z;
    unsigned sum, cnt, mine, sp = 0u;
    for (;;) {
        sum = 0u; cnt = 0u; mine = 0u;
#pragma unroll
        for (unsigned j = 0; j < 16; ++j) { const unsigned c = xb_ld(&bar[XB_XCNT(j)]); sum += c; cnt += (c > 0u) ? 1u : 0u; mine = (j == x) ? c : mine; }
        if (sum == G) break;
        __builtin_amdgcn_s_sleep(1);
        if ((++sp & 255u) == 0u) { if (xb_ld(&bar[XB_TMO])) break; if (sp > XB_SPIN_CAP) { atomicAdd(&bar[XB_TMO], 1u); break; } }
    }
    nloc = mine > 0u ? mine : 1u; nx = cnt > 0u ? cnt : 1u;
}
__device__ __forceinline__ void xcd_barrier(const XcdBarrier& b) {
    asm volatile("s_waitcnt vmcnt(0)" ::: "memory");
    __syncthreads();
    if (threadIdx.x == 0) {
        unsigned* bar = b.bar;
        __builtin_amdgcn_s_waitcnt(0);
        unsigned nloc = b.st[0], nx = b.st[1];
        if (nloc == 0u) { xcd_barrier_complete(bar, b.x, nloc, nx); b.st[0] = nloc; b.st[1] = nx; }
        const unsigned old = xb_add(&bar[XB_XSUB(b.x)], 1u);
        const unsigned gen = old / nloc;
        if (old + 1u == (gen + 1u) * nloc) {
            __builtin_amdgcn_fence(__ATOMIC_RELEASE, "agent");
            asm volatile("s_waitcnt vmcnt(0)" ::: "memory");
            const unsigned og = xb_add(&bar[XB_TOP], 1u);
            const unsigned tg = og / nx;
            if (og + 1u == (tg + 1u) * nx) xb_add(&bar[XB_TOPGEN], 1u);
            else XB_SPIN(xb_ld(&bar[XB_TOPGEN]) == tg, bar);
            __builtin_amdgcn_fence(__ATOMIC_ACQUIRE, "agent");
            xb_add(&bar[XB_XGEN(b.x)], 1u);
            asm volatile("s_waitcnt vmcnt(0)" ::: "memory");
        } else {
            XB_SPIN(xb_ld(&bar[XB_XGEN(b.x)]) == gen, bar);
            __builtin_amdgcn_fence(__ATOMIC_ACQUIRE, "agent");
            asm volatile("s_waitcnt vmcnt(0)" ::: "memory");
        }
    }
    __syncthreads();
}

__device__ __forceinline__ void transpose_item(const float* W, int ldw, int K, int N, bf16* WT, LAS float* scr, int item, int lane) {
    const int nblk = N / 32, kb = item / nblk, nb = item % nblk, k0 = 64 * kb, n0 = 32 * nb;
#pragma unroll 8
    for (int i = 0; i < 32; ++i) { const int kk = 2 * i + (lane >> 5); scr[kk * 33 + (lane & 31)] = W[(size_t)(k0 + kk) * ldw + n0 + (lane & 31)]; }
    LDS_WAIT(); asm volatile("" ::: "memory");
    const int c = lane & 7;
#pragma unroll
    for (int j = 0; j < 4; ++j) { const int n = (lane >> 3) + 8 * j; const LAS float* s = scr + (8 * c) * 33 + n;
        u32x4 o; o.x = pk2(s[0 * 33], s[1 * 33]); o.y = pk2(s[2 * 33], s[3 * 33]); o.z = pk2(s[4 * 33], s[5 * 33]); o.w = pk2(s[6 * 33], s[7 * 33]);
        *(u32x4*)(WT + (size_t)(n0 + n) * K + k0 + 8 * c) = o; }
    LDS_WAIT(); asm volatile("" ::: "memory");
}
struct TrTile { const float* src; bf16* dst; int ldw, ldt; };
__device__ __forceinline__ void tr_load(const TrTile& t, int tid, f32x4 (&v)[8]) {
#pragma unroll
    for (int i = 0; i < 8; ++i) { const int id = tid + 512 * i, k = id >> 5, c4 = id & 31; v[i] = *(const f32x4*)(t.src + (size_t)k * t.ldw + 4 * c4); }
}
__device__ __forceinline__ void tr_store(const TrTile& t, int tid, const f32x4 (&v)[8], LAS float* L) {
#pragma unroll
    for (int i = 0; i < 8; ++i) { const int id = tid + 512 * i, k = id >> 5, c4 = id & 31;
        L[(4 * c4 + 0) * 129 + k] = v[i][0]; L[(4 * c4 + 1) * 129 + k] = v[i][1]; L[(4 * c4 + 2) * 129 + k] = v[i][2]; L[(4 * c4 + 3) * 129 + k] = v[i][3]; }
    __syncthreads();
#pragma unroll
    for (int i = 0; i < 4; ++i) { const int id = tid + 512 * i, kc = id & 15, n = id >> 4; const LAS float* s = L + n * 129 + 8 * kc;
        u32x4 o; o.x = pk2(s[0], s[1]); o.y = pk2(s[2], s[3]); o.z = pk2(s[4], s[5]); o.w = pk2(s[6], s[7]);
        *(u32x4*)(t.dst + (size_t)n * t.ldt + 8 * kc) = o; }
    __syncthreads();
}
template <bool FP8 = false>
__device__ __forceinline__ void tr_strip_i8(const float* src, int ldw, int K, signed char* dst, int ldt, float* scales, int tid, LAS unsigned* TL, LAS unsigned* CM) {
    constexpr float QMAX = FP8 ? 448.0f : 127.0f;
    const int c4 = tid & 31, g = tid >> 5, nk = K / 128;
    const float* p = src + (size_t)(4 * g) * ldw + 4 * c4;
    auto ld8 = [&](int kt, f32x4 (&v)[8]) {
#pragma unroll
        for (int h = 0; h < 2; ++h)
#pragma unroll
            for (int r = 0; r < 4; ++r) v[4 * h + r] = *(const f32x4*)(p + (size_t)(kt * 128 + 64 * h + r) * ldw); };
    float mx[4] = {0.f, 0.f, 0.f, 0.f};
    auto red = [&](const f32x4 (&v)[8]) {
#pragma unroll
        for (int i = 0; i < 8; ++i)
#pragma unroll
            for (int j = 0; j < 4; ++j) mx[j] = fmaxf(mx[j], fabsf(v[i][j])); };
    {   f32x4 va[8], vb[8]; ld8(0, va);
#pragma unroll 1
        for (int kt = 0; kt < nk; kt += 2) { ld8(kt + 1, vb); red(va); if (kt + 2 < nk) ld8(kt + 2, va); red(vb); } }
    f32x4 v[8]; ld8(0, v);
    if (tid < 128) CM[tid] = 0u;
    __syncthreads();
#pragma unroll
    for (int j = 0; j < 4; ++j) __hip_atomic_fetch_max(&CM[4 * c4 + j], __builtin_bit_cast(unsigned, mx[j]), __ATOMIC_RELAXED, __HIP_MEMORY_SCOPE_WORKGROUP);
    __syncthreads();
    if (tid < 128) { const float m = __builtin_bit_cast(float, CM[tid]); scales[tid] = m > 0.f ? m * (1.0f / QMAX) : 1.0f; }
    float inv[4];
#pragma unroll
    for (int j = 0; j < 4; ++j) { const float m = __builtin_bit_cast(float, CM[4 * c4 + j]); inv[j] = m > 0.f ? QMAX / m : 0.f; }
#pragma unroll 1
    for (int kt = 0; kt < nk; ++kt) {
        f32x4 w[8];
#pragma unroll
        for (int i = 0; i < 8; ++i) w[i] = v[i];
        if (kt + 1 < nk) ld8(kt + 1, v);
        LAS unsigned* T = TL + (kt & 1) * 4352;
#pragma unroll
        for (int h = 0; h < 2; ++h)
#pragma unroll
            for (int j = 0; j < 4; ++j) { unsigned pk;
                if constexpr (FP8) pk = pk4_fp8(w[4 * h][j] * inv[j], w[4 * h + 1][j] * inv[j], w[4 * h + 2][j] * inv[j], w[4 * h + 3][j] * inv[j]);
                else pk = q8x4((f32x4){w[4 * h][j], w[4 * h + 1][j], w[4 * h + 2][j], w[4 * h + 3][j]}, inv[j]);
                T[c4 * 133 + j * 33 + 16 * h + g] = pk; }
        __syncthreads();
#pragma unroll
        for (int i = 0; i < 2; ++i) { const int id = tid + 512 * i, kc = id & 7, n = id >> 3; const LAS unsigned* s = T + (n >> 2) * 133 + (n & 3) * 33 + 4 * kc;
            *(u32x4*)(dst + (size_t)n * ldt + kt * 128 + 16 * kc) = (u32x4){s[0], s[1], s[2], s[3]}; }
    }
    __syncthreads();
}
__device__ __forceinline__ unsigned offb(unsigned row, unsigned ch) { return 256u * row + 16u * (ch ^ (((row & 3u) << 2) | ((row >> 2) & 3u))); }
typedef short v4i16_t __attribute__((ext_vector_type(4)));
__device__ __forceinline__ s16x4 trd(const LAS unsigned char* p) { return __builtin_bit_cast(s16x4, __builtin_amdgcn_ds_read_tr16_b64_v4i16((LAS v4i16_t*)p)); }
#define MFMA32(a, b, c) __builtin_amdgcn_mfma_f32_32x32x16_bf16((a), (b), (c), 0, 0, 0)
#define MFMA16(a, b, c) __builtin_amdgcn_mfma_f32_16x16x32_bf16((a), (b), (c), 0, 0, 0)
__device__ __forceinline__ int crow(int reg, int h) { return (reg & 3) + 8 * (reg >> 2) + 4 * h; }

struct LruP { const float *conv_w, *conv_b, *ba, *bx, *lam; const bf16* wg; f32x2* carry; };
template <int PASS, int DIR>
__device__ __forceinline__ void lru_dir(LAS unsigned char* XC, LAS unsigned char* RN, const LruP& P, int b, int cp, int n, int w, int col, int g4) {
    const int ch = 128 * n + 16 * w + col;
    const float bav = P.ba[DIR * 1024 + ch], bxv = P.bx[DIR * 1024 + ch];
    const float c8 = 8.0f * log1pf(expf(-P.lam[DIR * 1024 + ch]));
    bf16x8 Ba[4], Bx[4];
    { const bf16* wa = P.wg + ((size_t)((n * 4 + DIR * 2 + 0) * 128 + 16 * w + col)) * 128 + 8 * g4; const bf16* wx = wa + 128 * 128;
#pragma unroll
      for (int ks = 0; ks < 4; ++ks) { Ba[ks] = *(const bf16x8*)(wa + 32 * ks); Bx[ks] = *(const bf16x8*)(wx + 32 * ks); } }
    float hrun = 0.f, atot = 1.f;
    if (PASS == 1) {
        const int Pn = DIR == 0 ? cp : 33 - cp; float Al = 1.f, Ul = 0.f;
#pragma unroll
        for (int k = 0; k < 9; ++k) { const int p = 9 * g4 + k;
            if (p < Pn) { const int cq = DIR == 0 ? p : (p == 0 ? 0 : 33 - p); const f32x2 ah = P.carry[((size_t)(b * 2 + DIR) * 33 + cq) * 1024 + ch]; Ul = ah.x * Ul + ah.y; Al = ah.x * Al; } }
#pragma unroll
        for (int gq = 0; gq < 4; ++gq) { const float Ag = __shfl(Al, col + 16 * gq), Ug = __shfl(Ul, col + 16 * gq); hrun = Ag * hrun + Ug; }
    }
#pragma unroll 4
    for (int mi = 0; mi < 16; ++mi) {
        const int m = DIR == 0 ? mi : 15 - mi;
        f32x4 ar = {0.f, 0.f, 0.f, 0.f}, ai = {0.f, 0.f, 0.f, 0.f};
        const LAS unsigned char* xrow = XC + (16 * m + col) * 272 + 16 * g4;
#pragma unroll
        for (int ks = 0; ks < 4; ++ks) { const bf16x8 af = *(const LAS bf16x8*)(xrow + 64 * ks); ar = MFMA16(af, Ba[ks], ar); ai = MFMA16(af, Bx[ks], ai); }
        float av[4], uv[4];
#pragma unroll
        for (int r = 0; r < 4; ++r) { const int t = 16 * m + 4 * g4 + r; const float xc = bf2f(*(const LAS unsigned short*)(XC + t * 272 + (16 * w + col) * 2));
            const float er = __expf(fminf(-(ar[r] + bav), 40.f)) + 1.0f, ei = __expf(fminf(-(ai[r] + bxv), 40.f)) + 1.0f; const float inv = __builtin_amdgcn_rcpf(er * ei);
            const float rg = inv * ei, ig = inv * er; const float a = __expf(-c8 * rg);
            av[r] = a; uv[r] = __builtin_amdgcn_sqrtf(fmaxf(1.0f - a * a, 0.f)) * ig * xc; }
        float Al = 1.f, Ul = 0.f;
#pragma unroll
        for (int rr = 0; rr < 4; ++rr) { const int r = DIR == 0 ? rr : 3 - rr; Ul = av[r] * Ul + uv[r]; Al = av[r] * Al; }
        float Ag[4], Ug[4];
#pragma unroll
        for (int gq = 0; gq < 4; ++gq) { Ag[gq] = __shfl(Al, col + 16 * gq); Ug[gq] = __shfl(Ul, col + 16 * gq); }
        float h = hrun, hin = hrun;
#pragma unroll
        for (int gi = 0; gi < 4; ++gi) { const int gq = DIR == 0 ? gi : 3 - gi; if (gq == g4) hin = h; h = Ag[gq] * h + Ug[gq]; atot *= Ag[gq]; }
        hrun = h;
        if (PASS == 1) {
            float hh = hin;
#pragma unroll
            for (int rr = 0; rr < 4; ++rr) { const int r = DIR == 0 ? rr : 3 - rr; hh = av[r] * hh + uv[r];
                LAS unsigned short* rp = (LAS unsigned short*)(RN + (16 * m + 4 * g4 + r) * 272 + (16 * w + col) * 2);
                if (DIR == 0) *rp = (unsigned short)f2bf(hh); else *rp = (unsigned short)f2bf(bf2f(*rp) + hh); }
        }
    }
    if (PASS == 0) { if (g4 == 0) P.carry[((size_t)(b * 2 + DIR) * 33 + cp) * 1024 + ch] = (f32x2){atot, hrun}; }
}
template <int PASS>
__device__ __forceinline__ void lru_unit(LAS unsigned char* lds, const LruP& P, int b, int cp, int n, const bf16* xsrc, int ldx, int seqlen, const bf16* grp, bf16* gout) {
    const int tid = opaque_tid(), lane = tid & 63, w = __builtin_amdgcn_readfirstlane(tid >> 6), col = lane & 15, g4 = lane >> 4;
    const int t0 = cp == 0 ? 0 : (cp - 1) * 256;
    LAS unsigned char* XC = lds;
    LAS unsigned char* RN = lds + 69632;
    __syncthreads();
    {
        const int j8 = tid & 15, ch0 = 128 * n + 8 * j8;
        float cw[4][8], cb[8];
#pragma unroll
        for (int k = 0; k < 4; ++k) { const f32x4 a = *(const f32x4*)(P.conv_w + k * 1024 + ch0), c = *(const f32x4*)(P.conv_w + k * 1024 + ch0 + 4);
            cw[k][0] = a[0]; cw[k][1] = a[1]; cw[k][2] = a[2]; cw[k][3] = a[3]; cw[k][4] = c[0]; cw[k][5] = c[1]; cw[k][6] = c[2]; cw[k][7] = c[3]; }
        { const f32x4 a = *(const f32x4*)(P.conv_b + ch0), c = *(const f32x4*)(P.conv_b + ch0 + 4); cb[0] = a[0]; cb[1] = a[1]; cb[2] = a[2]; cb[3] = a[3]; cb[4] = c[0]; cb[5] = c[1]; cb[6] = c[2]; cb[7] = c[3]; }
#pragma unroll 4
        for (int i = 0; i < 8; ++i) {
            const int t = (tid >> 4) + 32 * i; float a[8];
#pragma unroll
            for (int j = 0; j < 8; ++j) a[j] = cb[j];
#pragma unroll
            for (int k = 0; k < 4; ++k) { const int row = t0 + t + k - 2;
                if (row >= 0 && row < seqlen) { float xv[8]; unpack8(*(const u32x4*)(xsrc + (size_t)row * ldx + ch0), xv);
#pragma unroll
                    for (int j = 0; j < 8; ++j) a[j] += cw[k][j] * xv[j]; } }
            u32x4 o; o.x = pk2(a[0], a[1]); o.y = pk2(a[2], a[3]); o.z = pk2(a[4], a[5]); o.w = pk2(a[6], a[7]);
            *(LAS u32x4*)(XC + t * 272 + j8 * 16) = o;
        }
    }
    __syncthreads();
    lru_dir<PASS, 0>(XC, RN, P, b, cp, n, w, col, g4);
    lru_dir<PASS, 1>(XC, RN, P, b, cp, n, w, col, g4);
    if (PASS == 1) {
        __syncthreads();
        const int j8 = tid & 15, ch0 = 128 * n + 8 * j8;
#pragma unroll 4
        for (int i = 0; i < 8; ++i) { const int t = (tid >> 4) + 32 * i; float rv[8], gv[8];
            unpack8(*(const LAS u32x4*)(RN + t * 272 + j8 * 16), rv); const bf16* gp_in = grp + (size_t)(t0 + t) * ZLD + C_GR + ch0; unpack8(*(const u32x4*)gp_in, gv); bf16* gp = gout + (size_t)(t0 + t) * D + ch0;
            for (int j = 0; j < 8; ++j) gv[j] = gelu_tanh(gv[j]);
            u32x4 o; o.x = pk2(rv[0] * gv[0], rv[1] * gv[1]); o.y = pk2(rv[2] * gv[2], rv[3] * gv[3]); o.z = pk2(rv[4] * gv[4], rv[5] * gv[5]); o.w = pk2(rv[6] * gv[6], rv[7] * gv[7]);
            *(u32x4*)gp = o; }
    }
}

__device__ __forceinline__ void kv_unit(LAS unsigned char* lds, const bf16* ksrc, const bf16* vsrc, int ld, float l2g, bf16* out) {
    const int tid = opaque_tid(), lane = tid & 63, w = __builtin_amdgcn_readfirstlane(tid >> 6);
    LAS unsigned char* KF = lds; LAS unsigned char* KB = lds + 32768; LAS unsigned char* VI = lds + 65536;
    __syncthreads();
#pragma unroll
    for (int i = 0; i < 4; ++i) { const int idx = tid + 512 * i, j = idx >> 4, chn = idx & 15; float kv[8]; unpack8(*(const u32x4*)(ksrc + (size_t)j * ld + 8 * chn), kv);
        const float wf = exp2f(l2g * (float)(127 - j)), wb = exp2f(l2g * (float)j);
        u32x4 of, ob; of.x = pk2(kv[0] * wf, kv[1] * wf); of.y = pk2(kv[2] * wf, kv[3] * wf); of.z = pk2(kv[4] * wf, kv[5] * wf); of.w = pk2(kv[6] * wf, kv[7] * wf);
        ob.x = pk2(kv[0] * wb, kv[1] * wb); ob.y = pk2(kv[2] * wb, kv[3] * wb); ob.z = pk2(kv[4] * wb, kv[5] * wb); ob.w = pk2(kv[6] * wb, kv[7] * wb);
        *(LAS u32x4*)(KF + offb(j, chn)) = of; *(LAS u32x4*)(KB + offb(j, chn)) = ob; }
#pragma unroll
    for (int i = 0; i < 8; ++i) { const int idx = tid + 512 * i, j = idx >> 5, chn = idx & 31;
        *(LAS u32x4*)(VI + (chn >> 4) * 32768 + offb(j, chn & 15)) = *(const u32x4*)(vsrc + (size_t)j * ld + 8 * chn); }
    __syncthreads();
    const int h = lane >> 5, blk = (lane >> 4) & 1, q = (lane & 15) >> 2, p = lane & 3;
    f32x16 accF[4], accB[4];
#pragma unroll
    for (int dt = 0; dt < 4; ++dt)
#pragma unroll
        for (int r = 0; r < 16; ++r) { accF[dt][r] = 0.f; accB[dt][r] = 0.f; }
    const LAS unsigned char* Vimg = VI + (w >> 2) * 32768; const int cv = w & 3;
#pragma unroll 1
    for (int ks = 0; ks < 8; ++ks) {
        const unsigned r0 = 16 * ks + 8 * h + q, r1 = r0 + 4;
        const s16x4 v0 = trd(Vimg + offb(r0, 4 * cv + 2 * blk + (p >> 1)) + 8 * (p & 1)), v1 = trd(Vimg + offb(r1, 4 * cv + 2 * blk + (p >> 1)) + 8 * (p & 1));
        const bf16x8 bv = __builtin_shufflevector(v0, v1, 0, 1, 2, 3, 4, 5, 6, 7);
#pragma unroll
        for (int dt = 0; dt < 4; ++dt) {
            const unsigned o0 = offb(r0, 4 * dt + 2 * blk + (p >> 1)) + 8 * (p & 1), o1 = offb(r1, 4 * dt + 2 * blk + (p >> 1)) + 8 * (p & 1);
            const bf16x8 af = __builtin_shufflevector(trd(KF + o0), trd(KF + o1), 0, 1, 2, 3, 4, 5, 6, 7);
            const bf16x8 ab = __builtin_shufflevector(trd(KB + o0), trd(KB + o1), 0, 1, 2, 3, 4, 5, 6, 7);
            accF[dt] = MFMA32(af, bv, accF[dt]); accB[dt] = MFMA32(ab, bv, accB[dt]);
        }
    }
    __syncthreads();
    { const int v = 32 * w + (lane & 31);
#pragma unroll
      for (int dt = 0; dt < 4; ++dt)
#pragma unroll
        for (int rg = 0; rg < 4; ++rg) { const int d = 32 * dt + 8 * rg + 4 * h;
            u32x2 of, ob; of.x = pk2(accF[dt][4 * rg], accF[dt][4 * rg + 1]); of.y = pk2(accF[dt][4 * rg + 2], accF[dt][4 * rg + 3]);
            ob.x = pk2(accB[dt][4 * rg], accB[dt][4 * rg + 1]); ob.y = pk2(accB[dt][4 * rg + 2], accB[dt][4 * rg + 3]);
            *(LAS u32x2*)(lds + v * 272 + d * 2) = of; *(LAS u32x2*)(lds + 69632 + v * 272 + d * 2) = ob; } }
    __syncthreads();
#pragma unroll
    for (int i = 0; i < 16; ++i) { const int idx = tid + 512 * i, dir = idx >> 12, v = (idx >> 4) & 255, chn = idx & 15;
        *(u32x4*)(out + (size_t)dir * 32768 + v * 128 + 8 * chn) = *(const LAS u32x4*)(lds + dir * 69632 + v * 272 + chn * 16); }
}

__device__ __forceinline__ void xc_rows(const LruP& P, const bf16* xsrc, int ldx, int lgseq  , int nrows, bf16* dst, int gthread, int nthreads) {
    const int c8 = gthread & 127, ch0 = 8 * c8;
    float cw[4][8], cb[8];
#pragma unroll
    for (int k = 0; k < 4; ++k) { const f32x4 a = *(const f32x4*)(P.conv_w + k * 1024 + ch0), c = *(const f32x4*)(P.conv_w + k * 1024 + ch0 + 4);
        cw[k][0] = a[0]; cw[k][1] = a[1]; cw[k][2] = a[2]; cw[k][3] = a[3]; cw[k][4] = c[0]; cw[k][5] = c[1]; cw[k][6] = c[2]; cw[k][7] = c[3]; }
    { const f32x4 a = *(const f32x4*)(P.conv_b + ch0), c = *(const f32x4*)(P.conv_b + ch0 + 4); cb[0] = a[0]; cb[1] = a[1]; cb[2] = a[2]; cb[3] = a[3]; cb[4] = c[0]; cb[5] = c[1]; cb[6] = c[2]; cb[7] = c[3]; }
    const int seqmask = (1 << lgseq) - 1;
    for (int run = gthread >> 7; run < nrows / 16; run += nthreads >> 7) {
        const int row0 = run * 16, t0 = row0 & seqmask;
        u32x4 xw[19];
#pragma unroll
        for (int k = 0; k < 19; ++k) { const int tt = t0 + k - 2; xw[k] = (tt >= 0 && tt <= seqmask) ? *(const u32x4*)(xsrc + (size_t)(row0 + k - 2) * ldx + ch0) : (u32x4){0u, 0u, 0u, 0u}; }
#pragma unroll
        for (int r = 0; r < 16; ++r) { float a[8];
#pragma unroll
            for (int j = 0; j < 8; ++j) a[j] = cb[j];
#pragma unroll
            for (int k = 0; k < 4; ++k) { float xv[8]; unpack8(xw[r + k], xv);
#pragma unroll
                for (int j = 0; j < 8; ++j) a[j] += cw[k][j] * xv[j]; }
            u32x4 o; o.x = pk2(a[0], a[1]); o.y = pk2(a[2], a[3]); o.z = pk2(a[4], a[5]); o.w = pk2(a[6], a[7]);
            *(u32x4*)(dst + (size_t)(row0 + r) * 1024 + ch0) = o; }
    }
}
__device__ __forceinline__ void lru_sweep(LAS unsigned char* lds, const LruP& P, int n, int sub, int dir, const bf16* xcl, const bf16* xcc, bf16* hout) {
    const int tid = opaque_tid(), lane = tid & 63, w = __builtin_amdgcn_readfirstlane(tid >> 6), col = lane & 15, g4 = lane >> 4;
    LAS unsigned char* XC = lds;
    LAS f32x2* AGG = (LAS f32x2*)(lds + 69632);
    LAS unsigned char* OUT = lds + 69632 + 1024;
    const int chl = 16 * sub + col, ch = 128 * n + chl;
    const float bav = P.ba[dir * 1024 + ch], bxv = P.bx[dir * 1024 + ch];
    const float c8 = 8.0f * log1pf(expf(-P.lam[dir * 1024 + ch]));
    bf16x8 Ba[4], Bx[4];
    { const bf16* wa = P.wg + ((size_t)((n * 4 + dir * 2 + 0) * 128 + chl)) * 128 + 8 * g4; const bf16* wx = wa + 128 * 128;
#pragma unroll
      for (int ks = 0; ks < 4; ++ks) { Ba[ks] = *(const bf16x8*)(wa + 32 * ks); Bx[ks] = *(const bf16x8*)(wx + 32 * ks); } }
    u32x4 xq[8];
    auto gload = [&](int s) { const bf16* srcp = s == 0 ? xcc : xcl + (size_t)(dir ? 32 - s : s - 1) * 256 * 1024;
#pragma unroll
        for (int i = 0; i < 8; ++i) { const int it = tid + 512 * i; xq[i] = *(const u32x4*)(srcp + (size_t)(it >> 4) * 1024 + 128 * n + 8 * (it & 15)); } };
    auto lstore = [&]() {
#pragma unroll
        for (int i = 0; i < 8; ++i) { const int it = tid + 512 * i; *(LAS u32x4*)(XC + (it >> 4) * 272 + (it & 15) * 16) = xq[i]; } };
    float hchunk = 0.f;
    __syncthreads();
    gload(0); lstore();
#pragma unroll 1
    for (int s = 0; s < 33; ++s) {
        __syncthreads();
        if (s + 1 < 33) gload(s + 1);
        if (s >= 2) { const int cprev = dir ? 33 - s : s - 2; *(u32x4*)(hout + (size_t)cprev * 4096 + tid * 8) = *(const LAS u32x4*)(OUT + tid * 16); }
        float av[2][4], uv[2][4], Ag[2][4], Ug[2][4], Am[2], Um[2];
#pragma unroll
        for (int q2 = 0; q2 < 2; ++q2) {
            const int m = dir ? 2 * w + 1 - q2 : 2 * w + q2;
            f32x4 ar = {0.f, 0.f, 0.f, 0.f}, ai = {0.f, 0.f, 0.f, 0.f};
            const LAS unsigned char* xrow = XC + (16 * m + col) * 272 + 16 * g4;
#pragma unroll
            for (int ks = 0; ks < 4; ++ks) { const bf16x8 af = *(const LAS bf16x8*)(xrow + 64 * ks); ar = MFMA16(af, Ba[ks], ar); ai = MFMA16(af, Bx[ks], ai); }
#pragma unroll
            for (int r = 0; r < 4; ++r) { const int t = 16 * m + 4 * g4 + r; const float xc = bf2f(*(const LAS unsigned short*)(XC + t * 272 + chl * 2));
                const float er = __expf(fminf(-(ar[r] + bav), 40.f)) + 1.0f, ei = __expf(fminf(-(ai[r] + bxv), 40.f)) + 1.0f; const float inv = __builtin_amdgcn_rcpf(er * ei);
                const float rg = inv * ei, ig = inv * er; const float a = __expf(-c8 * rg);
                av[q2][r] = a; uv[q2][r] = __builtin_amdgcn_sqrtf(fmaxf(1.0f - a * a, 0.f)) * ig * xc; }
            float Al = 1.f, Ul = 0.f;
#pragma unroll
            for (int rr = 0; rr < 4; ++rr) { const int r = dir ? 3 - rr : rr; Ul = av[q2][r] * Ul + uv[q2][r]; Al = av[q2][r] * Al; }
            float am = 1.f, um = 0.f;
#pragma unroll
            for (int gq = 0; gq < 4; ++gq) { Ag[q2][gq] = __shfl(Al, col + 16 * gq); Ug[q2][gq] = __shfl(Ul, col + 16 * gq); }
#pragma unroll
            for (int gi = 0; gi < 4; ++gi) { const int gq = dir ? 3 - gi : gi; um = Ag[q2][gq] * um + Ug[q2][gq]; am = Ag[q2][gq] * am; }
            Am[q2] = am; Um[q2] = um;
        }
        if (g4 == 0) AGG[w * 16 + col] = (f32x2){Am[0] * Am[1], Am[1] * Um[0] + Um[1]};
        __syncthreads();
        float h = hchunk, hin = hchunk;
#pragma unroll
        for (int wi = 0; wi < 8; ++wi) { const int ww = dir ? 7 - wi : wi; const f32x2 au = AGG[ww * 16 + col]; if (ww == w) hin = h; h = au.x * h + au.y; }
        hchunk = h;
        float hrun = hin;
#pragma unroll
        for (int q2 = 0; q2 < 2; ++q2) {
            const int m = dir ? 2 * w + 1 - q2 : 2 * w + q2;
            float hg = hrun, hmy = hrun;
#pragma unroll
            for (int gi = 0; gi < 4; ++gi) { const int gq = dir ? 3 - gi : gi; if (gq == g4) hmy = hg; hg = Ag[q2][gq] * hg + Ug[q2][gq]; }
            hrun = hg;
            float hh = hmy;
#pragma unroll
            for (int rr = 0; rr < 4; ++rr) { const int r = dir ? 3 - rr : rr; hh = av[q2][r] * hh + uv[q2][r];
                *(LAS unsigned short*)(OUT + (16 * m + 4 * g4 + r) * 32 + col * 2) = (unsigned short)f2bf(hh); }
        }
        if (s + 1 < 33) lstore();
    }
    __syncthreads();
    { const int cprev = dir ? 0 : 31; *(u32x4*)(hout + (size_t)cprev * 4096 + tid * 8) = *(const LAS u32x4*)(OUT + tid * 16); }
}
__device__ __forceinline__ void lru_combine(const bf16* hf, const bf16* hb  , int c, const bf16* grp  , bf16* ar  , int tid) {
#pragma unroll
    for (int i = 0; i < 8; ++i) { const int it = tid + 512 * i, t = it >> 4, j8 = it & 15; const size_t ho = (size_t)(j8 >> 1) * (32 * 4096) + (size_t)c * 4096 + t * 16 + (j8 & 1) * 8;
        float a[8], b[8], g[8]; unpack8(__builtin_nontemporal_load((const u32x4*)(hf + ho)), a); unpack8(__builtin_nontemporal_load((const u32x4*)(hb + ho)), b); unpack8(*(const u32x4*)(grp + (size_t)t * ZLD + 8 * j8), g);
        u32x4 o; o.x = pk2((a[0] + b[0]) * gelu_tanh(g[0]), (a[1] + b[1]) * gelu_tanh(g[1])); o.y = pk2((a[2] + b[2]) * gelu_tanh(g[2]), (a[3] + b[3]) * gelu_tanh(g[3]));
        o.z = pk2((a[4] + b[4]) * gelu_tanh(g[4]), (a[5] + b[5]) * gelu_tanh(g[5])); o.w = pk2((a[6] + b[6]) * gelu_tanh(g[6]), (a[7] + b[7]) * gelu_tanh(g[7]));
        *(u32x4*)(ar + (size_t)t * 3072 + 8 * j8) = o; }
}

__device__ __forceinline__ void kvs_unit(LAS unsigned char* lds, const bf16* kctx, const bf16* vctx, const bf16* klat, const bf16* vlat, int dir, int part, float lg, bf16* st) {
    const int tid = opaque_tid(), lane = tid & 63, w = __builtin_amdgcn_readfirstlane(tid >> 6);
    const float l2g = lg * 1.4426950408889634f, cdec = __expf(128.0f * lg);
    const int h = lane >> 5, blk = (lane >> 4) & 1, q = (lane & 15) >> 2, p = lane & 3;
    float wj[4];
#pragma unroll
    for (int i = 0; i < 4; ++i) { const int j = (tid + 512 * i) >> 4; wj[i] = exp2f(l2g * (float)(dir ? j : 127 - j)); }
    f32x16 acc;
#pragma unroll
    for (int r = 0; r < 16; ++r) acc[r] = 0.f;
    u32x4 kq[4][4], vq[4];
    LAS unsigned char* SX = lds + 131072;
    auto src = [&](int s, const bf16*& kp, const bf16*& vp, int& ld) {
        if (s < 2) { const int cc = dir ? 1 - s : s; kp = kctx + (size_t)cc * 128 * ZC_LD; vp = vctx + (size_t)cc * 128 * ZC_LD; ld = ZC_LD; }
        else { const int c = dir ? 65 - s : s - 2; kp = klat + (size_t)c * 128 * ZLD; vp = vlat + (size_t)c * 128 * ZLD; ld = ZLD; } };
    auto gload = [&](int s, u32x4 (&kk)[4], u32x4& vv) { const bf16* kp; const bf16* vp; int ld; src(s, kp, vp, ld);
#pragma unroll
        for (int i = 0; i < 4; ++i) { const int idx = tid + 512 * i, j = idx >> 4, chn = idx & 15; kk[i] = *(const u32x4*)(kp + (size_t)j * ld + 8 * chn); }
        vv = *(const u32x4*)(vp + (size_t)(tid >> 2) * ld + 32 * part + 8 * (tid & 3)); };
    auto lstore = [&](int buf, const u32x4 (&kk)[4], const u32x4& vv) { LAS unsigned char* KB = lds + buf * 65536; LAS unsigned char* VB = KB + 32768;
#pragma unroll
        for (int i = 0; i < 4; ++i) { const int idx = tid + 512 * i, j = idx >> 4, chn = idx & 15; float kv[8]; unpack8(kk[i], kv); const float ww = wj[i];
            u32x4 o; o.x = pk2(kv[0] * ww, kv[1] * ww); o.y = pk2(kv[2] * ww, kv[3] * ww); o.z = pk2(kv[4] * ww, kv[5] * ww); o.w = pk2(kv[6] * ww, kv[7] * ww);
            *(LAS u32x4*)(KB + offb(j, chn)) = o; }
        *(LAS u32x4*)(VB + offb(tid >> 2, tid & 3)) = vv; };
    auto copyout = [&](int sprev) { const int c = dir ? 65 - sprev : sprev - 2;
        const u32x4 o = *(const LAS u32x4*)(SX + (sprev & 1) * 8704 + (tid >> 4) * 272 + (tid & 15) * 16);
        *(u32x4*)(st + (size_t)(c * 2 + dir) * 32768 + (size_t)(32 * part) * 128 + tid * 8) = o; };
    auto step = [&](int s, auto SETC, auto LOADC, auto STAGEC, auto COPYC) {
        constexpr int sp = decltype(SETC)::value;
        if constexpr (decltype(LOADC)::value) gload(s + 3, kq[(sp + 3) & 3], vq[(sp + 3) & 3]);
        if constexpr (decltype(COPYC)::value) copyout(s - 1);
        if (w < 4) {
            if constexpr (decltype(STAGEC)::value) { LAS unsigned char* sx = SX + (s & 1) * 8704 + (lane & 31) * 272 + (32 * w + 4 * h) * 2;
#pragma unroll
                for (int rg = 0; rg < 4; ++rg) { u32x2 o; o.x = pk2(acc[4 * rg], acc[4 * rg + 1]); o.y = pk2(acc[4 * rg + 2], acc[4 * rg + 3]); *(LAS u32x2*)(sx + 16 * rg) = o; } }
#pragma unroll
            for (int r = 0; r < 16; ++r) acc[r] *= cdec;
            const LAS unsigned char* KB = lds + (s & 1) * 65536; const LAS unsigned char* VB = KB + 32768;
#pragma unroll
            for (int ks = 0; ks < 8; ++ks) {
                const unsigned r0 = 16 * ks + 8 * h + q, r1 = r0 + 4;
                const bf16x8 bv = __builtin_shufflevector(trd(VB + offb(r0, 2 * blk + (p >> 1)) + 8 * (p & 1)), trd(VB + offb(r1, 2 * blk + (p >> 1)) + 8 * (p & 1)), 0, 1, 2, 3, 4, 5, 6, 7);
                const bf16x8 ak = __builtin_shufflevector(trd(KB + offb(r0, 4 * w + 2 * blk + (p >> 1)) + 8 * (p & 1)), trd(KB + offb(r1, 4 * w + 2 * blk + (p >> 1)) + 8 * (p & 1)), 0, 1, 2, 3, 4, 5, 6, 7);
                acc = MFMA32(ak, bv, acc);
            }
        }
        if (s + 1 < 66) lstore((s + 1) & 1, kq[(sp + 1) & 3], vq[(sp + 1) & 3]);
        __syncthreads();
    };
    using std::integral_constant; typedef integral_constant<bool, true> T_; typedef integral_constant<bool, false> F_;
    __syncthreads();
    gload(0, kq[0], vq[0]); gload(1, kq[1], vq[1]); gload(2, kq[2], vq[2]); lstore(0, kq[0], vq[0]);
    __syncthreads();
    step(0, integral_constant<int, 0>{}, T_{}, F_{}, F_{});
    step(1, integral_constant<int, 1>{}, T_{}, F_{}, F_{});
    step(2, integral_constant<int, 2>{}, T_{}, T_{}, F_{});
#pragma unroll 1
    for (int s4 = 3; s4 < 63; s4 += 4) {
        step(s4 + 0, integral_constant<int, 3>{}, T_{}, T_{}, T_{});
        step(s4 + 1, integral_constant<int, 0>{}, T_{}, T_{}, T_{});
        step(s4 + 2, integral_constant<int, 1>{}, T_{}, T_{}, T_{});
        step(s4 + 3, integral_constant<int, 2>{}, T_{}, T_{}, T_{});
    }
    step(63, integral_constant<int, 3>{}, F_{}, T_{}, T_{});
    step(64, integral_constant<int, 0>{}, F_{}, T_{}, T_{});
    step(65, integral_constant<int, 1>{}, F_{}, T_{}, T_{});
    copyout(65);
}

__device__ __forceinline__ void ro_unit(LAS unsigned char* lds, const bf16* qsrc, const bf16* ksrc, const bf16* vsrc, const bf16* gsp, bf16* gout, const bf16* Sf, const bf16* Sb, float l2g, int skip = 0) {
    const int tid = opaque_tid(), lane = tid & 63, w = __builtin_amdgcn_readfirstlane(tid >> 6), wi = w & 3, wv = w >> 2;
    LAS unsigned char* SF = lds; LAS unsigned char* SB = lds + 65536;
    LAS unsigned char* KI = lds; LAS unsigned char* VI = lds + 32768; LAS float* STATS = (LAS float*)(lds + 135168);
    const int h = lane >> 5, l31 = lane & 31, blk = (lane >> 4) & 1, q = (lane & 15) >> 2, p = lane & 3;
    __syncthreads();
    if (!(skip & 1)) {   u32x4 sf[8], sb[8];
#pragma unroll
        for (int i = 0; i < 8; ++i) { const int idx = tid + 512 * i; sf[i] = __builtin_nontemporal_load((const u32x4*)(Sf + (size_t)idx * 8)); sb[i] = __builtin_nontemporal_load((const u32x4*)(Sb + (size_t)idx * 8)); }
#pragma unroll
        for (int i = 0; i < 8; ++i) { const int idx = tid + 512 * i, v = idx >> 4, chn = idx & 15; *(LAS u32x4*)(SF + offb(v, chn)) = sf[i]; *(LAS u32x4*)(SB + offb(v, chn)) = sb[i]; }
    }
    bf16x8 qf[8];
#pragma unroll
    for (int s = 0; s < 8; ++s) qf[s] = *(const bf16x8*)(qsrc + (size_t)(32 * wi + l31) * ZLD + 16 * s + 8 * h);
    u32x4 kreg[4], vreg[8];
#pragma unroll
    for (int i = 0; i < 4; ++i) { const int idx = tid + 512 * i, j = idx >> 4, chn = idx & 15; kreg[i] = __builtin_nontemporal_load((const u32x4*)(ksrc + (size_t)j * ZLD + 8 * chn)); }
#pragma unroll
    for (int i = 0; i < 8; ++i) { const int idx = tid + 512 * i, j = idx >> 5, chn = idx & 31; vreg[i] = __builtin_nontemporal_load((const u32x4*)(vsrc + (size_t)j * ZLD + 8 * chn)); }
    __syncthreads();
    f32x16 z[4];
#pragma unroll
    for (int c = 0; c < 4; ++c)
#pragma unroll
        for (int r = 0; r < 16; ++r) z[c][r] = 0.f;
    if (!(skip & 1)) {
#pragma unroll
    for (int s = 0; s < 8; ++s)
#pragma unroll
        for (int c = 0; c < 4; ++c) { const bf16x8 bs = *(const LAS bf16x8*)(SF + offb(128 * wv + 32 * c + l31, 2 * s + h)); z[c] = MFMA32(qf[s], bs, z[c]); }
#pragma unroll
    for (int r = 0; r < 16; ++r) { const int i = 32 * wi + crow(r, h); const float f = exp2f(l2g * (float)(2 * i - 127));
#pragma unroll
        for (int c = 0; c < 4; ++c) z[c][r] *= f; }
#pragma unroll
    for (int s = 0; s < 8; ++s)
#pragma unroll
        for (int c = 0; c < 4; ++c) { const bf16x8 bs = *(const LAS bf16x8*)(SB + offb(128 * wv + 32 * c + l31, 2 * s + h)); z[c] = MFMA32(qf[s], bs, z[c]); }
#pragma unroll
    for (int r = 0; r < 16; ++r) { const int i = 32 * wi + crow(r, h); const float f = exp2f(l2g * (float)(128 - i));
#pragma unroll
        for (int c = 0; c < 4; ++c) z[c][r] *= f; }
    }
    __syncthreads();
#pragma unroll
    for (int i = 0; i < 4; ++i) { const int idx = tid + 512 * i, j = idx >> 4, chn = idx & 15; *(LAS u32x4*)(KI + offb(j, chn)) = kreg[i]; }
#pragma unroll
    for (int i = 0; i < 8; ++i) { const int idx = tid + 512 * i, j = idx >> 5, chn = idx & 31; *(LAS u32x4*)(VI + (chn >> 4) * 32768 + offb(j, chn & 15)) = vreg[i]; }
    __syncthreads();
    const LAS unsigned char* Vimg = VI + wv * 32768;
    u32x4 gsq[8];
#pragma unroll
    for (int i = 0; i < 8; ++i) { const int idx = tid + 512 * i, r = idx >> 5, chn = idx & 31; gsq[i] = __builtin_nontemporal_load((const u32x4*)(gsp + (size_t)r * ZLD + 8 * chn)); }
    if (!(skip & 2))
#pragma unroll
    for (int jt = 0; jt < 4; ++jt) {
        f32x16 x;
#pragma unroll
        for (int r = 0; r < 16; ++r) x[r] = 0.f;
#pragma unroll
        for (int s = 0; s < 8; ++s) { const bf16x8 ak = *(const LAS bf16x8*)(KI + offb(32 * jt + l31, 2 * s + h)); x = MFMA32(ak, qf[s], x); }
        const int ii = 32 * wi + l31;
#pragma unroll
        for (int r = 0; r < 16; ++r) { const int jj = 32 * jt + crow(r, h); const int dd = ii > jj ? ii - jj : jj - ii; x[r] *= exp2f(l2g * (float)dd); }
#pragma unroll
        for (int s2 = 0; s2 < 2; ++s2) {
            u32x4 pw; pw.x = pk2(x[8 * s2], x[8 * s2 + 1]); pw.y = pk2(x[8 * s2 + 2], x[8 * s2 + 3]); pw.z = pk2(x[8 * s2 + 4], x[8 * s2 + 5]); pw.w = pk2(x[8 * s2 + 6], x[8 * s2 + 7]);
            const bf16x8 xs = __builtin_bit_cast(bf16x8, pw);
            const unsigned r0 = 32 * jt + 16 * s2 + 4 * h + q, r1 = r0 + 8;
#pragma unroll
            for (int c = 0; c < 4; ++c) {
                const s16x4 v0 = trd(Vimg + offb(r0, 4 * c + 2 * blk + (p >> 1)) + 8 * (p & 1)), v1 = trd(Vimg + offb(r1, 4 * c + 2 * blk + (p >> 1)) + 8 * (p & 1));
                const bf16x8 pb = __builtin_shufflevector(v0, v1, 0, 1, 2, 3, 4, 5, 6, 7);
                z[c] = MFMA32(xs, pb, z[c]);
            }
        }
#pragma unroll
        for (int i2 = 0; i2 < 2; ++i2) { const int i = 2 * jt + i2; float gv[8]; unpack8(gsq[i], gv);
#pragma unroll
            for (int j = 0; j < 8; ++j) gv[j] = gv[j] * sigmoidf_(gv[j]);
            gsq[i].x = pk2(gv[0], gv[1]); gsq[i].y = pk2(gv[2], gv[3]); gsq[i].z = pk2(gv[4], gv[5]); gsq[i].w = pk2(gv[6], gv[7]); }
    }
#pragma unroll
    for (int r = 0; r < 16; ++r) { float s1 = (z[0][r] + z[1][r]) + (z[2][r] + z[3][r]); float s2 = (z[0][r] * z[0][r] + z[1][r] * z[1][r]) + (z[2][r] * z[2][r] + z[3][r] * z[3][r]);
        s1 = row16_sum(s1); s2 = row16_sum(s2);
        s1 += __shfl_xor(s1, 16); s2 += __shfl_xor(s2, 16);
        if (l31 == 0) { STATS[((wi * 2 + wv) * 32 + crow(r, h)) * 2] = s1; STATS[((wi * 2 + wv) * 32 + crow(r, h)) * 2 + 1] = s2; } }
    __syncthreads();
#pragma unroll
    for (int r = 0; r < 16; ++r) { const int il = crow(r, h);
        const float s1 = STATS[((wi * 2 + 0) * 32 + il) * 2] + STATS[((wi * 2 + 1) * 32 + il) * 2], s2 = STATS[((wi * 2 + 0) * 32 + il) * 2 + 1] + STATS[((wi * 2 + 1) * 32 + il) * 2 + 1];
        const float mean = s1 * (1.0f / 256.0f); const float var = fmaxf(s2 * (1.0f / 256.0f) - mean * mean, 0.f); const float rstd = __builtin_amdgcn_rsqf(var + EPS);
#pragma unroll
        for (int c = 0; c < 4; ++c) *(LAS unsigned short*)(lds + (32 * wi + il) * 528 + (128 * wv + 32 * c + l31) * 2) = (unsigned short)f2bf((z[c][r] - mean) * rstd); }
    __syncthreads();
    if (!(skip & 4))
#pragma unroll
    for (int i = 0; i < 8; ++i) { const int idx = tid + 512 * i, r = idx >> 5, chn = idx & 31; float ov[8], gv[8];
        unpack8(*(const LAS u32x4*)(lds + r * 528 + chn * 16), ov); unpack8(gsq[i], gv); bf16* gp = gout + (size_t)r * 3072 + 8 * chn;
        u32x4 o; o.x = pk2(ov[0] * gv[0], ov[1] * gv[1]); o.y = pk2(ov[2] * gv[2], ov[3] * gv[3]); o.z = pk2(ov[4] * gv[4], ov[5] * gv[5]); o.w = pk2(ov[6] * gv[6], ov[7] * gv[7]);
        *(u32x4*)gp = o; }
}

struct Args { const float* in[26]; float* out; unsigned char* ws; int lo, hi; };
enum { I_X = 0, I_C, I_CTX, I_CCTX, I_ADAW, I_ADAB, I_N1G, I_WIN, I_CONVW, I_CONVB, I_WA, I_BA, I_WX, I_BX, I_LAM, I_WRNN, I_WRET, I_WOUT, I_N2G, I_RW, I_RB, I_W1, I_B1, I_W2, I_B2, I_FG };
constexpr int ST_GRP = 3, ST_M0 = 27, ST_M1 = 28, ST_RNG = 29, ST_END = ST_RNG + 3 * NRANGE;

__global__ void __launch_bounds__(NTHR, 2) fwd_kernel(Args args) {
    extern __shared__ __attribute__((aligned(16))) unsigned char lds_raw[];
    LAS unsigned char* lds = (LAS unsigned char*)lds_raw;
    const int tid = threadIdx.x, lane = tid & 63, wave = __builtin_amdgcn_readfirstlane(tid >> 6);
    const int G = gridDim.x, bid = blockIdx.x;
    const int gw = bid * NWAVES + wave, NGW = G * NWAVES;
    unsigned char* ws = args.ws;
    volatile LAS unsigned* MISC = (volatile LAS unsigned*)(lds + MISC_OFF);
    if (tid < 64) MISC[tid] = 0u;
    __syncthreads();
    const int lo = args.lo, hi = args.hi;
    XcdBarrier bar; bar.bar = (unsigned*)(ws + WS_CTL) + CW_BAR; bar.x = 0; bar.st = nullptr;
    if (!MK_PER_PHASE) bar = xcd_barrier_post((unsigned*)(ws + WS_CTL) + CW_BAR, MISC);
#define IN(k) (lo <= (k) && (k) < hi)
#define SEAM(k) do { if (IN(k) && IN((k) + 1)) xcd_barrier(bar); } while (0)
#if MK_PROBE
    unsigned long long t_last = wall_clock64();
#define STAMP(kind) do { if (bid == 0 && threadIdx.x == 0) { const unsigned long long t_ = wall_clock64(); MISC[16 + (kind)] += (unsigned)(t_ - t_last); t_last = t_; } } while (0)
#else
#define STAMP(kind) do { } while (0)
#endif

    float* mod = (float*)(ws + WS_MOD);
    f32x2* rope = (f32x2*)(ws + WS_ROPE);
    f32x2* carry = (f32x2*)(ws + WS_CARRY); bf16* RWB = (bf16*)(ws + WS_RWB);
    bf16* WG = (bf16*)(ws + WS_WG); bf16* WRNN = (bf16*)(ws + WS_WRNN); bf16* WOUT = (bf16*)(ws + WS_WOUT); bf16* WRET = WRNN + 1024; bf16* WIN = (bf16*)(ws + WS_WIN);
    bf16* HL = (bf16*)(ws + WS_HL); bf16* ZC = (bf16*)(ws + WS_ZC); bf16* CTXU = (bf16*)(ws + WS_CTXU); bf16* Z = (bf16*)(ws + WS_Z); bf16* STB = (bf16*)(ws + WS_ST);
    bf16* T1 = (bf16*)(ws + WS_T1); bf16* MG = (bf16*)(ws + WS_MG);
    bf16* W1T = (bf16*)(ws + WS_W1T); bf16* W2T = (bf16*)(ws + WS_W2T); bf16* HPAD = (bf16*)(ws + WS_HPAD); bf16* HID = (bf16*)(ws + WS_HID); bf16* YPAD = (bf16*)(ws + WS_YPAD);
    float* WRNNS = (float*)(ws + WS_WFS); float* WRETS = WRNNS + 1024; float* WOUTS = WRNNS + 2048; float* W2S = WRNNS + 4096;
    bf16* AR = (bf16*)(ws + WS_AR); bf16* AT = (bf16*)(ws + WS_AT);
    bf16* XCB = T1; bf16* XCC = CTXU;
    bf16* HDF = MG; bf16* HDB = (bf16*)(ws + 880 * MiB);
    float* HLS = (float*)(ws + WS_HLS); float* WINS = (float*)(ws + WS_WINS); float* W1S = (float*)(ws + WS_W1S); float* HPS = (float*)(ws + WS_HPS);
    int* ROWTOK = (int*)(ws + WS_HPAD);
    int* EIDX = (int*)(ws + WS_EIDX); float* GATE = (float*)(ws + WS_GATE); int* LPOS = (int*)(ws + WS_LPOS); int* AROW = (int*)(ws + WS_AROW);
    int* BCNT = (int*)(ws + WS_BCNT); int* BBASE = (int*)(ws + WS_BBASE); int* TILEE = (int*)(ws + WS_TILEE); int* NTILE = (int*)(ws + WS_NTILE);

    if (PH_EN(0) && IN(0)) for (int rep = 0; rep < DUP_N(0); ++rep) {
        const int tid = opaque_tid(), lane = tid & 63, wave = __builtin_amdgcn_readfirstlane(tid >> 6), gw = bid * NWAVES + wave; (void)lane; (void)gw; (void)rep;
        if (bid < 96) {
            LAS float* sc = (LAS float*)lds;
            LAS float* red = (LAS float*)(lds + 40960);
            for (int i = tid; i < 9 * 1024; i += NTHR) { const int r = i >> 10, k = i & 1023; const float v = r < 8 ? args.in[I_C][r * 1024 + k] : args.in[I_CCTX][k]; sc[i] = v * sigmoidf_(v); }
            __syncthreads();
            const int n0 = bid * 64; float a9[9];
#pragma unroll
            for (int r = 0; r < 9; ++r) a9[r] = 0.f;
            for (int k = wave * 128; k < wave * 128 + 128; ++k) { const float wv = args.in[I_ADAW][(size_t)k * 6144 + n0 + lane];
#pragma unroll
                for (int r = 0; r < 9; ++r) a9[r] += sc[r * 1024 + k] * wv; }
#pragma unroll
            for (int r = 0; r < 9; ++r) red[(wave * 9 + r) * 64 + lane] = a9[r];
            __syncthreads();
            for (int i = tid; i < 9 * 64; i += NTHR) { const int r = i >> 6, l = i & 63; float s = 0.f;
#pragma unroll
                for (int w8 = 0; w8 < 8; ++w8) s += red[(w8 * 9 + r) * 64 + l];
                mod[r * 6144 + n0 + l] = s + args.in[I_ADAB][n0 + l]; }
            __syncthreads();
        }
        if (bid == 97 % G) {
            for (int i = tid; i < 32 * 1024; i += NTHR) { const int d = i >> 5, e = i & 31; const float wv = args.in[I_RW][i]; const unsigned hi = f2bf(wv); const float rem = wv - bf2f((unsigned short)hi);
                RWB[e * 1024 + d] = (bf16)hi; RWB[32 * 1024 + e * 1024 + d] = (bf16)f2bf(rem); }
        }
        if (bid == 96) {
            for (int i = tid; i < 128 * 32; i += NTHR) { const int pos = i >> 5, f = i & 31; const float inv = powf(10000.0f, -(float)f / 32.0f); const float ang = (float)pos * inv; float s, c; sincosf(ang, &s, &c); rope[i] = (f32x2){c, s}; }
        }
        {
            LAS float* L = (LAS float*)(lds + 65536); LAS unsigned* CM = (LAS unsigned*)(lds + 65536 + 66048); LAS unsigned* TL = (LAS unsigned*)lds;
            for (int it = bid; it < 848; it += G) {
                if (it < 80) tr_strip_i8<false>(args.in[I_WIN] + it * 128, DIN, 1024, (signed char*)WIN + (size_t)it * 128 * 1024, 1024, WINS + it * 128, tid, TL, CM);
                else if (it < 592) { const int s = it - 80, e = s >> 4, nt = s & 15; tr_strip_i8<false>(args.in[I_W1] + (size_t)e * 1024 * 2048 + nt * 128, 2048, 1024, (signed char*)W1T + ((size_t)e * 2048 + nt * 128) * 1024, 1024, W1S + e * 2048 + nt * 128, tid, TL, CM); }
                else { const int s = it - 592, e = s >> 3, nt = s & 7; tr_strip_i8<true>(args.in[I_W2] + (size_t)e * 1024 * 1024 + nt * 128, 1024, 1024, (signed char*)W2T + ((size_t)e * 1024 + nt * 128) * 1024, 1024, W2S + e * 1024 + nt * 128, tid, TL, CM); }
            }
            constexpr int NT_ALL = 64 + 128 + 64 + 32;
            auto desc = [&](int it) -> TrTile { TrTile t;
                if (it < 64) { const int kt = it >> 3, nt = it & 7; t.src = args.in[I_WRNN] + (size_t)kt * 128 * 1024 + nt * 128; t.ldw = 1024; t.dst = WRNN + (size_t)nt * 128 * 3072 + kt * 128; t.ldt = 3072; return t; }
                it -= 64;
                if (it < 128) { const int kt = it >> 3, nt = it & 7; t.src = args.in[I_WRET] + (size_t)kt * 128 * 1024 + nt * 128; t.ldw = 1024; t.dst = WRET + (size_t)nt * 128 * 3072 + kt * 128; t.ldt = 3072; return t; }
                it -= 128;
                if (it < 64) { const int kt = it >> 3, nt = it & 7; t.src = args.in[I_WOUT] + (size_t)kt * 128 * 1024 + nt * 128; t.ldw = 1024; t.dst = WOUT + (size_t)nt * 128 * 1024 + kt * 128; t.ldt = 1024; return t; }
                it -= 64;
                { const int q = it & 3, n = it >> 2; const int dir = q >> 1, typ = q & 1;
                  t.src = (typ ? args.in[I_WX] : args.in[I_WA]) + (size_t)(dir * 8 + n) * 128 * 128; t.ldw = 128; t.dst = WG + (size_t)(n * 4 + q) * 128 * 128; t.ldt = 128; return t; } };
            f32x4 v[8];
            int it = NT_ALL - 1 - ((bid + 80) % G);
            if (it >= 0) { const TrTile t0 = desc(it); tr_load(t0, tid, v); }
            while (it >= 0) {
                const TrTile tc = desc(it); const int nx = it - G;
                f32x4 w[8];
#pragma unroll
                for (int i = 0; i < 8; ++i) w[i] = v[i];
                if (nx >= 0) { const TrTile tn = desc(nx); tr_load(tn, tid, v); }
                tr_store(tc, tid, w, L);
                it = nx;
            }
        }
    }
    SEAM(0); STAMP(0);
    if (PH_EN(1) && IN(1)) for (int rep = 0; rep < DUP_N(1); ++rep) {
        const int tid = opaque_tid(), lane = tid & 63, wave = __builtin_amdgcn_readfirstlane(tid >> 6), gw = bid * NWAVES + wave; (void)lane; (void)gw; (void)rep;
        auto rowsrc = [&](int m) { return (const f32x4*)(m < NTOK ? args.in[I_X] + (size_t)m * D : args.in[I_CTX] + (size_t)(m - NTOK) * D) + lane; };
        f32x4 nx[4];
        if (gw < NROWS_HL) { const f32x4* xr = rowsrc(gw);
#pragma unroll
            for (int j = 0; j < 4; ++j) nx[j] = xr[64 * j]; }
#pragma unroll 1
        for (int m = gw; m < NROWS_HL; m += NGW) {
            const int r = m < NTOK ? (m >> 13) : 8;
            f32x4 v[4]; float ss = 0.f;
#pragma unroll
            for (int j = 0; j < 4; ++j) v[j] = nx[j];
            if (m + NGW < NROWS_HL) { const f32x4* xr = rowsrc(m + NGW);
#pragma unroll
                for (int j = 0; j < 4; ++j) nx[j] = xr[64 * j]; }
#pragma unroll
            for (int j = 0; j < 4; ++j) ss += (v[j].x * v[j].x + v[j].y * v[j].y) + (v[j].z * v[j].z + v[j].w * v[j].w);
            const float rstd = 1.0f / sqrtf(wave_sum(ss) * (1.0f / D) + EPS);
            float am = 0.f;
#pragma unroll
            for (int j = 0; j < 4; ++j) { const int c0 = 4 * lane + 256 * j; const f32x4 gn = *(const f32x4*)(args.in[I_N1G] + c0), sh = *(const f32x4*)(mod + r * 6144 + c0), sc = *(const f32x4*)(mod + r * 6144 + 1024 + c0);
                v[j] = (v[j] * rstd * gn) * (sc + 1.0f) + sh; am = fmaxf(fmaxf(am, fmaxf(fabsf(v[j].x), fabsf(v[j].y))), fmaxf(fabsf(v[j].z), fabsf(v[j].w))); }
            am = wave_max(am); const float inv = am > 0.f ? 127.0f / am : 0.f;
            if (lane == 0) HLS[m] = am > 0.f ? am * (1.0f / 127.0f) : 1.0f;
            unsigned* o4 = (unsigned*)((signed char*)HL + (size_t)m * D) + lane;
#pragma unroll
            for (int j = 0; j < 4; ++j) o4[64 * j] = q8x4(v[j], inv);
        }
    }
    SEAM(1); STAMP(1);
    if (PH_EN(2) && IN(2)) for (int rep = 0; rep < DUP_N(2); ++rep) {
        const int tid = opaque_tid(), lane = tid & 63, wave = __builtin_amdgcn_readfirstlane(tid >> 6), gw = bid * NWAVES + wave; (void)lane; (void)gw; (void)rep;
        pg8::Gemm g{HL, WIN, 512, 512, 512, HLS, WINS, nullptr}; pg8::CtxOrder S{G, bid}; EpiCtx E{ZC};
        pg8::gemm_phase<EpiCtx, pg8::CtxOrder, 1>(lds, g, S, E);
    }
    SEAM(2); STAMP(2);
    for (int grp = 0; grp < NGRP; ++grp) {
        const int s0 = ST_GRP + 6 * grp;
        if (PH_EN(3) && IN(s0 + 0)) for (int rep = 0; rep < DUP_N(3); ++rep) {
        const int tid = opaque_tid(), lane = tid & 63, wave = __builtin_amdgcn_readfirstlane(tid >> 6), gw = bid * NWAVES + wave; (void)lane; (void)gw; (void)rep;
            pg8::Gemm g{HL + (size_t)grp * GROWS * 512, WIN, 512, 512, 512, HLS + grp * GROWS, WINS, nullptr}; pg8::StaticOrder S; S.init(GROWS / 256, DIN / 256, G, bid); EpiIn E{Z, rope, DRY(3) ? 1 : 0};
            STAGGER(STAG_B); pg8::gemm_phase<EpiIn, pg8::StaticOrder, 1>(lds, g, S, E);
        }
        SEAM(s0 + 0); STAMP(3);
        if (PH_EN(4) && IN(s0 + 1)) for (int rep = 0; rep < DUP_N(4); ++rep) {
        const int tid = opaque_tid(), lane = tid & 63, wave = __builtin_amdgcn_readfirstlane(tid >> 6), gw = bid * NWAVES + wave; (void)lane; (void)gw; (void)rep;
            for (int u = bid; u < GB * 8 * 2 * 8; u += G) { const int hd = u & 7, y = u >> 3, bl = y >> 4, dir = (y >> 3) & 1, part = y & 7; const int b = grp * GB + bl;
                const float lg = log1pf(-exp2f(-5.0f - (float)hd));
                const bf16* zc = ZC + (size_t)(b * CTXL) * ZC_LD; const bf16* zl = Z + (size_t)(bl * SEQ) * ZLD;
                kvs_unit(lds, zc + ZC_K + hd * 128, zc + ZC_V + hd * 256, zl + C_K + hd * 128, zl + C_V + hd * 256, dir, part, lg, STB + (size_t)((bl * 8 + hd) * 64) * 2 * 32768); }
            LruP LP{args.in[I_CONVW], args.in[I_CONVB], args.in[I_BA], args.in[I_BX], args.in[I_LAM], WG, carry};
            xc_rows(LP, Z + C_XR, ZLD, 13, GROWS, XCB, bid * NTHR + tid, G * NTHR);
            if (grp == 0) xc_rows(LP, ZC + ZC_XR, ZC_LD, 8, NCTX, XCC, bid * NTHR + tid, G * NTHR);
        }
        SEAM(s0 + 1); STAMP(4);
        if (PH_EN(5) && IN(s0 + 2)) for (int rep = 0; rep < DUP_N(5); ++rep) {
        const int tid = opaque_tid(), lane = tid & 63, wave = __builtin_amdgcn_readfirstlane(tid >> 6), gw = bid * NWAVES + wave; (void)lane; (void)gw; (void)rep;
            LruP LP{args.in[I_CONVW], args.in[I_CONVB], args.in[I_BA], args.in[I_BX], args.in[I_LAM], WG, carry};
            for (int u = bid; u < GB * 8 * 8 * 2; u += G) { const int n = u & 7, bl = (u >> 3) & 1, y = u >> 4, dir = y & 1, sub = y >> 1;
                bf16* hb_ = (dir ? HDB : HDF) + (size_t)((bl * 8 + n) * 8 + sub) * (32 * 4096);
                lru_sweep(lds, LP, n, sub, dir, XCB + (size_t)(bl * SEQ) * 1024, XCC + (size_t)((grp * GB + bl) * CTXL) * 1024, hb_); }
        }
        SEAM(s0 + 2); STAMP(5);
        if (PH_EN(6) && IN(s0 + 3)) for (int rep = 0; rep < DUP_N(6); ++rep) {
        const int tid = opaque_tid(), lane = tid & 63, wave = __builtin_amdgcn_readfirstlane(tid >> 6), gw = bid * NWAVES + wave; (void)lane; (void)gw; (void)rep;
            for (int u = bid; u < GB * 64 * 8; u += G) { const int hd = u & 7, c = (u >> 3) & 63, bl = u >> 9; const float l2g = log1pf(-exp2f(-5.0f - (float)hd)) * 1.4426950408889634f;
                bf16* zr = Z + (size_t)(bl * SEQ + c * 128) * ZLD; const bf16* sp = STB + (size_t)(((bl * 8 + hd) * 64 + c) * 2) * 32768;
                ro_unit(lds, zr + C_Q + hd * 128, zr + C_K + hd * 128, zr + C_V + hd * 256, zr + C_GS + hd * 256, AR + (size_t)(bl * SEQ + c * 128) * 3072 + 1024 + hd * 256, sp, sp + 32768, l2g, DRY(6) ? (MK_DRYMODE >= 8 ? MK_DRYMODE - 8 : 0) : 0); }
            if (!(DRY(6) && MK_DRYMODE >= 8))
            for (int u = bid; u < GB * 32 * 8; u += G) { const int n = u & 7, c = (u >> 3) & 31, bl = u >> 8; const size_t ub = (size_t)((bl * 8 + n) * 8) * (32 * 4096);
                lru_combine(HDF + ub, HDB + ub, c, Z + (size_t)(bl * SEQ + c * 256) * ZLD + C_GR + 128 * n, AR + (size_t)(bl * SEQ + c * 256) * 3072 + 128 * n, tid); }
        }
        SEAM(s0 + 3); STAMP(6);
        if (PH_EN(7) && IN(s0 + 4)) for (int rep = 0; rep < DUP_N(7); ++rep) {
        const int tid = opaque_tid(), lane = tid & 63, wave = __builtin_amdgcn_readfirstlane(tid >> 6), gw = bid * NWAVES + wave; (void)lane; (void)gw; (void)rep;
            { pg8::Gemm g{AR, WRNN, 3072, 3072, 3072, nullptr, nullptr, nullptr}; pg8::FOrder S; S.so.init(GROWS / 256, 4, G, bid); EpiF E{Z, MG, DRY(7) ? 1 : 0};
              pg8::gemm_phase<EpiF, pg8::FOrder>(lds, g, S, E); }
        }
        SEAM(s0 + 4); STAMP(7);
        if (PH_EN(8) && IN(s0 + 5)) for (int rep = 0; rep < DUP_N(8); ++rep) {
        const int tid = opaque_tid(), lane = tid & 63, wave = __builtin_amdgcn_readfirstlane(tid >> 6), gw = bid * NWAVES + wave; (void)lane; (void)gw; (void)rep;
            pg8::Gemm g{MG, WOUT, D, D, D, nullptr, nullptr, nullptr}; pg8::StaticOrder S; S.init(GROWS / 256, 4, G, bid); EpiX1 E{args.in[I_X], args.out, mod, grp * GROWS};
            pg8::gemm_phase<EpiX1, pg8::StaticOrder>(lds, g, S, E);
        }
        if (grp == NGRP - 1) SEAM(s0 + 5);
        STAMP(8);
    }
    if (PH_EN(9) && IN(ST_M0)) for (int rep = 0; rep < DUP_N(9); ++rep) {
        const int tid = opaque_tid(), lane = tid & 63, wave = __builtin_amdgcn_readfirstlane(tid >> 6), gw = bid * NWAVES + wave; (void)lane; (void)gw; (void)rep;
        LAS unsigned char* AH = lds;
        LAS unsigned char* AL = lds + 66048;
        LAS float* RED = (LAS float*)lds;
        LAS float* LOG = (LAS float*)(lds + 32768);
        LAS int* CNT = (LAS int*)(lds + 132096 + 512);
        const int h5 = lane >> 5, l31 = lane & 31;
        bf16x8 bh[8], bl[8];
#pragma unroll
        for (int s = 0; s < 8; ++s) { bh[s] = *(const bf16x8*)(RWB + (size_t)l31 * 1024 + 128 * wave + 16 * s + 8 * h5); bl[s] = *(const bf16x8*)(RWB + 32 * 1024 + (size_t)l31 * 1024 + 128 * wave + 16 * s + 8 * h5); }
        f32x4 xv[4][4];
        auto ldtile = [&](int blk, int tile) { const int m0 = blk * 256 + tile * 32 + wave * 4;
#pragma unroll
            for (int r4 = 0; r4 < 4; ++r4)
#pragma unroll
                for (int j = 0; j < 4; ++j) xv[r4][j] = __builtin_nontemporal_load((const f32x4*)(args.out + (size_t)(m0 + r4) * D) + lane + 64 * j); };
        for (int blk = bid; blk < NTOK / 256; blk += G) {
            __syncthreads();
            if (tid < 32) CNT[tid] = 0;
            ldtile(blk, 0);
#pragma unroll 1
            for (int tile = 0; tile < 8; ++tile) {
                __syncthreads();
                const int m0 = blk * 256 + tile * 32 + wave * 4; const int b = m0 >> 13;
#pragma unroll
                for (int r4 = 0; r4 < 4; ++r4) {
                    const int m = m0 + r4; f32x4 v[4]; float ss = 0.f;
#pragma unroll
                    for (int j = 0; j < 4; ++j) { v[j] = xv[r4][j]; ss += (v[j].x * v[j].x + v[j].y * v[j].y) + (v[j].z * v[j].z + v[j].w * v[j].w); }
                    const float rstd = 1.0f / sqrtf(wave_sum(ss) * (1.0f / D) + EPS);
                    float am = 0.f;
#pragma unroll
                    for (int j = 0; j < 4; ++j) { const int c0 = 4 * lane + 256 * j; const f32x4 gn = *(const f32x4*)(args.in[I_N2G] + c0), sh = *(const f32x4*)(mod + b * 6144 + 3072 + c0), sc = *(const f32x4*)(mod + b * 6144 + 4096 + c0);
                        v[j] = (v[j] * rstd * gn) * (sc + 1.0f) + sh; am = fmaxf(fmaxf(am, fmaxf(fabsf(v[j].x), fabsf(v[j].y))), fmaxf(fabsf(v[j].z), fabsf(v[j].w))); }
                    am = wave_max(am); const float inv = am > 0.f ? 127.0f / am : 0.f;
                    if (lane == 0) HLS[m] = am > 0.f ? am * (1.0f / 127.0f) : 1.0f;
                    unsigned* o4 = (unsigned*)((signed char*)HL + (size_t)m * D) + lane;
                    const int rowl = wave * 4 + r4;
#pragma unroll
                    for (int j = 0; j < 4; ++j) { o4[64 * j] = q8x4(v[j], inv);
                        u32x2 hi; hi.x = pk2(v[j].x, v[j].y); hi.y = pk2(v[j].z, v[j].w);
                        u32x2 lo; lo.x = pk2(v[j].x - bflo(hi.x), v[j].y - bfhi(hi.x)); lo.y = pk2(v[j].z - bflo(hi.y), v[j].w - bfhi(hi.y));
                        *(LAS u32x2*)(AH + rowl * 2064 + (4 * lane + 256 * j) * 2) = hi; *(LAS u32x2*)(AL + rowl * 2064 + (4 * lane + 256 * j) * 2) = lo; }
                }
                if (tile + 1 < 8) ldtile(blk, tile + 1);
                __syncthreads();
                f32x16 acc;
#pragma unroll
                for (int r = 0; r < 16; ++r) acc[r] = 0.f;
#pragma unroll
                for (int s = 0; s < 8; ++s) { const int ko = (128 * wave + 16 * s + 8 * h5) * 2;
                    const bf16x8 ah = *(const LAS bf16x8*)(AH + l31 * 2064 + ko), al = *(const LAS bf16x8*)(AL + l31 * 2064 + ko);
                    acc = MFMA32(ah, bh[s], acc); acc = MFMA32(ah, bl[s], acc); acc = MFMA32(al, bh[s], acc); }
                __syncthreads();
#pragma unroll
                for (int r = 0; r < 16; ++r) RED[(wave * 32 + crow(r, h5)) * 32 + l31] = acc[r];
                __syncthreads();
#pragma unroll
                for (int i = 0; i < 2; ++i) { const int idx = tid + 512 * i, t = idx >> 5, e = idx & 31; float sum = args.in[I_RB][e];
#pragma unroll
                    for (int w8 = 0; w8 < 8; ++w8) sum += RED[(w8 * 32 + t) * 32 + e];
                    LOG[t * 33 + e] = sum; }
                __syncthreads();
#pragma unroll
                for (int r4 = 0; r4 < 4; ++r4) {
                    const int m = m0 + r4; float tv[4]; int ti[4]; float cur = lane < 32 ? LOG[(wave * 4 + r4) * 33 + lane] : -3.0e38f;
#pragma unroll
                    for (int k = 0; k < 4; ++k) { float mx = cur;
#pragma unroll
                        for (int o = 1; o < 64; o <<= 1) mx = fmaxf(mx, __shfl_xor(mx, o));
                        const unsigned long long msk = __ballot(cur == mx && lane < 32); const int sel = __ffsll((long long)msk) - 1; tv[k] = mx; ti[k] = sel; if (lane == sel) cur = -3.0e38f; }
                    const float e1 = __expf(tv[1] - tv[0]), e2 = __expf(tv[2] - tv[0]), e3 = __expf(tv[3] - tv[0]); const float inv = 1.0f / (1.0f + e1 + e2 + e3);
                    if (lane < 4) { const int k = lane; const int ee = k == 0 ? ti[0] : k == 1 ? ti[1] : k == 2 ? ti[2] : ti[3]; const float gg = (k == 0 ? 1.0f : k == 1 ? e1 : k == 2 ? e2 : e3) * inv;
                        const int lp = __hip_atomic_fetch_add(&CNT[ee], 1, __ATOMIC_RELAXED, __HIP_MEMORY_SCOPE_WORKGROUP);
                        EIDX[m * 4 + k] = ee; GATE[m * 4 + k] = gg; LPOS[m * 4 + k] = lp; }
                }
            }
            __syncthreads();
            if (tid < 32) BCNT[blk * 32 + tid] = CNT[tid];
        }
    }
    SEAM(ST_M0); STAMP(9);
#define MOE_TABLES() do { \
        LAS int* TB = (LAS int*)lds;                   \
        LAS int* EB = (LAS int*)(lds + 32768);         \
        __syncthreads(); \
        for (int i = tid; i < NRANGE * WBR * 32; i += NTHR) TB[i] = BCNT[i]; \
        __syncthreads(); \
        if (tid < NRANGE * 32) { const int r = tid >> 5, e = tid & 31; int run = 0; _Pragma("unroll 4") for (int wb = 0; wb < WBR; ++wb) { const int c_ = TB[(r * WBR + wb) * 32 + e]; TB[(r * WBR + wb) * 32 + e] = run; run += c_; } EB[128 + tid] = run; } \
        __syncthreads(); \
        if (tid < NRANGE) { int run = 0; _Pragma("unroll 1") for (int e = 0; e < 32; ++e) { EB[tid * 32 + e] = run; run += (EB[128 + tid * 32 + e] + 255) & ~255; } EB[256 + tid] = run >> 8; } \
        __syncthreads(); \
        for (int i = tid; i < NRANGE * WBR * 32; i += NTHR) { const int r = i / (WBR * 32), e = i & 31; TB[i] += EB[r * 32 + e]; } \
        __syncthreads(); } while (0)
#define MOE_SCATTER(r) do { \
        LAS int* TB = (LAS int*)lds; LAS int* EB = (LAS int*)(lds + 32768); \
        for (int idx = bid * NTHR + tid; idx < RTOK * 4; idx += G * NTHR) { const int m = (r) * RTOK + (idx >> 2), k = idx & 3; const int wb = (idx >> 2) >> 8; \
            const int e = EIDX[m * 4 + k]; const int row = TB[((r) * WBR + wb) * 32 + e] + LPOS[m * 4 + k]; AROW[m * 4 + k] = row; HPS[row] = HLS[m]; ROWTOK[row] = m; } \
        for (int e = bid; e < 32; e += G) { const int tot = EB[128 + (r) * 32 + e], base = EB[(r) * 32 + e]; const int npad = ((tot + 255) & ~255) - tot; \
            for (int i = tid; i < npad; i += NTHR) { HPS[base + tot + i] = 0.f; ROWTOK[base + tot + i] = -1; } } } while (0)
    if (PH_EN(10) && IN(ST_M1)) for (int rep = 0; rep < DUP_N(10); ++rep) {
        const int tid = opaque_tid(), lane = tid & 63, wave = __builtin_amdgcn_readfirstlane(tid >> 6), gw = bid * NWAVES + wave; (void)lane; (void)gw; (void)rep;
        MOE_TABLES();
        if (bid == 0) {
            LAS int* TB = (LAS int*)lds; LAS int* EB = (LAS int*)(lds + 32768);
            for (int i = tid; i < NRANGE * WBR * 32; i += NTHR) BBASE[i] = TB[i];
            if (tid < NRANGE) NTILE[tid] = EB[256 + tid];
            for (int i = tid; i < NRANGE * 32; i += NTHR) { const int r = i >> 5, e = i & 31; const int base = EB[r * 32 + e], nt = (EB[128 + i] + 255) >> 8; for (int t = 0; t < nt; ++t) TILEE[r * TILE_LD + (base >> 8) + t] = e; }
        }
        MOE_SCATTER(0);
    }
    SEAM(ST_M1); STAMP(10);
    for (int r = 0; r < NRANGE; ++r) {
        const int s0 = ST_RNG + 3 * r;
        if (PH_EN(11) && IN(s0 + 0)) for (int rep = 0; rep < DUP_N(11); ++rep) {
        const int tid = opaque_tid(), lane = tid & 63, wave = __builtin_amdgcn_readfirstlane(tid >> 6), gw = bid * NWAVES + wave; (void)lane; (void)gw; (void)rep;
            pg8::Gemm g{HL, W1T, 512, 512, 512, HPS, W1S, ROWTOK}; pg8::MoeOrder S{TILEE + r * TILE_LD, NTILE[r], 8, G, bid}; EpiHid E{(unsigned char*)HID, args.in[I_B1]};
            STAGGER(STAG_M2); pg8::gemm_phase<EpiHid, pg8::MoeOrder, 1, true>(lds, g, S, E);
        }
        SEAM(s0 + 0); STAMP(11);
        if (PH_EN(12) && IN(s0 + 1)) for (int rep = 0; rep < DUP_N(12); ++rep) {
        const int tid = opaque_tid(), lane = tid & 63, wave = __builtin_amdgcn_readfirstlane(tid >> 6), gw = bid * NWAVES + wave; (void)lane; (void)gw; (void)rep;
            pg8::Gemm g{HID, W2T, 512, 512, 512, nullptr, W2S, nullptr}; pg8::MoeOrder S{TILEE + r * TILE_LD, NTILE[r], 4, G, bid}; EpiY E{(unsigned char*)YPAD, args.in[I_B2]};
            STAGGER(STAG_M3); pg8::gemm_phase<EpiY, pg8::MoeOrder, 2>(lds, g, S, E);
        }
        SEAM(s0 + 1); STAMP(12);
        if (PH_EN(13) && IN(s0 + 2)) for (int rep = 0; rep < DUP_N(13); ++rep) {
        const int tid = opaque_tid(), lane = tid & 63, wave = __builtin_amdgcn_readfirstlane(tid >> 6), gw = bid * NWAVES + wave; (void)lane; (void)gw; (void)rep;
            if (NGW * 32 == RTOK) {
                const int m0 = r * RTOK + gw * 16, m1 = m0 + NGW * 16;
                const int arow0 = AROW[m0 * 4 + lane], arow1 = AROW[m1 * 4 + lane]; const float gate0 = GATE[m0 * 4 + lane], gate1 = GATE[m1 * 4 + lane];
                f32x4 g2v0[4], g2v1[4], fgv[4];
#pragma unroll
                for (int j = 0; j < 4; ++j) { g2v0[j] = *(const f32x4*)(mod + (m0 >> 13) * 6144 + 5120 + 4 * lane + 256 * j); g2v1[j] = *(const f32x4*)(mod + (m1 >> 13) * 6144 + 5120 + 4 * lane + 256 * j);
                    fgv[j] = *(const f32x4*)(args.in[I_FG] + 4 * lane + 256 * j); }
                f32x4 xv[4][4]; unsigned yw[4][4][4];
                auto issue = [&](int mbase, int arow_r, int i, f32x4 (&xx)[4], unsigned (&yy)[4][4]) { const int m = mbase + i;
#pragma unroll
                    for (int j = 0; j < 4; ++j) xx[j] = __builtin_nontemporal_load((const f32x4*)(args.out + (size_t)m * D) + lane + 64 * j);
#pragma unroll
                    for (int k = 0; k < 4; ++k) { const int row = __shfl(arow_r, 4 * i + k); const unsigned* yp = (const unsigned*)((const unsigned char*)YPAD + (size_t)row * D) + lane;
#pragma unroll
                        for (int j = 0; j < 4; ++j) yy[k][j] = __builtin_nontemporal_load(yp + 64 * j); } };
                issue(m0, arow0, 0, xv[0], yw[0]); issue(m0, arow0, 1, xv[1], yw[1]); issue(m0, arow0, 2, xv[2], yw[2]);
#pragma unroll 1
                for (int kb = 0; kb < 2; ++kb) {
                    const int mb = kb ? m1 : m0; const int arow_c = kb ? arow1 : arow0; const float gate_c = kb ? gate1 : gate0;
                    f32x4 g2c[4];
#pragma unroll
                    for (int j = 0; j < 4; ++j) g2c[j] = kb ? g2v1[j] : g2v0[j];
                    auto ahead = [&](int t, f32x4 (&xx)[4], unsigned (&yy)[4][4]) { const bool nx = t >= 16;
                        issue(nx ? m1 : mb, nx ? arow1 : arow_c, nx ? (kb ? 15 : t - 16) : t, xx, yy); };
                    auto finish = [&](int i, const f32x4 (&xx)[4], const unsigned (&yy)[4][4]) { const int m = mb + i; f32x4 v[4]; float ss = 0.f;
#pragma unroll
                        for (int j = 0; j < 4; ++j) { f32x4 y = {0.f, 0.f, 0.f, 0.f};
#pragma unroll
                            for (int k = 0; k < 4; ++k) { const float gk = __shfl(gate_c, 4 * i + k); const int w = (int)yy[k][j]; const f32x2 lo = __builtin_amdgcn_cvt_pk_f32_fp8(w, false), hi = __builtin_amdgcn_cvt_pk_f32_fp8(w, true);
                                y.x += gk * lo.x; y.y += gk * lo.y; y.z += gk * hi.x; y.w += gk * hi.y; }
                            v[j] = xx[j] + g2c[j] * y; ss += (v[j].x * v[j].x + v[j].y * v[j].y) + (v[j].z * v[j].z + v[j].w * v[j].w); }
                        const float rstd = 1.0f / sqrtf(wave_sum(ss) * (1.0f / D) + EPS);
#pragma unroll
                        for (int j = 0; j < 4; ++j) ((f32x4*)((DRY(13) ? (float*)(ws + WS_DUMMY) + (size_t)((m - r * RTOK) & 16383) * D : args.out + (size_t)m * D)) + lane)[64 * j] = v[j] * rstd * fgv[j]; };
#pragma unroll 1
                    for (int i = 0; i < 16; i += 4) {
                        ahead(i + 3, xv[3], yw[3]); finish(i, xv[0], yw[0]);
                        ahead(i + 4, xv[0], yw[0]); finish(i + 1, xv[1], yw[1]);
                        ahead(i + 5, xv[1], yw[1]); finish(i + 2, xv[2], yw[2]);
                        ahead(i + 6, xv[2], yw[2]); finish(i + 3, xv[3], yw[3]);
                    }
                }
            } else {
            for (int mb = r * RTOK + gw * 16; mb < (r + 1) * RTOK; mb += NGW * 16) {
                const int arow_l = AROW[mb * 4 + lane]; const float gate_l = GATE[mb * 4 + lane];
                const int b = mb >> 13;
                f32x4 g2v[4], fgv[4];
#pragma unroll
                for (int j = 0; j < 4; ++j) { g2v[j] = *(const f32x4*)(mod + b * 6144 + 5120 + 4 * lane + 256 * j); fgv[j] = *(const f32x4*)(args.in[I_FG] + 4 * lane + 256 * j); }
                f32x4 xv[2][4]; unsigned yw[2][4][4];
                auto issue = [&](int i, f32x4 (&xx)[4], unsigned (&yy)[4][4]) { const int m = mb + i;
#pragma unroll
                    for (int j = 0; j < 4; ++j) xx[j] = __builtin_nontemporal_load((const f32x4*)(args.out + (size_t)m * D) + lane + 64 * j);
#pragma unroll
                    for (int k = 0; k < 4; ++k) { const int row = __shfl(arow_l, 4 * i + k); const unsigned* yp = (const unsigned*)((const unsigned char*)YPAD + (size_t)row * D) + lane;
#pragma unroll
                        for (int j = 0; j < 4; ++j) yy[k][j] = __builtin_nontemporal_load(yp + 64 * j); } };
                auto finish = [&](int i, const f32x4 (&xx)[4], const unsigned (&yy)[4][4]) { const int m = mb + i; f32x4 v[4]; float ss = 0.f;
#pragma unroll
                    for (int j = 0; j < 4; ++j) { f32x4 y = {0.f, 0.f, 0.f, 0.f};
#pragma unroll
                        for (int k = 0; k < 4; ++k) { const float gk = __shfl(gate_l, 4 * i + k); const int w = (int)yy[k][j]; const f32x2 lo = __builtin_amdgcn_cvt_pk_f32_fp8(w, false), hi = __builtin_amdgcn_cvt_pk_f32_fp8(w, true);
                            y.x += gk * lo.x; y.y += gk * lo.y; y.z += gk * hi.x; y.w += gk * hi.y; }
                        v[j] = xx[j] + g2v[j] * y; ss += (v[j].x * v[j].x + v[j].y * v[j].y) + (v[j].z * v[j].z + v[j].w * v[j].w); }
                    const float rstd = 1.0f / sqrtf(wave_sum(ss) * (1.0f / D) + EPS);
#pragma unroll
                    for (int j = 0; j < 4; ++j) ((f32x4*)((DRY(13) ? (float*)(ws + WS_DUMMY) + (size_t)((m - r * RTOK) & 16383) * D : args.out + (size_t)m * D)) + lane)[64 * j] = v[j] * rstd * fgv[j]; };
                issue(0, xv[0], yw[0]);
#pragma unroll 1
                for (int i = 0; i < 16; i += 2) {
                    issue(i + 1, xv[1], yw[1]);
                    finish(i, xv[0], yw[0]);
                    if (i + 2 < 16) issue(i + 2, xv[0], yw[0]);
                    finish(i + 1, xv[1], yw[1]);
                }
            }
            }
            if (r + 1 < NRANGE) { MOE_TABLES(); MOE_SCATTER(r + 1); }
        }
        if (r + 1 < NRANGE) SEAM(s0 + 2);
        STAMP(13);
    }
#if MK_PROBE
    {
        unsigned* PR = (unsigned*)(ws + WS_CTL) + 8192;
        xcd_barrier(bar);
        if (bid == 0 && threadIdx.x == 0) { PR[0] = MISC[16 + PROBE_SEL1]; PR[1] = MISC[16 + PROBE_SEL2]; }
        xcd_barrier(bar);
        const float d1 = (float)__hip_atomic_load(PR, __ATOMIC_RELAXED, __HIP_MEMORY_SCOPE_AGENT) * 0.01f, d2 = (float)__hip_atomic_load(PR + 1, __ATOMIC_RELAXED, __HIP_MEMORY_SCOPE_AGENT) * 0.01f;
        const float sc = 1.0f + sqrtf(d1 * 1e-4f);
        for (size_t i = (size_t)bid * NTHR + threadIdx.x; i < (size_t)NTOK * D / 4; i += (size_t)G * NTHR) { f32x4 v = ((f32x4*)args.out)[i]; v *= sc; if (i == 0) v.x += d2 * 0.25f; ((f32x4*)args.out)[i] = v; }
    }
#endif
#undef IN
#undef SEAM
}

extern "C" void kernel_launch(void* const* d_in, const int* in_sizes, int n_in, void* d_out, int out_size, void* d_ws, size_t ws_size, hipStream_t stream) {
    static int grid = 0;
    if (grid == 0) {
        if (n_in != 26 || in_sizes[0] != NTOK * D || out_size != NTOK * D || ws_size < WS_END) { fprintf(stderr, "kernel_launch: unexpected shapes (n_in %d, in0 %d, out %d, ws %zu); nothing launched\n", n_in, n_in > 0 ? in_sizes[0] : -1, out_size, ws_size); grid = -1; return; }
        int dev = 0, cus = 0, per_cu = 0;
        if (hipGetDevice(&dev) != hipSuccess || hipDeviceGetAttribute(&cus, hipDeviceAttributeMultiprocessorCount, dev) != hipSuccess) { grid = -1; return; }
        if (hipFuncSetAttribute((const void*)fwd_kernel, hipFuncAttributeMaxDynamicSharedMemorySize, LDS_BYTES) != hipSuccess) { fprintf(stderr, "kernel_launch: hipFuncSetAttribute failed\n"); grid = -1; return; }
        if (hipOccupancyMaxActiveBlocksPerMultiprocessor(&per_cu, (const void*)fwd_kernel, NTHR, LDS_BYTES) != hipSuccess || per_cu < 1) fprintf(stderr, "kernel_launch: occupancy query reports %d\n", per_cu);
        (void)hipGetLastError();
        grid = cus;
    }
    if (grid < 0) return;
    if (hipMemsetAsync((char*)d_ws + WS_CTL, 0, CTL_ZERO_BYTES, stream) != hipSuccess) return;
    Args a{};
    for (int i = 0; i < 26; ++i) a.in[i] = (const float*)d_in[i];
    a.out = (float*)d_out; a.ws = (unsigned char*)d_ws;
#if MK_PER_PHASE
    for (int s = 0; s < ST_END; ++s) { a.lo = s; a.hi = s + 1; hipLaunchKernelGGL(fwd_kernel, dim3(grid), dim3(NTHR), LDS_BYTES, stream, a); }
#else
    a.lo = 0; a.hi = ST_END;
    hipLaunchKernelGGL(fwd_kernel, dim3(grid), dim3(NTHR), LDS_BYTES, stream, a);
#endif
    const hipError_t le = hipPeekAtLastError();
    if (le != hipSuccess) fprintf(stderr, "kernel_launch: launch failed: %s\n", hipGetErrorName(le));
}
```

```cpp
#include <hip/hip_runtime.h>
#include <type_traits>
#include <cstdio>
#include <cstdint>

#ifndef MK_PER_PHASE
#define MK_PER_PHASE 0
#endif

#ifndef MK_PROBE
#define MK_PROBE 0
#endif
#ifndef PROBE_SEL1
#define PROBE_SEL1 3
#endif
#ifndef PROBE_SEL2
#define PROBE_SEL2 4
#endif
#ifndef MK_DUP
#define MK_DUP 0u
#endif
#define DUP_N(k) ((((MK_DUP) >> (k)) & 1u) ? 2 : 1)
#define DRY(k) ((((MK_DUP) >> (k)) & 1u) && rep == 0)
#ifndef MK_DRYMODE
#define MK_DRYMODE 0
#endif
#ifndef STAG_B
#define STAG_B 0
#endif
#ifndef STAG_M2
#define STAG_M2 0
#endif
#ifndef STAG_M3
#define STAG_M3 0
#endif
#define STAGGER(n) do { const int slot_ = (bid >> 3) & 3; for (int i_ = 0; i_ < slot_ * (n); ++i_) __builtin_amdgcn_s_sleep(127); } while (0)
#ifndef MK_PHASES
#define MK_PHASES 0xFFFFu
#endif
#define PH_EN(k) (((MK_PHASES) >> (k)) & 1u)
#define LAS __attribute__((address_space(3)))
#define GAS __attribute__((address_space(1)))
typedef unsigned short bf16;
typedef short bf16x8 __attribute__((ext_vector_type(8)));
typedef short s16x4 __attribute__((ext_vector_type(4)));
typedef float f32x2 __attribute__((ext_vector_type(2)));
typedef float f32x4 __attribute__((ext_vector_type(4)));
typedef float f32x16 __attribute__((ext_vector_type(16)));
typedef unsigned u32x2 __attribute__((ext_vector_type(2)));
typedef unsigned u32x4 __attribute__((ext_vector_type(4)));

constexpr int D = 1024, NB = 8, SEQ = 8192, NTOK = NB * SEQ, CTXL = 256, NCTX = NB * CTXL, DIN = 10240, ZLD = 10240 + 128;
constexpr int NROWS_HL = NTOK + NCTX;
constexpr int GB = 2, NGRP = NB / GB, GROWS = GB * SEQ;
constexpr int NEXP = 32, TOPK = 4, DEXP = 1024;
constexpr int NRANGE = 1, RTOK = NTOK / NRANGE, WBR = RTOK / 256;
constexpr int RROWS = 4 * RTOK + 32 * 256, RTILES = RROWS / 256, TILE_LD = RTILES + 32;
constexpr float EPS = 1e-6f;
constexpr float K_SCALE = 0.08838834764831845f;
constexpr int C_XR = 0, C_GR = 1024, C_Q = 2048, C_K = 3072, C_V = 4096, C_GS = 6144, C_GA = 8192, C_GB = 9216;
constexpr int ZC_LD = 4096, ZC_XR = 0, ZC_K = 1024, ZC_V = 2048;

constexpr size_t MiB = 1u << 20;
constexpr size_t WS_CTL = 0, CTL_ZERO_BYTES = 1 * MiB;
constexpr size_t WS_MOD = 1 * MiB;
constexpr size_t WS_ROPE = 1 * MiB + 256 * 1024;
constexpr size_t WS_RWB = 1 * MiB + 512 * 1024;
constexpr size_t WS_CARRY = 2 * MiB;
constexpr size_t WS_HLS = 7 * MiB;
constexpr size_t WS_WINS = 7 * MiB + 320 * 1024;
constexpr size_t WS_W1S = 7 * MiB + 384 * 1024;
constexpr size_t WS_HPS = 880 * MiB;
constexpr size_t WS_WFS = 7 * MiB + 640 * 1024;
constexpr size_t WS_EIDX = 8 * MiB, WS_GATE = 9 * MiB, WS_LPOS = 10 * MiB, WS_AROW = 11 * MiB;
constexpr size_t WS_BCNT = 12 * MiB;
constexpr size_t WS_BBASE = 12 * MiB + 64 * 1024;
constexpr size_t WS_TILEE = 12 * MiB + 128 * 1024;
constexpr size_t WS_NTILE = 12 * MiB + 192 * 1024;
constexpr size_t WS_WG = 14 * MiB;
constexpr size_t WS_WRNN = 16 * MiB, WS_WOUT = 22 * MiB, WS_WIN = 24 * MiB;
constexpr size_t WS_HL = 44 * MiB;
constexpr size_t WS_ZC = 176 * MiB;
constexpr size_t WS_CTXU = 192 * MiB;
constexpr size_t WS_Z = 208 * MiB;
constexpr size_t WS_ST = 536 * MiB;
constexpr size_t WS_T1 = 664 * MiB, WS_MG = 696 * MiB;
constexpr size_t WS_W1T = 736 * MiB;
constexpr size_t WS_W2T = 848 * MiB;
constexpr size_t WS_HPAD = 208 * MiB, WS_HID = 210 * MiB, WS_YPAD = 474 * MiB;
constexpr size_t WS_AR = 912 * MiB, WS_AT = 944 * MiB;
constexpr size_t WS_DUMMY = 912 * MiB;
constexpr size_t WS_END = 1024 * MiB;
constexpr int CW_BAR = 4096;

constexpr int LDS_BYTES = 149504;
constexpr int MISC_OFF = LDS_BYTES - 256;
constexpr int NWAVES = 8, NTHR = 512;

__device__ __forceinline__ unsigned f2bf(float f) { unsigned u = __builtin_bit_cast(unsigned, f); return (u + 0x7fffu + ((u >> 16) & 1u)) >> 16; }
typedef __bf16 hwbf16x2 __attribute__((ext_vector_type(2)));
__device__ __forceinline__ unsigned pk2(float lo, float hi) { const f32x2 v = {lo, hi}; return __builtin_bit_cast(unsigned, __builtin_convertvector(v, hwbf16x2)); }
__device__ __forceinline__ float bflo(unsigned w) { return __builtin_bit_cast(float, w << 16); }
__device__ __forceinline__ float bfhi(unsigned w) { return __builtin_bit_cast(float, w & 0xffff0000u); }
__device__ __forceinline__ float bf2f(unsigned short h) { return __builtin_bit_cast(float, ((unsigned)h) << 16); }
__device__ __forceinline__ float sigmoidf_(float x) { return __builtin_amdgcn_rcpf(1.0f + __expf(-x)); }
__device__ __forceinline__ float wave_sum(float v) {
#pragma unroll
    for (int o = 1; o < 64; o <<= 1) v += __shfl_xor(v, o);
    return v;
}
template <int CTRL> __device__ __forceinline__ float dpp_f(float v) { return __builtin_bit_cast(float, __builtin_amdgcn_update_dpp(0, __builtin_bit_cast(int, v), CTRL, 0xF, 0xF, true)); }
__device__ __forceinline__ float row16_sum(float v) { v += dpp_f<0xB1>(v); v += dpp_f<0x4E>(v); v += dpp_f<0x141>(v); v += dpp_f<0x140>(v); return v; }
__device__ __forceinline__ float wave_max(float v) {
#pragma unroll
    for (int o = 1; o < 64; o <<= 1) v = fmaxf(v, __shfl_xor(v, o));
    return v;
}
__device__ __forceinline__ unsigned q8x4(f32x4 v, float inv) {
    const int a = (int)rintf(v.x * inv), b = (int)rintf(v.y * inv), c = (int)rintf(v.z * inv), d = (int)rintf(v.w * inv);
    return ((unsigned)a & 0xffu) | (((unsigned)b & 0xffu) << 8) | (((unsigned)c & 0xffu) << 16) | (((unsigned)d & 0xffu) << 24);
}
#define LDS_WAIT() asm volatile("s_waitcnt lgkmcnt(0)" ::: "memory")
__device__ __forceinline__ int opaque_tid() { int t = threadIdx.x; asm volatile("" : "+v"(t)); return t; }
template <class T> __device__ __forceinline__ T* opaque_ptr(T* p) { unsigned long long u = (unsigned long long)p; asm volatile("" : "+s"(u)); return (T*)u; }

namespace pg8 {
constexpr int BM = 256, BK = 64, HALF = 128, HTB = HALF * BK * 2, STAGE_BYTES = 8 * HTB, NXCD = 8, WGM = 8;
__host__ __device__ __forceinline__ int lds_byte(int r, int c) { const int st = (r >> 4) * 2 + (c >> 5), rr = r & 15, cc = c & 31, ob = rr * 64 + cc * 2; return st * 1024 + (ob ^ (((ob >> 9) & 1) << 5)); }
__host__ __device__ __forceinline__ void stage_rc(int b, int& R, int& C) { const int st = b / 1024, sb = b % 1024, swz = sb ^ (((sb >> 9) & 1) << 5); R = (st >> 1) * 16 + swz / 64; C = (st & 1) * 32 + (swz % 64) / 2; }
__host__ __device__ __forceinline__ int perm32(int rho) { const int n = rho >> 4, i = rho & 15; return 8 * (i >> 2) + 4 * n + (i & 3); }
struct Unit { int pm, pn; int koff = 0, nt = 0; };
struct Gemm { const bf16* A; const bf16* Bt; int lda, ldb, K; const float* SA; const float* SB; const int* RT; };
struct StaticOrder {
    int nM, nN, nwg, G, c;
    __device__ void init(int nM_, int nN_, int G_, int c_) { nM = nM_; nN = nN_; nwg = nM * nN; G = G_; c = c_; }
    __device__ bool next(int i, Unit& u) const {
        const long L = (long)i * G + c; if (L >= nwg) return false;
        int wgid = (int)L; { const int q = nwg / NXCD, r = nwg % NXCD, xcd = wgid % NXCD, off = wgid / NXCD; wgid = (xcd < r ? xcd * (q + 1) : r * (q + 1) + (xcd - r) * q) + off; }
        const int nig = WGM * nN, gid = wgid / nig, fm = gid * WGM, gsz = (nM - fm) < WGM ? (nM - fm) : WGM;
        u.pm = fm + ((wgid % nig) % gsz); u.pn = (wgid % nig) / gsz; return true;
    }
};
struct CtxOrder {
    int G, c;
    __device__ bool next(int i, Unit& u) const { const int L = i * G + c; if (L >= 128) return false; const int j = L >> 3; u.pm = 256 + (L & 7); u.pn = j < 4 ? j : j + 8; return true; }
};
struct FOrder {
    StaticOrder so;
    __device__ bool next(int i, Unit& u) const { Unit t; if (!so.next(i >> 1, t)) return false; u.pm = t.pm; u.pn = t.pn; u.koff = (i & 1) ? 1024 : 0; u.nt = (i & 1) ? 32 : 16; return true; }
};
struct MoeOrder {
    const int* tile_e; int ntiles, npn, G, c;
    __device__ bool next_pm(int i, Unit& u) const {
        if ((G & 7) == 0 && ((G >> 3) % npn) == 0) { const int x = c & 7, y = c >> 3, T = (G >> 3) / npn; const int ti = (i * 8 + x) * T + y / npn, pl = y % npn;
            if (ti >= ntiles) return false; u.pm = ti; u.pn = pl; return true; }
        const long L = (long)i * G + c; if (L >= (long)ntiles * npn) return false; const int ti = (int)(L / npn), pl = (int)(L % npn);
        u.pm = ti; u.pn = pl; return true; }
    __device__ int expert(const Unit& u) const { return tile_e[u.pm]; }
    __device__ bool next(int i, Unit& u) const { if (!next_pm(i, u)) return false; u.pn += expert(u) * npn; return true; }
};

typedef int i32x4 __attribute__((ext_vector_type(4)));
typedef int i32x8 __attribute__((ext_vector_type(8)));
template <int MODE> struct Frag { bf16x8 v[2]; };
template <> struct Frag<2> { i32x8 w; };
template <class Epi, class Sched, int MODE = 0, bool GATHER = false>
__device__ __forceinline__ void gemm_phase(LAS unsigned char* lds, const Gemm g, const Sched& S, const Epi& E) {
    const int tid = opaque_tid(), wid = __builtin_amdgcn_readfirstlane(tid >> 6), lane = tid & 63, wr = wid >> 2, wc = wid & 3, fr = lane & 15, fq = lane >> 4;
    const int K = g.K, nt = K / BK;
    const bf16* gA = opaque_ptr(g.A); const bf16* gBt = opaque_ptr(g.Bt);
    unsigned voffA[2], voffB[2]; int RA[2]; unsigned CA[2];
#pragma unroll
    for (int i = 0; i < 2; ++i) { int R, C; stage_rc(tid * 16 + i * 8192, R, C); const int Rb = 64 * (R >> 5) + (Epi::PERM ? perm32(R & 31) : (R & 31));
        voffA[i] = (unsigned)(R * g.lda + C) * 2u; voffB[i] = (unsigned)(Rb * g.ldb + C) * 2u; RA[i] = R; CA[i] = (unsigned)C * 2u; }
    (void)RA; (void)CA;
    const size_t kstep = (size_t)(BK * 2);
    const size_t hstepA = GATHER ? (size_t)0 : (size_t)HALF * g.lda * 2, hstepB = (size_t)32 * g.ldb * 2;
    unsigned vC[2][2], vN[2][2];
    auto gather_offs = [&](int pm, unsigned (&v)[2][2]) {
        int t00 = g.RT[pm * 256 + RA[0]], t01 = g.RT[pm * 256 + RA[1]], t10 = g.RT[pm * 256 + 128 + RA[0]], t11 = g.RT[pm * 256 + 128 + RA[1]];
        asm volatile("" : "+v"(t00), "+v"(t01), "+v"(t10), "+v"(t11));
        t00 = t00 < 0 ? 0 : t00; t01 = t01 < 0 ? 0 : t01; t10 = t10 < 0 ? 0 : t10; t11 = t11 < 0 ? 0 : t11;
        v[0][0] = (unsigned)t00 * (unsigned)(g.lda * 2) + CA[0]; v[0][1] = (unsigned)t01 * (unsigned)(g.lda * 2) + CA[1];
        v[1][0] = (unsigned)t10 * (unsigned)(g.lda * 2) + CA[0]; v[1][1] = (unsigned)t11 * (unsigned)(g.lda * 2) + CA[1]; };
    const size_t tstepA = (size_t)BM * g.lda * 2, tstepB = (size_t)BM * g.ldb * 2;
    const unsigned ldsw = (unsigned)wid * 1024u;
    const int aoff = lds_byte(wr * 64 + fr, fq * 8), boff = lds_byte(wc * 32 + fr, fq * 8);
#define PG8_SA(b, h) (((b) * 2 + (h)) * HTB)
#define PG8_SB(b, h) ((4 + (b) * 2 + (h)) * HTB)
#define PG8_STAGE(bufoff, gbase, voff) do { _Pragma("unroll") for (int _i = 0; _i < 2; ++_i) \
        __builtin_amdgcn_global_load_lds((const unsigned*)((const char*)(gbase) + (voff)[_i]), (LAS unsigned*)(lds + (bufoff) + ldsw + _i * 8192), 16, 0, 0); } while (0)
#define PG8_STAGE_A(bufoff, gbase, hh, nx) do { if constexpr (GATHER) { _Pragma("unroll") for (int _i = 0; _i < 2; ++_i) { const unsigned _o = (nx) ? vN[hh][_i] : vC[hh][_i]; \
        __builtin_amdgcn_global_load_lds((const unsigned*)((const char*)(gbase) + _o), (LAS unsigned*)(lds + (bufoff) + ldsw + _i * 8192), 16, 0, 0); } } else PG8_STAGE(bufoff, gbase, voffA); } while (0)
#define PG8_LD1(dst, p) do { if constexpr (MODE == 2) (dst).w = __builtin_shufflevector(*(const LAS i32x4*)(p), *(const LAS i32x4*)((p) + 1024), 0, 1, 2, 3, 4, 5, 6, 7); \
        else { (dst).v[0] = *(const LAS bf16x8*)(p); (dst).v[1] = *(const LAS bf16x8*)((p) + 1024); } } while (0)
#define PG8_LDA(dst, b, h) do { _Pragma("unroll") for (int m = 0; m < 4; ++m) PG8_LD1(dst[m], lds + PG8_SA(b, h) + aoff + m * 2048); } while (0)
#define PG8_LDB(dst, b, h) do { _Pragma("unroll") for (int n = 0; n < 2; ++n) PG8_LD1(dst[n], lds + PG8_SB(b, h) + boff + n * 2048); } while (0)
#define PG8_MMA(ai, bj, At, Bt) do { __builtin_amdgcn_s_setprio(1); _Pragma("unroll") for (int m = 0; m < 4; ++m) _Pragma("unroll") for (int n = 0; n < 2; ++n) { \
        if constexpr (MODE == 2) {   \
              \
            asm volatile("v_mfma_scale_f32_16x16x128_f8f6f4 %0, %1, %2, %0, %3, %3 op_sel_hi:[0,0,0]" : "+v"(acc[ai][bj][m][n]) : "v"(Bt[n].w), "v"(At[m].w), "v"(sc1)); \
        } else { _Pragma("unroll") for (int k = 0; k < 2; ++k) \
        { if constexpr (MODE == 1) acc[ai][bj][m][n] = __builtin_bit_cast(f32x4, __builtin_amdgcn_mfma_i32_16x16x64_i8(__builtin_bit_cast(i32x4, Bt[n].v[k]), __builtin_bit_cast(i32x4, At[m].v[k]), __builtin_bit_cast(i32x4, acc[ai][bj][m][n]), 0, 0, 0)); \
          else acc[ai][bj][m][n] = __builtin_amdgcn_mfma_f32_16x16x32_bf16(Bt[n].v[k], At[m].v[k], acc[ai][bj][m][n], 0, 0, 0); } } } __builtin_amdgcn_s_setprio(0); } while (0)
#define PG8_WAIT_V(n) asm volatile("s_waitcnt vmcnt(" #n ")" ::: "memory")
#define PG8_WAIT_VN(n) asm volatile("s_waitcnt vmcnt(%0)" :: "n"(n) : "memory")
#define PG8_WAIT_L(n) asm volatile("s_waitcnt lgkmcnt(" #n ")" ::: "memory")
#define PG8_BAR __builtin_amdgcn_s_barrier()
#define PG8_SCHED __builtin_amdgcn_sched_barrier(0)
    Unit cur, nxt; int ui = 0;
    if (!S.next(0, cur)) return;
    constexpr int FIRST_NST = (MK_DRYMODE != 0 || MK_DUP != 0u) ? 0 : Epi::NST;
    constexpr int SC_OFF = 8 * HTB;
    auto stage_scales = [&](const Unit& u, int par) {
        if constexpr (MODE != 0) { if (MODE == 1 || wid >= 4) { const float* sp = wid < 4 ? g.SA + u.pm * 256 + tid : g.SB + u.pn * 256 + (tid - 256);
            __builtin_amdgcn_global_load_lds((const unsigned*)sp, (LAS unsigned*)(lds + SC_OFF + par * 2048 + wid * 256), 4, 0, 0); } } };
    stage_scales(cur, 0);
    f32x4 acc[2][2][4][2];
#pragma unroll
    for (int a = 0; a < 2; ++a)
#pragma unroll
        for (int b = 0; b < 2; ++b)
#pragma unroll
            for (int m = 0; m < 4; ++m)
#pragma unroll
                for (int n = 0; n < 2; ++n) acc[a][b][m][n] = (f32x4){0.f, 0.f, 0.f, 0.f};
    Frag<MODE> At[4], B0[2], B1[2]; const int sc1 = 0x7f7f7f7f; (void)sc1;
    const char* cA = GATHER ? (const char*)gA : (const char*)gA + (size_t)cur.pm * tstepA + (size_t)cur.koff * 2; const char* cB = (const char*)gBt + (size_t)cur.pn * tstepB + (size_t)cur.koff * 2;
    if constexpr (GATHER) gather_offs(cur.pm, vC);
    PG8_STAGE(PG8_SB(0, 0), cB, voffB); PG8_STAGE(PG8_SB(0, 1), cB + hstepB, voffB); PG8_STAGE_A(PG8_SA(0, 0), cA, 0, false); PG8_STAGE_A(PG8_SA(0, 1), cA + hstepA, 1, false);
    if (wr == 1) PG8_BAR;
    PG8_WAIT_V(2); PG8_BAR;
    PG8_STAGE(PG8_SB(1, 0), cB + kstep, voffB); PG8_STAGE_A(PG8_SA(1, 0), cA + kstep, 0, false); PG8_STAGE(PG8_SB(1, 1), cB + hstepB + kstep, voffB);
    PG8_WAIT_V(6); PG8_BAR;
    for (;;) {
        bool has_next;
        if constexpr (GATHER) {
            has_next = S.next_pm(ui + 1, nxt);
            if (has_next) { int t00 = g.RT[nxt.pm * 256 + RA[0]], t01 = g.RT[nxt.pm * 256 + RA[1]], t10 = g.RT[nxt.pm * 256 + 128 + RA[0]], t11 = g.RT[nxt.pm * 256 + 128 + RA[1]]; int ex = S.expert(nxt);
                asm volatile("" : "+v"(t00), "+v"(t01), "+v"(t10), "+v"(t11), "+v"(ex));
                nxt.pn += __builtin_amdgcn_readfirstlane(ex) * S.npn;
                t00 = t00 < 0 ? 0 : t00; t01 = t01 < 0 ? 0 : t01; t10 = t10 < 0 ? 0 : t10; t11 = t11 < 0 ? 0 : t11;
                vN[0][0] = (unsigned)t00 * (unsigned)(g.lda * 2) + CA[0]; vN[0][1] = (unsigned)t01 * (unsigned)(g.lda * 2) + CA[1];
                vN[1][0] = (unsigned)t10 * (unsigned)(g.lda * 2) + CA[0]; vN[1][1] = (unsigned)t11 * (unsigned)(g.lda * 2) + CA[1]; }
            else {
#pragma unroll
                for (int hh = 0; hh < 2; ++hh)
#pragma unroll
                    for (int i = 0; i < 2; ++i) vN[hh][i] = vC[hh][i]; }
        } else has_next = S.next(ui + 1, nxt);
        const char* nA = (has_next && !GATHER) ? (const char*)gA + (size_t)nxt.pm * tstepA + (size_t)nxt.koff * 2 : cA; const char* nB = has_next ? (const char*)gBt + (size_t)nxt.pn * tstepB + (size_t)nxt.koff * 2 : cB;
        const int ntc = cur.nt ? cur.nt : nt;
#pragma unroll 1
        for (int t = 0; t < ntc; t += 2) {
            const bool last = (t == ntc - 2);
            const char* a1 = cA + (size_t)(t + 1) * kstep;
            const char* a2 = last ? nA : cA + (size_t)(t + 2) * kstep; const char* b2 = last ? nB : cB + (size_t)(t + 2) * kstep;
            const char* a3 = a2 + kstep; const char* b3 = b2 + kstep;
            PG8_LDB(B0, 0, 0); PG8_LDB(B1, 0, 1); PG8_SCHED; PG8_LDA(At, 0, 0); PG8_STAGE_A(PG8_SA(1, 1), a1 + hstepA, 1, false);
            if (t == 0 && ui > 0) PG8_WAIT_VN(8 + FIRST_NST); else PG8_WAIT_V(8);
            PG8_WAIT_L(0); PG8_BAR; PG8_MMA(0, 0, At, B0); PG8_MMA(0, 1, At, B1); PG8_SCHED; PG8_BAR; PG8_SCHED;
            PG8_LDA(At, 0, 1); PG8_STAGE(PG8_SB(0, 0), b2, voffB); PG8_STAGE(PG8_SB(0, 1), b2 + hstepB, voffB); PG8_STAGE_A(PG8_SA(0, 0), a2, 0, last);
            if (t == 0 && ui > 0) PG8_WAIT_VN(8 + FIRST_NST); else PG8_WAIT_V(8);
            PG8_WAIT_L(0); PG8_BAR; PG8_MMA(1, 0, At, B0); PG8_MMA(1, 1, At, B1); PG8_SCHED; PG8_BAR; PG8_SCHED;
            PG8_LDB(B0, 1, 0); PG8_LDB(B1, 1, 1); PG8_SCHED; PG8_LDA(At, 1, 0); PG8_STAGE_A(PG8_SA(0, 1), a2 + hstepA, 1, last);
            PG8_WAIT_V(8); PG8_WAIT_L(0); PG8_BAR; PG8_MMA(0, 0, At, B0); PG8_MMA(0, 1, At, B1); PG8_SCHED; PG8_BAR; PG8_SCHED;
            PG8_LDA(At, 1, 1); PG8_STAGE(PG8_SB(1, 0), b3, voffB); PG8_STAGE(PG8_SB(1, 1), b3 + hstepB, voffB); PG8_STAGE_A(PG8_SA(1, 0), a3, 0, last);
            PG8_WAIT_V(8); PG8_WAIT_L(0); PG8_BAR; PG8_MMA(1, 0, At, B0); PG8_MMA(1, 1, At, B1); PG8_SCHED; PG8_BAR; PG8_SCHED;
        }
        if (wr == 0) PG8_BAR;
        if constexpr (MODE == 2) {
            int fq_ = fq; asm volatile("" : "+v"(fq_));
            const LAS float* sb = (const LAS float*)(lds + SC_OFF + (ui & 1) * 2048) + 256 + wc * 64 + (Epi::PERM ? 8 : 4) * fq_;
            f32x4 cs[2][2];
#pragma unroll
            for (int b = 0; b < 2; ++b)
#pragma unroll
                for (int n = 0; n < 2; ++n) cs[b][n] = *(const LAS f32x4*)(sb + b * 32 + (Epi::PERM ? 4 : 16) * n);
#pragma unroll
            for (int a = 0; a < 2; ++a)
#pragma unroll
                for (int b = 0; b < 2; ++b)
#pragma unroll
                    for (int m = 0; m < 4; ++m)
#pragma unroll
                        for (int n = 0; n < 2; ++n) acc[a][b][m][n] *= cs[b][n];
        }
        if constexpr (MODE == 1) {
            static_assert(Epi::PERM, "int8 path is written for the PERM layout");
            int fr_ = fr, fq_ = fq; asm volatile("" : "+v"(fr_), "+v"(fq_));
            const LAS float* sa = (const LAS float*)(lds + SC_OFF + (ui & 1) * 2048) + wr * 64 + fr_; const LAS float* sb = (const LAS float*)(lds + SC_OFF + (ui & 1) * 2048) + 256 + wc * 64 + 8 * fq_;
            float rs[2][4]; f32x4 cs[2][2];
#pragma unroll
            for (int a = 0; a < 2; ++a)
#pragma unroll
                for (int m = 0; m < 4; ++m) rs[a][m] = sa[a * 128 + m * 16];
#pragma unroll
            for (int b = 0; b < 2; ++b)
#pragma unroll
                for (int n = 0; n < 2; ++n) cs[b][n] = *(const LAS f32x4*)(sb + b * 32 + 4 * n);
#pragma unroll
            for (int a = 0; a < 2; ++a)
#pragma unroll
                for (int b = 0; b < 2; ++b)
#pragma unroll
                    for (int m = 0; m < 4; ++m)
#pragma unroll
                        for (int n = 0; n < 2; ++n) { const i32x4 iv = __builtin_bit_cast(i32x4, acc[a][b][m][n]); acc[a][b][m][n] = __builtin_convertvector(iv, f32x4) * cs[b][n] * rs[a][m]; }
        }
        bool keep = false;
        { int fr_ = fr, fq_ = fq; asm volatile("" : "+v"(fr_), "+v"(fq_));
          if constexpr (Epi::MID) { if (E.is_mid(cur)) { E.mid(acc, cur, wr, wc, fr_, fq_); keep = true; } else E(acc, cur, wr, wc, fr_, fq_); } else E(acc, cur, wr, wc, fr_, fq_); }
        if (!has_next) break;
        if (!keep) {
#pragma unroll
        for (int a = 0; a < 2; ++a)
#pragma unroll
            for (int b = 0; b < 2; ++b)
#pragma unroll
                for (int m = 0; m < 4; ++m)
#pragma unroll
                    for (int n = 0; n < 2; ++n) acc[a][b][m][n] = (f32x4){0.f, 0.f, 0.f, 0.f}; }
        cur = nxt; cA = nA; cB = nB; ++ui;
        stage_scales(cur, ui & 1);
        if constexpr (GATHER) {
#pragma unroll
            for (int hh = 0; hh < 2; ++hh)
#pragma unroll
                for (int i = 0; i < 2; ++i) vC[hh][i] = vN[hh][i]; }
        if (wr == 1) PG8_BAR;
    }
    PG8_WAIT_V(0);
    PG8_BAR;
#undef PG8_SA
#undef PG8_SB
#undef PG8_STAGE
#undef PG8_STAGE_A
#undef PG8_LDA
#undef PG8_LD1
#undef PG8_LDB
#undef PG8_MMA
#undef PG8_WAIT_V
#undef PG8_WAIT_VN
#undef PG8_WAIT_L
#undef PG8_BAR
#undef PG8_SCHED
}
}
using pg8::Unit;

template <class F>
__device__ __forceinline__ void epi_perm_loop(const f32x4 (&acc)[2][2][4][2], int wr, int wc, int fr, int fq, F&& f) {
#pragma unroll
    for (int ai = 0; ai < 2; ++ai)
#pragma unroll
        for (int m = 0; m < 4; ++m) { const int rt = ai * 128 + wr * 64 + m * 16 + fr;
#pragma unroll
            for (int bj = 0; bj < 2; ++bj) { const int ct = wc * 64 + bj * 32 + 8 * fq; f(rt, ct, acc[ai][bj][m][0], acc[ai][bj][m][1]); }
            asm volatile("" ::: "memory"); }
}
__device__ __forceinline__ unsigned pk4_fp8(float a, float b, float c, float d) { int w = 0; w = __builtin_amdgcn_cvt_pk_fp8_f32(a, b, w, false); w = __builtin_amdgcn_cvt_pk_fp8_f32(c, d, w, true); return (unsigned)w; }
__device__ __forceinline__ u32x4 xp16(u32x4 w, int src) { u32x4 r; r.x = __shfl(w.x, src); r.y = __shfl(w.y, src); r.z = __shfl(w.z, src); r.w = __shfl(w.w, src); return r; }
__device__ __forceinline__ u32x2 xp8(u32x2 w, int src) { u32x2 r; r.x = __shfl(w.x, src); r.y = __shfl(w.y, src); return r; }
template <class DT, class LD, class F>
__device__ __forceinline__ void epi_perm_pipe(const f32x4 (&acc)[2][2][4][2], int wr, int wc, int fr, int fq, LD&& ld, F&& f) {
    DT cur = ld(wr * 64 + fr, wc * 64 + 8 * fq);
#pragma unroll
    for (int it = 0; it < 16; ++it) { const int ai = it >> 3, m = (it >> 1) & 3, bj = it & 1; const int rt = ai * 128 + wr * 64 + m * 16 + fr, ct = wc * 64 + bj * 32 + 8 * fq;
        DT nxt = cur;
        if (it + 1 < 16) { const int i2 = it + 1, a2 = i2 >> 3, m2 = (i2 >> 1) & 3, b2 = i2 & 1; nxt = ld(a2 * 128 + wr * 64 + m2 * 16 + fr, wc * 64 + b2 * 32 + 8 * fq); }
        asm volatile("" ::: "memory");
        f(rt, ct, acc[ai][bj][m][0], acc[ai][bj][m][1], cur);
        cur = nxt; }
}
__device__ __forceinline__ u32x4 pack8(f32x4 v0, f32x4 v1) { u32x4 w; w.x = pk2(v0[0], v0[1]); w.y = pk2(v0[2], v0[3]); w.z = pk2(v1[0], v1[1]); w.w = pk2(v1[2], v1[3]); return w; }
__device__ __forceinline__ float gelu_tanh(float x) { const float u = 1.5957691216057308f * (x + 0.044715f * x * x * x); return x * sigmoidf_(u); }
__device__ __forceinline__ void unpack8(u32x4 w, float (&f)[8]) { f[0] = bflo(w.x); f[1] = bfhi(w.x); f[2] = bflo(w.y); f[3] = bfhi(w.y); f[4] = bflo(w.z); f[5] = bfhi(w.z); f[6] = bflo(w.w); f[7] = bfhi(w.w); }

struct EpiCtx {
    static constexpr bool PERM = true; static constexpr bool MID = false; static constexpr int NST = 16;
    bf16* ZC;
    __device__ __forceinline__ void operator()(const f32x4 (&acc)[2][2][4][2], const Unit& u, int wr, int wc, int fr, int fq) const {
        const int pn = u.pn; const int ctile = pn < 4 ? pn : pn - 8;
        const float sc = (pn >= 12 && pn < 16) ? K_SCALE : 1.0f;
        char* zc = (char*)(ZC + (size_t)(u.pm - 256) * 256 * ZC_LD + ctile * 256); int ldz = ZC_LD; asm volatile("" : "+s"(ldz));
        const int ln = fq * 16 + fr, xs = (ln & 3) * 16 + (ln >> 2), dr = (ln >> 2) - fr, dc = 8 * ((ln & 3) - fq);
        epi_perm_loop(acc, wr, wc, fr, fq, [&](int rt, int ct, f32x4 v0, f32x4 v1) { v0 *= sc; v1 *= sc; *(u32x4*)(zc + (unsigned)(((rt + dr) * ldz + ct + dc) * 2)) = xp16(pack8(v0, v1), xs); });
    }
};
struct EpiIn {
    static constexpr bool PERM = true; static constexpr bool MID = false; static constexpr int NST = 16;
    bf16* Z; const f32x2* rope; int dry;
    template <bool ROPE>
    __device__ __forceinline__ void run(const f32x4 (&acc)[2][2][4][2], const Unit& u, int wr, int wc, int fr, int fq, float sc) const {
        const int pn = u.pn; const int row0 = u.pm * 256, col0 = pn * 256; const f32x2* rp_ = rope;
        char* zt = (char*)(Z + (size_t)row0 * ZLD + col0); int ldz = ZLD; asm volatile("" : "+s"(ldz));
        const int ln = fq * 16 + fr;
        f32x4 cq[2][2], nq[2][2];
        auto ldrope = [&](int g, f32x4 (&q)[2][2]) { const int ai = g >> 2, m = g & 3; const int rt = ai * 128 + wr * 64 + m * 16 + fr; const int t = (row0 + rt) & (SEQ - 1);
#pragma unroll
            for (int bj = 0; bj < 2; ++bj) { const int ct = wc * 64 + bj * 32 + 8 * fq; const int e0 = (col0 + ct) & 127; const int p0 = e0 >> 1;
                const int pos = p0 < 32 ? (t >> 6) : (t & 63); const int f0 = p0 & 31; const f32x4* rp = (const f32x4*)(rp_ + pos * 32 + f0);
                q[bj][0] = rp[0]; q[bj][1] = rp[1]; } };
        if constexpr (ROPE) ldrope(0, cq);
#pragma unroll
        for (int g = 0; g < 8; ++g) { const int ai = g >> 2, m = g & 3; const int rt = ai * 128 + wr * 64 + m * 16 + fr; u32x4 pw[2];
            if constexpr (ROPE) { if (g + 1 < 8) ldrope(g + 1, nq); }
            asm volatile("" ::: "memory");
#pragma unroll
            for (int bj = 0; bj < 2; ++bj) { f32x4 v0 = acc[ai][bj][m][0], v1 = acc[ai][bj][m][1];
                if constexpr (ROPE) { const f32x4 cs0 = cq[bj][0], cs1 = cq[bj][1]; f32x4 o0, o1;
                    o0[0] = v0[0] * cs0[0] - v0[1] * cs0[1]; o0[1] = v0[0] * cs0[1] + v0[1] * cs0[0];
                    o0[2] = v0[2] * cs0[2] - v0[3] * cs0[3]; o0[3] = v0[2] * cs0[3] + v0[3] * cs0[2];
                    o1[0] = v1[0] * cs1[0] - v1[1] * cs1[1]; o1[1] = v1[0] * cs1[1] + v1[1] * cs1[0];
                    o1[2] = v1[2] * cs1[2] - v1[3] * cs1[3]; o1[3] = v1[2] * cs1[3] + v1[3] * cs1[2];
                    v0 = o0 * sc; v1 = o1 * sc; }
                pw[bj] = pack8(v0, v1); }
#pragma unroll
            for (int s = 0; s < 2; ++s) { const int rr = 8 * s + (ln >> 3), pp = ln & 7; const int srcl = (pp & 3) * 16 + rr;
                const u32x4 a0 = xp16(pw[0], srcl), a1 = xp16(pw[1], srcl); const u32x4 ow = (pp >> 2) ? a1 : a0;
                if (!(MK_DRYMODE == 1 && dry) || ow.x == 0x7fc12345u) __builtin_nontemporal_store(ow, (u32x4*)(zt + (unsigned)(((rt - fr + rr) * ldz + wc * 64 + 8 * pp) * 2))); }
            if constexpr (ROPE) {
#pragma unroll
                for (int bj = 0; bj < 2; ++bj) { cq[bj][0] = nq[bj][0]; cq[bj][1] = nq[bj][1]; } }
            asm volatile("" ::: "memory"); }
    }
    __device__ __forceinline__ void operator()(const f32x4 (&acc)[2][2][4][2], const Unit& u, int wr, int wc, int fr, int fq) const {
        if (MK_DRYMODE >= 2 && dry) return;
        const int pn = u.pn;
        if (pn >= 8 && pn < 16) run<true>(acc, u, wr, wc, fr, fq, pn >= 12 ? K_SCALE : 1.0f); else run<false>(acc, u, wr, wc, fr, fq, 1.0f);
    }
};
struct EpiT1 {
    static constexpr bool PERM = true; static constexpr bool MID = false; static constexpr int NST = 16;
    const bf16* Z; bf16* T1;
    __device__ __forceinline__ void operator()(const f32x4 (&acc)[2][2][4][2], const Unit& u, int wr, int wc, int fr, int fq) const {
        const char* zt = (const char*)(Z + (size_t)u.pm * 256 * ZLD + C_GA + u.pn * 256); char* tt = (char*)(T1 + (size_t)u.pm * 256 * D + u.pn * 256);
        int ldz = ZLD, ldt = D; asm volatile("" : "+s"(ldz), "+s"(ldt));
        const int ln = fq * 16 + fr, xs = (ln & 3) * 16 + (ln >> 2), dr = (ln >> 2) - fr, dc = 8 * ((ln & 3) - fq);
        epi_perm_pipe<u32x4>(acc, wr, wc, fr, fq, [&](int rt, int ct) { return *(const u32x4*)(zt + (unsigned)((rt * ldz + ct) * 2)); },
            [&](int rt, int ct, f32x4 v0, f32x4 v1, u32x4 gw) { float gte[8]; unpack8(gw, gte);
            for (int j = 0; j < 4; ++j) { v0[j] *= sigmoidf_(gte[j]); v1[j] *= sigmoidf_(gte[4 + j]); }
            *(u32x4*)(tt + (unsigned)(((rt + dr) * ldt + ct + dc) * 2)) = xp16(pack8(v0, v1), xs); });
    }
};
struct EpiMg {
    static constexpr bool PERM = true; static constexpr bool MID = false; static constexpr int NST = 16;
    const bf16* Z; const bf16* T1; bf16* MG;
    __device__ __forceinline__ void operator()(const f32x4 (&acc)[2][2][4][2], const Unit& u, int wr, int wc, int fr, int fq) const {
        const char* zt = (const char*)(Z + (size_t)u.pm * 256 * ZLD + C_GB + u.pn * 256); const char* tt = (const char*)(T1 + (size_t)u.pm * 256 * D + u.pn * 256); char* mt = (char*)(MG + (size_t)u.pm * 256 * D + u.pn * 256);
        int ldz = ZLD, ldt = D; asm volatile("" : "+s"(ldz), "+s"(ldt));
        const int ln = fq * 16 + fr, xs = (ln & 3) * 16 + (ln >> 2), dr = (ln >> 2) - fr, dc = 8 * ((ln & 3) - fq);
        struct D2 { u32x4 a, b; };
        epi_perm_pipe<D2>(acc, wr, wc, fr, fq, [&](int rt, int ct) { D2 d; d.a = *(const u32x4*)(zt + (unsigned)((rt * ldz + ct) * 2)); d.b = *(const u32x4*)(tt + (unsigned)((rt * ldt + ct) * 2)); return d; },
            [&](int rt, int ct, f32x4 v0, f32x4 v1, D2 dd) { float gte[8], t1v[8]; unpack8(dd.a, gte); unpack8(dd.b, t1v);
            for (int j = 0; j < 4; ++j) { v0[j] = t1v[j] + v0[j] * sigmoidf_(gte[j]); v1[j] = t1v[4 + j] + v1[j] * sigmoidf_(gte[4 + j]); }
            *(u32x4*)(mt + (unsigned)(((rt + dr) * ldt + ct + dc) * 2)) = xp16(pack8(v0, v1), xs); });
    }
};
struct EpiF {
    static constexpr bool PERM = true; static constexpr bool MID = true; static constexpr int NST = 16;
    const bf16* Z; bf16* MG; int dry;
    __device__ __forceinline__ bool is_mid(const Unit& u) const { return u.koff == 0; }
    __device__ __forceinline__ void mid(f32x4 (&acc)[2][2][4][2], const Unit& u, int wr, int wc, int fr, int fq) const {
        if (MK_DRYMODE == 2 && dry) return;
        const char* za = (const char*)(Z + (size_t)u.pm * 256 * ZLD + C_GA + u.pn * 256); const char* zb = za + (C_GB - C_GA) * 2;
        int ldz = ZLD; asm volatile("" : "+s"(ldz));
        auto off = [&](int it) { const int ai = it >> 3, m = (it >> 1) & 3, bj = it & 1; return (unsigned)(((ai * 128 + wr * 64 + m * 16 + fr) * ldz + wc * 64 + bj * 32 + 8 * fq) * 2); };
        u32x4 qa[3], qb[3];
        qa[0] = *(const u32x4*)(za + off(0)); qb[0] = *(const u32x4*)(zb + off(0)); qa[1] = *(const u32x4*)(za + off(1)); qb[1] = *(const u32x4*)(zb + off(1));
#pragma unroll
        for (int it = 0; it < 16; ++it) { const int ai = it >> 3, m = (it >> 1) & 3, bj = it & 1;
            if (it + 2 < 16) { qa[(it + 2) % 3] = *(const u32x4*)(za + off(it + 2)); qb[(it + 2) % 3] = *(const u32x4*)(zb + off(it + 2)); }
            asm volatile("" ::: "memory");
            float ga[8], gb[8]; unpack8(qa[it % 3], ga); unpack8(qb[it % 3], gb);
#pragma unroll
            for (int j = 0; j < 4; ++j) {
                acc[ai][bj][m][0][j] *= (1.0f + fminf(__expf(-gb[j]), 1e30f)) * __builtin_amdgcn_rcpf(1.0f + __expf(-ga[j]));
                acc[ai][bj][m][1][j] *= (1.0f + fminf(__expf(-gb[4 + j]), 1e30f)) * __builtin_amdgcn_rcpf(1.0f + __expf(-ga[4 + j])); } }
    }
    __device__ __forceinline__ void operator()(const f32x4 (&acc)[2][2][4][2], const Unit& u, int wr, int wc, int fr, int fq) const {
        if (MK_DRYMODE == 2 && dry) return;
        const char* zb = (const char*)(Z + (size_t)u.pm * 256 * ZLD + C_GB + u.pn * 256); char* mt = (char*)(MG + (size_t)u.pm * 256 * D + u.pn * 256);
        int ldz = ZLD, ldt = D; asm volatile("" : "+s"(ldz), "+s"(ldt));
        const int ln = fq * 16 + fr, xs = (ln & 3) * 16 + (ln >> 2), dr = (ln >> 2) - fr, dc = 8 * ((ln & 3) - fq);
        auto off = [&](int it) { const int ai = it >> 3, m = (it >> 1) & 3, bj = it & 1; return (unsigned)(((ai * 128 + wr * 64 + m * 16 + fr) * ldz + wc * 64 + bj * 32 + 8 * fq) * 2); };
        u32x4 qb[4]; qb[0] = *(const u32x4*)(zb + off(0)); qb[1] = *(const u32x4*)(zb + off(1)); qb[2] = *(const u32x4*)(zb + off(2));
#pragma unroll
        for (int it = 0; it < 16; ++it) { const int ai = it >> 3, m = (it >> 1) & 3, bj = it & 1; const int rt = ai * 128 + wr * 64 + m * 16 + fr, ct = wc * 64 + bj * 32 + 8 * fq;
            if (it + 3 < 16) qb[(it + 3) & 3] = *(const u32x4*)(zb + off(it + 3));
            asm volatile("" ::: "memory");
            float gb[8]; unpack8(qb[it & 3], gb); f32x4 v0 = acc[ai][bj][m][0], v1 = acc[ai][bj][m][1];
#pragma unroll
            for (int j = 0; j < 4; ++j) { v0[j] *= __builtin_amdgcn_rcpf(1.0f + fminf(__expf(-gb[j]), 1e30f)); v1[j] *= __builtin_amdgcn_rcpf(1.0f + fminf(__expf(-gb[4 + j]), 1e30f)); }
            *(u32x4*)(mt + (unsigned)(((rt + dr) * ldt + ct + dc) * 2)) = xp16(pack8(v0, v1), xs); }
    }
};
struct EpiX1 {
    static constexpr bool PERM = false; static constexpr bool MID = false; static constexpr int NST = 32;
    const float* X; float* O; const float* mod; int grow0;
    __device__ __forceinline__ void operator()(const f32x4 (&acc)[2][2][4][2], const Unit& u, int wr, int wc, int fr, int fq) const {
        const int trow = grow0 + u.pm * 256; const int b = trow >> 13;
        const char* xt = (const char*)(X + (size_t)trow * D + u.pn * 256); char* ot = (char*)(O + (size_t)trow * D + u.pn * 256); const float* g1 = mod + b * 6144 + 2048 + u.pn * 256;
        int ldx = D; asm volatile("" : "+s"(ldx));
        const int ln = fq * 16 + fr, xs = (ln & 3) * 16 + (ln >> 2);
        const int r0 = wr * 64 + (ln >> 2), c0 = wc * 64 + 4 * (ln & 3), c0g = wc * 64 + 4 * fq;
        f32x4 gv[2][2];
#pragma unroll
        for (int bj = 0; bj < 2; ++bj)
#pragma unroll
            for (int n = 0; n < 2; ++n) gv[bj][n] = *(const f32x4*)(g1 + c0g + bj * 32 + n * 16);
        auto xoff = [&](int it) { const int bj = it >> 4, n = (it >> 3) & 1, ai = (it >> 2) & 1, m = it & 3; return (unsigned)(((r0 + ai * 128 + m * 16) * ldx + c0 + bj * 32 + n * 16) * 4); };
        f32x4 xq[3]; xq[0] = *(const f32x4*)(xt + xoff(0)); xq[1] = *(const f32x4*)(xt + xoff(1));
#pragma unroll
        for (int it = 0; it < 32; ++it) { const int bj = it >> 4, n = (it >> 3) & 1, ai = (it >> 2) & 1, m = it & 3;
            if (it + 2 < 32) xq[(it + 2) % 3] = *(const f32x4*)(xt + xoff(it + 2));
            asm volatile("" ::: "memory");
            const f32x4 pr = gv[bj][n] * acc[ai][bj][m][n]; const u32x4 ps = xp16(__builtin_bit_cast(u32x4, pr), xs);
            *(f32x4*)(ot + xoff(it)) = xq[it % 3] + __builtin_bit_cast(f32x4, ps); }
    }
};
__device__ __forceinline__ float swiglu1(float g, float l) { const float gl = fminf(g, 7.0f), li = fminf(fmaxf(l, -7.0f), 7.0f); return gl * sigmoidf_(1.702f * gl) * (li + 1.0f); }
struct EpiHid {
    static constexpr bool PERM = true; static constexpr bool MID = false; static constexpr int NST = 16;
    unsigned char* HID; const float* b1;
    __device__ __forceinline__ void operator()(const f32x4 (&acc)[2][2][4][2], const Unit& u, int wr, int wc, int fr, int fq) const {
        const int e = u.pn >> 3, pl = u.pn & 7; const float* bb = b1 + e * 2048 + pl * 256; char* ht = (char*)(HID + (size_t)u.pm * 256 * DEXP + pl * 128);
        int ldh = DEXP; asm volatile("" : "+s"(ldh));
        const int ln = fq * 16 + fr, xs = (ln & 3) * 16 + (ln >> 2), dr = (ln >> 2) - fr, dc = 8 * ((ln & 3) - fq);
        f32x4 bq[2][2];
#pragma unroll
        for (int bj = 0; bj < 2; ++bj) { bq[bj][0] = *(const f32x4*)(bb + wc * 64 + bj * 32 + 8 * fq); bq[bj][1] = *(const f32x4*)(bb + wc * 64 + bj * 32 + 8 * fq + 4); }
        epi_perm_loop(acc, wr, wc, fr, fq, [&](int rt, int ct, f32x4 v0, f32x4 v1) { v0 += bq[(ct >> 5) & 1][0]; v1 += bq[(ct >> 5) & 1][1];
            const unsigned w = pk4_fp8(swiglu1(v0[0], v0[1]), swiglu1(v0[2], v0[3]), swiglu1(v1[0], v1[1]), swiglu1(v1[2], v1[3]));
            *(unsigned*)(ht + (unsigned)((rt + dr) * ldh + ((ct + dc) >> 1))) = (unsigned)__shfl((int)w, xs); });
    }
};
struct EpiY {
    static constexpr bool PERM = true; static constexpr bool MID = false; static constexpr int NST = 16;
    unsigned char* Y; const float* b2;
    __device__ __forceinline__ void operator()(const f32x4 (&acc)[2][2][4][2], const Unit& u, int wr, int wc, int fr, int fq) const {
        const int e = u.pn >> 2, pl = u.pn & 3; const float* bb = b2 + e * 1024 + pl * 256; char* yt = (char*)(Y + (size_t)u.pm * 256 * D + pl * 256);
        int ldy = D; asm volatile("" : "+s"(ldy));
        const int ln = fq * 16 + fr, xs = (ln & 3) * 16 + (ln >> 2), dr = (ln >> 2) - fr, dc = 8 * ((ln & 3) - fq);
        f32x4 bq[2][2];
#pragma unroll
        for (int bj = 0; bj < 2; ++bj) { bq[bj][0] = *(const f32x4*)(bb + wc * 64 + bj * 32 + 8 * fq); bq[bj][1] = *(const f32x4*)(bb + wc * 64 + bj * 32 + 8 * fq + 4); }
        epi_perm_loop(acc, wr, wc, fr, fq, [&](int rt, int ct, f32x4 v0, f32x4 v1) { v0 += bq[(ct >> 5) & 1][0]; v1 += bq[(ct >> 5) & 1][1];
            u32x2 w8; w8.x = pk4_fp8(v0[0], v0[1], v0[2], v0[3]); w8.y = pk4_fp8(v1[0], v1[1], v1[2], v1[3]);
            *(u32x2*)(yt + (unsigned)((rt + dr) * ldy + ct + dc)) = xp8(w8, xs); });
    }
};

#define XB_TMO      128
#define XB_XCNT(j)  (256  + 64 * (j))
#define XB_XSUB(j)  (1280 + 64 * (j))
#define XB_XGEN(j)  (2304 + 64 * (j))
#define XB_TOP      3328
#define XB_TOPGEN   3392
#define XCD_BAR_WORDS 3456
#define XB_SPIN_CAP (1u << 22)
__device__ __forceinline__ unsigned xb_ld(unsigned* p)              { return __hip_atomic_load(p, __ATOMIC_RELAXED, __HIP_MEMORY_SCOPE_AGENT); }
__device__ __forceinline__ unsigned xb_add(unsigned* p, unsigned v) { return __hip_atomic_fetch_add(p, v, __ATOMIC_RELAXED, __HIP_MEMORY_SCOPE_AGENT); }
__device__ __forceinline__ unsigned xb_xcc_id() { return (unsigned)__builtin_amdgcn_s_getreg((3 << 11) | 20) & 0xFu; }
#define XB_SPIN(cond, bar) do { unsigned _sp = 0; while (cond) { __builtin_amdgcn_s_sleep(1); \
    if ((++_sp & 255u) == 0u) { if (xb_ld(&(bar)[XB_TMO])) break; if (_sp > XB_SPIN_CAP) { atomicAdd(&(bar)[XB_TMO], 1u); break; } } } } while (0)
struct XcdBarrier { unsigned* bar; unsigned x; volatile LAS unsigned* st; };
__device__ __forceinline__ XcdBarrier xcd_barrier_post(unsigned* bar, volatile LAS unsigned* st) {
    XcdBarrier b; b.bar = bar; b.x = xb_xcc_id(); b.st = st;
    if (threadIdx.x == 0) (void)xb_add(&bar[XB_XCNT(b.x)], 1u);
    return b;
}
__device__ __forceinline__ void xcd_barrier_complete(unsigned* bar, unsigned x, unsigned& nloc, unsigned& nx) {
    const unsigned G = gridDim.x * gridDim.y * gridDim.z;
    unsigned sum, cnt, mine, sp = 0u;
    for (;;) {
        sum = 0u; cnt = 0u; mine = 0u;
#pragma unroll
        for (unsigned j = 0; j < 16; ++j) { const unsigned c = xb_ld(&bar[XB_XCNT(j)]); sum += c; cnt += (c > 0u) ? 1u : 0u; mine = (j == x) ? c : mine; }
        if (sum == G) break;
        __builtin_amdgcn_s_sleep(1);
        if ((++sp & 255u) == 0u) { if (xb_ld(&bar[XB_TMO])) break; if (sp > XB_SPIN_CAP) { atomicAdd(&bar[XB_TMO], 1u); break; } }
    }
    nloc = mine > 0u ? mine : 1u; nx = cnt > 0u ? cnt : 1u;
}
__device__ __forceinline__ void xcd_barrier(const XcdBarrier& b) {
    asm volatile("s_waitcnt vmcnt(0)" ::: "memory");
    __syncthreads();
    if (threadIdx.x == 0) {
        unsigned* bar = b.bar;
        __builtin_amdgcn_s_waitcnt(0);
        unsigned nloc = b.st[0], nx = b.st[1];
        if (nloc == 0u) { xcd_barrier_complete(bar, b.x, nloc, nx); b.st[0] = nloc; b.st[1] = nx; }
        const unsigned old = xb_add(&bar[XB_XSUB(b.x)], 1u);
        const unsigned gen = old / nloc;
        if (old + 1u == (gen + 1u) * nloc) {
            __builtin_amdgcn_fence(__ATOMIC_RELEASE, "agent");
            asm volatile("s_waitcnt vmcnt(0)" ::: "memory");
            const unsigned og = xb_add(&bar[XB_TOP], 1u);
            const unsigned tg = og / nx;
            if (og + 1u == (tg + 1u) * nx) xb_add(&bar[XB_TOPGEN], 1u);
            else XB_SPIN(xb_ld(&bar[XB_TOPGEN]) == tg, bar);
            __builtin_amdgcn_fence(__ATOMIC_ACQUIRE, "agent");
            xb_add(&bar[XB_XGEN(b.x)], 1u);
            asm volatile("s_waitcnt vmcnt(0)" ::: "memory");
        } else {
            XB_SPIN(xb_ld(&bar[XB_XGEN(b.x)]) == gen, bar);
            __builtin_amdgcn_fence(__ATOMIC_ACQUIRE, "agent");
            asm volatile("s_waitcnt vmcnt(0)" ::: "memory");
        }
    }
    __syncthreads();
}

__device__ __forceinline__ void transpose_item(const float* W, int ldw, int K, int N, bf16* WT, LAS float* scr, int item, int lane) {
    const int nblk = N / 32, kb = item / nblk, nb = item % nblk, k0 = 64 * kb, n0 = 32 * nb;
#pragma unroll 8
    for (int i = 0; i < 32; ++i) { const int kk = 2 * i + (lane >> 5); scr[kk * 33 + (lane & 31)] = W[(size_t)(k0 + kk) * ldw + n0 + (lane & 31)]; }
    LDS_WAIT(); asm volatile("" ::: "memory");
    const int c = lane & 7;
#pragma unroll
    for (int j = 0; j < 4; ++j) { const int n = (lane >> 3) + 8 * j; const LAS float* s = scr + (8 * c) * 33 + n;
        u32x4 o; o.x = pk2(s[0 * 33], s[1 * 33]); o.y = pk2(s[2 * 33], s[3 * 33]); o.z = pk2(s[4 * 33], s[5 * 33]); o.w = pk2(s[6 * 33], s[7 * 33]);
        *(u32x4*)(WT + (size_t)(n0 + n) * K + k0 + 8 * c) = o; }
    LDS_WAIT(); asm volatile("" ::: "memory");
}
struct TrTile { const float* src; bf16* dst; int ldw, ldt; };
__device__ __forceinline__ void tr_load(const TrTile& t, int tid, f32x4 (&v)[8]) {
#pragma unroll
    for (int i = 0; i < 8; ++i) { const int id = tid + 512 * i, k = id >> 5, c4 = id & 31; v[i] = *(const f32x4*)(t.src + (size_t)k * t.ldw + 4 * c4); }
}
__device__ __forceinline__ void tr_store(const TrTile& t, int tid, const f32x4 (&v)[8], LAS float* L) {
#pragma unroll
    for (int i = 0; i < 8; ++i) { const int id = tid + 512 * i, k = id >> 5, c4 = id & 31;
        L[(4 * c4 + 0) * 129 + k] = v[i][0]; L[(4 * c4 + 1) * 129 + k] = v[i][1]; L[(4 * c4 + 2) * 129 + k] = v[i][2]; L[(4 * c4 + 3) * 129 + k] = v[i][3]; }
    __syncthreads();
#pragma unroll
    for (int i = 0; i < 4; ++i) { const int id = tid + 512 * i, kc = id & 15, n = id >> 4; const LAS float* s = L + n * 129 + 8 * kc;
        u32x4 o; o.x = pk2(s[0], s[1]); o.y = pk2(s[2], s[3]); o.z = pk2(s[4], s[5]); o.w = pk2(s[6], s[7]);
        *(u32x4*)(t.dst + (size_t)n * t.ldt + 8 * kc) = o; }
    __syncthreads();
}
template <bool FP8 = false>
__device__ __forceinline__ void tr_strip_i8(const float* src, int ldw, int K, signed char* dst, int ldt, float* scales, int tid, LAS unsigned* TL, LAS unsigned* CM) {
    constexpr float QMAX = FP8 ? 448.0f : 127.0f;
    const int c4 = tid & 31, g = tid >> 5, nk = K / 128;
    const float* p = src + (size_t)(4 * g) * ldw + 4 * c4;
    auto ld8 = [&](int kt, f32x4 (&v)[8]) {
#pragma unroll
        for (int h = 0; h < 2; ++h)
#pragma unroll
            for (int r = 0; r < 4; ++r) v[4 * h + r] = *(const f32x4*)(p + (size_t)(kt * 128 + 64 * h + r) * ldw); };
    float mx[4] = {0.f, 0.f, 0.f, 0.f};
    auto red = [&](const f32x4 (&v)[8]) {
#pragma unroll
        for (int i = 0; i < 8; ++i)
#pragma unroll
            for (int j = 0; j < 4; ++j) mx[j] = fmaxf(mx[j], fabsf(v[i][j])); };
    {   f32x4 va[8], vb[8]; ld8(0, va);
#pragma unroll 1
        for (int kt = 0; kt < nk; kt += 2) { ld8(kt + 1, vb); red(va); if (kt + 2 < nk) ld8(kt + 2, va); red(vb); } }
    f32x4 v[8]; ld8(0, v);
    if (tid < 128) CM[tid] = 0u;
    __syncthreads();
#pragma unroll
    for (int j = 0; j < 4; ++j) __hip_atomic_fetch_max(&CM[4 * c4 + j], __builtin_bit_cast(unsigned, mx[j]), __ATOMIC_RELAXED, __HIP_MEMORY_SCOPE_WORKGROUP);
    __syncthreads();
    if (tid < 128) { const float m = __builtin_bit_cast(float, CM[tid]); scales[tid] = m > 0.f ? m * (1.0f / QMAX) : 1.0f; }
    float inv[4];
#pragma unroll
    for (int j = 0; j < 4; ++j) { const float m = __builtin_bit_cast(float, CM[4 * c4 + j]); inv[j] = m > 0.f ? QMAX / m : 0.f; }
#pragma unroll 1
    for (int kt = 0; kt < nk; ++kt) {
        f32x4 w[8];
#pragma unroll
        for (int i = 0; i < 8; ++i) w[i] = v[i];
        if (kt + 1 < nk) ld8(kt + 1, v);
        LAS unsigned* T = TL + (kt & 1) * 4352;
#pragma unroll
        for (int h = 0; h < 2; ++h)
#pragma unroll
            for (int j = 0; j < 4; ++j) { unsigned pk;
                if constexpr (FP8) pk = pk4_fp8(w[4 * h][j] * inv[j], w[4 * h + 1][j] * inv[j], w[4 * h + 2][j] * inv[j], w[4 * h + 3][j] * inv[j]);
                else pk = q8x4((f32x4){w[4 * h][j], w[4 * h + 1][j], w[4 * h + 2][j], w[4 * h + 3][j]}, inv[j]);
                T[c4 * 133 + j * 33 + 16 * h + g] = pk; }
        __syncthreads();
#pragma unroll
        for (int i = 0; i < 2; ++i) { const int id = tid + 512 * i, kc = id & 7, n = id >> 3; const LAS unsigned* s = T + (n >> 2) * 133 + (n & 3) * 33 + 4 * kc;
            *(u32x4*)(dst + (size_t)n * ldt + kt * 128 + 16 * kc) = (u32x4){s[0], s[1], s[2], s[3]}; }
    }
    __syncthreads();
}
__device__ __forceinline__ unsigned offb(unsigned row, unsigned ch) { return 256u * row + 16u * (ch ^ (((row & 3u) << 2) | ((row >> 2) & 3u))); }
typedef short v4i16_t __attribute__((ext_vector_type(4)));
__device__ __forceinline__ s16x4 trd(const LAS unsigned char* p) { return __builtin_bit_cast(s16x4, __builtin_amdgcn_ds_read_tr16_b64_v4i16((LAS v4i16_t*)p)); }
#define MFMA32(a, b, c) __builtin_amdgcn_mfma_f32_32x32x16_bf16((a), (b), (c), 0, 0, 0)
#define MFMA16(a, b, c) __builtin_amdgcn_mfma_f32_16x16x32_bf16((a), (b), (c), 0, 0, 0)
__device__ __forceinline__ int crow(int reg, int h) { return (reg & 3) + 8 * (reg >> 2) + 4 * h; }

struct LruP { const float *conv_w, *conv_b, *ba, *bx, *lam; const bf16* wg; f32x2* carry; };
template <int PASS, int DIR>
__device__ __forceinline__ void lru_dir(LAS unsigned char* XC, LAS unsigned char* RN, const LruP& P, int b, int cp, int n, int w, int col, int g4) {
    const int ch = 128 * n + 16 * w + col;
    const float bav = P.ba[DIR * 1024 + ch], bxv = P.bx[DIR * 1024 + ch];
    const float c8 = 8.0f * log1pf(expf(-P.lam[DIR * 1024 + ch]));
    bf16x8 Ba[4], Bx[4];
    { const bf16* wa = P.wg + ((size_t)((n * 4 + DIR * 2 + 0) * 128 + 16 * w + col)) * 128 + 8 * g4; const bf16* wx = wa + 128 * 128;
#pragma unroll
      for (int ks = 0; ks < 4; ++ks) { Ba[ks] = *(const bf16x8*)(wa + 32 * ks); Bx[ks] = *(const bf16x8*)(wx + 32 * ks); } }
    float hrun = 0.f, atot = 1.f;
    if (PASS == 1) {
        const int Pn = DIR == 0 ? cp : 33 - cp; float Al = 1.f, Ul = 0.f;
#pragma unroll
        for (int k = 0; k < 9; ++k) { const int p = 9 * g4 + k;
            if (p < Pn) { const int cq = DIR == 0 ? p : (p == 0 ? 0 : 33 - p); const f32x2 ah = P.carry[((size_t)(b * 2 + DIR) * 33 + cq) * 1024 + ch]; Ul = ah.x * Ul + ah.y; Al = ah.x * Al; } }
#pragma unroll
        for (int gq = 0; gq < 4; ++gq) { const float Ag = __shfl(Al, col + 16 * gq), Ug = __shfl(Ul, col + 16 * gq); hrun = Ag * hrun + Ug; }
    }
#pragma unroll 4
    for (int mi = 0; mi < 16; ++mi) {
        const int m = DIR == 0 ? mi : 15 - mi;
        f32x4 ar = {0.f, 0.f, 0.f, 0.f}, ai = {0.f, 0.f, 0.f, 0.f};
        const LAS unsigned char* xrow = XC + (16 * m + col) * 272 + 16 * g4;
#pragma unroll
        for (int ks = 0; ks < 4; ++ks) { const bf16x8 af = *(const LAS bf16x8*)(xrow + 64 * ks); ar = MFMA16(af, Ba[ks], ar); ai = MFMA16(af, Bx[ks], ai); }
        float av[4], uv[4];
#pragma unroll
        for (int r = 0; r < 4; ++r) { const int t = 16 * m + 4 * g4 + r; const float xc = bf2f(*(const LAS unsigned short*)(XC + t * 272 + (16 * w + col) * 2));
            const float er = __expf(fminf(-(ar[r] + bav), 40.f)) + 1.0f, ei = __expf(fminf(-(ai[r] + bxv), 40.f)) + 1.0f; const float inv = __builtin_amdgcn_rcpf(er * ei);
            const float rg = inv * ei, ig = inv * er; const float a = __expf(-c8 * rg);
            av[r] = a; uv[r] = __builtin_amdgcn_sqrtf(fmaxf(1.0f - a * a, 0.f)) * ig * xc; }
        float Al = 1.f, Ul = 0.f;
#pragma unroll
        for (int rr = 0; rr < 4; ++rr) { const int r = DIR == 0 ? rr : 3 - rr; Ul = av[r] * Ul + uv[r]; Al = av[r] * Al; }
        float Ag[4], Ug[4];
#pragma unroll
        for (int gq = 0; gq < 4; ++gq) { Ag[gq] = __shfl(Al, col + 16 * gq); Ug[gq] = __shfl(Ul, col + 16 * gq); }
        float h = hrun, hin = hrun;
#pragma unroll
        for (int gi = 0; gi < 4; ++gi) { const int gq = DIR == 0 ? gi : 3 - gi; if (gq == g4) hin = h; h = Ag[gq] * h + Ug[gq]; atot *= Ag[gq]; }
        hrun = h;
        if (PASS == 1) {
            float hh = hin;
#pragma unroll
            for (int rr = 0; rr < 4; ++rr) { const int r = DIR == 0 ? rr : 3 - rr; hh = av[r] * hh + uv[r];
                LAS unsigned short* rp = (LAS unsigned short*)(RN + (16 * m + 4 * g4 + r) * 272 + (16 * w + col) * 2);
                if (DIR == 0) *rp = (unsigned short)f2bf(hh); else *rp = (unsigned short)f2bf(bf2f(*rp) + hh); }
        }
    }
    if (PASS == 0) { if (g4 == 0) P.carry[((size_t)(b * 2 + DIR) * 33 + cp) * 1024 + ch] = (f32x2){atot, hrun}; }
}
template <int PASS>
__device__ __forceinline__ void lru_unit(LAS unsigned char* lds, const LruP& P, int b, int cp, int n, const bf16* xsrc, int ldx, int seqlen, const bf16* grp, bf16* gout) {
    const int tid = opaque_tid(), lane = tid & 63, w = __builtin_amdgcn_readfirstlane(tid >> 6), col = lane & 15, g4 = lane >> 4;
    const int t0 = cp == 0 ? 0 : (cp - 1) * 256;
    LAS unsigned char* XC = lds;
    LAS unsigned char* RN = lds + 69632;
    __syncthreads();
    {
        const int j8 = tid & 15, ch0 = 128 * n + 8 * j8;
        float cw[4][8], cb[8];
#pragma unroll
        for (int k = 0; k < 4; ++k) { const f32x4 a = *(const f32x4*)(P.conv_w + k * 1024 + ch0), c = *(const f32x4*)(P.conv_w + k * 1024 + ch0 + 4);
            cw[k][0] = a[0]; cw[k][1] = a[1]; cw[k][2] = a[2]; cw[k][3] = a[3]; cw[k][4] = c[0]; cw[k][5] = c[1]; cw[k][6] = c[2]; cw[k][7] = c[3]; }
        { const f32x4 a = *(const f32x4*)(P.conv_b + ch0), c = *(const f32x4*)(P.conv_b + ch0 + 4); cb[0] = a[0]; cb[1] = a[1]; cb[2] = a[2]; cb[3] = a[3]; cb[4] = c[0]; cb[5] = c[1]; cb[6] = c[2]; cb[7] = c[3]; }
#pragma unroll 4
        for (int i = 0; i < 8; ++i) {
            const int t = (tid >> 4) + 32 * i; float a[8];
#pragma unroll
            for (int j = 0; j < 8; ++j) a[j] = cb[j];
#pragma unroll
            for (int k = 0; k < 4; ++k) { const int row = t0 + t + k - 2;
                if (row >= 0 && row < seqlen) { float xv[8]; unpack8(*(const u32x4*)(xsrc + (size_t)row * ldx + ch0), xv);
#pragma unroll
                    for (int j = 0; j < 8; ++j) a[j] += cw[k][j] * xv[j]; } }
            u32x4 o; o.x = pk2(a[0], a[1]); o.y = pk2(a[2], a[3]); o.z = pk2(a[4], a[5]); o.w = pk2(a[6], a[7]);
            *(LAS u32x4*)(XC + t * 272 + j8 * 16) = o;
        }
    }
    __syncthreads();
    lru_dir<PASS, 0>(XC, RN, P, b, cp, n, w, col, g4);
    lru_dir<PASS, 1>(XC, RN, P, b, cp, n, w, col, g4);
    if (PASS == 1) {
        __syncthreads();
        const int j8 = tid & 15, ch0 = 128 * n + 8 * j8;
#pragma unroll 4
        for (int i = 0; i < 8; ++i) { const int t = (tid >> 4) + 32 * i; float rv[8], gv[8];
            unpack8(*(const LAS u32x4*)(RN + t * 272 + j8 * 16), rv); const bf16* gp_in = grp + (size_t)(t0 + t) * ZLD + C_GR + ch0; unpack8(*(const u32x4*)gp_in, gv); bf16* gp = gout + (size_t)(t0 + t) * D + ch0;
            for (int j = 0; j < 8; ++j) gv[j] = gelu_tanh(gv[j]);
            u32x4 o; o.x = pk2(rv[0] * gv[0], rv[1] * gv[1]); o.y = pk2(rv[2] * gv[2], rv[3] * gv[3]); o.z = pk2(rv[4] * gv[4], rv[5] * gv[5]); o.w = pk2(rv[6] * gv[6], rv[7] * gv[7]);
            *(u32x4*)gp = o; }
    }
}

__device__ __forceinline__ void kv_unit(LAS unsigned char* lds, const bf16* ksrc, const bf16* vsrc, int ld, float l2g, bf16* out) {
    const int tid = opaque_tid(), lane = tid & 63, w = __builtin_amdgcn_readfirstlane(tid >> 6);
    LAS unsigned char* KF = lds; LAS unsigned char* KB = lds + 32768; LAS unsigned char* VI = lds + 65536;
    __syncthreads();
#pragma unroll
    for (int i = 0; i < 4; ++i) { const int idx = tid + 512 * i, j = idx >> 4, chn = idx & 15; float kv[8]; unpack8(*(const u32x4*)(ksrc + (size_t)j * ld + 8 * chn), kv);
        const float wf = exp2f(l2g * (float)(127 - j)), wb = exp2f(l2g * (float)j);
        u32x4 of, ob; of.x = pk2(kv[0] * wf, kv[1] * wf); of.y = pk2(kv[2] * wf, kv[3] * wf); of.z = pk2(kv[4] * wf, kv[5] * wf); of.w = pk2(kv[6] * wf, kv[7] * wf);
        ob.x = pk2(kv[0] * wb, kv[1] * wb); ob.y = pk2(kv[2] * wb, kv[3] * wb); ob.z = pk2(kv[4] * wb, kv[5] * wb); ob.w = pk2(kv[6] * wb, kv[7] * wb);
        *(LAS u32x4*)(KF + offb(j, chn)) = of; *(LAS u32x4*)(KB + offb(j, chn)) = ob; }
#pragma unroll
    for (int i = 0; i < 8; ++i) { const int idx = tid + 512 * i, j = idx >> 5, chn = idx & 31;
        *(LAS u32x4*)(VI + (chn >> 4) * 32768 + offb(j, chn & 15)) = *(const u32x4*)(vsrc + (size_t)j * ld + 8 * chn); }
    __syncthreads();
    const int h = lane >> 5, blk = (lane >> 4) & 1, q = (lane & 15) >> 2, p = lane & 3;
    f32x16 accF[4], accB[4];
#pragma unroll
    for (int dt = 0; dt < 4; ++dt)
#pragma unroll
        for (int r = 0; r < 16; ++r) { accF[dt][r] = 0.f; accB[dt][r] = 0.f; }
    const LAS unsigned char* Vimg = VI + (w >> 2) * 32768; const int cv = w & 3;
#pragma unroll 1
    for (int ks = 0; ks < 8; ++ks) {
        const unsigned r0 = 16 * ks + 8 * h + q, r1 = r0 + 4;
        const s16x4 v0 = trd(Vimg + offb(r0, 4 * cv + 2 * blk + (p >> 1)) + 8 * (p & 1)), v1 = trd(Vimg + offb(r1, 4 * cv + 2 * blk + (p >> 1)) + 8 * (p & 1));
        const bf16x8 bv = __builtin_shufflevector(v0, v1, 0, 1, 2, 3, 4, 5, 6, 7);
#pragma unroll
        for (int dt = 0; dt < 4; ++dt) {
            const unsigned o0 = offb(r0, 4 * dt + 2 * blk + (p >> 1)) + 8 * (p & 1), o1 = offb(r1, 4 * dt + 2 * blk + (p >> 1)) + 8 * (p & 1);
            const bf16x8 af = __builtin_shufflevector(trd(KF + o0), trd(KF + o1), 0, 1, 2, 3, 4, 5, 6, 7);
            const bf16x8 ab = __builtin_shufflevector(trd(KB + o0), trd(KB + o1), 0, 1, 2, 3, 4, 5, 6, 7);
            accF[dt] = MFMA32(af, bv, accF[dt]); accB[dt] = MFMA32(ab, bv, accB[dt]);
        }
    }
    __syncthreads();
    { const int v = 32 * w + (lane & 31);
#pragma unroll
      for (int dt = 0; dt < 4; ++dt)
#pragma unroll
        for (int rg = 0; rg < 4; ++rg) { const int d = 32 * dt + 8 * rg + 4 * h;
            u32x2 of, ob; of.x = pk2(accF[dt][4 * rg], accF[dt][4 * rg + 1]); of.y = pk2(accF[dt][4 * rg + 2], accF[dt][4 * rg + 3]);
            ob.x = pk2(accB[dt][4 * rg], accB[dt][4 * rg + 1]); ob.y = pk2(accB[dt][4 * rg + 2], accB[dt][4 * rg + 3]);
            *(LAS u32x2*)(lds + v * 272 + d * 2) = of; *(LAS u32x2*)(lds + 69632 + v * 272 + d * 2) = ob; } }
    __syncthreads();
#pragma unroll
    for (int i = 0; i < 16; ++i) { const int idx = tid + 512 * i, dir = idx >> 12, v = (idx >> 4) & 255, chn = idx & 15;
        *(u32x4*)(out + (size_t)dir * 32768 + v * 128 + 8 * chn) = *(const LAS u32x4*)(lds + dir * 69632 + v * 272 + chn * 16); }
}

__device__ __forceinline__ void xc_rows(const LruP& P, const bf16* xsrc, int ldx, int lgseq  , int nrows, bf16* dst, int gthread, int nthreads) {
    const int c8 = gthread & 127, ch0 = 8 * c8;
    float cw[4][8], cb[8];
#pragma unroll
    for (int k = 0; k < 4; ++k) { const f32x4 a = *(const f32x4*)(P.conv_w + k * 1024 + ch0), c = *(const f32x4*)(P.conv_w + k * 1024 + ch0 + 4);
        cw[k][0] = a[0]; cw[k][1] = a[1]; cw[k][2] = a[2]; cw[k][3] = a[3]; cw[k][4] = c[0]; cw[k][5] = c[1]; cw[k][6] = c[2]; cw[k][7] = c[3]; }
    { const f32x4 a = *(const f32x4*)(P.conv_b + ch0), c = *(const f32x4*)(P.conv_b + ch0 + 4); cb[0] = a[0]; cb[1] = a[1]; cb[2] = a[2]; cb[3] = a[3]; cb[4] = c[0]; cb[5] = c[1]; cb[6] = c[2]; cb[7] = c[3]; }
    const int seqmask = (1 << lgseq) - 1;
    for (int run = gthread >> 7; run < nrows / 16; run += nthreads >> 7) {
        const int row0 = run * 16, t0 = row0 & seqmask;
        u32x4 xw[19];
#pragma unroll
        for (int k = 0; k < 19; ++k) { const int tt = t0 + k - 2; xw[k] = (tt >= 0 && tt <= seqmask) ? *(const u32x4*)(xsrc + (size_t)(row0 + k - 2) * ldx + ch0) : (u32x4){0u, 0u, 0u, 0u}; }
#pragma unroll
        for (int r = 0; r < 16; ++r) { float a[8];
#pragma unroll
            for (int j = 0; j < 8; ++j) a[j] = cb[j];
#pragma unroll
            for (int k = 0; k < 4; ++k) { float xv[8]; unpack8(xw[r + k], xv);
#pragma unroll
                for (int j = 0; j < 8; ++j) a[j] += cw[k][j] * xv[j]; }
            u32x4 o; o.x = pk2(a[0], a[1]); o.y = pk2(a[2], a[3]); o.z = pk2(a[4], a[5]); o.w = pk2(a[6], a[7]);
            *(u32x4*)(dst + (size_t)(row0 + r) * 1024 + ch0) = o; }
    }
}
__device__ __forceinline__ void lru_sweep(LAS unsigned char* lds, const LruP& P, int n, int sub, int dir, const bf16* xcl, const bf16* xcc, bf16* hout) {
    const int tid = opaque_tid(), lane = tid & 63, w = __builtin_amdgcn_readfirstlane(tid >> 6), col = lane & 15, g4 = lane >> 4;
    LAS unsigned char* XC = lds;
    LAS f32x2* AGG = (LAS f32x2*)(lds + 69632);
    LAS unsigned char* OUT = lds + 69632 + 1024;
    const int chl = 16 * sub + col, ch = 128 * n + chl;
    const float bav = P.ba[dir * 1024 + ch], bxv = P.bx[dir * 1024 + ch];
    const float c8 = 8.0f * log1pf(expf(-P.lam[dir * 1024 + ch]));
    bf16x8 Ba[4], Bx[4];
    { const bf16* wa = P.wg + ((size_t)((n * 4 + dir * 2 + 0) * 128 + chl)) * 128 + 8 * g4; const bf16* wx = wa + 128 * 128;
#pragma unroll
      for (int ks = 0; ks < 4; ++ks) { Ba[ks] = *(const bf16x8*)(wa + 32 * ks); Bx[ks] = *(const bf16x8*)(wx + 32 * ks); } }
    u32x4 xq[8];
    auto gload = [&](int s) { const bf16* srcp = s == 0 ? xcc : xcl + (size_t)(dir ? 32 - s : s - 1) * 256 * 1024;
#pragma unroll
        for (int i = 0; i < 8; ++i) { const int it = tid + 512 * i; xq[i] = *(const u32x4*)(srcp + (size_t)(it >> 4) * 1024 + 128 * n + 8 * (it & 15)); } };
    auto lstore = [&]() {
#pragma unroll
        for (int i = 0; i < 8; ++i) { const int it = tid + 512 * i; *(LAS u32x4*)(XC + (it >> 4) * 272 + (it & 15) * 16) = xq[i]; } };
    float hchunk = 0.f;
    __syncthreads();
    gload(0); lstore();
#pragma unroll 1
    for (int s = 0; s < 33; ++s) {
        __syncthreads();
        if (s + 1 < 33) gload(s + 1);
        if (s >= 2) { const int cprev = dir ? 33 - s : s - 2; *(u32x4*)(hout + (size_t)cprev * 4096 + tid * 8) = *(const LAS u32x4*)(OUT + tid * 16); }
        float av[2][4], uv[2][4], Ag[2][4], Ug[2][4], Am[2], Um[2];
#pragma unroll
        for (int q2 = 0; q2 < 2; ++q2) {
            const int m = dir ? 2 * w + 1 - q2 : 2 * w + q2;
            f32x4 ar = {0.f, 0.f, 0.f, 0.f}, ai = {0.f, 0.f, 0.f, 0.f};
            const LAS unsigned char* xrow = XC + (16 * m + col) * 272 + 16 * g4;
#pragma unroll
            for (int ks = 0; ks < 4; ++ks) { const bf16x8 af = *(const LAS bf16x8*)(xrow + 64 * ks); ar = MFMA16(af, Ba[ks], ar); ai = MFMA16(af, Bx[ks], ai); }
#pragma unroll
            for (int r = 0; r < 4; ++r) { const int t = 16 * m + 4 * g4 + r; const float xc = bf2f(*(const LAS unsigned short*)(XC + t * 272 + chl * 2));
                const float er = __expf(fminf(-(ar[r] + bav), 40.f)) + 1.0f, ei = __expf(fminf(-(ai[r] + bxv), 40.f)) + 1.0f; const float inv = __builtin_amdgcn_rcpf(er * ei);
                const float rg = inv * ei, ig = inv * er; const float a = __expf(-c8 * rg);
                av[q2][r] = a; uv[q2][r] = __builtin_amdgcn_sqrtf(fmaxf(1.0f - a * a, 0.f)) * ig * xc; }
            float Al = 1.f, Ul = 0.f;
#pragma unroll
            for (int rr = 0; rr < 4; ++rr) { const int r = dir ? 3 - rr : rr; Ul = av[q2][r] * Ul + uv[q2][r]; Al = av[q2][r] * Al; }
            float am = 1.f, um = 0.f;
#pragma unroll
            for (int gq = 0; gq < 4; ++gq) { Ag[q2][gq] = __shfl(Al, col + 16 * gq); Ug[q2][gq] = __shfl(Ul, col + 16 * gq); }
#pragma unroll
            for (int gi = 0; gi < 4; ++gi) { const int gq = dir ? 3 - gi : gi; um = Ag[q2][gq] * um + Ug[q2][gq]; am = Ag[q2][gq] * am; }
            Am[q2] = am; Um[q2] = um;
        }
        if (g4 == 0) AGG[w * 16 + col] = (f32x2){Am[0] * Am[1], Am[1] * Um[0] + Um[1]};
        __syncthreads();
        float h = hchunk, hin = hchunk;
#pragma unroll
        for (int wi = 0; wi < 8; ++wi) { const int ww = dir ? 7 - wi : wi; const f32x2 au = AGG[ww * 16 + col]; if (ww == w) hin = h; h = au.x * h + au.y; }
        hchunk = h;
        float hrun = hin;
#pragma unroll
        for (int q2 = 0; q2 < 2; ++q2) {
            const int m = dir ? 2 * w + 1 - q2 : 2 * w + q2;
            float hg = hrun, hmy = hrun;
#pragma unroll
            for (int gi = 0; gi < 4; ++gi) { const int gq = dir ? 3 - gi : gi; if (gq == g4) hmy = hg; hg = Ag[q2][gq] * hg + Ug[q2][gq]; }
            hrun = hg;
            float hh = hmy;
#pragma unroll
            for (int rr = 0; rr < 4; ++rr) { const int r = dir ? 3 - rr : rr; hh = av[q2][r] * hh + uv[q2][r];
                *(LAS unsigned short*)(OUT + (16 * m + 4 * g4 + r) * 32 + col * 2) = (unsigned short)f2bf(hh); }
        }
        if (s + 1 < 33) lstore();
    }
    __syncthreads();
    { const int cprev = dir ? 0 : 31; *(u32x4*)(hout + (size_t)cprev * 4096 + tid * 8) = *(const LAS u32x4*)(OUT + tid * 16); }
}
__device__ __forceinline__ void lru_combine(const bf16* hf, const bf16* hb  , int c, const bf16* grp  , bf16* ar  , int tid) {
    u32x4 qa[8], qb[8], qg[8];
#pragma unroll
    for (int i = 0; i < 8; ++i) { const int it = tid + 512 * i, t = it >> 4, j8 = it & 15; const size_t ho = (size_t)(j8 >> 1) * (32 * 4096) + (size_t)c * 4096 + t * 16 + (j8 & 1) * 8;
        qa[i] = __builtin_nontemporal_load((const u32x4*)(hf + ho)); qb[i] = __builtin_nontemporal_load((const u32x4*)(hb + ho)); qg[i] = *(const u32x4*)(grp + (size_t)t * ZLD + 8 * j8); }
#pragma unroll
    for (int i = 0; i < 8; ++i) { const int it = tid + 512 * i, t = it >> 4, j8 = it & 15;
        float a[8], b[8], g[8]; unpack8(qa[i], a); unpack8(qb[i], b); unpack8(qg[i], g);
        u32x4 o; o.x = pk2((a[0] + b[0]) * gelu_tanh(g[0]), (a[1] + b[1]) * gelu_tanh(g[1])); o.y = pk2((a[2] + b[2]) * gelu_tanh(g[2]), (a[3] + b[3]) * gelu_tanh(g[3]));
        o.z = pk2((a[4] + b[4]) * gelu_tanh(g[4]), (a[5] + b[5]) * gelu_tanh(g[5])); o.w = pk2((a[6] + b[6]) * gelu_tanh(g[6]), (a[7] + b[7]) * gelu_tanh(g[7]));
        *(u32x4*)(ar + (size_t)t * 3072 + 8 * j8) = o; }
}

__device__ __forceinline__ void kvs_unit(LAS unsigned char* lds, const bf16* kctx, const bf16* vctx, const bf16* klat, const bf16* vlat, int dir, int part, float lg, bf16* st) {
    const int tid = opaque_tid(), lane = tid & 63, w = __builtin_amdgcn_readfirstlane(tid >> 6);
    const float l2g = lg * 1.4426950408889634f, cdec = __expf(128.0f * lg);
    const int h = lane >> 5, blk = (lane >> 4) & 1, q = (lane & 15) >> 2, p = lane & 3;
    float wj[4];
#pragma unroll
    for (int i = 0; i < 4; ++i) { const int j = (tid + 512 * i) >> 4; wj[i] = exp2f(l2g * (float)(dir ? j : 127 - j)); }
    f32x16 acc;
#pragma unroll
    for (int r = 0; r < 16; ++r) acc[r] = 0.f;
    u32x4 kq[4][4], vq[4];
    LAS unsigned char* SX = lds + 131072;
    auto src = [&](int s, const bf16*& kp, const bf16*& vp, int& ld) {
        if (s < 2) { const int cc = dir ? 1 - s : s; kp = kctx + (size_t)cc * 128 * ZC_LD; vp = vctx + (size_t)cc * 128 * ZC_LD; ld = ZC_LD; }
        else { const int c = dir ? 65 - s : s - 2; kp = klat + (size_t)c * 128 * ZLD; vp = vlat + (size_t)c * 128 * ZLD; ld = ZLD; } };
    auto gload = [&](int s, u32x4 (&kk)[4], u32x4& vv) { const bf16* kp; const bf16* vp; int ld; src(s, kp, vp, ld);
#pragma unroll
        for (int i = 0; i < 4; ++i) { const int idx = tid + 512 * i, j = idx >> 4, chn = idx & 15; kk[i] = *(const u32x4*)(kp + (size_t)j * ld + 8 * chn); }
        vv = *(const u32x4*)(vp + (size_t)(tid >> 2) * ld + 32 * part + 8 * (tid & 3)); };
    auto lstore = [&](int buf, const u32x4 (&kk)[4], const u32x4& vv) { LAS unsigned char* KB = lds + buf * 65536; LAS unsigned char* VB = KB + 32768;
#pragma unroll
        for (int i = 0; i < 4; ++i) { const int idx = tid + 512 * i, j = idx >> 4, chn = idx & 15; float kv[8]; unpack8(kk[i], kv); const float ww = wj[i];
            u32x4 o; o.x = pk2(kv[0] * ww, kv[1] * ww); o.y = pk2(kv[2] * ww, kv[3] * ww); o.z = pk2(kv[4] * ww, kv[5] * ww); o.w = pk2(kv[6] * ww, kv[7] * ww);
            *(LAS u32x4*)(KB + offb(j, chn)) = o; }
        *(LAS u32x4*)(VB + offb(tid >> 2, tid & 3)) = vv; };
    auto copyout = [&](int sprev) { const int c = dir ? 65 - sprev : sprev - 2;
        const u32x4 o = *(const LAS u32x4*)(SX + (sprev & 1) * 8704 + (tid >> 4) * 272 + (tid & 15) * 16);
        *(u32x4*)(st + (size_t)(c * 2 + dir) * 32768 + (size_t)(32 * part) * 128 + tid * 8) = o; };
    auto step = [&](int s, auto SETC, auto LOADC, auto STAGEC, auto COPYC) {
        constexpr int sp = decltype(SETC)::value;
        if constexpr (decltype(LOADC)::value) gload(s + 3, kq[(sp + 3) & 3], vq[(sp + 3) & 3]);
        if constexpr (decltype(COPYC)::value) copyout(s - 1);
        if (w < 4) {
            if constexpr (decltype(STAGEC)::value) { LAS unsigned char* sx = SX + (s & 1) * 8704 + (lane & 31) * 272 + (32 * w + 4 * h) * 2;
#pragma unroll
                for (int rg = 0; rg < 4; ++rg) { u32x2 o; o.x = pk2(acc[4 * rg], acc[4 * rg + 1]); o.y = pk2(acc[4 * rg + 2], acc[4 * rg + 3]); *(LAS u32x2*)(sx + 16 * rg) = o; } }
#pragma unroll
            for (int r = 0; r < 16; ++r) acc[r] *= cdec;
            const LAS unsigned char* KB = lds + (s & 1) * 65536; const LAS unsigned char* VB = KB + 32768;
#pragma unroll
            for (int ks = 0; ks < 8; ++ks) {
                const unsigned r0 = 16 * ks + 8 * h + q, r1 = r0 + 4;
                const bf16x8 bv = __builtin_shufflevector(trd(VB + offb(r0, 2 * blk + (p >> 1)) + 8 * (p & 1)), trd(VB + offb(r1, 2 * blk + (p >> 1)) + 8 * (p & 1)), 0, 1, 2, 3, 4, 5, 6, 7);
                const bf16x8 ak = __builtin_shufflevector(trd(KB + offb(r0, 4 * w + 2 * blk + (p >> 1)) + 8 * (p & 1)), trd(KB + offb(r1, 4 * w + 2 * blk + (p >> 1)) + 8 * (p & 1)), 0, 1, 2, 3, 4, 5, 6, 7);
                acc = MFMA32(ak, bv, acc);
            }
        }
        if (s + 1 < 66) lstore((s + 1) & 1, kq[(sp + 1) & 3], vq[(sp + 1) & 3]);
        __syncthreads();
    };
    using std::integral_constant; typedef integral_constant<bool, true> T_; typedef integral_constant<bool, false> F_;
    __syncthreads();
    gload(0, kq[0], vq[0]); gload(1, kq[1], vq[1]); gload(2, kq[2], vq[2]); lstore(0, kq[0], vq[0]);
    __syncthreads();
    step(0, integral_constant<int, 0>{}, T_{}, F_{}, F_{});
    step(1, integral_constant<int, 1>{}, T_{}, F_{}, F_{});
    step(2, integral_constant<int, 2>{}, T_{}, T_{}, F_{});
#pragma unroll 1
    for (int s4 = 3; s4 < 63; s4 += 4) {
        step(s4 + 0, integral_constant<int, 3>{}, T_{}, T_{}, T_{});
        step(s4 + 1, integral_constant<int, 0>{}, T_{}, T_{}, T_{});
        step(s4 + 2, integral_constant<int, 1>{}, T_{}, T_{}, T_{});
        step(s4 + 3, integral_constant<int, 2>{}, T_{}, T_{}, T_{});
    }
    step(63, integral_constant<int, 3>{}, F_{}, T_{}, T_{});
    step(64, integral_constant<int, 0>{}, F_{}, T_{}, T_{});
    step(65, integral_constant<int, 1>{}, F_{}, T_{}, T_{});
    copyout(65);
}

__device__ __forceinline__ void ro_unit(LAS unsigned char* lds, const bf16* qsrc, const bf16* ksrc, const bf16* vsrc, const bf16* gsp, bf16* gout, const bf16* Sf, const bf16* Sb, float l2g, int skip = 0) {
    const int tid = opaque_tid(), lane = tid & 63, w = __builtin_amdgcn_readfirstlane(tid >> 6), wi = w & 3, wv = w >> 2;
    LAS unsigned char* SF = lds; LAS unsigned char* SB = lds + 65536;
    LAS unsigned char* KI = lds; LAS unsigned char* VI = lds + 32768; LAS float* STATS = (LAS float*)(lds + 135168);
    const int h = lane >> 5, l31 = lane & 31, blk = (lane >> 4) & 1, q = (lane & 15) >> 2, p = lane & 3;
    __syncthreads();
    if (!(skip & 1)) {   u32x4 sf[8], sb[8];
#pragma unroll
        for (int i = 0; i < 8; ++i) { const int idx = tid + 512 * i; sf[i] = __builtin_nontemporal_load((const u32x4*)(Sf + (size_t)idx * 8)); sb[i] = __builtin_nontemporal_load((const u32x4*)(Sb + (size_t)idx * 8)); }
#pragma unroll
        for (int i = 0; i < 8; ++i) { const int idx = tid + 512 * i, v = idx >> 4, chn = idx & 15; *(LAS u32x4*)(SF + offb(v, chn)) = sf[i]; *(LAS u32x4*)(SB + offb(v, chn)) = sb[i]; }
    }
    bf16x8 qf[8];
#pragma unroll
    for (int s = 0; s < 8; ++s) qf[s] = *(const bf16x8*)(qsrc + (size_t)(32 * wi + l31) * ZLD + 16 * s + 8 * h);
    u32x4 kreg[4], vreg[8];
#pragma unroll
    for (int i = 0; i < 4; ++i) { const int idx = tid + 512 * i, j = idx >> 4, chn = idx & 15; kreg[i] = __builtin_nontemporal_load((const u32x4*)(ksrc + (size_t)j * ZLD + 8 * chn)); }
#pragma unroll
    for (int i = 0; i < 8; ++i) { const int idx = tid + 512 * i, j = idx >> 5, chn = idx & 31; vreg[i] = __builtin_nontemporal_load((const u32x4*)(vsrc + (size_t)j * ZLD + 8 * chn)); }
    __syncthreads();
    f32x16 z[4];
#pragma unroll
    for (int c = 0; c < 4; ++c)
#pragma unroll
        for (int r = 0; r < 16; ++r) z[c][r] = 0.f;
    if (!(skip & 1)) {
#pragma unroll
    for (int s = 0; s < 8; ++s)
#pragma unroll
        for (int c = 0; c < 4; ++c) { const bf16x8 bs = *(const LAS bf16x8*)(SF + offb(128 * wv + 32 * c + l31, 2 * s + h)); z[c] = MFMA32(qf[s], bs, z[c]); }
#pragma unroll
    for (int r = 0; r < 16; ++r) { const int i = 32 * wi + crow(r, h); const float f = exp2f(l2g * (float)(2 * i - 127));
#pragma unroll
        for (int c = 0; c < 4; ++c) z[c][r] *= f; }
#pragma unroll
    for (int s = 0; s < 8; ++s)
#pragma unroll
        for (int c = 0; c < 4; ++c) { const bf16x8 bs = *(const LAS bf16x8*)(SB + offb(128 * wv + 32 * c + l31, 2 * s + h)); z[c] = MFMA32(qf[s], bs, z[c]); }
#pragma unroll
    for (int r = 0; r < 16; ++r) { const int i = 32 * wi + crow(r, h); const float f = exp2f(l2g * (float)(128 - i));
#pragma unroll
        for (int c = 0; c < 4; ++c) z[c][r] *= f; }
    }
    __syncthreads();
#pragma unroll
    for (int i = 0; i < 4; ++i) { const int idx = tid + 512 * i, j = idx >> 4, chn = idx & 15; *(LAS u32x4*)(KI + offb(j, chn)) = kreg[i]; }
#pragma unroll
    for (int i = 0; i < 8; ++i) { const int idx = tid + 512 * i, j = idx >> 5, chn = idx & 31; *(LAS u32x4*)(VI + (chn >> 4) * 32768 + offb(j, chn & 15)) = vreg[i]; }
    __syncthreads();
    const LAS unsigned char* Vimg = VI + wv * 32768;
    u32x4 gsq[8];
#pragma unroll
    for (int i = 0; i < 8; ++i) { const int idx = tid + 512 * i, r = idx >> 5, chn = idx & 31; gsq[i] = __builtin_nontemporal_load((const u32x4*)(gsp + (size_t)r * ZLD + 8 * chn)); }
    if (!(skip & 2))
#pragma unroll
    for (int jt = 0; jt < 4; ++jt) {
        f32x16 x;
#pragma unroll
        for (int r = 0; r < 16; ++r) x[r] = 0.f;
#pragma unroll
        for (int s = 0; s < 8; ++s) { const bf16x8 ak = *(const LAS bf16x8*)(KI + offb(32 * jt + l31, 2 * s + h)); x = MFMA32(ak, qf[s], x); }
        const int ii = 32 * wi + l31;
#pragma unroll
        for (int r = 0; r < 16; ++r) { const int jj = 32 * jt + crow(r, h); const int dd = ii > jj ? ii - jj : jj - ii; x[r] *= exp2f(l2g * (float)dd); }
#pragma unroll
        for (int s2 = 0; s2 < 2; ++s2) {
            u32x4 pw; pw.x = pk2(x[8 * s2], x[8 * s2 + 1]); pw.y = pk2(x[8 * s2 + 2], x[8 * s2 + 3]); pw.z = pk2(x[8 * s2 + 4], x[8 * s2 + 5]); pw.w = pk2(x[8 * s2 + 6], x[8 * s2 + 7]);
            const bf16x8 xs = __builtin_bit_cast(bf16x8, pw);
            const unsigned r0 = 32 * jt + 16 * s2 + 4 * h + q, r1 = r0 + 8;
#pragma unroll
            for (int c = 0; c < 4; ++c) {
                const s16x4 v0 = trd(Vimg + offb(r0, 4 * c + 2 * blk + (p >> 1)) + 8 * (p & 1)), v1 = trd(Vimg + offb(r1, 4 * c + 2 * blk + (p >> 1)) + 8 * (p & 1));
                const bf16x8 pb = __builtin_shufflevector(v0, v1, 0, 1, 2, 3, 4, 5, 6, 7);
                z[c] = MFMA32(xs, pb, z[c]);
            }
        }
#pragma unroll
        for (int i2 = 0; i2 < 2; ++i2) { const int i = 2 * jt + i2; float gv[8]; unpack8(gsq[i], gv);
#pragma unroll
            for (int j = 0; j < 8; ++j) gv[j] = gv[j] * sigmoidf_(gv[j]);
            gsq[i].x = pk2(gv[0], gv[1]); gsq[i].y = pk2(gv[2], gv[3]); gsq[i].z = pk2(gv[4], gv[5]); gsq[i].w = pk2(gv[6], gv[7]); }
    }
#pragma unroll
    for (int r = 0; r < 16; ++r) { float s1 = (z[0][r] + z[1][r]) + (z[2][r] + z[3][r]); float s2 = (z[0][r] * z[0][r] + z[1][r] * z[1][r]) + (z[2][r] * z[2][r] + z[3][r] * z[3][r]);
        s1 = row16_sum(s1); s2 = row16_sum(s2);
        s1 += __shfl_xor(s1, 16); s2 += __shfl_xor(s2, 16);
        if (l31 == 0) { STATS[((wi * 2 + wv) * 32 + crow(r, h)) * 2] = s1; STATS[((wi * 2 + wv) * 32 + crow(r, h)) * 2 + 1] = s2; } }
    __syncthreads();
#pragma unroll
    for (int r = 0; r < 16; ++r) { const int il = crow(r, h);
        const float s1 = STATS[((wi * 2 + 0) * 32 + il) * 2] + STATS[((wi * 2 + 1) * 32 + il) * 2], s2 = STATS[((wi * 2 + 0) * 32 + il) * 2 + 1] + STATS[((wi * 2 + 1) * 32 + il) * 2 + 1];
        const float mean = s1 * (1.0f / 256.0f); const float var = fmaxf(s2 * (1.0f / 256.0f) - mean * mean, 0.f); const float rstd = __builtin_amdgcn_rsqf(var + EPS);
#pragma unroll
        for (int c = 0; c < 4; ++c) *(LAS unsigned short*)(lds + (32 * wi + il) * 528 + (128 * wv + 32 * c + l31) * 2) = (unsigned short)f2bf((z[c][r] - mean) * rstd); }
    __syncthreads();
    if (!(skip & 4))
#pragma unroll
    for (int i = 0; i < 8; ++i) { const int idx = tid + 512 * i, r = idx >> 5, chn = idx & 31; float ov[8], gv[8];
        unpack8(*(const LAS u32x4*)(lds + r * 528 + chn * 16), ov); unpack8(gsq[i], gv); bf16* gp = gout + (size_t)r * 3072 + 8 * chn;
        u32x4 o; o.x = pk2(ov[0] * gv[0], ov[1] * gv[1]); o.y = pk2(ov[2] * gv[2], ov[3] * gv[3]); o.z = pk2(ov[4] * gv[4], ov[5] * gv[5]); o.w = pk2(ov[6] * gv[6], ov[7] * gv[7]);
        *(u32x4*)gp = o; }
}

struct Args { const float* in[26]; float* out; unsigned char* ws; int lo, hi; };
enum { I_X = 0, I_C, I_CTX, I_CCTX, I_ADAW, I_ADAB, I_N1G, I_WIN, I_CONVW, I_CONVB, I_WA, I_BA, I_WX, I_BX, I_LAM, I_WRNN, I_WRET, I_WOUT, I_N2G, I_RW, I_RB, I_W1, I_B1, I_W2, I_B2, I_FG };
constexpr int ST_GRP = 3, ST_M0 = 27, ST_M1 = 28, ST_RNG = 29, ST_END = ST_RNG + 3 * NRANGE;

__global__ void __launch_bounds__(NTHR, 2) fwd_kernel(Args args) {
    extern __shared__ __attribute__((aligned(16))) unsigned char lds_raw[];
    LAS unsigned char* lds = (LAS unsigned char*)lds_raw;
    const int tid = threadIdx.x, lane = tid & 63, wave = __builtin_amdgcn_readfirstlane(tid >> 6);
    const int G = gridDim.x, bid = blockIdx.x;
    const int gw = bid * NWAVES + wave, NGW = G * NWAVES;
    unsigned char* ws = args.ws;
    volatile LAS unsigned* MISC = (volatile LAS unsigned*)(lds + MISC_OFF);
    if (tid < 64) MISC[tid] = 0u;
    __syncthreads();
    const int lo = args.lo, hi = args.hi;
    XcdBarrier bar; bar.bar = (unsigned*)(ws + WS_CTL) + CW_BAR; bar.x = 0; bar.st = nullptr;
    if (!MK_PER_PHASE) bar = xcd_barrier_post((unsigned*)(ws + WS_CTL) + CW_BAR, MISC);
#define IN(k) (lo <= (k) && (k) < hi)
#define SEAM(k) do { if (IN(k) && IN((k) + 1)) xcd_barrier(bar); } while (0)
#if MK_PROBE
    unsigned long long t_last = wall_clock64();
#define STAMP(kind) do { if (bid == 0 && threadIdx.x == 0) { const unsigned long long t_ = wall_clock64(); MISC[16 + (kind)] += (unsigned)(t_ - t_last); t_last = t_; } } while (0)
#else
#define STAMP(kind) do { } while (0)
#endif

    float* mod = (float*)(ws + WS_MOD);
    f32x2* rope = (f32x2*)(ws + WS_ROPE);
    f32x2* carry = (f32x2*)(ws + WS_CARRY); bf16* RWB = (bf16*)(ws + WS_RWB);
    bf16* WG = (bf16*)(ws + WS_WG); bf16* WRNN = (bf16*)(ws + WS_WRNN); bf16* WOUT = (bf16*)(ws + WS_WOUT); bf16* WRET = WRNN + 1024; bf16* WIN = (bf16*)(ws + WS_WIN);
    bf16* HL = (bf16*)(ws + WS_HL); bf16* ZC = (bf16*)(ws + WS_ZC); bf16* CTXU = (bf16*)(ws + WS_CTXU); bf16* Z = (bf16*)(ws + WS_Z); bf16* STB = (bf16*)(ws + WS_ST);
    bf16* T1 = (bf16*)(ws + WS_T1); bf16* MG = (bf16*)(ws + WS_MG);
    bf16* W1T = (bf16*)(ws + WS_W1T); bf16* W2T = (bf16*)(ws + WS_W2T); bf16* HPAD = (bf16*)(ws + WS_HPAD); bf16* HID = (bf16*)(ws + WS_HID); bf16* YPAD = (bf16*)(ws + WS_YPAD);
    float* WRNNS = (float*)(ws + WS_WFS); float* WRETS = WRNNS + 1024; float* WOUTS = WRNNS + 2048; float* W2S = WRNNS + 4096;
    bf16* AR = (bf16*)(ws + WS_AR); bf16* AT = (bf16*)(ws + WS_AT);
    bf16* XCB = T1; bf16* XCC = CTXU;
    bf16* HDF = MG; bf16* HDB = (bf16*)(ws + 880 * MiB);
    float* HLS = (float*)(ws + WS_HLS); float* WINS = (float*)(ws + WS_WINS); float* W1S = (float*)(ws + WS_W1S); float* HPS = (float*)(ws + WS_HPS);
    int* ROWTOK = (int*)(ws + WS_HPAD);
    int* EIDX = (int*)(ws + WS_EIDX); float* GATE = (float*)(ws + WS_GATE); int* LPOS = (int*)(ws + WS_LPOS); int* AROW = (int*)(ws + WS_AROW);
    int* BCNT = (int*)(ws + WS_BCNT); int* BBASE = (int*)(ws + WS_BBASE); int* TILEE = (int*)(ws + WS_TILEE); int* NTILE = (int*)(ws + WS_NTILE);

    if (PH_EN(0) && IN(0)) for (int rep = 0; rep < DUP_N(0); ++rep) {
        const int tid = opaque_tid(), lane = tid & 63, wave = __builtin_amdgcn_readfirstlane(tid >> 6), gw = bid * NWAVES + wave; (void)lane; (void)gw; (void)rep;
        if (bid < 96) {
            LAS float* sc = (LAS float*)lds;
            LAS float* red = (LAS float*)(lds + 40960);
            for (int i = tid; i < 9 * 1024; i += NTHR) { const int r = i >> 10, k = i & 1023; const float v = r < 8 ? args.in[I_C][r * 1024 + k] : args.in[I_CCTX][k]; sc[i] = v * sigmoidf_(v); }
            __syncthreads();
            const int n0 = bid * 64; float a9[9];
#pragma unroll
            for (int r = 0; r < 9; ++r) a9[r] = 0.f;
            for (int k = wave * 128; k < wave * 128 + 128; ++k) { const float wv = args.in[I_ADAW][(size_t)k * 6144 + n0 + lane];
#pragma unroll
                for (int r = 0; r < 9; ++r) a9[r] += sc[r * 1024 + k] * wv; }
#pragma unroll
            for (int r = 0; r < 9; ++r) red[(wave * 9 + r) * 64 + lane] = a9[r];
            __syncthreads();
            for (int i = tid; i < 9 * 64; i += NTHR) { const int r = i >> 6, l = i & 63; float s = 0.f;
#pragma unroll
                for (int w8 = 0; w8 < 8; ++w8) s += red[(w8 * 9 + r) * 64 + l];
                mod[r * 6144 + n0 + l] = s + args.in[I_ADAB][n0 + l]; }
            __syncthreads();
        }
        if (bid == 97 % G) {
            for (int i = tid; i < 32 * 1024; i += NTHR) { const int d = i >> 5, e = i & 31; const float wv = args.in[I_RW][i]; const unsigned hi = f2bf(wv); const float rem = wv - bf2f((unsigned short)hi);
                RWB[e * 1024 + d] = (bf16)hi; RWB[32 * 1024 + e * 1024 + d] = (bf16)f2bf(rem); }
        }
        if (bid == 96) {
            for (int i = tid; i < 128 * 32; i += NTHR) { const int pos = i >> 5, f = i & 31; const float inv = powf(10000.0f, -(float)f / 32.0f); const float ang = (float)pos * inv; float s, c; sincosf(ang, &s, &c); rope[i] = (f32x2){c, s}; }
        }
        {
            LAS float* L = (LAS float*)(lds + 65536); LAS unsigned* CM = (LAS unsigned*)(lds + 65536 + 66048); LAS unsigned* TL = (LAS unsigned*)lds;
            for (int it = bid; it < 848; it += G) {
                if (it < 80) tr_strip_i8<false>(args.in[I_WIN] + it * 128, DIN, 1024, (signed char*)WIN + (size_t)it * 128 * 1024, 1024, WINS + it * 128, tid, TL, CM);
                else if (it < 592) { const int s = it - 80, e = s >> 4, nt = s & 15; tr_strip_i8<false>(args.in[I_W1] + (size_t)e * 1024 * 2048 + nt * 128, 2048, 1024, (signed char*)W1T + ((size_t)e * 2048 + nt * 128) * 1024, 1024, W1S + e * 2048 + nt * 128, tid, TL, CM); }
                else { const int s = it - 592, e = s >> 3, nt = s & 7; tr_strip_i8<true>(args.in[I_W2] + (size_t)e * 1024 * 1024 + nt * 128, 1024, 1024, (signed char*)W2T + ((size_t)e * 1024 + nt * 128) * 1024, 1024, W2S + e * 1024 + nt * 128, tid, TL, CM); }
            }
            constexpr int NT_ALL = 64 + 128 + 64 + 32;
            auto desc = [&](int it) -> TrTile { TrTile t;
                if (it < 64) { const int kt = it >> 3, nt = it & 7; t.src = args.in[I_WRNN] + (size_t)kt * 128 * 1024 + nt * 128; t.ldw = 1024; t.dst = WRNN + (size_t)nt * 128 * 3072 + kt * 128; t.ldt = 3072; return t; }
                it -= 64;
                if (it < 128) { const int kt = it >> 3, nt = it & 7; t.src = args.in[I_WRET] + (size_t)kt * 128 * 1024 + nt * 128; t.ldw = 1024; t.dst = WRET + (size_t)nt * 128 * 3072 + kt * 128; t.ldt = 3072; return t; }
                it -= 128;
                if (it < 64) { const int kt = it >> 3, nt = it & 7; t.src = args.in[I_WOUT] + (size_t)kt * 128 * 1024 + nt * 128; t.ldw = 1024; t.dst = WOUT + (size_t)nt * 128 * 1024 + kt * 128; t.ldt = 1024; return t; }
                it -= 64;
                { const int q = it & 3, n = it >> 2; const int dir = q >> 1, typ = q & 1;
                  t.src = (typ ? args.in[I_WX] : args.in[I_WA]) + (size_t)(dir * 8 + n) * 128 * 128; t.ldw = 128; t.dst = WG + (size_t)(n * 4 + q) * 128 * 128; t.ldt = 128; return t; } };
            f32x4 v[8];
            int it = NT_ALL - 1 - ((bid + 80) % G);
            if (it >= 0) { const TrTile t0 = desc(it); tr_load(t0, tid, v); }
            while (it >= 0) {
                const TrTile tc = desc(it); const int nx = it - G;
                f32x4 w[8];
#pragma unroll
                for (int i = 0; i < 8; ++i) w[i] = v[i];
                if (nx >= 0) { const TrTile tn = desc(nx); tr_load(tn, tid, v); }
                tr_store(tc, tid, w, L);
                it = nx;
            }
        }
    }
    SEAM(0); STAMP(0);
    if (PH_EN(1) && IN(1)) for (int rep = 0; rep < DUP_N(1); ++rep) {
        const int tid = opaque_tid(), lane = tid & 63, wave = __builtin_amdgcn_readfirstlane(tid >> 6), gw = bid * NWAVES + wave; (void)lane; (void)gw; (void)rep;
        auto rowsrc = [&](int m) { return (const f32x4*)(m < NTOK ? args.in[I_X] + (size_t)m * D : args.in[I_CTX] + (size_t)(m - NTOK) * D) + lane; };
        f32x4 nx[4];
        if (gw < NROWS_HL) { const f32x4* xr = rowsrc(gw);
#pragma unroll
            for (int j = 0; j < 4; ++j) nx[j] = xr[64 * j]; }
#pragma unroll 1
        for (int m = gw; m < NROWS_HL; m += NGW) {
            const int r = m < NTOK ? (m >> 13) : 8;
            f32x4 v[4]; float ss = 0.f;
#pragma unroll
            for (int j = 0; j < 4; ++j) v[j] = nx[j];
            if (m + NGW < NROWS_HL) { const f32x4* xr = rowsrc(m + NGW);
#pragma unroll
                for (int j = 0; j < 4; ++j) nx[j] = xr[64 * j]; }
#pragma unroll
            for (int j = 0; j < 4; ++j) ss += (v[j].x * v[j].x + v[j].y * v[j].y) + (v[j].z * v[j].z + v[j].w * v[j].w);
            const float rstd = 1.0f / sqrtf(wave_sum(ss) * (1.0f / D) + EPS);
            float am = 0.f;
#pragma unroll
            for (int j = 0; j < 4; ++j) { const int c0 = 4 * lane + 256 * j; const f32x4 gn = *(const f32x4*)(args.in[I_N1G] + c0), sh = *(const f32x4*)(mod + r * 6144 + c0), sc = *(const f32x4*)(mod + r * 6144 + 1024 + c0);
                v[j] = (v[j] * rstd * gn) * (sc + 1.0f) + sh; am = fmaxf(fmaxf(am, fmaxf(fabsf(v[j].x), fabsf(v[j].y))), fmaxf(fabsf(v[j].z), fabsf(v[j].w))); }
            am = wave_max(am); const float inv = am > 0.f ? 127.0f / am : 0.f;
            if (lane == 0) HLS[m] = am > 0.f ? am * (1.0f / 127.0f) : 1.0f;
            unsigned* o4 = (unsigned*)((signed char*)HL + (size_t)m * D) + lane;
#pragma unroll
            for (int j = 0; j < 4; ++j) o4[64 * j] = q8x4(v[j], inv);
        }
    }
    SEAM(1); STAMP(1);
    if (PH_EN(2) && IN(2)) for (int rep = 0; rep < DUP_N(2); ++rep) {
        const int tid = opaque_tid(), lane = tid & 63, wave = __builtin_amdgcn_readfirstlane(tid >> 6), gw = bid * NWAVES + wave; (void)lane; (void)gw; (void)rep;
        pg8::Gemm g{HL, WIN, 512, 512, 512, HLS, WINS, nullptr}; pg8::CtxOrder S{G, bid}; EpiCtx E{ZC};
        pg8::gemm_phase<EpiCtx, pg8::CtxOrder, 1>(lds, g, S, E);
    }
    SEAM(2); STAMP(2);
    for (int grp = 0; grp < NGRP; ++grp) {
        const int s0 = ST_GRP + 6 * grp;
        if (PH_EN(3) && IN(s0 + 0)) for (int rep = 0; rep < DUP_N(3); ++rep) {
        const int tid = opaque_tid(), lane = tid & 63, wave = __builtin_amdgcn_readfirstlane(tid >> 6), gw = bid * NWAVES + wave; (void)lane; (void)gw; (void)rep;
            pg8::Gemm g{HL + (size_t)grp * GROWS * 512, WIN, 512, 512, 512, HLS + grp * GROWS, WINS, nullptr}; pg8::StaticOrder S; S.init(GROWS / 256, DIN / 256, G, bid); EpiIn E{Z, rope, DRY(3) ? 1 : 0};
            STAGGER(STAG_B); pg8::gemm_phase<EpiIn, pg8::StaticOrder, 1>(lds, g, S, E);
        }
        SEAM(s0 + 0); STAMP(3);
        if (PH_EN(4) && IN(s0 + 1)) for (int rep = 0; rep < DUP_N(4); ++rep) {
        const int tid = opaque_tid(), lane = tid & 63, wave = __builtin_amdgcn_readfirstlane(tid >> 6), gw = bid * NWAVES + wave; (void)lane; (void)gw; (void)rep;
            for (int u = bid; u < GB * 8 * 2 * 8; u += G) { const int hd = u & 7, y = u >> 3, bl = y >> 4, dir = (y >> 3) & 1, part = y & 7; const int b = grp * GB + bl;
                const float lg = log1pf(-exp2f(-5.0f - (float)hd));
                const bf16* zc = ZC + (size_t)(b * CTXL) * ZC_LD; const bf16* zl = Z + (size_t)(bl * SEQ) * ZLD;
                kvs_unit(lds, zc + ZC_K + hd * 128, zc + ZC_V + hd * 256, zl + C_K + hd * 128, zl + C_V + hd * 256, dir, part, lg, STB + (size_t)((bl * 8 + hd) * 64) * 2 * 32768); }
            LruP LP{args.in[I_CONVW], args.in[I_CONVB], args.in[I_BA], args.in[I_BX], args.in[I_LAM], WG, carry};
            xc_rows(LP, Z + C_XR, ZLD, 13, GROWS, XCB, bid * NTHR + tid, G * NTHR);
            if (grp == 0) xc_rows(LP, ZC + ZC_XR, ZC_LD, 8, NCTX, XCC, bid * NTHR + tid, G * NTHR);
        }
        SEAM(s0 + 1); STAMP(4);
        if (PH_EN(5) && IN(s0 + 2)) for (int rep = 0; rep < DUP_N(5); ++rep) {
        const int tid = opaque_tid(), lane = tid & 63, wave = __builtin_amdgcn_readfirstlane(tid >> 6), gw = bid * NWAVES + wave; (void)lane; (void)gw; (void)rep;
            LruP LP{args.in[I_CONVW], args.in[I_CONVB], args.in[I_BA], args.in[I_BX], args.in[I_LAM], WG, carry};
            for (int u = bid; u < GB * 8 * 8 * 2; u += G) { const int n = u & 7, bl = (u >> 3) & 1, y = u >> 4, dir = y & 1, sub = y >> 1;
                bf16* hb_ = (dir ? HDB : HDF) + (size_t)((bl * 8 + n) * 8 + sub) * (32 * 4096);
                lru_sweep(lds, LP, n, sub, dir, XCB + (size_t)(bl * SEQ) * 1024, XCC + (size_t)((grp * GB + bl) * CTXL) * 1024, hb_); }
        }
        SEAM(s0 + 2); STAMP(5);
        if (PH_EN(6) && IN(s0 + 3)) for (int rep = 0; rep < DUP_N(6); ++rep) {
        const int tid = opaque_tid(), lane = tid & 63, wave = __builtin_amdgcn_readfirstlane(tid >> 6), gw = bid * NWAVES + wave; (void)lane; (void)gw; (void)rep;
            for (int u = bid; u < GB * 64 * 8; u += G) { const int hd = u & 7, c = (u >> 3) & 63, bl = u >> 9; const float l2g = log1pf(-exp2f(-5.0f - (float)hd)) * 1.4426950408889634f;
                bf16* zr = Z + (size_t)(bl * SEQ + c * 128) * ZLD; const bf16* sp = STB + (size_t)(((bl * 8 + hd) * 64 + c) * 2) * 32768;
                ro_unit(lds, zr + C_Q + hd * 128, zr + C_K + hd * 128, zr + C_V + hd * 256, zr + C_GS + hd * 256, AR + (size_t)(bl * SEQ + c * 128) * 3072 + 1024 + hd * 256, sp, sp + 32768, l2g, DRY(6) ? (MK_DRYMODE >= 8 ? MK_DRYMODE - 8 : 0) : 0); }
            if (!(DRY(6) && MK_DRYMODE >= 8))
            for (int u = bid; u < GB * 32 * 8; u += G) { const int n = u & 7, c = (u >> 3) & 31, bl = u >> 8; const size_t ub = (size_t)((bl * 8 + n) * 8) * (32 * 4096);
                lru_combine(HDF + ub, HDB + ub, c, Z + (size_t)(bl * SEQ + c * 256) * ZLD + C_GR + 128 * n, AR + (size_t)(bl * SEQ + c * 256) * 3072 + 128 * n, tid); }
        }
        SEAM(s0 + 3); STAMP(6);
        if (PH_EN(7) && IN(s0 + 4)) for (int rep = 0; rep < DUP_N(7); ++rep) {
        const int tid = opaque_tid(), lane = tid & 63, wave = __builtin_amdgcn_readfirstlane(tid >> 6), gw = bid * NWAVES + wave; (void)lane; (void)gw; (void)rep;
            { pg8::Gemm g{AR, WRNN, 3072, 3072, 3072, nullptr, nullptr, nullptr}; pg8::FOrder S; S.so.init(GROWS / 256, 4, G, bid); EpiF E{Z, MG, DRY(7) ? 1 : 0};
              pg8::gemm_phase<EpiF, pg8::FOrder>(lds, g, S, E); }
        }
        SEAM(s0 + 4); STAMP(7);
        if (PH_EN(8) && IN(s0 + 5)) for (int rep = 0; rep < DUP_N(8); ++rep) {
        const int tid = opaque_tid(), lane = tid & 63, wave = __builtin_amdgcn_readfirstlane(tid >> 6), gw = bid * NWAVES + wave; (void)lane; (void)gw; (void)rep;
            pg8::Gemm g{MG, WOUT, D, D, D, nullptr, nullptr, nullptr}; pg8::StaticOrder S; S.init(GROWS / 256, 4, G, bid); EpiX1 E{args.in[I_X], args.out, mod, grp * GROWS};
            pg8::gemm_phase<EpiX1, pg8::StaticOrder>(lds, g, S, E);
        }
        if (grp == NGRP - 1) SEAM(s0 + 5);
        STAMP(8);
    }
    if (PH_EN(9) && IN(ST_M0)) for (int rep = 0; rep < DUP_N(9); ++rep) {
        const int tid = opaque_tid(), lane = tid & 63, wave = __builtin_amdgcn_readfirstlane(tid >> 6), gw = bid * NWAVES + wave; (void)lane; (void)gw; (void)rep;
        LAS unsigned char* AH = lds;
        LAS unsigned char* AL = lds + 66048;
        LAS float* RED = (LAS float*)lds;
        LAS float* LOG = (LAS float*)(lds + 32768);
        LAS int* CNT = (LAS int*)(lds + 132096 + 512);
        const int h5 = lane >> 5, l31 = lane & 31;
        bf16x8 bh[8], bl[8];
#pragma unroll
        for (int s = 0; s < 8; ++s) { bh[s] = *(const bf16x8*)(RWB + (size_t)l31 * 1024 + 128 * wave + 16 * s + 8 * h5); bl[s] = *(const bf16x8*)(RWB + 32 * 1024 + (size_t)l31 * 1024 + 128 * wave + 16 * s + 8 * h5); }
        f32x4 xv[4][4];
        auto ldtile = [&](int blk, int tile) { const int m0 = blk * 256 + tile * 32 + wave * 4;
#pragma unroll
            for (int r4 = 0; r4 < 4; ++r4)
#pragma unroll
                for (int j = 0; j < 4; ++j) xv[r4][j] = __builtin_nontemporal_load((const f32x4*)(args.out + (size_t)(m0 + r4) * D) + lane + 64 * j); };
        for (int blk = bid; blk < NTOK / 256; blk += G) {
            __syncthreads();
            if (tid < 32) CNT[tid] = 0;
            ldtile(blk, 0);
#pragma unroll 1
            for (int tile = 0; tile < 8; ++tile) {
                __syncthreads();
                const int m0 = blk * 256 + tile * 32 + wave * 4; const int b = m0 >> 13;
#pragma unroll
                for (int r4 = 0; r4 < 4; ++r4) {
                    const int m = m0 + r4; f32x4 v[4]; float ss = 0.f;
#pragma unroll
                    for (int j = 0; j < 4; ++j) { v[j] = xv[r4][j]; ss += (v[j].x * v[j].x + v[j].y * v[j].y) + (v[j].z * v[j].z + v[j].w * v[j].w); }
                    const float rstd = 1.0f / sqrtf(wave_sum(ss) * (1.0f / D) + EPS);
                    float am = 0.f;
#pragma unroll
                    for (int j = 0; j < 4; ++j) { const int c0 = 4 * lane + 256 * j; const f32x4 gn = *(const f32x4*)(args.in[I_N2G] + c0), sh = *(const f32x4*)(mod + b * 6144 + 3072 + c0), sc = *(const f32x4*)(mod + b * 6144 + 4096 + c0);
                        v[j] = (v[j] * rstd * gn) * (sc + 1.0f) + sh; am = fmaxf(fmaxf(am, fmaxf(fabsf(v[j].x), fabsf(v[j].y))), fmaxf(fabsf(v[j].z), fabsf(v[j].w))); }
                    am = wave_max(am); const float inv = am > 0.f ? 127.0f / am : 0.f;
                    if (lane == 0) HLS[m] = am > 0.f ? am * (1.0f / 127.0f) : 1.0f;
                    unsigned* o4 = (unsigned*)((signed char*)HL + (size_t)m * D) + lane;
                    const int rowl = wave * 4 + r4;
#pragma unroll
                    for (int j = 0; j < 4; ++j) { o4[64 * j] = q8x4(v[j], inv);
                        u32x2 hi; hi.x = pk2(v[j].x, v[j].y); hi.y = pk2(v[j].z, v[j].w);
                        u32x2 lo; lo.x = pk2(v[j].x - bflo(hi.x), v[j].y - bfhi(hi.x)); lo.y = pk2(v[j].z - bflo(hi.y), v[j].w - bfhi(hi.y));
                        *(LAS u32x2*)(AH + rowl * 2064 + (4 * lane + 256 * j) * 2) = hi; *(LAS u32x2*)(AL + rowl * 2064 + (4 * lane + 256 * j) * 2) = lo; }
                }
                if (tile + 1 < 8) ldtile(blk, tile + 1);
                __syncthreads();
                f32x16 acc;
#pragma unroll
                for (int r = 0; r < 16; ++r) acc[r] = 0.f;
#pragma unroll
                for (int s = 0; s < 8; ++s) { const int ko = (128 * wave + 16 * s + 8 * h5) * 2;
                    const bf16x8 ah = *(const LAS bf16x8*)(AH + l31 * 2064 + ko), al = *(const LAS bf16x8*)(AL + l31 * 2064 + ko);
                    acc = MFMA32(ah, bh[s], acc); acc = MFMA32(ah, bl[s], acc); acc = MFMA32(al, bh[s], acc); }
                __syncthreads();
#pragma unroll
                for (int r = 0; r < 16; ++r) RED[(wave * 32 + crow(r, h5)) * 32 + l31] = acc[r];
                __syncthreads();
#pragma unroll
                for (int i = 0; i < 2; ++i) { const int idx = tid + 512 * i, t = idx >> 5, e = idx & 31; float sum = args.in[I_RB][e];
#pragma unroll
                    for (int w8 = 0; w8 < 8; ++w8) sum += RED[(w8 * 32 + t) * 32 + e];
                    LOG[t * 33 + e] = sum; }
                __syncthreads();
#pragma unroll
                for (int r4 = 0; r4 < 4; ++r4) {
                    const int m = m0 + r4; float tv[4]; int ti[4]; float cur = lane < 32 ? LOG[(wave * 4 + r4) * 33 + lane] : -3.0e38f;
#pragma unroll
                    for (int k = 0; k < 4; ++k) { float mx = cur;
#pragma unroll
                        for (int o = 1; o < 64; o <<= 1) mx = fmaxf(mx, __shfl_xor(mx, o));
                        const unsigned long long msk = __ballot(cur == mx && lane < 32); const int sel = __ffsll((long long)msk) - 1; tv[k] = mx; ti[k] = sel; if (lane == sel) cur = -3.0e38f; }
                    const float e1 = __expf(tv[1] - tv[0]), e2 = __expf(tv[2] - tv[0]), e3 = __expf(tv[3] - tv[0]); const float inv = 1.0f / (1.0f + e1 + e2 + e3);
                    if (lane < 4) { const int k = lane; const int ee = k == 0 ? ti[0] : k == 1 ? ti[1] : k == 2 ? ti[2] : ti[3]; const float gg = (k == 0 ? 1.0f : k == 1 ? e1 : k == 2 ? e2 : e3) * inv;
                        const int lp = __hip_atomic_fetch_add(&CNT[ee], 1, __ATOMIC_RELAXED, __HIP_MEMORY_SCOPE_WORKGROUP);
                        EIDX[m * 4 + k] = ee; GATE[m * 4 + k] = gg; LPOS[m * 4 + k] = lp; }
                }
            }
            __syncthreads();
            if (tid < 32) BCNT[blk * 32 + tid] = CNT[tid];
        }
    }
    SEAM(ST_M0); STAMP(9);
#define MOE_TABLES() do { \
        LAS int* TB = (LAS int*)lds;                   \
        LAS int* EB = (LAS int*)(lds + 32768);         \
        __syncthreads(); \
        for (int i = tid; i < NRANGE * WBR * 32; i += NTHR) TB[i] = BCNT[i]; \
        __syncthreads(); \
        if (tid < NRANGE * 32) { const int r = tid >> 5, e = tid & 31; int run = 0; _Pragma("unroll 4") for (int wb = 0; wb < WBR; ++wb) { const int c_ = TB[(r * WBR + wb) * 32 + e]; TB[(r * WBR + wb) * 32 + e] = run; run += c_; } EB[128 + tid] = run; } \
        __syncthreads(); \
        if (tid < NRANGE) { int run = 0; _Pragma("unroll 1") for (int e = 0; e < 32; ++e) { EB[tid * 32 + e] = run; run += (EB[128 + tid * 32 + e] + 255) & ~255; } EB[256 + tid] = run >> 8; } \
        __syncthreads(); \
        for (int i = tid; i < NRANGE * WBR * 32; i += NTHR) { const int r = i / (WBR * 32), e = i & 31; TB[i] += EB[r * 32 + e]; } \
        __syncthreads(); } while (0)
#define MOE_SCATTER(r) do { \
        LAS int* TB = (LAS int*)lds; LAS int* EB = (LAS int*)(lds + 32768); \
        for (int idx = bid * NTHR + tid; idx < RTOK * 4; idx += G * NTHR) { const int m = (r) * RTOK + (idx >> 2), k = idx & 3; const int wb = (idx >> 2) >> 8; \
            const int e = EIDX[m * 4 + k]; const int row = TB[((r) * WBR + wb) * 32 + e] + LPOS[m * 4 + k]; AROW[m * 4 + k] = row; HPS[row] = HLS[m]; ROWTOK[row] = m; } \
        for (int e = bid; e < 32; e += G) { const int tot = EB[128 + (r) * 32 + e], base = EB[(r) * 32 + e]; const int npad = ((tot + 255) & ~255) - tot; \
            for (int i = tid; i < npad; i += NTHR) { HPS[base + tot + i] = 0.f; ROWTOK[base + tot + i] = -1; } } } while (0)
    if (PH_EN(10) && IN(ST_M1)) for (int rep = 0; rep < DUP_N(10); ++rep) {
        const int tid = opaque_tid(), lane = tid & 63, wave = __builtin_amdgcn_readfirstlane(tid >> 6), gw = bid * NWAVES + wave; (void)lane; (void)gw; (void)rep;
        MOE_TABLES();
        if (bid == 0) {
            LAS int* TB = (LAS int*)lds; LAS int* EB = (LAS int*)(lds + 32768);
            for (int i = tid; i < NRANGE * WBR * 32; i += NTHR) BBASE[i] = TB[i];
            if (tid < NRANGE) NTILE[tid] = EB[256 + tid];
            for (int i = tid; i < NRANGE * 32; i += NTHR) { const int r = i >> 5, e = i & 31; const int base = EB[r * 32 + e], nt = (EB[128 + i] + 255) >> 8; for (int t = 0; t < nt; ++t) TILEE[r * TILE_LD + (base >> 8) + t] = e; }
        }
        MOE_SCATTER(0);
    }
    SEAM(ST_M1); STAMP(10);
    for (int r = 0; r < NRANGE; ++r) {
        const int s0 = ST_RNG + 3 * r;
        if (PH_EN(11) && IN(s0 + 0)) for (int rep = 0; rep < DUP_N(11); ++rep) {
        const int tid = opaque_tid(), lane = tid & 63, wave = __builtin_amdgcn_readfirstlane(tid >> 6), gw = bid * NWAVES + wave; (void)lane; (void)gw; (void)rep;
            pg8::Gemm g{HL, W1T, 512, 512, 512, HPS, W1S, ROWTOK}; pg8::MoeOrder S{TILEE + r * TILE_LD, NTILE[r], 8, G, bid}; EpiHid E{(unsigned char*)HID, args.in[I_B1]};
            STAGGER(STAG_M2); pg8::gemm_phase<EpiHid, pg8::MoeOrder, 1, true>(lds, g, S, E);
        }
        SEAM(s0 + 0); STAMP(11);
        if (PH_EN(12) && IN(s0 + 1)) for (int rep = 0; rep < DUP_N(12); ++rep) {
        const int tid = opaque_tid(), lane = tid & 63, wave = __builtin_amdgcn_readfirstlane(tid >> 6), gw = bid * NWAVES + wave; (void)lane; (void)gw; (void)rep;
            pg8::Gemm g{HID, W2T, 512, 512, 512, nullptr, W2S, nullptr}; pg8::MoeOrder S{TILEE + r * TILE_LD, NTILE[r], 4, G, bid}; EpiY E{(unsigned char*)YPAD, args.in[I_B2]};
            STAGGER(STAG_M3); pg8::gemm_phase<EpiY, pg8::MoeOrder, 2>(lds, g, S, E);
        }
        SEAM(s0 + 1); STAMP(12);
        if (PH_EN(13) && IN(s0 + 2)) for (int rep = 0; rep < DUP_N(13); ++rep) {
        const int tid = opaque_tid(), lane = tid & 63, wave = __builtin_amdgcn_readfirstlane(tid >> 6), gw = bid * NWAVES + wave; (void)lane; (void)gw; (void)rep;
            if (NGW * 32 == RTOK) {
                const int m0 = r * RTOK + gw * 16, m1 = m0 + NGW * 16;
                const int arow0 = AROW[m0 * 4 + lane], arow1 = AROW[m1 * 4 + lane]; const float gate0 = GATE[m0 * 4 + lane], gate1 = GATE[m1 * 4 + lane];
                f32x4 g2v0[4], g2v1[4], fgv[4];
#pragma unroll
                for (int j = 0; j < 4; ++j) { g2v0[j] = *(const f32x4*)(mod + (m0 >> 13) * 6144 + 5120 + 4 * lane + 256 * j); g2v1[j] = *(const f32x4*)(mod + (m1 >> 13) * 6144 + 5120 + 4 * lane + 256 * j);
                    fgv[j] = *(const f32x4*)(args.in[I_FG] + 4 * lane + 256 * j); }
                f32x4 xv[4][4]; unsigned yw[4][4][4];
                auto issue = [&](int mbase, int arow_r, int i, f32x4 (&xx)[4], unsigned (&yy)[4][4]) { const int m = mbase + i;
#pragma unroll
                    for (int j = 0; j < 4; ++j) xx[j] = __builtin_nontemporal_load((const f32x4*)(args.out + (size_t)m * D) + lane + 64 * j);
#pragma unroll
                    for (int k = 0; k < 4; ++k) { const int row = __shfl(arow_r, 4 * i + k); const unsigned* yp = (const unsigned*)((const unsigned char*)YPAD + (size_t)row * D) + lane;
#pragma unroll
                        for (int j = 0; j < 4; ++j) yy[k][j] = __builtin_nontemporal_load(yp + 64 * j); } };
                issue(m0, arow0, 0, xv[0], yw[0]); issue(m0, arow0, 1, xv[1], yw[1]); issue(m0, arow0, 2, xv[2], yw[2]);
#pragma unroll 1
                for (int kb = 0; kb < 2; ++kb) {
                    const int mb = kb ? m1 : m0; const int arow_c = kb ? arow1 : arow0; const float gate_c = kb ? gate1 : gate0;
                    f32x4 g2c[4];
#pragma unroll
                    for (int j = 0; j < 4; ++j) g2c[j] = kb ? g2v1[j] : g2v0[j];
                    auto ahead = [&](int t, f32x4 (&xx)[4], unsigned (&yy)[4][4]) { const bool nx = t >= 16;
                        issue(nx ? m1 : mb, nx ? arow1 : arow_c, nx ? (kb ? 15 : t - 16) : t, xx, yy); };
                    auto finish = [&](int i, const f32x4 (&xx)[4], const unsigned (&yy)[4][4]) { const int m = mb + i; f32x4 v[4]; float ss = 0.f;
#pragma unroll
                        for (int j = 0; j < 4; ++j) { f32x4 y = {0.f, 0.f, 0.f, 0.f};
#pragma unroll
                            for (int k = 0; k < 4; ++k) { const float gk = __shfl(gate_c, 4 * i + k); const int w = (int)yy[k][j]; const f32x2 lo = __builtin_amdgcn_cvt_pk_f32_fp8(w, false), hi = __builtin_amdgcn_cvt_pk_f32_fp8(w, true);
                                y.x += gk * lo.x; y.y += gk * lo.y; y.z += gk * hi.x; y.w += gk * hi.y; }
                            v[j] = xx[j] + g2c[j] * y; ss += (v[j].x * v[j].x + v[j].y * v[j].y) + (v[j].z * v[j].z + v[j].w * v[j].w); }
                        const float rstd = 1.0f / sqrtf(wave_sum(ss) * (1.0f / D) + EPS);
#pragma unroll
                        for (int j = 0; j < 4; ++j) ((f32x4*)((DRY(13) ? (float*)(ws + WS_DUMMY) + (size_t)((m - r * RTOK) & 16383) * D : args.out + (size_t)m * D)) + lane)[64 * j] = v[j] * rstd * fgv[j]; };
#pragma unroll 1
                    for (int i = 0; i < 16; i += 4) {
                        ahead(i + 3, xv[3], yw[3]); finish(i, xv[0], yw[0]);
                        ahead(i + 4, xv[0], yw[0]); finish(i + 1, xv[1], yw[1]);
                        ahead(i + 5, xv[1], yw[1]); finish(i + 2, xv[2], yw[2]);
                        ahead(i + 6, xv[2], yw[2]); finish(i + 3, xv[3], yw[3]);
                    }
                }
            } else {
            for (int mb = r * RTOK + gw * 16; mb < (r + 1) * RTOK; mb += NGW * 16) {
                const int arow_l = AROW[mb * 4 + lane]; const float gate_l = GATE[mb * 4 + lane];
                const int b = mb >> 13;
                f32x4 g2v[4], fgv[4];
#pragma unroll
                for (int j = 0; j < 4; ++j) { g2v[j] = *(const f32x4*)(mod + b * 6144 + 5120 + 4 * lane + 256 * j); fgv[j] = *(const f32x4*)(args.in[I_FG] + 4 * lane + 256 * j); }
                f32x4 xv[2][4]; unsigned yw[2][4][4];
                auto issue = [&](int i, f32x4 (&xx)[4], unsigned (&yy)[4][4]) { const int m = mb + i;
#pragma unroll
                    for (int j = 0; j < 4; ++j) xx[j] = __builtin_nontemporal_load((const f32x4*)(args.out + (size_t)m * D) + lane + 64 * j);
#pragma unroll
                    for (int k = 0; k < 4; ++k) { const int row = __shfl(arow_l, 4 * i + k); const unsigned* yp = (const unsigned*)((const unsigned char*)YPAD + (size_t)row * D) + lane;
#pragma unroll
                        for (int j = 0; j < 4; ++j) yy[k][j] = __builtin_nontemporal_load(yp + 64 * j); } };
                auto finish = [&](int i, const f32x4 (&xx)[4], const unsigned (&yy)[4][4]) { const int m = mb + i; f32x4 v[4]; float ss = 0.f;
#pragma unroll
                    for (int j = 0; j < 4; ++j) { f32x4 y = {0.f, 0.f, 0.f, 0.f};
#pragma unroll
                        for (int k = 0; k < 4; ++k) { const float gk = __shfl(gate_l, 4 * i + k); const int w = (int)yy[k][j]; const f32x2 lo = __builtin_amdgcn_cvt_pk_f32_fp8(w, false), hi = __builtin_amdgcn_cvt_pk_f32_fp8(w, true);
                            y.x += gk * lo.x; y.y += gk * lo.y; y.z += gk * hi.x; y.w += gk * hi.y; }
                        v[j] = xx[j] + g2v[j] * y; ss += (v[j].x * v[j].x + v[j].y * v[j].y) + (v[j].z * v[j].z + v[j].w * v[j].w); }
                    const float rstd = 1.0f / sqrtf(wave_sum(ss) * (1.0f / D) + EPS);
#pragma unroll
                    for (int j = 0; j < 4; ++j) ((f32x4*)((DRY(13) ? (float*)(ws + WS_DUMMY) + (size_t)((m - r * RTOK) & 16383) * D : args.out + (size_t)m * D)) + lane)[64 * j] = v[j] * rstd * fgv[j]; };
                issue(0, xv[0], yw[0]);
#pragma unroll 1
                for (int i = 0; i < 16; i += 2) {
                    issue(i + 1, xv[1], yw[1]);
                    finish(i, xv[0], yw[0]);
                    if (i + 2 < 16) issue(i + 2, xv[0], yw[0]);
                    finish(i + 1, xv[1], yw[1]);
                }
            }
            }
            if (r + 1 < NRANGE) { MOE_TABLES(); MOE_SCATTER(r + 1); }
        }
        if (r + 1 < NRANGE) SEAM(s0 + 2);
        STAMP(13);
    }
#if MK_PROBE
    {
        unsigned* PR = (unsigned*)(ws + WS_CTL) + 8192;
        xcd_barrier(bar);
        if (bid == 0 && threadIdx.x == 0) { PR[0] = MISC[16 + PROBE_SEL1]; PR[1] = MISC[16 + PROBE_SEL2]; }
        xcd_barrier(bar);
        const float d1 = (float)__hip_atomic_load(PR, __ATOMIC_RELAXED, __HIP_MEMORY_SCOPE_AGENT) * 0.01f, d2 = (float)__hip_atomic_load(PR + 1, __ATOMIC_RELAXED, __HIP_MEMORY_SCOPE_AGENT) * 0.01f;
        const float sc = 1.0f + sqrtf(d1 * 1e-4f);
        for (size_t i = (size_t)bid * NTHR + threadIdx.x; i < (size_t)NTOK * D / 4; i += (size_t)G * NTHR) { f32x4 v = ((f32x4*)args.out)[i]; v *= sc; if (i == 0) v.x += d2 * 0.25f; ((f32x4*)args.out)[i] = v; }
    }
#endif
#undef IN
#undef SEAM
}

extern "C" void kernel_launch(void* const* d_in, const int* in_sizes, int n_in, void* d_out, int out_size, void* d_ws, size_t ws_size, hipStream_t stream) {
    static int grid = 0;
    if (grid == 0) {
        if (n_in != 26 || in_sizes[0] != NTOK * D || out_size != NTOK * D || ws_size < WS_END) { fprintf(stderr, "kernel_launch: unexpected shapes (n_in %d, in0 %d, out %d, ws %zu); nothing launched\n", n_in, n_in > 0 ? in_sizes[0] : -1, out_size, ws_size); grid = -1; return; }
        int dev = 0, cus = 0, per_cu = 0;
        if (hipGetDevice(&dev) != hipSuccess || hipDeviceGetAttribute(&cus, hipDeviceAttributeMultiprocessorCount, dev) != hipSuccess) { grid = -1; return; }
        if (hipFuncSetAttribute((const void*)fwd_kernel, hipFuncAttributeMaxDynamicSharedMemorySize, LDS_BYTES) != hipSuccess) { fprintf(stderr, "kernel_launch: hipFuncSetAttribute failed\n"); grid = -1; return; }
        if (hipOccupancyMaxActiveBlocksPerMultiprocessor(&per_cu, (const void*)fwd_kernel, NTHR, LDS_BYTES) != hipSuccess || per_cu < 1) fprintf(stderr, "kernel_launch: occupancy query reports %d\n", per_cu);
        (void)hipGetLastError();
        grid = cus;
    }
    if (grid < 0) return;
    if (hipMemsetAsync((char*)d_ws + WS_CTL, 0, CTL_ZERO_BYTES, stream) != hipSuccess) return;
    Args a{};
    for (int i = 0; i < 26; ++i) a.in[i] = (const float*)d_in[i];
    a.out = (float*)d_out; a.ws = (unsigned char*)d_ws;
#if MK_PER_PHASE
    for (int s = 0; s < ST_END; ++s) { a.lo = s; a.hi = s + 1; hipLaunchKernelGGL(fwd_kernel, dim3(grid), dim3(NTHR), LDS_BYTES, stream, a); }
#else
    a.lo = 0; a.hi = ST_END;
    hipLaunchKernelGGL(fwd_kernel, dim3(grid), dim3(NTHR), LDS_BYTES, stream, a);
#endif
    const hipError_t le = hipPeekAtLastError();
    if (le != hipSuccess) fprintf(stderr, "kernel_launch: launch failed: %s\n", hipGetErrorName(le));
}
```

```cpp
#include <hip/hip_runtime.h>
#include <type_traits>
#include <cstdio>
#include <cstdint>

#ifndef MK_PER_PHASE
#define MK_PER_PHASE 0
#endif

#ifndef MK_PROBE
#define MK_PROBE 0
#endif
#ifndef PROBE_SEL1
#define PROBE_SEL1 3
#endif
#ifndef PROBE_SEL2
#define PROBE_SEL2 4
#endif
#ifndef MK_DUP
#define MK_DUP 0u
#endif
#define DUP_N(k) ((((MK_DUP) >> (k)) & 1u) ? 2 : 1)
#define DRY(k) ((((MK_DUP) >> (k)) & 1u) && rep == 0)
#ifndef MK_DRYMODE
#define MK_DRYMODE 0
#endif
#ifndef STAG_B
#define STAG_B 0
#endif
#ifndef STAG_M2
#define STAG_M2 0
#endif
#ifndef STAG_M3
#define STAG_M3 0
#endif
#define STAGGER(n) do { const int slot_ = (bid >> 3) & 3; for (int i_ = 0; i_ < slot_ * (n); ++i_) __builtin_amdgcn_s_sleep(127); } while (0)
#ifndef MK_PHASES
#define MK_PHASES 0xFFFFu
#endif
#define PH_EN(k) (((MK_PHASES) >> (k)) & 1u)
#define LAS __attribute__((address_space(3)))
#define GAS __attribute__((address_space(1)))
typedef unsigned short bf16;
typedef short bf16x8 __attribute__((ext_vector_type(8)));
typedef short s16x4 __attribute__((ext_vector_type(4)));
typedef float f32x2 __attribute__((ext_vector_type(2)));
typedef float f32x4 __attribute__((ext_vector_type(4)));
typedef float f32x16 __attribute__((ext_vector_type(16)));
typedef unsigned u32x2 __attribute__((ext_vector_type(2)));
typedef unsigned u32x4 __attribute__((ext_vector_type(4)));

constexpr int D = 1024, NB = 8, SEQ = 8192, NTOK = NB * SEQ, CTXL = 256, NCTX = NB * CTXL, DIN = 10240, ZLD = 10240 + 128;
constexpr int NROWS_HL = NTOK + NCTX;
constexpr int GB = 2, NGRP = NB / GB, GROWS = GB * SEQ;
constexpr int NEXP = 32, TOPK = 4, DEXP = 1024;
constexpr int NRANGE = 1, RTOK = NTOK / NRANGE, WBR = RTOK / 256;
constexpr int RROWS = 4 * RTOK + 32 * 256, RTILES = RROWS / 256, TILE_LD = RTILES + 32;
constexpr float EPS = 1e-6f;
constexpr float K_SCALE = 0.08838834764831845f;
constexpr int C_XR = 0, C_GR = 1024, C_Q = 2048, C_K = 3072, C_V = 4096, C_GS = 6144, C_GA = 8192, C_GB = 9216;
constexpr int ZC_LD = 4096, ZC_XR = 0, ZC_K = 1024, ZC_V = 2048;

constexpr size_t MiB = 1u << 20;
constexpr size_t WS_CTL = 0, CTL_ZERO_BYTES = 1 * MiB;
constexpr size_t WS_MOD = 1 * MiB;
constexpr size_t WS_ROPE = 1 * MiB + 256 * 1024;
constexpr size_t WS_RWB = 1 * MiB + 512 * 1024;
constexpr size_t WS_CARRY = 2 * MiB;
constexpr size_t WS_HLS = 7 * MiB;
constexpr size_t WS_WINS = 7 * MiB + 320 * 1024;
constexpr size_t WS_W1S = 7 * MiB + 384 * 1024;
constexpr size_t WS_HPS = 880 * MiB;
constexpr size_t WS_WFS = 7 * MiB + 640 * 1024;
constexpr size_t WS_EIDX = 8 * MiB, WS_GATE = 9 * MiB, WS_LPOS = 10 * MiB, WS_AROW = 11 * MiB;
constexpr size_t WS_BCNT = 12 * MiB;
constexpr size_t WS_BBASE = 12 * MiB + 64 * 1024;
constexpr size_t WS_TILEE = 12 * MiB + 128 * 1024;
constexpr size_t WS_NTILE = 12 * MiB + 192 * 1024;
constexpr size_t WS_WG = 14 * MiB;
constexpr size_t WS_WRNN = 16 * MiB, WS_WOUT = 22 * MiB, WS_WIN = 24 * MiB;
constexpr size_t WS_HL = 44 * MiB;
constexpr size_t WS_ZC = 176 * MiB;
constexpr size_t WS_CTXU = 192 * MiB;
constexpr size_t WS_Z = 208 * MiB;
constexpr size_t WS_ST = 536 * MiB;
constexpr size_t WS_T1 = 664 * MiB, WS_MG = 696 * MiB;
constexpr size_t WS_W1T = 736 * MiB;
constexpr size_t WS_W2T = 848 * MiB;
constexpr size_t WS_HPAD = 208 * MiB, WS_HID = 210 * MiB, WS_YPAD = 474 * MiB;
constexpr size_t WS_AR = 912 * MiB, WS_AT = 944 * MiB;
constexpr size_t WS_DUMMY = 912 * MiB;
constexpr size_t WS_END = 1024 * MiB;
constexpr int CW_BAR = 4096;

constexpr int LDS_BYTES = 149504;
constexpr int MISC_OFF = LDS_BYTES - 256;
constexpr int NWAVES = 8, NTHR = 512;

__device__ __forceinline__ unsigned f2bf(float f) { unsigned u = __builtin_bit_cast(unsigned, f); return (u + 0x7fffu + ((u >> 16) & 1u)) >> 16; }
typedef __bf16 hwbf16x2 __attribute__((ext_vector_type(2)));
__device__ __forceinline__ unsigned pk2(float lo, float hi) { const f32x2 v = {lo, hi}; return __builtin_bit_cast(unsigned, __builtin_convertvector(v, hwbf16x2)); }
__device__ __forceinline__ float bflo(unsigned w) { return __builtin_bit_cast(float, w << 16); }
__device__ __forceinline__ float bfhi(unsigned w) { return __builtin_bit_cast(float, w & 0xffff0000u); }
__device__ __forceinline__ float bf2f(unsigned short h) { return __builtin_bit_cast(float, ((unsigned)h) << 16); }
__device__ __forceinline__ float sigmoidf_(float x) { return __builtin_amdgcn_rcpf(1.0f + __expf(-x)); }
template <int CTRL> __device__ __forceinline__ float dpp_f(float v) { return __builtin_bit_cast(float, __builtin_amdgcn_update_dpp(0, __builtin_bit_cast(int, v), CTRL, 0xF, 0xF, true)); }
__device__ __forceinline__ float row16_sum(float v) { v += dpp_f<0xB1>(v); v += dpp_f<0x4E>(v); v += dpp_f<0x141>(v); v += dpp_f<0x140>(v); return v; }
__device__ __forceinline__ float row16_max(float v) { v = fmaxf(v, dpp_f<0xB1>(v)); v = fmaxf(v, dpp_f<0x4E>(v)); v = fmaxf(v, dpp_f<0x141>(v)); v = fmaxf(v, dpp_f<0x140>(v)); return v; }
__device__ __forceinline__ float lane_f(float v, int l) { return __builtin_bit_cast(float, __builtin_amdgcn_readlane(__builtin_bit_cast(int, v), l)); }
__device__ __forceinline__ float wave_sum(float v) { v = row16_sum(v); return (lane_f(v, 0) + lane_f(v, 16)) + (lane_f(v, 32) + lane_f(v, 48)); }
__device__ __forceinline__ float wave_max(float v) { v = row16_max(v); return fmaxf(fmaxf(lane_f(v, 0), lane_f(v, 16)), fmaxf(lane_f(v, 32), lane_f(v, 48))); }
__device__ __forceinline__ unsigned q8x4(f32x4 v, float inv) {
    const int a = (int)rintf(v.x * inv), b = (int)rintf(v.y * inv), c = (int)rintf(v.z * inv), d = (int)rintf(v.w * inv);
    return ((unsigned)a & 0xffu) | (((unsigned)b & 0xffu) << 8) | (((unsigned)c & 0xffu) << 16) | (((unsigned)d & 0xffu) << 24);
}
#define LDS_WAIT() asm volatile("s_waitcnt lgkmcnt(0)" ::: "memory")
__device__ __forceinline__ int opaque_tid() { int t = threadIdx.x; asm volatile("" : "+v"(t)); return t; }
template <class T> __device__ __forceinline__ T* opaque_ptr(T* p) { unsigned long long u = (unsigned long long)p; asm volatile("" : "+s"(u)); return (T*)u; }

namespace pg8 {
constexpr int BM = 256, BK = 64, HALF = 128, HTB = HALF * BK * 2, STAGE_BYTES = 8 * HTB, NXCD = 8, WGM = 8;
__host__ __device__ __forceinline__ int lds_byte(int r, int c) { const int st = (r >> 4) * 2 + (c >> 5), rr = r & 15, cc = c & 31, ob = rr * 64 + cc * 2; return st * 1024 + (ob ^ (((ob >> 9) & 1) << 5)); }
__host__ __device__ __forceinline__ void stage_rc(int b, int& R, int& C) { const int st = b / 1024, sb = b % 1024, swz = sb ^ (((sb >> 9) & 1) << 5); R = (st >> 1) * 16 + swz / 64; C = (st & 1) * 32 + (swz % 64) / 2; }
__host__ __device__ __forceinline__ int perm32(int rho) { const int n = rho >> 4, i = rho & 15; return 8 * (i >> 2) + 4 * n + (i & 3); }
struct Unit { int pm, pn; int koff = 0, nt = 0; };
struct Gemm { const bf16* A; const bf16* Bt; int lda, ldb, K; const float* SA; const float* SB; const int* RT; const float* BIAS = nullptr; };
struct StaticOrder {
    int nM, nN, nwg, G, c;
    __device__ void init(int nM_, int nN_, int G_, int c_) { nM = nM_; nN = nN_; nwg = nM * nN; G = G_; c = c_; }
    __device__ bool next(int i, Unit& u) const {
        const long L = (long)i * G + c; if (L >= nwg) return false;
        int wgid = (int)L; { const int q = nwg / NXCD, r = nwg % NXCD, xcd = wgid % NXCD, off = wgid / NXCD; wgid = (xcd < r ? xcd * (q + 1) : r * (q + 1) + (xcd - r) * q) + off; }
        const int nig = WGM * nN, gid = wgid / nig, fm = gid * WGM, gsz = (nM - fm) < WGM ? (nM - fm) : WGM;
        u.pm = fm + ((wgid % nig) % gsz); u.pn = (wgid % nig) / gsz; return true;
    }
};
struct CtxOrder {
    int G, c;
    __device__ bool next(int i, Unit& u) const { const int L = i * G + c; if (L >= 128) return false; const int j = L >> 3; u.pm = 256 + (L & 7); u.pn = j < 4 ? j : j + 8; return true; }
};
struct FOrder {
    StaticOrder so;
    __device__ bool next(int i, Unit& u) const { Unit t; if (!so.next(i >> 1, t)) return false; u.pm = t.pm; u.pn = t.pn; u.koff = (i & 1) ? 1024 : 0; u.nt = (i & 1) ? 32 : 16; return true; }
};
struct MoeOrder {
    const int* tile_e; int ntiles, npn, G, c;
    __device__ bool next_pm(int i, Unit& u) const {
        if ((G & 7) == 0 && ((G >> 3) % npn) == 0) { const int x = c & 7, y = c >> 3, T = (G >> 3) / npn; const int ti = (i * 8 + x) * T + y / npn, pl = y % npn;
            if (ti >= ntiles) return false; u.pm = ti; u.pn = pl; return true; }
        const long L = (long)i * G + c; if (L >= (long)ntiles * npn) return false; const int ti = (int)(L / npn), pl = (int)(L % npn);
        u.pm = ti; u.pn = pl; return true; }
    __device__ int expert(const Unit& u) const { const int* p = tile_e + u.pm; int e; asm volatile("s_load_dword %0, %1, 0x0\n\ts_waitcnt lgkmcnt(0)" : "=s"(e) : "s"(p) : "memory"); return e; }
    __device__ bool next(int i, Unit& u) const { if (!next_pm(i, u)) return false; u.pn += expert(u) * npn; return true; }
};

typedef int i32x4 __attribute__((ext_vector_type(4)));
typedef int i32x8 __attribute__((ext_vector_type(8)));
template <int MODE> struct Frag { bf16x8 v[2]; };
template <> struct Frag<2> { i32x8 w; };
template <class E, class = void> struct bias_lds : std::false_type {};
template <class E> struct bias_lds<E, std::void_t<decltype(E::BIAS_LDS)>> : std::integral_constant<bool, E::BIAS_LDS> {};
template <class Epi, class Sched, int MODE = 0, bool GATHER = false>
__device__ __forceinline__ void gemm_phase(LAS unsigned char* lds, const Gemm g, const Sched& S, const Epi& E) {
    const int tid = opaque_tid(), wid = __builtin_amdgcn_readfirstlane(tid >> 6), lane = tid & 63, wr = wid >> 2, wc = wid & 3, fr = lane & 15, fq = lane >> 4;
    const int K = g.K, nt = K / BK;
    const bf16* gA = opaque_ptr(g.A); const bf16* gBt = opaque_ptr(g.Bt);
    unsigned voffA[2], voffB[2]; int RA[2]; unsigned CA[2];
#pragma unroll
    for (int i = 0; i < 2; ++i) { int R, C; stage_rc(tid * 16 + i * 8192, R, C); const int Rb = 64 * (R >> 5) + (Epi::PERM ? perm32(R & 31) : (R & 31));
        voffA[i] = (unsigned)(R * g.lda + C) * 2u; voffB[i] = (unsigned)(Rb * g.ldb + C) * 2u; RA[i] = R; CA[i] = (unsigned)C * 2u; }
    (void)RA; (void)CA;
    const size_t kstep = (size_t)(BK * 2);
    const size_t hstepA = GATHER ? (size_t)0 : (size_t)HALF * g.lda * 2, hstepB = (size_t)32 * g.ldb * 2;
    unsigned vC[2][2], vN[2][2];
    auto gather_offs = [&](int pm, unsigned (&v)[2][2]) {
        int t00 = g.RT[pm * 256 + RA[0]], t01 = g.RT[pm * 256 + RA[1]], t10 = g.RT[pm * 256 + 128 + RA[0]], t11 = g.RT[pm * 256 + 128 + RA[1]];
        asm volatile("" : "+v"(t00), "+v"(t01), "+v"(t10), "+v"(t11));
        t00 = t00 < 0 ? 0 : t00; t01 = t01 < 0 ? 0 : t01; t10 = t10 < 0 ? 0 : t10; t11 = t11 < 0 ? 0 : t11;
        v[0][0] = (unsigned)t00 * (unsigned)(g.lda * 2) + CA[0]; v[0][1] = (unsigned)t01 * (unsigned)(g.lda * 2) + CA[1];
        v[1][0] = (unsigned)t10 * (unsigned)(g.lda * 2) + CA[0]; v[1][1] = (unsigned)t11 * (unsigned)(g.lda * 2) + CA[1]; };
    const size_t tstepA = (size_t)BM * g.lda * 2, tstepB = (size_t)BM * g.ldb * 2;
    const unsigned ldsw = (unsigned)wid * 1024u;
    const int aoff = lds_byte(wr * 64 + fr, fq * 8), boff = lds_byte(wc * 32 + fr, fq * 8);
#define PG8_SA(b, h) (((b) * 2 + (h)) * HTB)
#define PG8_SB(b, h) ((4 + (b) * 2 + (h)) * HTB)
#define PG8_STAGE(bufoff, gbase, voff) do { _Pragma("unroll") for (int _i = 0; _i < 2; ++_i) \
        __builtin_amdgcn_global_load_lds((const unsigned*)((const char*)(gbase) + (voff)[_i]), (LAS unsigned*)(lds + (bufoff) + ldsw + _i * 8192), 16, 0, 0); } while (0)
#define PG8_STAGE_A(bufoff, gbase, hh, nx) do { if constexpr (GATHER) { _Pragma("unroll") for (int _i = 0; _i < 2; ++_i) { const unsigned _o = (nx) ? vN[hh][_i] : vC[hh][_i]; \
        __builtin_amdgcn_global_load_lds((const unsigned*)((const char*)(gbase) + _o), (LAS unsigned*)(lds + (bufoff) + ldsw + _i * 8192), 16, 0, 0); } } else PG8_STAGE(bufoff, gbase, voffA); } while (0)
#define PG8_LD1(dst, p) do { if constexpr (MODE == 2) (dst).w = __builtin_shufflevector(*(const LAS i32x4*)(p), *(const LAS i32x4*)((p) + 1024), 0, 1, 2, 3, 4, 5, 6, 7); \
        else { (dst).v[0] = *(const LAS bf16x8*)(p); (dst).v[1] = *(const LAS bf16x8*)((p) + 1024); } } while (0)
#define PG8_LDA(dst, b, h) do { _Pragma("unroll") for (int m = 0; m < 4; ++m) PG8_LD1(dst[m], lds + PG8_SA(b, h) + aoff + m * 2048); } while (0)
#define PG8_LDB(dst, b, h) do { _Pragma("unroll") for (int n = 0; n < 2; ++n) PG8_LD1(dst[n], lds + PG8_SB(b, h) + boff + n * 2048); } while (0)
#define PG8_MMA(ai, bj, At, Bt) do { __builtin_amdgcn_s_setprio(1); _Pragma("unroll") for (int m = 0; m < 4; ++m) _Pragma("unroll") for (int n = 0; n < 2; ++n) { \
        if constexpr (MODE == 2) {   \
              \
            asm volatile("v_mfma_scale_f32_16x16x128_f8f6f4 %0, %1, %2, %0, %3, %3 op_sel_hi:[0,0,0]" : "+v"(acc[ai][bj][m][n]) : "v"(Bt[n].w), "v"(At[m].w), "v"(sc1)); \
        } else { _Pragma("unroll") for (int k = 0; k < 2; ++k) \
        { if constexpr (MODE == 1) acc[ai][bj][m][n] = __builtin_bit_cast(f32x4, __builtin_amdgcn_mfma_i32_16x16x64_i8(__builtin_bit_cast(i32x4, Bt[n].v[k]), __builtin_bit_cast(i32x4, At[m].v[k]), __builtin_bit_cast(i32x4, acc[ai][bj][m][n]), 0, 0, 0)); \
          else acc[ai][bj][m][n] = __builtin_amdgcn_mfma_f32_16x16x32_bf16(Bt[n].v[k], At[m].v[k], acc[ai][bj][m][n], 0, 0, 0); } } } __builtin_amdgcn_s_setprio(0); } while (0)
#define PG8_WAIT_V(n) asm volatile("s_waitcnt vmcnt(" #n ")" ::: "memory")
#define PG8_WAIT_VN(n) asm volatile("s_waitcnt vmcnt(%0)" :: "n"(n) : "memory")
#define PG8_WAIT_L(n) asm volatile("s_waitcnt lgkmcnt(" #n ")" ::: "memory")
#define PG8_BAR __builtin_amdgcn_s_barrier()
#define PG8_SCHED __builtin_amdgcn_sched_barrier(0)
    Unit cur, nxt; int ui = 0;
    if (!S.next(0, cur)) return;
    constexpr int FIRST_NST = (MK_DRYMODE != 0 || MK_DUP != 0u) ? 0 : Epi::NST;
    constexpr int SC_OFF = 8 * HTB;
    auto stage_scales = [&](const Unit& u, int par) {
        if constexpr (MODE != 0) { if (MODE == 1 || wid >= 4) { const float* sp = wid < 4 ? g.SA + u.pm * 256 + tid : g.SB + u.pn * 256 + (tid - 256);
            __builtin_amdgcn_global_load_lds((const unsigned*)sp, (LAS unsigned*)(lds + SC_OFF + par * 3072 + wid * 256), 4, 0, 0); }
            if constexpr (bias_lds<Epi>::value) { if (wid < 4) __builtin_amdgcn_global_load_lds((const unsigned*)(g.BIAS + u.pn * 256 + tid), (LAS unsigned*)(lds + SC_OFF + par * 3072 + 2048 + wid * 256), 4, 0, 0); } } };
    stage_scales(cur, 0);
    f32x4 acc[2][2][4][2];
#pragma unroll
    for (int a = 0; a < 2; ++a)
#pragma unroll
        for (int b = 0; b < 2; ++b)
#pragma unroll
            for (int m = 0; m < 4; ++m)
#pragma unroll
                for (int n = 0; n < 2; ++n) acc[a][b][m][n] = (f32x4){0.f, 0.f, 0.f, 0.f};
    Frag<MODE> At[4], B0[2], B1[2]; const int sc1 = 0x7f7f7f7f; (void)sc1;
    const char* cA = GATHER ? (const char*)gA : (const char*)gA + (size_t)cur.pm * tstepA + (size_t)cur.koff * 2; const char* cB = (const char*)gBt + (size_t)cur.pn * tstepB + (size_t)cur.koff * 2;
    if constexpr (GATHER) gather_offs(cur.pm, vC);
    PG8_STAGE(PG8_SB(0, 0), cB, voffB); PG8_STAGE(PG8_SB(0, 1), cB + hstepB, voffB); PG8_STAGE_A(PG8_SA(0, 0), cA, 0, false); PG8_STAGE_A(PG8_SA(0, 1), cA + hstepA, 1, false);
    if (wr == 1) PG8_BAR;
    PG8_WAIT_V(2); PG8_BAR;
    PG8_STAGE(PG8_SB(1, 0), cB + kstep, voffB); PG8_STAGE_A(PG8_SA(1, 0), cA + kstep, 0, false); PG8_STAGE(PG8_SB(1, 1), cB + hstepB + kstep, voffB);
    PG8_WAIT_V(6); PG8_BAR;
    for (;;) {
        bool has_next;
        if constexpr (GATHER) {
            has_next = S.next_pm(ui + 1, nxt);
            if (has_next) { int t00 = g.RT[nxt.pm * 256 + RA[0]], t01 = g.RT[nxt.pm * 256 + RA[1]], t10 = g.RT[nxt.pm * 256 + 128 + RA[0]], t11 = g.RT[nxt.pm * 256 + 128 + RA[1]]; const int ex = S.expert(nxt);
                asm volatile("" : "+v"(t00), "+v"(t01), "+v"(t10), "+v"(t11));
                nxt.pn += ex * S.npn;
                t00 = t00 < 0 ? 0 : t00; t01 = t01 < 0 ? 0 : t01; t10 = t10 < 0 ? 0 : t10; t11 = t11 < 0 ? 0 : t11;
                vN[0][0] = (unsigned)t00 * (unsigned)(g.lda * 2) + CA[0]; vN[0][1] = (unsigned)t01 * (unsigned)(g.lda * 2) + CA[1];
                vN[1][0] = (unsigned)t10 * (unsigned)(g.lda * 2) + CA[0]; vN[1][1] = (unsigned)t11 * (unsigned)(g.lda * 2) + CA[1]; }
            else {
#pragma unroll
                for (int hh = 0; hh < 2; ++hh)
#pragma unroll
                    for (int i = 0; i < 2; ++i) vN[hh][i] = vC[hh][i]; }
        } else has_next = S.next(ui + 1, nxt);
        const char* nA = (has_next && !GATHER) ? (const char*)gA + (size_t)nxt.pm * tstepA + (size_t)nxt.koff * 2 : cA; const char* nB = has_next ? (const char*)gBt + (size_t)nxt.pn * tstepB + (size_t)nxt.koff * 2 : cB;
        const int ntc = cur.nt ? cur.nt : nt;
#pragma unroll 1
        for (int t = 0; t < ntc; t += 2) {
            const bool last = (t == ntc - 2);
            const char* a1 = cA + (size_t)(t + 1) * kstep;
            const char* a2 = last ? nA : cA + (size_t)(t + 2) * kstep; const char* b2 = last ? nB : cB + (size_t)(t + 2) * kstep;
            const char* a3 = a2 + kstep; const char* b3 = b2 + kstep;
            PG8_LDB(B0, 0, 0); PG8_LDB(B1, 0, 1); PG8_SCHED; PG8_LDA(At, 0, 0); PG8_STAGE_A(PG8_SA(1, 1), a1 + hstepA, 1, false);
            if (t == 0 && ui > 0) PG8_WAIT_VN(8 + FIRST_NST); else PG8_WAIT_V(8);
            PG8_WAIT_L(0); PG8_BAR; PG8_MMA(0, 0, At, B0); PG8_MMA(0, 1, At, B1); PG8_SCHED; PG8_BAR; PG8_SCHED;
            PG8_LDA(At, 0, 1); PG8_STAGE(PG8_SB(0, 0), b2, voffB); PG8_STAGE(PG8_SB(0, 1), b2 + hstepB, voffB); PG8_STAGE_A(PG8_SA(0, 0), a2, 0, last);
            if (t == 0 && ui > 0) PG8_WAIT_VN(8 + FIRST_NST); else PG8_WAIT_V(8);
            PG8_WAIT_L(0); PG8_BAR; PG8_MMA(1, 0, At, B0); PG8_MMA(1, 1, At, B1); PG8_SCHED; PG8_BAR; PG8_SCHED;
            PG8_LDB(B0, 1, 0); PG8_LDB(B1, 1, 1); PG8_SCHED; PG8_LDA(At, 1, 0); PG8_STAGE_A(PG8_SA(0, 1), a2 + hstepA, 1, last);
            PG8_WAIT_V(8); PG8_WAIT_L(0); PG8_BAR; PG8_MMA(0, 0, At, B0); PG8_MMA(0, 1, At, B1); PG8_SCHED; PG8_BAR; PG8_SCHED;
            PG8_LDA(At, 1, 1); PG8_STAGE(PG8_SB(1, 0), b3, voffB); PG8_STAGE(PG8_SB(1, 1), b3 + hstepB, voffB); PG8_STAGE_A(PG8_SA(1, 0), a3, 0, last);
            PG8_WAIT_V(8); PG8_WAIT_L(0); PG8_BAR; PG8_MMA(1, 0, At, B0); PG8_MMA(1, 1, At, B1); PG8_SCHED; PG8_BAR; PG8_SCHED;
        }
        if (wr == 0) PG8_BAR;
        if constexpr (MODE == 2) {
            int fq_ = fq; asm volatile("" : "+v"(fq_));
            const LAS float* sb = (const LAS float*)(lds + SC_OFF + (ui & 1) * 3072) + 256 + wc * 64 + (Epi::PERM ? 8 : 4) * fq_;
            f32x4 cs[2][2];
#pragma unroll
            for (int b = 0; b < 2; ++b)
#pragma unroll
                for (int n = 0; n < 2; ++n) cs[b][n] = *(const LAS f32x4*)(sb + b * 32 + (Epi::PERM ? 4 : 16) * n);
#pragma unroll
            for (int a = 0; a < 2; ++a)
#pragma unroll
                for (int b = 0; b < 2; ++b)
#pragma unroll
                    for (int m = 0; m < 4; ++m)
#pragma unroll
                        for (int n = 0; n < 2; ++n) acc[a][b][m][n] *= cs[b][n];
        }
        if constexpr (MODE == 1) {
            static_assert(Epi::PERM, "int8 path is written for the PERM layout");
            int fr_ = fr, fq_ = fq; asm volatile("" : "+v"(fr_), "+v"(fq_));
            const LAS float* sa = (const LAS float*)(lds + SC_OFF + (ui & 1) * 3072) + wr * 64 + fr_; const LAS float* sb = (const LAS float*)(lds + SC_OFF + (ui & 1) * 3072) + 256 + wc * 64 + 8 * fq_;
            float rs[2][4]; f32x4 cs[2][2];
#pragma unroll
            for (int a = 0; a < 2; ++a)
#pragma unroll
                for (int m = 0; m < 4; ++m) rs[a][m] = sa[a * 128 + m * 16];
#pragma unroll
            for (int b = 0; b < 2; ++b)
#pragma unroll
                for (int n = 0; n < 2; ++n) cs[b][n] = *(const LAS f32x4*)(sb + b * 32 + 4 * n);
#pragma unroll
            for (int a = 0; a < 2; ++a)
#pragma unroll
                for (int b = 0; b < 2; ++b)
#pragma unroll
                    for (int m = 0; m < 4; ++m)
#pragma unroll
                        for (int n = 0; n < 2; ++n) { const i32x4 iv = __builtin_bit_cast(i32x4, acc[a][b][m][n]); acc[a][b][m][n] = __builtin_convertvector(iv, f32x4) * cs[b][n] * rs[a][m]; }
        }
        bool keep = false;
        { int fr_ = fr, fq_ = fq; asm volatile("" : "+v"(fr_), "+v"(fq_));
          if constexpr (bias_lds<Epi>::value) E.with_bias(acc, cur, wr, wc, fr_, fq_, (const LAS float*)(lds + SC_OFF + (ui & 1) * 3072) + 512);
          else if constexpr (Epi::MID) { if (E.is_mid(cur)) { E.mid(acc, cur, wr, wc, fr_, fq_); keep = true; } else E(acc, cur, wr, wc, fr_, fq_); } else E(acc, cur, wr, wc, fr_, fq_); }
        if (!has_next) break;
        if (!keep) {
#pragma unroll
        for (int a = 0; a < 2; ++a)
#pragma unroll
            for (int b = 0; b < 2; ++b)
#pragma unroll
                for (int m = 0; m < 4; ++m)
#pragma unroll
                    for (int n = 0; n < 2; ++n) acc[a][b][m][n] = (f32x4){0.f, 0.f, 0.f, 0.f}; }
        cur = nxt; cA = nA; cB = nB; ++ui;
        stage_scales(cur, ui & 1);
        if constexpr (GATHER) {
#pragma unroll
            for (int hh = 0; hh < 2; ++hh)
#pragma unroll
                for (int i = 0; i < 2; ++i) vC[hh][i] = vN[hh][i]; }
        if (wr == 1) PG8_BAR;
    }
    PG8_WAIT_V(0);
    PG8_BAR;
#undef PG8_SA
#undef PG8_SB
#undef PG8_STAGE
#undef PG8_STAGE_A
#undef PG8_LDA
#undef PG8_LD1
#undef PG8_LDB
#undef PG8_MMA
#undef PG8_WAIT_V
#undef PG8_WAIT_VN
#undef PG8_WAIT_L
#undef PG8_BAR
#undef PG8_SCHED
}
}
using pg8::Unit;

template <class F>
__device__ __forceinline__ void epi_perm_loop(const f32x4 (&acc)[2][2][4][2], int wr, int wc, int fr, int fq, F&& f) {
#pragma unroll
    for (int ai = 0; ai < 2; ++ai)
#pragma unroll
        for (int m = 0; m < 4; ++m) { const int rt = ai * 128 + wr * 64 + m * 16 + fr;
#pragma unroll
            for (int bj = 0; bj < 2; ++bj) { const int ct = wc * 64 + bj * 32 + 8 * fq; f(rt, ct, acc[ai][bj][m][0], acc[ai][bj][m][1]); }
            asm volatile("" ::: "memory"); }
}
template <class F>
__device__ __forceinline__ void epi_perm_loop_bj(const f32x4 (&acc)[2][2][4][2], int wr, int wc, int fr, int fq, F&& f) {
#pragma unroll
    for (int ai = 0; ai < 2; ++ai)
#pragma unroll
        for (int m = 0; m < 4; ++m) { const int rt = ai * 128 + wr * 64 + m * 16 + fr;
            f(rt, wc * 64 + 8 * fq, std::integral_constant<int, 0>{}, acc[ai][0][m][0], acc[ai][0][m][1]);
            f(rt, wc * 64 + 32 + 8 * fq, std::integral_constant<int, 1>{}, acc[ai][1][m][0], acc[ai][1][m][1]);
            asm volatile("" ::: "memory"); }
}
__device__ __forceinline__ unsigned pk4_fp8(float a, float b, float c, float d) { int w = 0; w = __builtin_amdgcn_cvt_pk_fp8_f32(a, b, w, false); w = __builtin_amdgcn_cvt_pk_fp8_f32(c, d, w, true); return (unsigned)w; }
__device__ __forceinline__ u32x4 xp16(u32x4 w, int src) { u32x4 r; r.x = __shfl(w.x, src); r.y = __shfl(w.y, src); r.z = __shfl(w.z, src); r.w = __shfl(w.w, src); return r; }
__device__ __forceinline__ u32x2 xp8(u32x2 w, int src) { u32x2 r; r.x = __shfl(w.x, src); r.y = __shfl(w.y, src); return r; }
template <class DT, class LD, class F>
__device__ __forceinline__ void epi_perm_pipe(const f32x4 (&acc)[2][2][4][2], int wr, int wc, int fr, int fq, LD&& ld, F&& f) {
    DT cur = ld(wr * 64 + fr, wc * 64 + 8 * fq);
#pragma unroll
    for (int it = 0; it < 16; ++it) { const int ai = it >> 3, m = (it >> 1) & 3, bj = it & 1; const int rt = ai * 128 + wr * 64 + m * 16 + fr, ct = wc * 64 + bj * 32 + 8 * fq;
        DT nxt = cur;
        if (it + 1 < 16) { const int i2 = it + 1, a2 = i2 >> 3, m2 = (i2 >> 1) & 3, b2 = i2 & 1; nxt = ld(a2 * 128 + wr * 64 + m2 * 16 + fr, wc * 64 + b2 * 32 + 8 * fq); }
        asm volatile("" ::: "memory");
        f(rt, ct, acc[ai][bj][m][0], acc[ai][bj][m][1], cur);
        cur = nxt; }
}
__device__ __forceinline__ u32x4 pack8(f32x4 v0, f32x4 v1) { u32x4 w; w.x = pk2(v0[0], v0[1]); w.y = pk2(v0[2], v0[3]); w.z = pk2(v1[0], v1[1]); w.w = pk2(v1[2], v1[3]); return w; }
__device__ __forceinline__ float gelu_tanh(float x) { const float u = 1.5957691216057308f * (x + 0.044715f * x * x * x); return x * sigmoidf_(u); }
__device__ __forceinline__ void unpack8(u32x4 w, float (&f)[8]) { f[0] = bflo(w.x); f[1] = bfhi(w.x); f[2] = bflo(w.y); f[3] = bfhi(w.y); f[4] = bflo(w.z); f[5] = bfhi(w.z); f[6] = bflo(w.w); f[7] = bfhi(w.w); }

struct EpiCtx {
    static constexpr bool PERM = true; static constexpr bool MID = false; static constexpr int NST = 16;
    bf16* ZC;
    __device__ __forceinline__ void operator()(const f32x4 (&acc)[2][2][4][2], const Unit& u, int wr, int wc, int fr, int fq) const {
        const int pn = u.pn; const int ctile = pn < 4 ? pn : pn - 8;
        const float sc = (pn >= 12 && pn < 16) ? K_SCALE : 1.0f;
        char* zc = (char*)(ZC + (size_t)(u.pm - 256) * 256 * ZC_LD + ctile * 256); int ldz = ZC_LD; asm volatile("" : "+s"(ldz));
        const int ln = fq * 16 + fr, xs = (ln & 3) * 16 + (ln >> 2), dr = (ln >> 2) - fr, dc = 8 * ((ln & 3) - fq);
        epi_perm_loop(acc, wr, wc, fr, fq, [&](int rt, int ct, f32x4 v0, f32x4 v1) { v0 *= sc; v1 *= sc; *(u32x4*)(zc + (unsigned)(((rt + dr) * ldz + ct + dc) * 2)) = xp16(pack8(v0, v1), xs); });
    }
};
struct EpiIn {
    static constexpr bool PERM = true; static constexpr bool MID = false; static constexpr int NST = 16;
    bf16* Z; const f32x2* rope; int dry;
    template <bool ROPE>
    __device__ __forceinline__ void run(const f32x4 (&acc)[2][2][4][2], const Unit& u, int wr, int wc, int fr, int fq, float sc) const {
        const int pn = u.pn; const int row0 = u.pm * 256, col0 = pn * 256; const f32x2* rp_ = rope;
        char* zt = (char*)(Z + (size_t)row0 * ZLD + col0); int ldz = ZLD; asm volatile("" : "+s"(ldz));
        const int ln = fq * 16 + fr;
        f32x4 cq[2][2], nq[2][2];
        auto ldrope = [&](int g, f32x4 (&q)[2][2]) { const int ai = g >> 2, m = g & 3; const int rt = ai * 128 + wr * 64 + m * 16 + fr; const int t = (row0 + rt) & (SEQ - 1);
#pragma unroll
            for (int bj = 0; bj < 2; ++bj) { const int ct = wc * 64 + bj * 32 + 8 * fq; const int e0 = (col0 + ct) & 127; const int p0 = e0 >> 1;
                const int pos = p0 < 32 ? (t >> 6) : (t & 63); const int f0 = p0 & 31; const f32x4* rp = (const f32x4*)(rp_ + pos * 32 + f0);
                q[bj][0] = rp[0]; q[bj][1] = rp[1]; } };
        if constexpr (ROPE) ldrope(0, cq);
#pragma unroll
        for (int g = 0; g < 8; ++g) { const int ai = g >> 2, m = g & 3; const int rt = ai * 128 + wr * 64 + m * 16 + fr; u32x4 pw[2];
            if constexpr (ROPE) { if (g + 1 < 8) ldrope(g + 1, nq); }
            asm volatile("" ::: "memory");
#pragma unroll
            for (int bj = 0; bj < 2; ++bj) { f32x4 v0 = acc[ai][bj][m][0], v1 = acc[ai][bj][m][1];
                if constexpr (ROPE) { const f32x4 cs0 = cq[bj][0], cs1 = cq[bj][1]; f32x4 o0, o1;
                    o0[0] = v0[0] * cs0[0] - v0[1] * cs0[1]; o0[1] = v0[0] * cs0[1] + v0[1] * cs0[0];
                    o0[2] = v0[2] * cs0[2] - v0[3] * cs0[3]; o0[3] = v0[2] * cs0[3] + v0[3] * cs0[2];
                    o1[0] = v1[0] * cs1[0] - v1[1] * cs1[1]; o1[1] = v1[0] * cs1[1] + v1[1] * cs1[0];
                    o1[2] = v1[2] * cs1[2] - v1[3] * cs1[3]; o1[3] = v1[2] * cs1[3] + v1[3] * cs1[2];
                    v0 = o0 * sc; v1 = o1 * sc; }
                pw[bj] = pack8(v0, v1); }
#pragma unroll
            for (int s = 0; s < 2; ++s) { const int rr = 8 * s + (ln >> 3), pp = ln & 7; const int srcl = (pp & 3) * 16 + rr;
                const u32x4 a0 = xp16(pw[0], srcl), a1 = xp16(pw[1], srcl); const u32x4 ow = (pp >> 2) ? a1 : a0;
                if (!(MK_DRYMODE == 1 && dry) || ow.x == 0x7fc12345u) __builtin_nontemporal_store(ow, (u32x4*)(zt + (unsigned)(((rt - fr + rr) * ldz + wc * 64 + 8 * pp) * 2))); }
            if constexpr (ROPE) {
#pragma unroll
                for (int bj = 0; bj < 2; ++bj) { cq[bj][0] = nq[bj][0]; cq[bj][1] = nq[bj][1]; } }
            asm volatile("" ::: "memory"); }
    }
    __device__ __forceinline__ void operator()(const f32x4 (&acc)[2][2][4][2], const Unit& u, int wr, int wc, int fr, int fq) const {
        if (MK_DRYMODE >= 2 && dry) return;
        const int pn = u.pn;
        if (pn >= 8 && pn < 16) run<true>(acc, u, wr, wc, fr, fq, pn >= 12 ? K_SCALE : 1.0f); else run<false>(acc, u, wr, wc, fr, fq, 1.0f);
    }
};
struct EpiT1 {
    static constexpr bool PERM = true; static constexpr bool MID = false; static constexpr int NST = 16;
    const bf16* Z; bf16* T1;
    __device__ __forceinline__ void operator()(const f32x4 (&acc)[2][2][4][2], const Unit& u, int wr, int wc, int fr, int fq) const {
        const char* zt = (const char*)(Z + (size_t)u.pm * 256 * ZLD + C_GA + u.pn * 256); char* tt = (char*)(T1 + (size_t)u.pm * 256 * D + u.pn * 256);
        int ldz = ZLD, ldt = D; asm volatile("" : "+s"(ldz), "+s"(ldt));
        const int ln = fq * 16 + fr, xs = (ln & 3) * 16 + (ln >> 2), dr = (ln >> 2) - fr, dc = 8 * ((ln & 3) - fq);
        epi_perm_pipe<u32x4>(acc, wr, wc, fr, fq, [&](int rt, int ct) { return *(const u32x4*)(zt + (unsigned)((rt * ldz + ct) * 2)); },
            [&](int rt, int ct, f32x4 v0, f32x4 v1, u32x4 gw) { float gte[8]; unpack8(gw, gte);
            for (int j = 0; j < 4; ++j) { v0[j] *= sigmoidf_(gte[j]); v1[j] *= sigmoidf_(gte[4 + j]); }
            *(u32x4*)(tt + (unsigned)(((rt + dr) * ldt + ct + dc) * 2)) = xp16(pack8(v0, v1), xs); });
    }
};
struct EpiMg {
    static constexpr bool PERM = true; static constexpr bool MID = false; static constexpr int NST = 16;
    const bf16* Z; const bf16* T1; bf16* MG;
    __device__ __forceinline__ void operator()(const f32x4 (&acc)[2][2][4][2], const Unit& u, int wr, int wc, int fr, int fq) const {
        const char* zt = (const char*)(Z + (size_t)u.pm * 256 * ZLD + C_GB + u.pn * 256); const char* tt = (const char*)(T1 + (size_t)u.pm * 256 * D + u.pn * 256); char* mt = (char*)(MG + (size_t)u.pm * 256 * D + u.pn * 256);
        int ldz = ZLD, ldt = D; asm volatile("" : "+s"(ldz), "+s"(ldt));
        const int ln = fq * 16 + fr, xs = (ln & 3) * 16 + (ln >> 2), dr = (ln >> 2) - fr, dc = 8 * ((ln & 3) - fq);
        struct D2 { u32x4 a, b; };
        epi_perm_pipe<D2>(acc, wr, wc, fr, fq, [&](int rt, int ct) { D2 d; d.a = *(const u32x4*)(zt + (unsigned)((rt * ldz + ct) * 2)); d.b = *(const u32x4*)(tt + (unsigned)((rt * ldt + ct) * 2)); return d; },
            [&](int rt, int ct, f32x4 v0, f32x4 v1, D2 dd) { float gte[8], t1v[8]; unpack8(dd.a, gte); unpack8(dd.b, t1v);
            for (int j = 0; j < 4; ++j) { v0[j] = t1v[j] + v0[j] * sigmoidf_(gte[j]); v1[j] = t1v[4 + j] + v1[j] * sigmoidf_(gte[4 + j]); }
            *(u32x4*)(mt + (unsigned)(((rt + dr) * ldt + ct + dc) * 2)) = xp16(pack8(v0, v1), xs); });
    }
};
struct EpiF {
    static constexpr bool PERM = true; static constexpr bool MID = true; static constexpr int NST = 16;
    const bf16* Z; bf16* MG; int dry;
    __device__ __forceinline__ bool is_mid(const Unit& u) const { return u.koff == 0; }
    __device__ __forceinline__ void mid(f32x4 (&acc)[2][2][4][2], const Unit& u, int wr, int wc, int fr, int fq) const {
        if (MK_DRYMODE == 2 && dry) return;
        const char* za = (const char*)(Z + (size_t)u.pm * 256 * ZLD + C_GA + u.pn * 256); const char* zb = za + (C_GB - C_GA) * 2;
        int ldz = ZLD; asm volatile("" : "+s"(ldz));
        auto off = [&](int it) { const int ai = it >> 3, m = (it >> 1) & 3, bj = it & 1; return (unsigned)(((ai * 128 + wr * 64 + m * 16 + fr) * ldz + wc * 64 + bj * 32 + 8 * fq) * 2); };
        u32x4 qa[3], qb[3];
        qa[0] = *(const u32x4*)(za + off(0)); qb[0] = *(const u32x4*)(zb + off(0)); qa[1] = *(const u32x4*)(za + off(1)); qb[1] = *(const u32x4*)(zb + off(1));
#pragma unroll
        for (int it = 0; it < 16; ++it) { const int ai = it >> 3, m = (it >> 1) & 3, bj = it & 1;
            if (it + 2 < 16) { qa[(it + 2) % 3] = *(const u32x4*)(za + off(it + 2)); qb[(it + 2) % 3] = *(const u32x4*)(zb + off(it + 2)); }
            asm volatile("" ::: "memory");
            float ga[8], gb[8]; unpack8(qa[it % 3], ga); unpack8(qb[it % 3], gb);
#pragma unroll
            for (int j = 0; j < 4; ++j) {
                acc[ai][bj][m][0][j] *= (1.0f + fminf(__expf(-gb[j]), 1e30f)) * __builtin_amdgcn_rcpf(1.0f + __expf(-ga[j]));
                acc[ai][bj][m][1][j] *= (1.0f + fminf(__expf(-gb[4 + j]), 1e30f)) * __builtin_amdgcn_rcpf(1.0f + __expf(-ga[4 + j])); } }
    }
    __device__ __forceinline__ void operator()(const f32x4 (&acc)[2][2][4][2], const Unit& u, int wr, int wc, int fr, int fq) const {
        if (MK_DRYMODE == 2 && dry) return;
        const char* zb = (const char*)(Z + (size_t)u.pm * 256 * ZLD + C_GB + u.pn * 256); char* mt = (char*)(MG + (size_t)u.pm * 256 * D + u.pn * 256);
        int ldz = ZLD, ldt = D; asm volatile("" : "+s"(ldz), "+s"(ldt));
        const int ln = fq * 16 + fr, xs = (ln & 3) * 16 + (ln >> 2), dr = (ln >> 2) - fr, dc = 8 * ((ln & 3) - fq);
        auto off = [&](int it) { const int ai = it >> 3, m = (it >> 1) & 3, bj = it & 1; return (unsigned)(((ai * 128 + wr * 64 + m * 16 + fr) * ldz + wc * 64 + bj * 32 + 8 * fq) * 2); };
        u32x4 qb[4]; qb[0] = *(const u32x4*)(zb + off(0)); qb[1] = *(const u32x4*)(zb + off(1)); qb[2] = *(const u32x4*)(zb + off(2));
#pragma unroll
        for (int it = 0; it < 16; ++it) { const int ai = it >> 3, m = (it >> 1) & 3, bj = it & 1; const int rt = ai * 128 + wr * 64 + m * 16 + fr, ct = wc * 64 + bj * 32 + 8 * fq;
            if (it + 3 < 16) qb[(it + 3) & 3] = *(const u32x4*)(zb + off(it + 3));
            asm volatile("" ::: "memory");
            float gb[8]; unpack8(qb[it & 3], gb); f32x4 v0 = acc[ai][bj][m][0], v1 = acc[ai][bj][m][1];
#pragma unroll
            for (int j = 0; j < 4; ++j) { v0[j] *= __builtin_amdgcn_rcpf(1.0f + fminf(__expf(-gb[j]), 1e30f)); v1[j] *= __builtin_amdgcn_rcpf(1.0f + fminf(__expf(-gb[4 + j]), 1e30f)); }
            *(u32x4*)(mt + (unsigned)(((rt + dr) * ldt + ct + dc) * 2)) = xp16(pack8(v0, v1), xs); }
    }
};
struct EpiX1 {
    static constexpr bool PERM = true; static constexpr bool MID = false; static constexpr int NST = 16;
    const float* X; float* O; const float* mod; int grow0;
    __device__ __forceinline__ void operator()(const f32x4 (&acc)[2][2][4][2], const Unit& u, int wr, int wc, int fr, int fq) const {
        const int trow = grow0 + u.pm * 256; const int b = trow >> 13;
        const char* xt = (const char*)(X + (size_t)trow * D + u.pn * 256); char* ot = (char*)(O + (size_t)trow * D) + u.pn * 512; const float* g1 = mod + b * 6144 + 2048 + u.pn * 256;
        int ldx = D; asm volatile("" : "+s"(ldx));
        const int ln = fq * 16 + fr, xs = (ln & 3) * 16 + (ln >> 2), dr = (ln >> 2) - fr, dc = 8 * ((ln & 3) - fq);
        f32x4 gv[2][2];
#pragma unroll
        for (int bj = 0; bj < 2; ++bj)
#pragma unroll
            for (int n = 0; n < 2; ++n) gv[bj][n] = *(const f32x4*)(g1 + wc * 64 + bj * 32 + 8 * fq + 4 * n);
        auto xoff = [&](int it) { const int ai = it >> 3, m = (it >> 1) & 3, bj = it & 1; return (unsigned)(((ai * 128 + wr * 64 + m * 16 + fr) * ldx + wc * 64 + bj * 32 + 8 * fq) * 4); };
        f32x4 xa[3], xb[3];
        xa[0] = *(const f32x4*)(xt + xoff(0)); xb[0] = *(const f32x4*)(xt + xoff(0) + 16); xa[1] = *(const f32x4*)(xt + xoff(1)); xb[1] = *(const f32x4*)(xt + xoff(1) + 16);
#pragma unroll
        for (int it = 0; it < 16; ++it) { const int ai = it >> 3, m = (it >> 1) & 3, bj = it & 1; const int rt = ai * 128 + wr * 64 + m * 16 + fr, ct = wc * 64 + bj * 32 + 8 * fq;
            if (it + 2 < 16) { xa[(it + 2) % 3] = *(const f32x4*)(xt + xoff(it + 2)); xb[(it + 2) % 3] = *(const f32x4*)(xt + xoff(it + 2) + 16); }
            asm volatile("" ::: "memory");
            const f32x4 v0 = xa[it % 3] + gv[bj][0] * acc[ai][bj][m][0], v1 = xb[it % 3] + gv[bj][1] * acc[ai][bj][m][1];
            *(u32x4*)(ot + (unsigned)(((rt + dr) * ldx) * 4 + (ct + dc) * 2)) = xp16(pack8(v0, v1), xs); }
    }
};
__device__ __forceinline__ float swiglu1(float g, float l) { const float gl = fminf(g, 7.0f), li = fminf(fmaxf(l, -7.0f), 7.0f); return gl * __builtin_amdgcn_rcpf(1.0f + __builtin_amdgcn_exp2f(gl * -2.4554669595930156f)) * (li + 1.0f); }
struct EpiHid {
    static constexpr bool PERM = true; static constexpr bool MID = false; static constexpr int NST = 16;
    unsigned char* HID;
    static constexpr bool BIAS_LDS = true;
    __device__ __forceinline__ void with_bias(const f32x4 (&acc)[2][2][4][2], const Unit& u, int wr, int wc, int fr, int fq, const LAS float* bb) const {
        const int pl = u.pn & 7; char* ht = (char*)(HID + (size_t)u.pm * 256 * DEXP + pl * 128);
        int ldh = DEXP; asm volatile("" : "+s"(ldh));
        const int ln = fq * 16 + fr, xs = (ln & 3) * 16 + (ln >> 2), dr = (ln >> 2) - fr, dc = 8 * ((ln & 3) - fq);
        f32x4 bq[2][2];
#pragma unroll
        for (int bj = 0; bj < 2; ++bj) { bq[bj][0] = *(const LAS f32x4*)(bb + wc * 64 + bj * 32 + 8 * fq); bq[bj][1] = *(const LAS f32x4*)(bb + wc * 64 + bj * 32 + 8 * fq + 4); }
        epi_perm_loop_bj(acc, wr, wc, fr, fq, [&](int rt, int ct, auto BJ, f32x4 v0, f32x4 v1) { constexpr int bj = decltype(BJ)::value; v0 += bq[bj][0]; v1 += bq[bj][1];
            const unsigned w = pk4_fp8(swiglu1(v0[0], v0[1]), swiglu1(v0[2], v0[3]), swiglu1(v1[0], v1[1]), swiglu1(v1[2], v1[3]));
            *(unsigned*)(ht + (unsigned)((rt + dr) * ldh + ((ct + dc) >> 1))) = (unsigned)__shfl((int)w, xs); });
    }
};
struct EpiY {
    static constexpr bool PERM = true; static constexpr bool MID = false; static constexpr int NST = 16;
    unsigned char* Y;
    static constexpr bool BIAS_LDS = true;
    __device__ __forceinline__ void with_bias(const f32x4 (&acc)[2][2][4][2], const Unit& u, int wr, int wc, int fr, int fq, const LAS float* bb) const {
        const int pl = u.pn & 3; char* yt = (char*)(Y + (size_t)u.pm * 256 * D + pl * 256);
        int ldy = D; asm volatile("" : "+s"(ldy));
        const int ln = fq * 16 + fr, xs = (ln & 3) * 16 + (ln >> 2), dr = (ln >> 2) - fr, dc = 8 * ((ln & 3) - fq);
        f32x4 bq[2][2];
#pragma unroll
        for (int bj = 0; bj < 2; ++bj) { bq[bj][0] = *(const LAS f32x4*)(bb + wc * 64 + bj * 32 + 8 * fq); bq[bj][1] = *(const LAS f32x4*)(bb + wc * 64 + bj * 32 + 8 * fq + 4); }
        epi_perm_loop_bj(acc, wr, wc, fr, fq, [&](int rt, int ct, auto BJ, f32x4 v0, f32x4 v1) { constexpr int bj = decltype(BJ)::value; v0 += bq[bj][0]; v1 += bq[bj][1];
            u32x2 w8; w8.x = pk4_fp8(v0[0], v0[1], v0[2], v0[3]); w8.y = pk4_fp8(v1[0], v1[1], v1[2], v1[3]);
            *(u32x2*)(yt + (unsigned)((rt + dr) * ldy + ct + dc)) = xp8(w8, xs); });
    }
};

#define XB_TMO      128
#define XB_XCNT(j)  (256  + 64 * (j))
#define XB_XSUB(j)  (1280 + 64 * (j))
#define XB_XGEN(j)  (2304 + 64 * (j))
#define XB_TOP      3328
#define XB_TOPGEN   3392
#define XCD_BAR_WORDS 3456
#define XB_SPIN_CAP (1u << 22)
__device__ __forceinline__ unsigned xb_ld(unsigned* p)              { return __hip_atomic_load(p, __ATOMIC_RELAXED, __HIP_MEMORY_SCOPE_AGENT); }
__device__ __forceinline__ unsigned xb_add(unsigned* p, unsigned v) { return __hip_atomic_fetch_add(p, v, __ATOMIC_RELAXED, __HIP_MEMORY_SCOPE_AGENT); }
__device__ __forceinline__ unsigned xb_xcc_id() { return (unsigned)__builtin_amdgcn_s_getreg((3 << 11) | 20) & 0xFu; }
#define XB_SPIN(cond, bar) do { unsigned _sp = 0; while (cond) { __builtin_amdgcn_s_sleep(1); \
    if ((++_sp & 255u) == 0u) { if (xb_ld(&(bar)[XB_TMO])) break; if (_sp > XB_SPIN_CAP) { atomicAdd(&(bar)[XB_TMO], 1u); break; } } } } while (0)
struct XcdBarrier { unsigned* bar; unsigned x; volatile LAS unsigned* st; };
__device__ __forceinline__ XcdBarrier xcd_barrier_post(unsigned* bar, volatile LAS unsigned* st) {
    XcdBarrier b; b.bar = bar; b.x = xb_xcc_id(); b.st = st;
    if (threadIdx.x == 0) (void)xb_add(&bar[XB_XCNT(b.x)], 1u);
    return b;
}
__device__ __forceinline__ void xcd_barrier_complete(unsigned* bar, unsigned x, unsigned& nloc, unsigned& nx) {
    const unsigned G = gridDim.x * gridDim.y * gridDim.z;
    unsigned sum, cnt, mine, sp = 0u;
    for (;;) {
        sum = 0u; cnt = 0u; mine = 0u;
#pragma unroll
        for (unsigned j = 0; j < 16; ++j) { const unsigned c = xb_ld(&bar[XB_XCNT(j)]); sum += c; cnt += (c > 0u) ? 1u : 0u; mine = (j == x) ? c : mine; }
        if (sum == G) break;
        __builtin_amdgcn_s_sleep(1);
        if ((++sp & 255u) == 0u) { if (xb_ld(&bar[XB_TMO])) break; if (sp > XB_SPIN_CAP) { atomicAdd(&bar[XB_TMO], 1u); break; } }
    }
    nloc = mine > 0u ? mine : 1u; nx = cnt > 0u ? cnt : 1u;
}
__device__ __forceinline__ void xcd_barrier(const XcdBarrier& b) {
    asm volatile("s_waitcnt vmcnt(0)" ::: "memory");
    __syncthreads();
    if (threadIdx.x == 0) {
        unsigned* bar = b.bar;
        __builtin_amdgcn_s_waitcnt(0);
        unsigned nloc = b.st[0], nx = b.st[1];
        if (nloc == 0u) { xcd_barrier_complete(bar, b.x, nloc, nx); b.st[0] = nloc; b.st[1] = nx; }
        const unsigned old = xb_add(&bar[XB_XSUB(b.x)], 1u);
        const unsigned gen = old / nloc;
        if (old + 1u == (gen + 1u) * nloc) {
            __builtin_amdgcn_fence(__ATOMIC_RELEASE, "agent");
            asm volatile("s_waitcnt vmcnt(0)" ::: "memory");
            const unsigned og = xb_add(&bar[XB_TOP], 1u);
            const unsigned tg = og / nx;
            if (og + 1u == (tg + 1u) * nx) xb_add(&bar[XB_TOPGEN], 1u);
            else XB_SPIN(xb_ld(&bar[XB_TOPGEN]) == tg, bar);
            __builtin_amdgcn_fence(__ATOMIC_ACQUIRE, "agent");
            xb_add(&bar[XB_XGEN(b.x)], 1u);
            asm volatile("s_waitcnt vmcnt(0)" ::: "memory");
        } else {
            XB_SPIN(xb_ld(&bar[XB_XGEN(b.x)]) == gen, bar);
            __builtin_amdgcn_fence(__ATOMIC_ACQUIRE, "agent");
            asm volatile("s_waitcnt vmcnt(0)" ::: "memory");
        }
    }
    __syncthreads();
}

__device__ __forceinline__ void transpose_item(const float* W, int ldw, int K, int N, bf16* WT, LAS float* scr, int item, int lane) {
    const int nblk = N / 32, kb = item / nblk, nb = item % nblk, k0 = 64 * kb, n0 = 32 * nb;
#pragma unroll 8
    for (int i = 0; i < 32; ++i) { const int kk = 2 * i + (lane >> 5); scr[kk * 33 + (lane & 31)] = W[(size_t)(k0 + kk) * ldw + n0 + (lane & 31)]; }
    LDS_WAIT(); asm volatile("" ::: "memory");
    const int c = lane & 7;
#pragma unroll
    for (int j = 0; j < 4; ++j) { const int n = (lane >> 3) + 8 * j; const LAS float* s = scr + (8 * c) * 33 + n;
        u32x4 o; o.x = pk2(s[0 * 33], s[1 * 33]); o.y = pk2(s[2 * 33], s[3 * 33]); o.z = pk2(s[4 * 33], s[5 * 33]); o.w = pk2(s[6 * 33], s[7 * 33]);
        *(u32x4*)(WT + (size_t)(n0 + n) * K + k0 + 8 * c) = o; }
    LDS_WAIT(); asm volatile("" ::: "memory");
}
struct TrTile { const float* src; bf16* dst; int ldw, ldt; };
__device__ __forceinline__ void tr_load(const TrTile& t, int tid, f32x4 (&v)[8]) {
#pragma unroll
    for (int i = 0; i < 8; ++i) { const int id = tid + 512 * i, k = id >> 5, c4 = id & 31; v[i] = *(const f32x4*)(t.src + (size_t)k * t.ldw + 4 * c4); }
}
__device__ __forceinline__ void tr_store(const TrTile& t, int tid, const f32x4 (&v)[8], LAS float* L) {
#pragma unroll
    for (int i = 0; i < 8; ++i) { const int id = tid + 512 * i, k = id >> 5, c4 = id & 31;
        L[(4 * c4 + 0) * 129 + k] = v[i][0]; L[(4 * c4 + 1) * 129 + k] = v[i][1]; L[(4 * c4 + 2) * 129 + k] = v[i][2]; L[(4 * c4 + 3) * 129 + k] = v[i][3]; }
    __syncthreads();
#pragma unroll
    for (int i = 0; i < 4; ++i) { const int id = tid + 512 * i, kc = id & 15, n = id >> 4; const LAS float* s = L + n * 129 + 8 * kc;
        u32x4 o; o.x = pk2(s[0], s[1]); o.y = pk2(s[2], s[3]); o.z = pk2(s[4], s[5]); o.w = pk2(s[6], s[7]);
        *(u32x4*)(t.dst + (size_t)n * t.ldt + 8 * kc) = o; }
    __syncthreads();
}
template <bool FP8 = false>
__device__ __forceinline__ void tr_strip_i8(const float* src, int ldw, int K, signed char* dst, int ldt, float* scales, int tid, LAS unsigned* TL, LAS unsigned* CM) {
    constexpr float QMAX = FP8 ? 448.0f : 127.0f;
    const int c4 = tid & 31, g = tid >> 5, nk = K / 128;
    const float* p = src + (size_t)(4 * g) * ldw + 4 * c4;
    auto ld8 = [&](int kt, f32x4 (&v)[8]) {
#pragma unroll
        for (int h = 0; h < 2; ++h)
#pragma unroll
            for (int r = 0; r < 4; ++r) v[4 * h + r] = *(const f32x4*)(p + (size_t)(kt * 128 + 64 * h + r) * ldw); };
    float mx[4] = {0.f, 0.f, 0.f, 0.f};
    auto red = [&](const f32x4 (&v)[8]) {
#pragma unroll
        for (int i = 0; i < 8; ++i)
#pragma unroll
            for (int j = 0; j < 4; ++j) mx[j] = fmaxf(mx[j], fabsf(v[i][j])); };
    {   f32x4 va[8], vb[8]; ld8(0, va);
#pragma unroll 1
        for (int kt = 0; kt < nk; kt += 2) { ld8(kt + 1, vb); red(va); if (kt + 2 < nk) ld8(kt + 2, va); red(vb); } }
    f32x4 v[8]; ld8(0, v);
    if (tid < 128) CM[tid] = 0u;
    __syncthreads();
#pragma unroll
    for (int j = 0; j < 4; ++j) __hip_atomic_fetch_max(&CM[4 * c4 + j], __builtin_bit_cast(unsigned, mx[j]), __ATOMIC_RELAXED, __HIP_MEMORY_SCOPE_WORKGROUP);
    __syncthreads();
    if (tid < 128) { const float m = __builtin_bit_cast(float, CM[tid]); scales[tid] = m > 0.f ? m * (1.0f / QMAX) : 1.0f; }
    float inv[4];
#pragma unroll
    for (int j = 0; j < 4; ++j) { const float m = __builtin_bit_cast(float, CM[4 * c4 + j]); inv[j] = m > 0.f ? QMAX / m : 0.f; }
#pragma unroll 1
    for (int kt = 0; kt < nk; ++kt) {
        f32x4 w[8];
#pragma unroll
        for (int i = 0; i < 8; ++i) w[i] = v[i];
        if (kt + 1 < nk) ld8(kt + 1, v);
        LAS unsigned* T = TL + (kt & 1) * 4352;
#pragma unroll
        for (int h = 0; h < 2; ++h)
#pragma unroll
            for (int j = 0; j < 4; ++j) { unsigned pk;
                if constexpr (FP8) pk = pk4_fp8(w[4 * h][j] * inv[j], w[4 * h + 1][j] * inv[j], w[4 * h + 2][j] * inv[j], w[4 * h + 3][j] * inv[j]);
                else pk = q8x4((f32x4){w[4 * h][j], w[4 * h + 1][j], w[4 * h + 2][j], w[4 * h + 3][j]}, inv[j]);
                T[c4 * 133 + j * 33 + 16 * h + g] = pk; }
        __syncthreads();
#pragma unroll
        for (int i = 0; i < 2; ++i) { const int id = tid + 512 * i, kc = id & 7, n = id >> 3; const LAS unsigned* s = T + (n >> 2) * 133 + (n & 3) * 33 + 4 * kc;
            *(u32x4*)(dst + (size_t)n * ldt + kt * 128 + 16 * kc) = (u32x4){s[0], s[1], s[2], s[3]}; }
    }
    __syncthreads();
}
__device__ __forceinline__ unsigned offb(unsigned row, unsigned ch) { return 256u * row + 16u * (ch ^ (((row & 3u) << 2) | ((row >> 2) & 3u))); }
typedef short v4i16_t __attribute__((ext_vector_type(4)));
__device__ __forceinline__ s16x4 trd(const LAS unsigned char* p) { return __builtin_bit_cast(s16x4, __builtin_amdgcn_ds_read_tr16_b64_v4i16((LAS v4i16_t*)p)); }
#define MFMA32(a, b, c) __builtin_amdgcn_mfma_f32_32x32x16_bf16((a), (b), (c), 0, 0, 0)
#define MFMA16(a, b, c) __builtin_amdgcn_mfma_f32_16x16x32_bf16((a), (b), (c), 0, 0, 0)
__device__ __forceinline__ int crow(int reg, int h) { return (reg & 3) + 8 * (reg >> 2) + 4 * h; }

struct LruP { const float *conv_w, *conv_b, *ba, *bx, *lam; const bf16* wg; f32x2* carry; };
template <int PASS, int DIR>
__device__ __forceinline__ void lru_dir(LAS unsigned char* XC, LAS unsigned char* RN, const LruP& P, int b, int cp, int n, int w, int col, int g4) {
    const int ch = 128 * n + 16 * w + col;
    const float bav = P.ba[DIR * 1024 + ch], bxv = P.bx[DIR * 1024 + ch];
    const float c8 = 8.0f * log1pf(expf(-P.lam[DIR * 1024 + ch]));
    bf16x8 Ba[4], Bx[4];
    { const bf16* wa = P.wg + ((size_t)((n * 4 + DIR * 2 + 0) * 128 + 16 * w + col)) * 128 + 8 * g4; const bf16* wx = wa + 128 * 128;
#pragma unroll
      for (int ks = 0; ks < 4; ++ks) { Ba[ks] = *(const bf16x8*)(wa + 32 * ks); Bx[ks] = *(const bf16x8*)(wx + 32 * ks); } }
    float hrun = 0.f, atot = 1.f;
    if (PASS == 1) {
        const int Pn = DIR == 0 ? cp : 33 - cp; float Al = 1.f, Ul = 0.f;
#pragma unroll
        for (int k = 0; k < 9; ++k) { const int p = 9 * g4 + k;
            if (p < Pn) { const int cq = DIR == 0 ? p : (p == 0 ? 0 : 33 - p); const f32x2 ah = P.carry[((size_t)(b * 2 + DIR) * 33 + cq) * 1024 + ch]; Ul = ah.x * Ul + ah.y; Al = ah.x * Al; } }
#pragma unroll
        for (int gq = 0; gq < 4; ++gq) { const float Ag = __shfl(Al, col + 16 * gq), Ug = __shfl(Ul, col + 16 * gq); hrun = Ag * hrun + Ug; }
    }
#pragma unroll 4
    for (int mi = 0; mi < 16; ++mi) {
        const int m = DIR == 0 ? mi : 15 - mi;
        f32x4 ar = {0.f, 0.f, 0.f, 0.f}, ai = {0.f, 0.f, 0.f, 0.f};
        const LAS unsigned char* xrow = XC + (16 * m + col) * 272 + 16 * g4;
#pragma unroll
        for (int ks = 0; ks < 4; ++ks) { const bf16x8 af = *(const LAS bf16x8*)(xrow + 64 * ks); ar = MFMA16(af, Ba[ks], ar); ai = MFMA16(af, Bx[ks], ai); }
        float av[4], uv[4];
#pragma unroll
        for (int r = 0; r < 4; ++r) { const int t = 16 * m + 4 * g4 + r; const float xc = bf2f(*(const LAS unsigned short*)(XC + t * 272 + (16 * w + col) * 2));
            const float er = __expf(fminf(-(ar[r] + bav), 40.f)) + 1.0f, ei = __expf(fminf(-(ai[r] + bxv), 40.f)) + 1.0f; const float inv = __builtin_amdgcn_rcpf(er * ei);
            const float rg = inv * ei, ig = inv * er; const float a = __expf(-c8 * rg);
            av[r] = a; uv[r] = __builtin_amdgcn_sqrtf(fmaxf(1.0f - a * a, 0.f)) * ig * xc; }
        float Al = 1.f, Ul = 0.f;
#pragma unroll
        for (int rr = 0; rr < 4; ++rr) { const int r = DIR == 0 ? rr : 3 - rr; Ul = av[r] * Ul + uv[r]; Al = av[r] * Al; }
        float Ag[4], Ug[4];
#pragma unroll
        for (int gq = 0; gq < 4; ++gq) { Ag[gq] = __shfl(Al, col + 16 * gq); Ug[gq] = __shfl(Ul, col + 16 * gq); }
        float h = hrun, hin = hrun;
#pragma unroll
        for (int gi = 0; gi < 4; ++gi) { const int gq = DIR == 0 ? gi : 3 - gi; if (gq == g4) hin = h; h = Ag[gq] * h + Ug[gq]; atot *= Ag[gq]; }
        hrun = h;
        if (PASS == 1) {
            float hh = hin;
#pragma unroll
            for (int rr = 0; rr < 4; ++rr) { const int r = DIR == 0 ? rr : 3 - rr; hh = av[r] * hh + uv[r];
                LAS unsigned short* rp = (LAS unsigned short*)(RN + (16 * m + 4 * g4 + r) * 272 + (16 * w + col) * 2);
                if (DIR == 0) *rp = (unsigned short)f2bf(hh); else *rp = (unsigned short)f2bf(bf2f(*rp) + hh); }
        }
    }
    if (PASS == 0) { if (g4 == 0) P.carry[((size_t)(b * 2 + DIR) * 33 + cp) * 1024 + ch] = (f32x2){atot, hrun}; }
}
template <int PASS>
__device__ __forceinline__ void lru_unit(LAS unsigned char* lds, const LruP& P, int b, int cp, int n, const bf16* xsrc, int ldx, int seqlen, const bf16* grp, bf16* gout) {
    const int tid = opaque_tid(), lane = tid & 63, w = __builtin_amdgcn_readfirstlane(tid >> 6), col = lane & 15, g4 = lane >> 4;
    const int t0 = cp == 0 ? 0 : (cp - 1) * 256;
    LAS unsigned char* XC = lds;
    LAS unsigned char* RN = lds + 69632;
    __syncthreads();
    {
        const int j8 = tid & 15, ch0 = 128 * n + 8 * j8;
        float cw[4][8], cb[8];
#pragma unroll
        for (int k = 0; k < 4; ++k) { const f32x4 a = *(const f32x4*)(P.conv_w + k * 1024 + ch0), c = *(const f32x4*)(P.conv_w + k * 1024 + ch0 + 4);
            cw[k][0] = a[0]; cw[k][1] = a[1]; cw[k][2] = a[2]; cw[k][3] = a[3]; cw[k][4] = c[0]; cw[k][5] = c[1]; cw[k][6] = c[2]; cw[k][7] = c[3]; }
        { const f32x4 a = *(const f32x4*)(P.conv_b + ch0), c = *(const f32x4*)(P.conv_b + ch0 + 4); cb[0] = a[0]; cb[1] = a[1]; cb[2] = a[2]; cb[3] = a[3]; cb[4] = c[0]; cb[5] = c[1]; cb[6] = c[2]; cb[7] = c[3]; }
#pragma unroll 4
        for (int i = 0; i < 8; ++i) {
            const int t = (tid >> 4) + 32 * i; float a[8];
#pragma unroll
            for (int j = 0; j < 8; ++j) a[j] = cb[j];
#pragma unroll
            for (int k = 0; k < 4; ++k) { const int row = t0 + t + k - 2;
                if (row >= 0 && row < seqlen) { float xv[8]; unpack8(*(const u32x4*)(xsrc + (size_t)row * ldx + ch0), xv);
#pragma unroll
                    for (int j = 0; j < 8; ++j) a[j] += cw[k][j] * xv[j]; } }
            u32x4 o; o.x = pk2(a[0], a[1]); o.y = pk2(a[2], a[3]); o.z = pk2(a[4], a[5]); o.w = pk2(a[6], a[7]);
            *(LAS u32x4*)(XC + t * 272 + j8 * 16) = o;
        }
    }
    __syncthreads();
    lru_dir<PASS, 0>(XC, RN, P, b, cp, n, w, col, g4);
    lru_dir<PASS, 1>(XC, RN, P, b, cp, n, w, col, g4);
    if (PASS == 1) {
        __syncthreads();
        const int j8 = tid & 15, ch0 = 128 * n + 8 * j8;
#pragma unroll 4
        for (int i = 0; i < 8; ++i) { const int t = (tid >> 4) + 32 * i; float rv[8], gv[8];
            unpack8(*(const LAS u32x4*)(RN + t * 272 + j8 * 16), rv); const bf16* gp_in = grp + (size_t)(t0 + t) * ZLD + C_GR + ch0; unpack8(*(const u32x4*)gp_in, gv); bf16* gp = gout + (size_t)(t0 + t) * D + ch0;
            for (int j = 0; j < 8; ++j) gv[j] = gelu_tanh(gv[j]);
            u32x4 o; o.x = pk2(rv[0] * gv[0], rv[1] * gv[1]); o.y = pk2(rv[2] * gv[2], rv[3] * gv[3]); o.z = pk2(rv[4] * gv[4], rv[5] * gv[5]); o.w = pk2(rv[6] * gv[6], rv[7] * gv[7]);
            *(u32x4*)gp = o; }
    }
}

__device__ __forceinline__ void kv_unit(LAS unsigned char* lds, const bf16* ksrc, const bf16* vsrc, int ld, float l2g, bf16* out) {
    const int tid = opaque_tid(), lane = tid & 63, w = __builtin_amdgcn_readfirstlane(tid >> 6);
    LAS unsigned char* KF = lds; LAS unsigned char* KB = lds + 32768; LAS unsigned char* VI = lds + 65536;
    __syncthreads();
#pragma unroll
    for (int i = 0; i < 4; ++i) { const int idx = tid + 512 * i, j = idx >> 4, chn = idx & 15; float kv[8]; unpack8(*(const u32x4*)(ksrc + (size_t)j * ld + 8 * chn), kv);
        const float wf = exp2f(l2g * (float)(127 - j)), wb = exp2f(l2g * (float)j);
        u32x4 of, ob; of.x = pk2(kv[0] * wf, kv[1] * wf); of.y = pk2(kv[2] * wf, kv[3] * wf); of.z = pk2(kv[4] * wf, kv[5] * wf); of.w = pk2(kv[6] * wf, kv[7] * wf);
        ob.x = pk2(kv[0] * wb, kv[1] * wb); ob.y = pk2(kv[2] * wb, kv[3] * wb); ob.z = pk2(kv[4] * wb, kv[5] * wb); ob.w = pk2(kv[6] * wb, kv[7] * wb);
        *(LAS u32x4*)(KF + offb(j, chn)) = of; *(LAS u32x4*)(KB + offb(j, chn)) = ob; }
#pragma unroll
    for (int i = 0; i < 8; ++i) { const int idx = tid + 512 * i, j = idx >> 5, chn = idx & 31;
        *(LAS u32x4*)(VI + (chn >> 4) * 32768 + offb(j, chn & 15)) = *(const u32x4*)(vsrc + (size_t)j * ld + 8 * chn); }
    __syncthreads();
    const int h = lane >> 5, blk = (lane >> 4) & 1, q = (lane & 15) >> 2, p = lane & 3;
    f32x16 accF[4], accB[4];
#pragma unroll
    for (int dt = 0; dt < 4; ++dt)
#pragma unroll
        for (int r = 0; r < 16; ++r) { accF[dt][r] = 0.f; accB[dt][r] = 0.f; }
    const LAS unsigned char* Vimg = VI + (w >> 2) * 32768; const int cv = w & 3;
#pragma unroll 1
    for (int ks = 0; ks < 8; ++ks) {
        const unsigned r0 = 16 * ks + 8 * h + q, r1 = r0 + 4;
        const s16x4 v0 = trd(Vimg + offb(r0, 4 * cv + 2 * blk + (p >> 1)) + 8 * (p & 1)), v1 = trd(Vimg + offb(r1, 4 * cv + 2 * blk + (p >> 1)) + 8 * (p & 1));
        const bf16x8 bv = __builtin_shufflevector(v0, v1, 0, 1, 2, 3, 4, 5, 6, 7);
#pragma unroll
        for (int dt = 0; dt < 4; ++dt) {
            const unsigned o0 = offb(r0, 4 * dt + 2 * blk + (p >> 1)) + 8 * (p & 1), o1 = offb(r1, 4 * dt + 2 * blk + (p >> 1)) + 8 * (p & 1);
            const bf16x8 af = __builtin_shufflevector(trd(KF + o0), trd(KF + o1), 0, 1, 2, 3, 4, 5, 6, 7);
            const bf16x8 ab = __builtin_shufflevector(trd(KB + o0), trd(KB + o1), 0, 1, 2, 3, 4, 5, 6, 7);
            accF[dt] = MFMA32(af, bv, accF[dt]); accB[dt] = MFMA32(ab, bv, accB[dt]);
        }
    }
    __syncthreads();
    { const int v = 32 * w + (lane & 31);
#pragma unroll
      for (int dt = 0; dt < 4; ++dt)
#pragma unroll
        for (int rg = 0; rg < 4; ++rg) { const int d = 32 * dt + 8 * rg + 4 * h;
            u32x2 of, ob; of.x = pk2(accF[dt][4 * rg], accF[dt][4 * rg + 1]); of.y = pk2(accF[dt][4 * rg + 2], accF[dt][4 * rg + 3]);
            ob.x = pk2(accB[dt][4 * rg], accB[dt][4 * rg + 1]); ob.y = pk2(accB[dt][4 * rg + 2], accB[dt][4 * rg + 3]);
            *(LAS u32x2*)(lds + v * 272 + d * 2) = of; *(LAS u32x2*)(lds + 69632 + v * 272 + d * 2) = ob; } }
    __syncthreads();
#pragma unroll
    for (int i = 0; i < 16; ++i) { const int idx = tid + 512 * i, dir = idx >> 12, v = (idx >> 4) & 255, chn = idx & 15;
        *(u32x4*)(out + (size_t)dir * 32768 + v * 128 + 8 * chn) = *(const LAS u32x4*)(lds + dir * 69632 + v * 272 + chn * 16); }
}

__device__ __forceinline__ void xc_rows(const LruP& P, const bf16* xsrc, int ldx, int lgseq  , int nrows, bf16* dst, int gthread, int nthreads) {
    const int c8 = gthread & 127, ch0 = 8 * c8;
    float cw[4][8], cb[8];
#pragma unroll
    for (int k = 0; k < 4; ++k) { const f32x4 a = *(const f32x4*)(P.conv_w + k * 1024 + ch0), c = *(const f32x4*)(P.conv_w + k * 1024 + ch0 + 4);
        cw[k][0] = a[0]; cw[k][1] = a[1]; cw[k][2] = a[2]; cw[k][3] = a[3]; cw[k][4] = c[0]; cw[k][5] = c[1]; cw[k][6] = c[2]; cw[k][7] = c[3]; }
    { const f32x4 a = *(const f32x4*)(P.conv_b + ch0), c = *(const f32x4*)(P.conv_b + ch0 + 4); cb[0] = a[0]; cb[1] = a[1]; cb[2] = a[2]; cb[3] = a[3]; cb[4] = c[0]; cb[5] = c[1]; cb[6] = c[2]; cb[7] = c[3]; }
    const int seqmask = (1 << lgseq) - 1;
    for (int run = gthread >> 7; run < nrows / 16; run += nthreads >> 7) {
        const int row0 = run * 16, t0 = row0 & seqmask;
        u32x4 xw[19];
#pragma unroll
        for (int k = 0; k < 19; ++k) { const int tt = t0 + k - 2; xw[k] = (tt >= 0 && tt <= seqmask) ? *(const u32x4*)(xsrc + (size_t)(row0 + k - 2) * ldx + ch0) : (u32x4){0u, 0u, 0u, 0u}; }
#pragma unroll
        for (int r = 0; r < 16; ++r) { float a[8];
#pragma unroll
            for (int j = 0; j < 8; ++j) a[j] = cb[j];
#pragma unroll
            for (int k = 0; k < 4; ++k) { float xv[8]; unpack8(xw[r + k], xv);
#pragma unroll
                for (int j = 0; j < 8; ++j) a[j] += cw[k][j] * xv[j]; }
            u32x4 o; o.x = pk2(a[0], a[1]); o.y = pk2(a[2], a[3]); o.z = pk2(a[4], a[5]); o.w = pk2(a[6], a[7]);
            *(u32x4*)(dst + (size_t)(row0 + r) * 1024 + ch0) = o; }
    }
}
template <int dir>
__device__ __forceinline__ void lru_sweep(LAS unsigned char* lds, const LruP& P, int n, int sub, const bf16* xcl, const bf16* xcc, bf16* hout) {
    const int tid = opaque_tid(), lane = tid & 63, w = __builtin_amdgcn_readfirstlane(tid >> 6), col = lane & 15, g4 = lane >> 4;
    LAS unsigned char* XC = lds;
    LAS f32x2* AGG = (LAS f32x2*)(lds + 69632);
    LAS unsigned char* OUT = lds + 69632 + 1024;
    const int chl = 16 * sub + col, ch = 128 * n + chl;
    const float bav = P.ba[dir * 1024 + ch], bxv = P.bx[dir * 1024 + ch];
    const float c8 = 8.0f * log1pf(expf(-P.lam[dir * 1024 + ch]));
    bf16x8 Ba[4], Bx[4];
    { const bf16* wa = P.wg + ((size_t)((n * 4 + dir * 2 + 0) * 128 + chl)) * 128 + 8 * g4; const bf16* wx = wa + 128 * 128;
#pragma unroll
      for (int ks = 0; ks < 4; ++ks) { Ba[ks] = *(const bf16x8*)(wa + 32 * ks); Bx[ks] = *(const bf16x8*)(wx + 32 * ks); } }
    u32x4 xq[8];
    auto gload = [&](int s) { const bf16* srcp = s == 0 ? xcc : xcl + (size_t)(dir ? 32 - s : s - 1) * 256 * 1024;
#pragma unroll
        for (int i = 0; i < 8; ++i) { const int it = tid + 512 * i; xq[i] = *(const u32x4*)(srcp + (size_t)(it >> 4) * 1024 + 128 * n + 8 * (it & 15)); } };
    auto lstore = [&]() {
#pragma unroll
        for (int i = 0; i < 8; ++i) { const int it = tid + 512 * i; *(LAS u32x4*)(XC + (it >> 4) * 272 + (it & 15) * 16) = xq[i]; } };
    float hchunk = 0.f;
    __syncthreads();
    gload(0); lstore();
#pragma unroll 1
    for (int s = 0; s < 33; ++s) {
        __syncthreads();
        if (s + 1 < 33) gload(s + 1);
        if (s >= 2) { const int cprev = dir ? 33 - s : s - 2; __builtin_nontemporal_store(*(const LAS u32x4*)(OUT + tid * 16), (u32x4*)(hout + (size_t)cprev * 4096 + tid * 8)); }
        float av[2][4], uv[2][4], Ag[2][4], Ug[2][4], Am[2], Um[2];
        bf16x8 afr[2][4]; unsigned short xcr[2][4];
#pragma unroll
        for (int q2 = 0; q2 < 2; ++q2) { const int m = dir ? 2 * w + 1 - q2 : 2 * w + q2; const LAS unsigned char* xrow = XC + (16 * m + col) * 272 + 16 * g4;
#pragma unroll
            for (int ks = 0; ks < 4; ++ks) afr[q2][ks] = *(const LAS bf16x8*)(xrow + 64 * ks);
#pragma unroll
            for (int r = 0; r < 4; ++r) xcr[q2][r] = *(const LAS unsigned short*)(XC + (16 * m + 4 * g4 + r) * 272 + chl * 2); }
        __builtin_amdgcn_sched_barrier(0);
#pragma unroll
        for (int q2 = 0; q2 < 2; ++q2) {
            const int m = dir ? 2 * w + 1 - q2 : 2 * w + q2; (void)m;
            f32x4 ar = {0.f, 0.f, 0.f, 0.f}, ai = {0.f, 0.f, 0.f, 0.f};
#pragma unroll
            for (int ks = 0; ks < 4; ++ks) { ar = MFMA16(afr[q2][ks], Ba[ks], ar); ai = MFMA16(afr[q2][ks], Bx[ks], ai); }
#pragma unroll
            for (int r = 0; r < 4; ++r) { const float xc = bf2f(xcr[q2][r]);
                const float er = __expf(fminf(-(ar[r] + bav), 40.f)) + 1.0f, ei = __expf(fminf(-(ai[r] + bxv), 40.f)) + 1.0f; const float inv = __builtin_amdgcn_rcpf(er * ei);
                const float rg = inv * ei, ig = inv * er; const float a = __expf(-c8 * rg);
                av[q2][r] = a; uv[q2][r] = __builtin_amdgcn_sqrtf(fmaxf(1.0f - a * a, 0.f)) * ig * xc; }
            float Al = 1.f, Ul = 0.f;
#pragma unroll
            for (int rr = 0; rr < 4; ++rr) { const int r = dir ? 3 - rr : rr; Ul = av[q2][r] * Ul + uv[q2][r]; Al = av[q2][r] * Al; }
            float am = 1.f, um = 0.f;
#pragma unroll
            for (int gq = 0; gq < 4; ++gq) { Ag[q2][gq] = __shfl(Al, col + 16 * gq); Ug[q2][gq] = __shfl(Ul, col + 16 * gq); }
#pragma unroll
            for (int gi = 0; gi < 4; ++gi) { const int gq = dir ? 3 - gi : gi; um = Ag[q2][gq] * um + Ug[q2][gq]; am = Ag[q2][gq] * am; }
            Am[q2] = am; Um[q2] = um;
        }
        if (g4 == 0) AGG[w * 16 + col] = (f32x2){Am[0] * Am[1], Am[1] * Um[0] + Um[1]};
        __syncthreads();
        float h = hchunk, hin = hchunk;
#pragma unroll
        for (int wi = 0; wi < 8; ++wi) { const int ww = dir ? 7 - wi : wi; const f32x2 au = AGG[ww * 16 + col]; if (ww == w) hin = h; h = au.x * h + au.y; }
        hchunk = h;
        float hrun = hin;
#pragma unroll
        for (int q2 = 0; q2 < 2; ++q2) {
            const int m = dir ? 2 * w + 1 - q2 : 2 * w + q2;
            float hg = hrun, hmy = hrun;
#pragma unroll
            for (int gi = 0; gi < 4; ++gi) { const int gq = dir ? 3 - gi : gi; if (gq == g4) hmy = hg; hg = Ag[q2][gq] * hg + Ug[q2][gq]; }
            hrun = hg;
            float hh = hmy;
#pragma unroll
            for (int rr = 0; rr < 4; ++rr) { const int r = dir ? 3 - rr : rr; hh = av[q2][r] * hh + uv[q2][r];
                *(LAS unsigned short*)(OUT + (16 * m + 4 * g4 + r) * 32 + col * 2) = (unsigned short)f2bf(hh); }
        }
        if (s + 1 < 33) lstore();
    }
    __syncthreads();
    { const int cprev = dir ? 0 : 31; __builtin_nontemporal_store(*(const LAS u32x4*)(OUT + tid * 16), (u32x4*)(hout + (size_t)cprev * 4096 + tid * 8)); }
}
__device__ __forceinline__ void lru_combine(const bf16* hf, const bf16* hb  , int c, const bf16* grp  , bf16* ar  , int tid) {
    u32x4 qa[8], qb[8], qg[8];
#pragma unroll
    for (int i = 0; i < 8; ++i) { const int it = tid + 512 * i, t = it >> 4, j8 = it & 15; const size_t ho = (size_t)(j8 >> 1) * (32 * 4096) + (size_t)c * 4096 + t * 16 + (j8 & 1) * 8;
        qa[i] = __builtin_nontemporal_load((const u32x4*)(hf + ho)); qb[i] = __builtin_nontemporal_load((const u32x4*)(hb + ho)); qg[i] = *(const u32x4*)(grp + (size_t)t * ZLD + 8 * j8); }
#pragma unroll
    for (int i = 0; i < 8; ++i) { const int it = tid + 512 * i, t = it >> 4, j8 = it & 15;
        float a[8], b[8], g[8]; unpack8(qa[i], a); unpack8(qb[i], b); unpack8(qg[i], g);
        u32x4 o; o.x = pk2((a[0] + b[0]) * gelu_tanh(g[0]), (a[1] + b[1]) * gelu_tanh(g[1])); o.y = pk2((a[2] + b[2]) * gelu_tanh(g[2]), (a[3] + b[3]) * gelu_tanh(g[3]));
        o.z = pk2((a[4] + b[4]) * gelu_tanh(g[4]), (a[5] + b[5]) * gelu_tanh(g[5])); o.w = pk2((a[6] + b[6]) * gelu_tanh(g[6]), (a[7] + b[7]) * gelu_tanh(g[7]));
        *(u32x4*)(ar + (size_t)t * 3072 + 8 * j8) = o; }
}

__device__ __forceinline__ void kvs_unit(LAS unsigned char* lds, const bf16* kctx, const bf16* vctx, const bf16* klat, const bf16* vlat, int dir, int part, float lg, bf16* st) {
    const int tid = opaque_tid(), lane = tid & 63, w = __builtin_amdgcn_readfirstlane(tid >> 6);
    const float l2g = lg * 1.4426950408889634f, cdec = __expf(128.0f * lg);
    const int h = lane >> 5, blk = (lane >> 4) & 1, q = (lane & 15) >> 2, p = lane & 3;
    const float wv_ = exp2f(l2g * (float)(dir ? (tid >> 2) : 127 - (tid >> 2)));
    f32x16 acc;
#pragma unroll
    for (int r = 0; r < 16; ++r) acc[r] = 0.f;
    u32x4 kq[4][4], vq[4];
    LAS unsigned char* SX = lds + 131072;
    auto src = [&](int s, const bf16*& kp, const bf16*& vp, int& ld) {
        if (s < 2) { const int cc = dir ? 1 - s : s; kp = kctx + (size_t)cc * 128 * ZC_LD; vp = vctx + (size_t)cc * 128 * ZC_LD; ld = ZC_LD; }
        else { const int c = dir ? 65 - s : s - 2; kp = klat + (size_t)c * 128 * ZLD; vp = vlat + (size_t)c * 128 * ZLD; ld = ZLD; } };
    auto gload = [&](int s, u32x4 (&kk)[4], u32x4& vv) { const bf16* kp; const bf16* vp; int ld; src(s, kp, vp, ld);
#pragma unroll
        for (int i = 0; i < 4; ++i) { const int idx = tid + 512 * i, j = idx >> 4, chn = idx & 15; kk[i] = *(const u32x4*)(kp + (size_t)j * ld + 8 * chn); }
        vv = *(const u32x4*)(vp + (size_t)(tid >> 2) * ld + 32 * part + 8 * (tid & 3)); };
    auto lstore = [&](int buf, const u32x4 (&kk)[4], const u32x4& vv) { LAS unsigned char* KB = lds + buf * 65536; LAS unsigned char* VB = KB + 32768;
#pragma unroll
        for (int i = 0; i < 4; ++i) { const int idx = tid + 512 * i, j = idx >> 4, chn = idx & 15; *(LAS u32x4*)(KB + offb(j, chn)) = kk[i]; }
        { float vf[8]; unpack8(vv, vf); u32x4 o; o.x = pk2(vf[0] * wv_, vf[1] * wv_); o.y = pk2(vf[2] * wv_, vf[3] * wv_); o.z = pk2(vf[4] * wv_, vf[5] * wv_); o.w = pk2(vf[6] * wv_, vf[7] * wv_);
          *(LAS u32x4*)(VB + offb(tid >> 2, tid & 3)) = o; } };
    auto copyout = [&](int sprev) { const int c = dir ? 65 - sprev : sprev - 2;
        const u32x4 o = *(const LAS u32x4*)(SX + (sprev & 1) * 8704 + (tid >> 4) * 272 + (tid & 15) * 16);
        __builtin_nontemporal_store(o, (u32x4*)(st + (size_t)(c * 2 + dir) * 32768 + (size_t)(32 * part) * 128 + tid * 8)); };
    auto step = [&](int s, auto SETC, auto LOADC, auto STAGEC, auto COPYC) {
        constexpr int sp = decltype(SETC)::value;
        if constexpr (decltype(LOADC)::value) gload(s + 3, kq[(sp + 3) & 3], vq[(sp + 3) & 3]);
        if constexpr (decltype(COPYC)::value) copyout(s - 1);
        if (w < 4) {
            if constexpr (decltype(STAGEC)::value) { LAS unsigned char* sx = SX + (s & 1) * 8704 + (lane & 31) * 272 + (32 * w + 4 * h) * 2;
#pragma unroll
                for (int rg = 0; rg < 4; ++rg) { u32x2 o; o.x = pk2(acc[4 * rg], acc[4 * rg + 1]); o.y = pk2(acc[4 * rg + 2], acc[4 * rg + 3]); *(LAS u32x2*)(sx + 16 * rg) = o; } }
#pragma unroll
            for (int r = 0; r < 16; ++r) acc[r] *= cdec;
            const LAS unsigned char* KB = lds + (s & 1) * 65536; const LAS unsigned char* VB = KB + 32768;
#pragma unroll
            for (int kh = 0; kh < 2; ++kh) { bf16x8 bvv[4], akk[4];
#pragma unroll
                for (int k4 = 0; k4 < 4; ++k4) { const int ks = 4 * kh + k4; const unsigned r0 = 16 * ks + 8 * h + q, r1 = r0 + 4;
                    bvv[k4] = __builtin_shufflevector(trd(VB + offb(r0, 2 * blk + (p >> 1)) + 8 * (p & 1)), trd(VB + offb(r1, 2 * blk + (p >> 1)) + 8 * (p & 1)), 0, 1, 2, 3, 4, 5, 6, 7);
                    akk[k4] = __builtin_shufflevector(trd(KB + offb(r0, 4 * w + 2 * blk + (p >> 1)) + 8 * (p & 1)), trd(KB + offb(r1, 4 * w + 2 * blk + (p >> 1)) + 8 * (p & 1)), 0, 1, 2, 3, 4, 5, 6, 7); }
                __builtin_amdgcn_sched_barrier(0);
#pragma unroll
                for (int k4 = 0; k4 < 4; ++k4) acc = MFMA32(akk[k4], bvv[k4], acc);
                __builtin_amdgcn_sched_barrier(0); }
        }
        if (s + 1 < 66) lstore((s + 1) & 1, kq[(sp + 1) & 3], vq[(sp + 1) & 3]);
        __syncthreads();
    };
    using std::integral_constant; typedef integral_constant<bool, true> T_; typedef integral_constant<bool, false> F_;
    __syncthreads();
    gload(0, kq[0], vq[0]); gload(1, kq[1], vq[1]); gload(2, kq[2], vq[2]); lstore(0, kq[0], vq[0]);
    __syncthreads();
    step(0, integral_constant<int, 0>{}, T_{}, F_{}, F_{});
    step(1, integral_constant<int, 1>{}, T_{}, F_{}, F_{});
    step(2, integral_constant<int, 2>{}, T_{}, T_{}, F_{});
#pragma unroll 1
    for (int s4 = 3; s4 < 63; s4 += 4) {
        step(s4 + 0, integral_constant<int, 3>{}, T_{}, T_{}, T_{});
        step(s4 + 1, integral_constant<int, 0>{}, T_{}, T_{}, T_{});
        step(s4 + 2, integral_constant<int, 1>{}, T_{}, T_{}, T_{});
        step(s4 + 3, integral_constant<int, 2>{}, T_{}, T_{}, T_{});
    }
    step(63, integral_constant<int, 3>{}, F_{}, T_{}, T_{});
    step(64, integral_constant<int, 0>{}, F_{}, T_{}, T_{});
    step(65, integral_constant<int, 1>{}, F_{}, T_{}, T_{});
    copyout(65);
}

struct RoSrc { const bf16* q; const bf16* k; const bf16* v; const bf16* gs; bf16* out; const bf16* Sf; const bf16* Sb; float l2g; };
__device__ __forceinline__ void ro_issue(const RoSrc& s, u32x4 (&sf)[8], u32x4 (&sb)[8], bf16x8 (&qf)[8]) {
    const int tid = opaque_tid(), lane = tid & 63, w = __builtin_amdgcn_readfirstlane(tid >> 6), wi = w & 3, h = lane >> 5, l31 = lane & 31;
#pragma unroll
    for (int i = 0; i < 8; ++i) { const int idx = tid + 512 * i; sf[i] = __builtin_nontemporal_load((const u32x4*)(s.Sf + (size_t)idx * 8)); sb[i] = __builtin_nontemporal_load((const u32x4*)(s.Sb + (size_t)idx * 8)); }
#pragma unroll
    for (int t = 0; t < 8; ++t) qf[t] = *(const bf16x8*)(s.q + (size_t)(32 * wi + l31) * ZLD + 16 * t + 8 * h);
}
__device__ __forceinline__ void ro_unit(LAS unsigned char* lds, const RoSrc& cur, u32x4 (&sf)[8], u32x4 (&sb)[8], bf16x8 (&qf)[8], bool has_next, const RoSrc& nxt) {
    const int tid = opaque_tid(), lane = tid & 63, w = __builtin_amdgcn_readfirstlane(tid >> 6), wi = w & 3, wv = w >> 2;
    LAS unsigned char* SF = lds; LAS unsigned char* SB = lds + 65536;
    LAS unsigned char* KI = lds; LAS unsigned char* VI = lds + 32768; LAS float* STATS = (LAS float*)(lds + 135168);
    const int h = lane >> 5, l31 = lane & 31, blk = (lane >> 4) & 1, q = (lane & 15) >> 2, p = lane & 3;
    const bf16* gsp = cur.gs; bf16* gout = cur.out; const float l2g = cur.l2g; constexpr int skip = 0;
    __syncthreads();
    u32x4 kreg[4], vreg[8];
#pragma unroll
    for (int i = 0; i < 4; ++i) { const int idx = tid + 512 * i, j = idx >> 4, chn = idx & 15; kreg[i] = __builtin_nontemporal_load((const u32x4*)(cur.k + (size_t)j * ZLD + 8 * chn)); }
#pragma unroll
    for (int i = 0; i < 8; ++i) { const int idx = tid + 512 * i, j = idx >> 5, chn = idx & 31; vreg[i] = __builtin_nontemporal_load((const u32x4*)(cur.v + (size_t)j * ZLD + 8 * chn)); }
#pragma unroll
    for (int i = 0; i < 8; ++i) { const int idx = tid + 512 * i, v = idx >> 4, chn = idx & 15; *(LAS u32x4*)(SF + offb(v, chn)) = sf[i]; *(LAS u32x4*)(SB + offb(v, chn)) = sb[i]; }
    __syncthreads();
    f32x16 z[4];
#pragma unroll
    for (int c = 0; c < 4; ++c)
#pragma unroll
        for (int r = 0; r < 16; ++r) z[c][r] = 0.f;
    if (!(skip & 1)) {
#pragma unroll
    for (int s = 0; s < 8; ++s)
#pragma unroll
        for (int c = 0; c < 4; ++c) { const bf16x8 bs = *(const LAS bf16x8*)(SF + offb(128 * wv + 32 * c + l31, 2 * s + h)); z[c] = MFMA32(qf[s], bs, z[c]); }
#pragma unroll
    for (int r = 0; r < 16; ++r) { const int i = 32 * wi + crow(r, h); const float f = __builtin_amdgcn_exp2f(l2g * (float)(2 * i - 127));
#pragma unroll
        for (int c = 0; c < 4; ++c) z[c][r] *= f; }
#pragma unroll
    for (int s = 0; s < 8; ++s)
#pragma unroll
        for (int c = 0; c < 4; ++c) { const bf16x8 bs = *(const LAS bf16x8*)(SB + offb(128 * wv + 32 * c + l31, 2 * s + h)); z[c] = MFMA32(qf[s], bs, z[c]); }
#pragma unroll
    for (int r = 0; r < 16; ++r) { const int i = 32 * wi + crow(r, h); const float f = __builtin_amdgcn_exp2f(l2g * (float)(128 - i));
#pragma unroll
        for (int c = 0; c < 4; ++c) z[c][r] *= f; }
    }
    __syncthreads();
#pragma unroll
    for (int i = 0; i < 4; ++i) { const int idx = tid + 512 * i, j = idx >> 4, chn = idx & 15; *(LAS u32x4*)(KI + offb(j, chn)) = kreg[i]; }
#pragma unroll
    for (int i = 0; i < 8; ++i) { const int idx = tid + 512 * i, j = idx >> 5, chn = idx & 31; *(LAS u32x4*)(VI + (chn >> 4) * 32768 + offb(j, chn & 15)) = vreg[i]; }
    __syncthreads();
    const LAS unsigned char* Vimg = VI + wv * 32768;
    u32x4 gsq[8];
#pragma unroll
    for (int i = 0; i < 8; ++i) { const int idx = tid + 512 * i, r = idx >> 5, chn = idx & 31; gsq[i] = __builtin_nontemporal_load((const u32x4*)(gsp + (size_t)r * ZLD + 8 * chn)); }
    if (!(skip & 2))
#pragma unroll
    for (int jt = 0; jt < 4; ++jt) {
        f32x16 x;
#pragma unroll
        for (int r = 0; r < 16; ++r) x[r] = 0.f;
#pragma unroll
        for (int s = 0; s < 8; ++s) { const bf16x8 ak = *(const LAS bf16x8*)(KI + offb(32 * jt + l31, 2 * s + h)); x = MFMA32(ak, qf[s], x); }
        const int ii = 32 * wi + l31;
#pragma unroll
        for (int r = 0; r < 16; ++r) { const int jj = 32 * jt + crow(r, h); const int dd = ii > jj ? ii - jj : jj - ii; x[r] *= __builtin_amdgcn_exp2f(l2g * (float)dd); }
#pragma unroll
        for (int s2 = 0; s2 < 2; ++s2) {
            u32x4 pw; pw.x = pk2(x[8 * s2], x[8 * s2 + 1]); pw.y = pk2(x[8 * s2 + 2], x[8 * s2 + 3]); pw.z = pk2(x[8 * s2 + 4], x[8 * s2 + 5]); pw.w = pk2(x[8 * s2 + 6], x[8 * s2 + 7]);
            const bf16x8 xs = __builtin_bit_cast(bf16x8, pw);
            const unsigned r0 = 32 * jt + 16 * s2 + 4 * h + q, r1 = r0 + 8;
#pragma unroll
            for (int c = 0; c < 4; ++c) {
                const s16x4 v0 = trd(Vimg + offb(r0, 4 * c + 2 * blk + (p >> 1)) + 8 * (p & 1)), v1 = trd(Vimg + offb(r1, 4 * c + 2 * blk + (p >> 1)) + 8 * (p & 1));
                const bf16x8 pb = __builtin_shufflevector(v0, v1, 0, 1, 2, 3, 4, 5, 6, 7);
                z[c] = MFMA32(xs, pb, z[c]);
            }
        }
#pragma unroll
        for (int i2 = 0; i2 < 2; ++i2) { const int i = 2 * jt + i2; float gv[8]; unpack8(gsq[i], gv);
#pragma unroll
            for (int j = 0; j < 8; ++j) gv[j] = gv[j] * sigmoidf_(gv[j]);
            gsq[i].x = pk2(gv[0], gv[1]); gsq[i].y = pk2(gv[2], gv[3]); gsq[i].z = pk2(gv[4], gv[5]); gsq[i].w = pk2(gv[6], gv[7]); }
    }
#pragma unroll
    for (int r = 0; r < 16; ++r) { float s1 = (z[0][r] + z[1][r]) + (z[2][r] + z[3][r]); float s2 = (z[0][r] * z[0][r] + z[1][r] * z[1][r]) + (z[2][r] * z[2][r] + z[3][r] * z[3][r]);
        s1 = row16_sum(s1); s2 = row16_sum(s2);
        { const float a0 = lane_f(s1, 0) + lane_f(s1, 16), a1 = lane_f(s1, 32) + lane_f(s1, 48), b0 = lane_f(s2, 0) + lane_f(s2, 16), b1 = lane_f(s2, 32) + lane_f(s2, 48); s1 = h ? a1 : a0; s2 = h ? b1 : b0; }
        if (l31 == 0) { STATS[((wi * 2 + wv) * 32 + crow(r, h)) * 2] = s1; STATS[((wi * 2 + wv) * 32 + crow(r, h)) * 2 + 1] = s2; } }
    __syncthreads();
#pragma unroll
    for (int r = 0; r < 16; ++r) { const int il = crow(r, h);
        const float s1 = STATS[((wi * 2 + 0) * 32 + il) * 2] + STATS[((wi * 2 + 1) * 32 + il) * 2], s2 = STATS[((wi * 2 + 0) * 32 + il) * 2 + 1] + STATS[((wi * 2 + 1) * 32 + il) * 2 + 1];
        const float mean = s1 * (1.0f / 256.0f); const float var = fmaxf(s2 * (1.0f / 256.0f) - mean * mean, 0.f); const float rstd = __builtin_amdgcn_rsqf(var + EPS);
#pragma unroll
        for (int c = 0; c < 4; ++c) *(LAS unsigned short*)(lds + (32 * wi + il) * 528 + (128 * wv + 32 * c + l31) * 2) = (unsigned short)f2bf((z[c][r] - mean) * rstd); }
    __syncthreads();
    (void)has_next; ro_issue(nxt, sf, sb, qf);
    if (!(skip & 4))
#pragma unroll
    for (int i = 0; i < 8; ++i) { const int idx = tid + 512 * i, r = idx >> 5, chn = idx & 31; float ov[8], gv[8];
        unpack8(*(const LAS u32x4*)(lds + r * 528 + chn * 16), ov); unpack8(gsq[i], gv); bf16* gp = gout + (size_t)r * 3072 + 8 * chn;
        u32x4 o; o.x = pk2(ov[0] * gv[0], ov[1] * gv[1]); o.y = pk2(ov[2] * gv[2], ov[3] * gv[3]); o.z = pk2(ov[4] * gv[4], ov[5] * gv[5]); o.w = pk2(ov[6] * gv[6], ov[7] * gv[7]);
        *(u32x4*)gp = o; asm volatile("" ::: "memory"); }
}

struct Args { const float* in[26]; float* out; unsigned char* ws; int lo, hi; };
enum { I_X = 0, I_C, I_CTX, I_CCTX, I_ADAW, I_ADAB, I_N1G, I_WIN, I_CONVW, I_CONVB, I_WA, I_BA, I_WX, I_BX, I_LAM, I_WRNN, I_WRET, I_WOUT, I_N2G, I_RW, I_RB, I_W1, I_B1, I_W2, I_B2, I_FG };
constexpr int ST_GRP = 3, ST_M0 = 27, ST_M1 = 28, ST_RNG = 29, ST_END = ST_RNG + 3 * NRANGE;

__global__ void __launch_bounds__(NTHR, 2) fwd_kernel(Args args) {
    extern __shared__ __attribute__((aligned(16))) unsigned char lds_raw[];
    LAS unsigned char* lds = (LAS unsigned char*)lds_raw;
    const int tid = threadIdx.x, lane = tid & 63, wave = __builtin_amdgcn_readfirstlane(tid >> 6);
    const int G = gridDim.x, bid = blockIdx.x;
    const int gw = bid * NWAVES + wave, NGW = G * NWAVES;
    unsigned char* ws = args.ws;
    volatile LAS unsigned* MISC = (volatile LAS unsigned*)(lds + MISC_OFF);
    if (tid < 64) MISC[tid] = 0u;
    __syncthreads();
    const int lo = args.lo, hi = args.hi;
    XcdBarrier bar; bar.bar = (unsigned*)(ws + WS_CTL) + CW_BAR; bar.x = 0; bar.st = nullptr;
    if (!MK_PER_PHASE) bar = xcd_barrier_post((unsigned*)(ws + WS_CTL) + CW_BAR, MISC);
#define IN(k) (lo <= (k) && (k) < hi)
#define SEAM(k) do { if (IN(k) && IN((k) + 1)) xcd_barrier(bar); } while (0)
#if MK_PROBE
    unsigned long long t_last = wall_clock64();
#define STAMP(kind) do { if (bid == 0 && threadIdx.x == 0) { const unsigned long long t_ = wall_clock64(); MISC[16 + (kind)] += (unsigned)(t_ - t_last); t_last = t_; } } while (0)
#else
#define STAMP(kind) do { } while (0)
#endif

    float* mod = (float*)(ws + WS_MOD);
    f32x2* rope = (f32x2*)(ws + WS_ROPE);
    f32x2* carry = (f32x2*)(ws + WS_CARRY); bf16* RWB = (bf16*)(ws + WS_RWB);
    bf16* WG = (bf16*)(ws + WS_WG); bf16* WRNN = (bf16*)(ws + WS_WRNN); bf16* WOUT = (bf16*)(ws + WS_WOUT); bf16* WRET = WRNN + 1024; bf16* WIN = (bf16*)(ws + WS_WIN);
    bf16* HL = (bf16*)(ws + WS_HL); bf16* ZC = (bf16*)(ws + WS_ZC); bf16* CTXU = (bf16*)(ws + WS_CTXU); bf16* Z = (bf16*)(ws + WS_Z); bf16* STB = (bf16*)(ws + WS_ST);
    bf16* T1 = (bf16*)(ws + WS_T1); bf16* MG = (bf16*)(ws + WS_MG);
    bf16* W1T = (bf16*)(ws + WS_W1T); bf16* W2T = (bf16*)(ws + WS_W2T); bf16* HPAD = (bf16*)(ws + WS_HPAD); bf16* HID = (bf16*)(ws + WS_HID); bf16* YPAD = (bf16*)(ws + WS_YPAD);
    float* WRNNS = (float*)(ws + WS_WFS); float* WRETS = WRNNS + 1024; float* WOUTS = WRNNS + 2048; float* W2S = WRNNS + 4096;
    bf16* AR = (bf16*)(ws + WS_AR); bf16* AT = (bf16*)(ws + WS_AT);
    bf16* XCB = T1; bf16* XCC = CTXU;
    bf16* HDF = MG; bf16* HDB = (bf16*)(ws + 880 * MiB);
    float* HLS = (float*)(ws + WS_HLS); float* WINS = (float*)(ws + WS_WINS); float* W1S = (float*)(ws + WS_W1S); float* HPS = (float*)(ws + WS_HPS);
    int* ROWTOK = (int*)(ws + WS_HPAD);
    int* EIDX = (int*)(ws + WS_EIDX); float* GATE = (float*)(ws + WS_GATE); int* LPOS = (int*)(ws + WS_LPOS); int* AROW = (int*)(ws + WS_AROW);
    int* BCNT = (int*)(ws + WS_BCNT); int* BBASE = (int*)(ws + WS_BBASE); int* TILEE = (int*)(ws + WS_TILEE); int* NTILE = (int*)(ws + WS_NTILE);

    if (PH_EN(0) && IN(0)) for (int rep = 0; rep < DUP_N(0); ++rep) {
        const int tid = opaque_tid(), lane = tid & 63, wave = __builtin_amdgcn_readfirstlane(tid >> 6), gw = bid * NWAVES + wave; (void)lane; (void)gw; (void)rep;
        if (bid < 96) {
            LAS float* sc = (LAS float*)lds;
            LAS float* red = (LAS float*)(lds + 40960);
            for (int i = tid; i < 9 * 1024; i += NTHR) { const int r = i >> 10, k = i & 1023; const float v = r < 8 ? args.in[I_C][r * 1024 + k] : args.in[I_CCTX][k]; sc[i] = v * sigmoidf_(v); }
            __syncthreads();
            const int n0 = bid * 64; float a9[9];
#pragma unroll
            for (int r = 0; r < 9; ++r) a9[r] = 0.f;
            for (int k = wave * 128; k < wave * 128 + 128; ++k) { const float wv = args.in[I_ADAW][(size_t)k * 6144 + n0 + lane];
#pragma unroll
                for (int r = 0; r < 9; ++r) a9[r] += sc[r * 1024 + k] * wv; }
#pragma unroll
            for (int r = 0; r < 9; ++r) red[(wave * 9 + r) * 64 + lane] = a9[r];
            __syncthreads();
            for (int i = tid; i < 9 * 64; i += NTHR) { const int r = i >> 6, l = i & 63; float s = 0.f;
#pragma unroll
                for (int w8 = 0; w8 < 8; ++w8) s += red[(w8 * 9 + r) * 64 + l];
                mod[r * 6144 + n0 + l] = s + args.in[I_ADAB][n0 + l]; }
            __syncthreads();
        }
        if (bid == 97 % G) {
            for (int i = tid; i < 32 * 1024; i += NTHR) { const int d = i >> 5, e = i & 31; const float wv = args.in[I_RW][i]; const unsigned hi = f2bf(wv); const float rem = wv - bf2f((unsigned short)hi);
                RWB[e * 1024 + d] = (bf16)hi; RWB[32 * 1024 + e * 1024 + d] = (bf16)f2bf(rem); }
        }
        if (bid == 96) {
            for (int i = tid; i < 128 * 32; i += NTHR) { const int pos = i >> 5, f = i & 31; const float inv = powf(10000.0f, -(float)f / 32.0f); const float ang = (float)pos * inv; float s, c; sincosf(ang, &s, &c); rope[i] = (f32x2){c, s}; }
        }
        {
            LAS float* L = (LAS float*)(lds + 65536); LAS unsigned* CM = (LAS unsigned*)(lds + 65536 + 66048); LAS unsigned* TL = (LAS unsigned*)lds;
            const int NS0 = G > 128 ? 720 : 848;
            for (int it = bid; it < NS0; it += G) {
                if (it < 80) tr_strip_i8<false>(args.in[I_WIN] + it * 128, DIN, 1024, (signed char*)WIN + (size_t)it * 128 * 1024, 1024, WINS + it * 128, tid, TL, CM);
                else if (it < 592) { const int s = it - 80, e = s >> 4, nt = s & 15; tr_strip_i8<false>(args.in[I_W1] + (size_t)e * 1024 * 2048 + nt * 128, 2048, 1024, (signed char*)W1T + ((size_t)e * 2048 + nt * 128) * 1024, 1024, W1S + e * 2048 + nt * 128, tid, TL, CM); }
                else { const int s = it - 592, e = s >> 3, nt = s & 7; tr_strip_i8<true>(args.in[I_W2] + (size_t)e * 1024 * 1024 + nt * 128, 1024, 1024, (signed char*)W2T + ((size_t)e * 1024 + nt * 128) * 1024, 1024, W2S + e * 1024 + nt * 128, tid, TL, CM); }
            }
            constexpr int NT_ALL = 64 + 128 + 64 + 32;
            auto desc = [&](int it) -> TrTile { TrTile t;
                if (it < 64) { const int kt = it >> 3, nt = it & 7; t.src = args.in[I_WRNN] + (size_t)kt * 128 * 1024 + nt * 128; t.ldw = 1024; t.dst = WRNN + (size_t)nt * 128 * 3072 + kt * 128; t.ldt = 3072; return t; }
                it -= 64;
                if (it < 128) { const int kt = it >> 3, nt = it & 7; t.src = args.in[I_WRET] + (size_t)kt * 128 * 1024 + nt * 128; t.ldw = 1024; t.dst = WRET + (size_t)nt * 128 * 3072 + kt * 128; t.ldt = 3072; return t; }
                it -= 128;
                if (it < 64) { const int kt = it >> 3, nt = it & 7; t.src = args.in[I_WOUT] + (size_t)kt * 128 * 1024 + nt * 128; t.ldw = 1024; t.dst = WOUT + (size_t)nt * 128 * 1024 + kt * 128; t.ldt = 1024; return t; }
                it -= 64;
                { const int q = it & 3, n = it >> 2; const int dir = q >> 1, typ = q & 1;
                  t.src = (typ ? args.in[I_WX] : args.in[I_WA]) + (size_t)(dir * 8 + n) * 128 * 128; t.ldw = 128; t.dst = WG + (size_t)(n * 4 + q) * 128 * 128; t.ldt = 128; return t; } };
            f32x4 v[8];
            int it = NT_ALL - 1 - ((bid + 32) % G);
            if (it >= 0) { const TrTile t0 = desc(it); tr_load(t0, tid, v); }
            while (it >= 0) {
                const TrTile tc = desc(it); const int nx = it - G;
                f32x4 w[8];
#pragma unroll
                for (int i = 0; i < 8; ++i) w[i] = v[i];
                if (nx >= 0) { const TrTile tn = desc(nx); tr_load(tn, tid, v); }
                tr_store(tc, tid, w, L);
                it = nx;
            }
        }
    }
    SEAM(0); STAMP(0);
    if (PH_EN(1) && IN(1)) for (int rep = 0; rep < DUP_N(1); ++rep) {
        const int tid = opaque_tid(), lane = tid & 63, wave = __builtin_amdgcn_readfirstlane(tid >> 6), gw = bid * NWAVES + wave; (void)lane; (void)gw; (void)rep;
        auto rowsrc = [&](int m) { return (const f32x4*)(m < NTOK ? args.in[I_X] + (size_t)m * D : args.in[I_CTX] + (size_t)(m - NTOK) * D) + lane; };
        f32x4 nx[4];
        if (gw < NROWS_HL) { const f32x4* xr = rowsrc(gw);
#pragma unroll
            for (int j = 0; j < 4; ++j) nx[j] = xr[64 * j]; }
        f32x4 gnv[4], shv[4], scv[4]; int rcur = -1;
#pragma unroll
        for (int j = 0; j < 4; ++j) gnv[j] = *(const f32x4*)(args.in[I_N1G] + 4 * lane + 256 * j);
#pragma unroll 1
        for (int m = gw; m < NROWS_HL; m += NGW) {
            const int r = m < NTOK ? (m >> 13) : 8;
            if (r != rcur) { rcur = r;
#pragma unroll
                for (int j = 0; j < 4; ++j) { shv[j] = *(const f32x4*)(mod + r * 6144 + 4 * lane + 256 * j); scv[j] = *(const f32x4*)(mod + r * 6144 + 1024 + 4 * lane + 256 * j); } }
            f32x4 v[4]; float ss = 0.f;
#pragma unroll
            for (int j = 0; j < 4; ++j) v[j] = nx[j];
            if (m + NGW < NROWS_HL) { const f32x4* xr = rowsrc(m + NGW);
#pragma unroll
                for (int j = 0; j < 4; ++j) nx[j] = xr[64 * j]; }
#pragma unroll
            for (int j = 0; j < 4; ++j) ss += (v[j].x * v[j].x + v[j].y * v[j].y) + (v[j].z * v[j].z + v[j].w * v[j].w);
            const float rstd = 1.0f / sqrtf(wave_sum(ss) * (1.0f / D) + EPS);
            float am = 0.f;
#pragma unroll
            for (int j = 0; j < 4; ++j) { v[j] = (v[j] * rstd * gnv[j]) * (scv[j] + 1.0f) + shv[j]; am = fmaxf(fmaxf(am, fmaxf(fabsf(v[j].x), fabsf(v[j].y))), fmaxf(fabsf(v[j].z), fabsf(v[j].w))); }
            am = wave_max(am); const float inv = am > 0.f ? 127.0f / am : 0.f;
            if (lane == 0) HLS[m] = am > 0.f ? am * (1.0f / 127.0f) : 1.0f;
            unsigned* o4 = (unsigned*)((signed char*)HL + (size_t)m * D) + lane;
#pragma unroll
            for (int j = 0; j < 4; ++j) o4[64 * j] = q8x4(v[j], inv);
        }
    }
    SEAM(1); STAMP(1);
    if (PH_EN(2) && IN(2)) for (int rep = 0; rep < DUP_N(2); ++rep) {
        const int tid = opaque_tid(), lane = tid & 63, wave = __builtin_amdgcn_readfirstlane(tid >> 6), gw = bid * NWAVES + wave; (void)lane; (void)gw; (void)rep;
        pg8::Gemm g{HL, WIN, 512, 512, 512, HLS, WINS, nullptr}; pg8::CtxOrder S{G, bid}; EpiCtx E{ZC};
        pg8::gemm_phase<EpiCtx, pg8::CtxOrder, 1>(lds, g, S, E);
        if (G > 128 && bid >= 128) {
            LAS unsigned* CM = (LAS unsigned*)(lds + 65536 + 66048); LAS unsigned* TL = (LAS unsigned*)lds;
            for (int it = 720 + (bid - 128); it < 848; it += G - 128) { const int s = it - 592, e = s >> 3, nt = s & 7;
                tr_strip_i8<true>(args.in[I_W2] + (size_t)e * 1024 * 1024 + nt * 128, 1024, 1024, (signed char*)W2T + ((size_t)e * 1024 + nt * 128) * 1024, 1024, W2S + e * 1024 + nt * 128, tid, TL, CM); }
        }
    }
    SEAM(2); STAMP(2);
    for (int grp = 0; grp < NGRP; ++grp) {
        const int s0 = ST_GRP + 6 * grp;
        if (PH_EN(3) && IN(s0 + 0)) for (int rep = 0; rep < DUP_N(3); ++rep) {
        const int tid = opaque_tid(), lane = tid & 63, wave = __builtin_amdgcn_readfirstlane(tid >> 6), gw = bid * NWAVES + wave; (void)lane; (void)gw; (void)rep;
            pg8::Gemm g{HL + (size_t)grp * GROWS * 512, WIN, 512, 512, 512, HLS + grp * GROWS, WINS, nullptr}; pg8::StaticOrder S; S.init(GROWS / 256, DIN / 256, G, bid); EpiIn E{Z, rope, DRY(3) ? 1 : 0};
            STAGGER(STAG_B); pg8::gemm_phase<EpiIn, pg8::StaticOrder, 1>(lds, g, S, E);
        }
        SEAM(s0 + 0); STAMP(3);
        if (PH_EN(4) && IN(s0 + 1)) for (int rep = 0; rep < DUP_N(4); ++rep) {
        const int tid = opaque_tid(), lane = tid & 63, wave = __builtin_amdgcn_readfirstlane(tid >> 6), gw = bid * NWAVES + wave; (void)lane; (void)gw; (void)rep;
            for (int u = bid; u < GB * 8 * 2 * 8; u += G) { const int hd = u & 7, y = u >> 3, bl = y >> 4, dir = (y >> 3) & 1, part = y & 7; const int b = grp * GB + bl;
                const float lg = log1pf(-exp2f(-5.0f - (float)hd));
                const bf16* zc = ZC + (size_t)(b * CTXL) * ZC_LD; const bf16* zl = Z + (size_t)(bl * SEQ) * ZLD;
                kvs_unit(lds, zc + ZC_K + hd * 128, zc + ZC_V + hd * 256, zl + C_K + hd * 128, zl + C_V + hd * 256, dir, part, lg, STB + (size_t)((bl * 8 + hd) * 64) * 2 * 32768); }
            LruP LP{args.in[I_CONVW], args.in[I_CONVB], args.in[I_BA], args.in[I_BX], args.in[I_LAM], WG, carry};
            xc_rows(LP, Z + C_XR, ZLD, 13, GROWS, XCB, bid * NTHR + tid, G * NTHR);
            if (grp == 0) xc_rows(LP, ZC + ZC_XR, ZC_LD, 8, NCTX, XCC, bid * NTHR + tid, G * NTHR);
        }
        SEAM(s0 + 1); STAMP(4);
        if (PH_EN(5) && IN(s0 + 2)) for (int rep = 0; rep < DUP_N(5); ++rep) {
        const int tid = opaque_tid(), lane = tid & 63, wave = __builtin_amdgcn_readfirstlane(tid >> 6), gw = bid * NWAVES + wave; (void)lane; (void)gw; (void)rep;
            LruP LP{args.in[I_CONVW], args.in[I_CONVB], args.in[I_BA], args.in[I_BX], args.in[I_LAM], WG, carry};
            for (int u = bid; u < GB * 8 * 8 * 2; u += G) { const int n = u & 7, bl = (u >> 3) & 1, y = u >> 4, dir = y & 1, sub = y >> 1;
                bf16* hb_ = (dir ? HDB : HDF) + (size_t)((bl * 8 + n) * 8 + sub) * (32 * 4096);
                if (dir) lru_sweep<1>(lds, LP, n, sub, XCB + (size_t)(bl * SEQ) * 1024, XCC + (size_t)((grp * GB + bl) * CTXL) * 1024, hb_);
                else lru_sweep<0>(lds, LP, n, sub, XCB + (size_t)(bl * SEQ) * 1024, XCC + (size_t)((grp * GB + bl) * CTXL) * 1024, hb_); }
        }
        SEAM(s0 + 2); STAMP(5);
        if (PH_EN(6) && IN(s0 + 3)) for (int rep = 0; rep < DUP_N(6); ++rep) {
        const int tid = opaque_tid(), lane = tid & 63, wave = __builtin_amdgcn_readfirstlane(tid >> 6), gw = bid * NWAVES + wave; (void)lane; (void)gw; (void)rep;
            const int ncb = (bid >> 3) % 3;
            auto combine_units = [&](int first, int last) {
                if (!(DRY(6) && MK_DRYMODE >= 8)) { int k = 0;
                for (int u = bid; u < GB * 32 * 8; u += G, ++k) { if (k < first || k >= last) continue; const int n = u & 7, c = (u >> 3) & 31, bl = u >> 8; const size_t ub = (size_t)((bl * 8 + n) * 8) * (32 * 4096);
                    lru_combine(HDF + ub, HDB + ub, c, Z + (size_t)(bl * SEQ + c * 256) * ZLD + C_GR + 128 * n, AR + (size_t)(bl * SEQ + c * 256) * 3072 + 128 * n, tid); } } };
            combine_units(0, ncb);
            {   auto mk = [&](int u) -> RoSrc { asm volatile("" : "+s"(u));
                    const int hd = u & 7, c = (u >> 3) & 63, bl = u >> 9; RoSrc s;
                    bf16* zr = Z + (size_t)(bl * SEQ + c * 128) * ZLD; const bf16* sp = STB + (size_t)(((bl * 8 + hd) * 64 + c) * 2) * 32768;
                    s.q = zr + C_Q + hd * 128; s.k = zr + C_K + hd * 128; s.v = zr + C_V + hd * 256; s.gs = zr + C_GS + hd * 256; s.out = AR + (size_t)(bl * SEQ + c * 128) * 3072 + 1024 + hd * 256;
                    s.Sf = sp; s.Sb = sp + 32768; s.l2g = log1pf(-exp2f(-5.0f - (float)hd)) * 1.4426950408889634f; return s; };
                constexpr int NU = GB * 64 * 8; int u = bid;
                if (u < NU) { u32x4 sf[8], sb[8]; bf16x8 qf[8]; RoSrc cur = mk(u); ro_issue(cur, sf, sb, qf);
#pragma unroll 1
                    for (; u < NU; u += G) { const bool hn = u + G < NU; const RoSrc nx = mk(hn ? u + G : u); ro_unit(lds, cur, sf, sb, qf, hn, nx); cur = nx; } } }
            combine_units(ncb, 1 << 30);
        }
        SEAM(s0 + 3); STAMP(6);
        if (PH_EN(7) && IN(s0 + 4)) for (int rep = 0; rep < DUP_N(7); ++rep) {
        const int tid = opaque_tid(), lane = tid & 63, wave = __builtin_amdgcn_readfirstlane(tid >> 6), gw = bid * NWAVES + wave; (void)lane; (void)gw; (void)rep;
            { pg8::Gemm g{AR, WRNN, 3072, 3072, 3072, nullptr, nullptr, nullptr}; pg8::FOrder S; S.so.init(GROWS / 256, 4, G, bid); EpiF E{Z, MG, DRY(7) ? 1 : 0};
              pg8::gemm_phase<EpiF, pg8::FOrder>(lds, g, S, E); }
        }
        SEAM(s0 + 4); STAMP(7);
        if (PH_EN(8) && IN(s0 + 5)) for (int rep = 0; rep < DUP_N(8); ++rep) {
        const int tid = opaque_tid(), lane = tid & 63, wave = __builtin_amdgcn_readfirstlane(tid >> 6), gw = bid * NWAVES + wave; (void)lane; (void)gw; (void)rep;
            pg8::Gemm g{MG, WOUT, D, D, D, nullptr, nullptr, nullptr}; pg8::StaticOrder S; S.init(GROWS / 256, 4, G, bid); EpiX1 E{args.in[I_X], args.out, mod, grp * GROWS};
            pg8::gemm_phase<EpiX1, pg8::StaticOrder>(lds, g, S, E);
        }
        if (grp == NGRP - 1) SEAM(s0 + 5);
        STAMP(8);
    }
    if (PH_EN(9) && IN(ST_M0)) for (int rep = 0; rep < DUP_N(9); ++rep) {
        const int tid = opaque_tid(), lane = tid & 63, wave = __builtin_amdgcn_readfirstlane(tid >> 6), gw = bid * NWAVES + wave; (void)lane; (void)gw; (void)rep;
        LAS unsigned char* AH = lds;
        LAS unsigned char* AL = lds + 66048;
        LAS float* RED = (LAS float*)lds;
        LAS float* LOG = (LAS float*)(lds + 32768);
        LAS int* CNT = (LAS int*)(lds + 132096 + 512);
        const int h5 = lane >> 5, l31 = lane & 31;
        bf16x8 bh[8], bl[8];
#pragma unroll
        for (int s = 0; s < 8; ++s) { bh[s] = *(const bf16x8*)(RWB + (size_t)l31 * 1024 + 128 * wave + 16 * s + 8 * h5); bl[s] = *(const bf16x8*)(RWB + 32 * 1024 + (size_t)l31 * 1024 + 128 * wave + 16 * s + 8 * h5); }
        u32x2 xv[4][4];
        auto ldtile = [&](int blk, int tile) { const int m0 = blk * 256 + tile * 32 + wave * 4;
#pragma unroll
            for (int r4 = 0; r4 < 4; ++r4)
#pragma unroll
                for (int j = 0; j < 4; ++j) xv[r4][j] = __builtin_nontemporal_load((const u32x2*)(args.out + (size_t)(m0 + r4) * D) + lane + 64 * j); };
        const float rb_e = args.in[I_RB][tid & 31];
        for (int blk = bid; blk < NTOK / 256; blk += G) {
            __syncthreads();
            if (tid < 32) CNT[tid] = 0;
            f32x4 gnv[4], shv[4], scv[4];
            { const int bb = (blk * 256) >> 13;
#pragma unroll
              for (int j = 0; j < 4; ++j) { const int c0 = 4 * lane + 256 * j; gnv[j] = *(const f32x4*)(args.in[I_N2G] + c0); shv[j] = *(const f32x4*)(mod + bb * 6144 + 3072 + c0); scv[j] = *(const f32x4*)(mod + bb * 6144 + 4096 + c0); } }
            ldtile(blk, 0);
#pragma unroll 1
            for (int tile = 0; tile < 8; ++tile) {
                __syncthreads();
                const int m0 = blk * 256 + tile * 32 + wave * 4; const int b = m0 >> 13;
#pragma unroll
                for (int r4 = 0; r4 < 4; ++r4) {
                    const int m = m0 + r4; f32x4 v[4]; float ss = 0.f;
#pragma unroll
                    for (int j = 0; j < 4; ++j) { v[j] = (f32x4){bflo(xv[r4][j].x), bfhi(xv[r4][j].x), bflo(xv[r4][j].y), bfhi(xv[r4][j].y)}; ss += (v[j].x * v[j].x + v[j].y * v[j].y) + (v[j].z * v[j].z + v[j].w * v[j].w); }
                    const float rstd = 1.0f / sqrtf(wave_sum(ss) * (1.0f / D) + EPS);
                    float am = 0.f;
#pragma unroll
                    for (int j = 0; j < 4; ++j) { v[j] = (v[j] * rstd * gnv[j]) * (scv[j] + 1.0f) + shv[j]; am = fmaxf(fmaxf(am, fmaxf(fabsf(v[j].x), fabsf(v[j].y))), fmaxf(fabsf(v[j].z), fabsf(v[j].w))); }
                    am = wave_max(am); const float inv = am > 0.f ? 127.0f / am : 0.f;
                    if (lane == 0) HLS[m] = am > 0.f ? am * (1.0f / 127.0f) : 1.0f;
                    unsigned* o4 = (unsigned*)((signed char*)HL + (size_t)m * D) + lane;
                    const int rowl = wave * 4 + r4;
#pragma unroll
                    for (int j = 0; j < 4; ++j) { o4[64 * j] = q8x4(v[j], inv);
                        u32x2 hi; hi.x = pk2(v[j].x, v[j].y); hi.y = pk2(v[j].z, v[j].w);
                        u32x2 lo; lo.x = pk2(v[j].x - bflo(hi.x), v[j].y - bfhi(hi.x)); lo.y = pk2(v[j].z - bflo(hi.y), v[j].w - bfhi(hi.y));
                        *(LAS u32x2*)(AH + rowl * 2064 + (4 * lane + 256 * j) * 2) = hi; *(LAS u32x2*)(AL + rowl * 2064 + (4 * lane + 256 * j) * 2) = lo; }
                }
                if (tile + 1 < 8) ldtile(blk, tile + 1);
                __syncthreads();
                f32x16 acc;
#pragma unroll
                for (int r = 0; r < 16; ++r) acc[r] = 0.f;
#pragma unroll
                for (int s = 0; s < 8; ++s) { const int ko = (128 * wave + 16 * s + 8 * h5) * 2;
                    const bf16x8 ah = *(const LAS bf16x8*)(AH + l31 * 2064 + ko), al = *(const LAS bf16x8*)(AL + l31 * 2064 + ko);
                    acc = MFMA32(ah, bh[s], acc); acc = MFMA32(ah, bl[s], acc); acc = MFMA32(al, bh[s], acc); }
                __syncthreads();
#pragma unroll
                for (int r = 0; r < 16; ++r) RED[(wave * 32 + crow(r, h5)) * 32 + l31] = acc[r];
                __syncthreads();
#pragma unroll
                for (int i = 0; i < 2; ++i) { const int idx = tid + 512 * i, t = idx >> 5, e = idx & 31; float sum = rb_e;
#pragma unroll
                    for (int w8 = 0; w8 < 8; ++w8) sum += RED[(w8 * 32 + t) * 32 + e];
                    LOG[t * 33 + e] = sum; }
                __syncthreads();
#pragma unroll
                for (int r4 = 0; r4 < 4; ++r4) {
                    const int m = m0 + r4; float tv[4]; int ti[4]; float cur = lane < 32 ? LOG[(wave * 4 + r4) * 33 + lane] : -3.0e38f;
#pragma unroll
                    for (int k = 0; k < 4; ++k) { const float mx = wave_max(cur);
                        const unsigned long long msk = __ballot(cur == mx && lane < 32); const int sel = __ffsll((long long)msk) - 1; tv[k] = mx; ti[k] = sel; if (lane == sel) cur = -3.0e38f; }
                    const float e1 = __expf(tv[1] - tv[0]), e2 = __expf(tv[2] - tv[0]), e3 = __expf(tv[3] - tv[0]); const float inv = 1.0f / (1.0f + e1 + e2 + e3);
                    if (lane < 4) { const int k = lane; const int ee = k == 0 ? ti[0] : k == 1 ? ti[1] : k == 2 ? ti[2] : ti[3]; const float gg = (k == 0 ? 1.0f : k == 1 ? e1 : k == 2 ? e2 : e3) * inv;
                        const int lp = __hip_atomic_fetch_add(&CNT[ee], 1, __ATOMIC_RELAXED, __HIP_MEMORY_SCOPE_WORKGROUP);
                        EIDX[m * 4 + k] = ee; GATE[m * 4 + k] = gg; LPOS[m * 4 + k] = lp; }
                }
            }
            __syncthreads();
            if (tid < 32) BCNT[blk * 32 + tid] = CNT[tid];
        }
    }
    SEAM(ST_M0); STAMP(9);
#define MOE_TABLES() do { \
        LAS int* TB = (LAS int*)lds;                   \
        LAS int* EB = (LAS int*)(lds + 32768);         \
        __syncthreads(); \
        for (int i = tid; i < NRANGE * WBR * 32; i += NTHR) TB[i] = BCNT[i]; \
        __syncthreads(); \
        if (tid < NRANGE * 32) { const int r = tid >> 5, e = tid & 31; int run = 0; _Pragma("unroll 4") for (int wb = 0; wb < WBR; ++wb) { const int c_ = TB[(r * WBR + wb) * 32 + e]; TB[(r * WBR + wb) * 32 + e] = run; run += c_; } EB[128 + tid] = run; } \
        __syncthreads(); \
        if (tid < NRANGE) { int run = 0; _Pragma("unroll 1") for (int e = 0; e < 32; ++e) { EB[tid * 32 + e] = run; run += (EB[128 + tid * 32 + e] + 255) & ~255; } EB[256 + tid] = run >> 8; } \
        __syncthreads(); \
        for (int i = tid; i < NRANGE * WBR * 32; i += NTHR) { const int r = i / (WBR * 32), e = i & 31; TB[i] += EB[r * 32 + e]; } \
        __syncthreads(); } while (0)
#define MOE_SCATTER(r) do { \
        LAS int* TB = (LAS int*)lds; LAS int* EB = (LAS int*)(lds + 32768); \
        for (int idx = bid * NTHR + tid; idx < RTOK * 4; idx += G * NTHR) { const int m = (r) * RTOK + (idx >> 2), k = idx & 3; const int wb = (idx >> 2) >> 8; \
            const int e = EIDX[m * 4 + k]; const int row = TB[((r) * WBR + wb) * 32 + e] + LPOS[m * 4 + k]; AROW[m * 4 + k] = row; HPS[row] = HLS[m]; ROWTOK[row] = m; } \
        for (int e = bid; e < 32; e += G) { const int tot = EB[128 + (r) * 32 + e], base = EB[(r) * 32 + e]; const int npad = ((tot + 255) & ~255) - tot; \
            for (int i = tid; i < npad; i += NTHR) { HPS[base + tot + i] = 0.f; ROWTOK[base + tot + i] = -1; } } } while (0)
    if (PH_EN(10) && IN(ST_M1)) for (int rep = 0; rep < DUP_N(10); ++rep) {
        const int tid = opaque_tid(), lane = tid & 63, wave = __builtin_amdgcn_readfirstlane(tid >> 6), gw = bid * NWAVES + wave; (void)lane; (void)gw; (void)rep;
        MOE_TABLES();
        if (bid == 0) {
            LAS int* TB = (LAS int*)lds; LAS int* EB = (LAS int*)(lds + 32768);
            for (int i = tid; i < NRANGE * WBR * 32; i += NTHR) BBASE[i] = TB[i];
            if (tid < NRANGE) NTILE[tid] = EB[256 + tid];
            for (int i = tid; i < NRANGE * 32; i += NTHR) { const int r = i >> 5, e = i & 31; const int base = EB[r * 32 + e], nt = (EB[128 + i] + 255) >> 8; for (int t = 0; t < nt; ++t) TILEE[r * TILE_LD + (base >> 8) + t] = e; }
        }
        MOE_SCATTER(0);
    }
    SEAM(ST_M1); STAMP(10);
    for (int r = 0; r < NRANGE; ++r) {
        const int s0 = ST_RNG + 3 * r;
        if (PH_EN(11) && IN(s0 + 0)) for (int rep = 0; rep < DUP_N(11); ++rep) {
        const int tid = opaque_tid(), lane = tid & 63, wave = __builtin_amdgcn_readfirstlane(tid >> 6), gw = bid * NWAVES + wave; (void)lane; (void)gw; (void)rep;
            pg8::Gemm g{HL, W1T, 512, 512, 512, HPS, W1S, ROWTOK, args.in[I_B1]}; pg8::MoeOrder S{TILEE + r * TILE_LD, NTILE[r], 8, G, bid}; EpiHid E{(unsigned char*)HID};
            STAGGER(STAG_M2); pg8::gemm_phase<EpiHid, pg8::MoeOrder, 1, true>(lds, g, S, E);
        }
        SEAM(s0 + 0); STAMP(11);
        if (PH_EN(12) && IN(s0 + 1)) for (int rep = 0; rep < DUP_N(12); ++rep) {
        const int tid = opaque_tid(), lane = tid & 63, wave = __builtin_amdgcn_readfirstlane(tid >> 6), gw = bid * NWAVES + wave; (void)lane; (void)gw; (void)rep;
            pg8::Gemm g{HID, W2T, 512, 512, 512, nullptr, W2S, nullptr, args.in[I_B2]}; pg8::MoeOrder S{TILEE + r * TILE_LD, NTILE[r], 4, G, bid}; EpiY E{(unsigned char*)YPAD};
            STAGGER(STAG_M3); pg8::gemm_phase<EpiY, pg8::MoeOrder, 2>(lds, g, S, E);
        }
        SEAM(s0 + 1); STAMP(12);
        if (PH_EN(13) && IN(s0 + 2)) for (int rep = 0; rep < DUP_N(13); ++rep) {
        const int tid = opaque_tid(), lane = tid & 63, wave = __builtin_amdgcn_readfirstlane(tid >> 6), gw = bid * NWAVES + wave; (void)lane; (void)gw; (void)rep;
            if (NGW * 32 == RTOK) {
                const int m0 = r * RTOK + gw * 16, m1 = m0 + NGW * 16;
                const int arow0 = AROW[m0 * 4 + lane], arow1 = AROW[m1 * 4 + lane]; const float gate0 = GATE[m0 * 4 + lane], gate1 = GATE[m1 * 4 + lane];
                f32x4 g2v0[4], g2v1[4], fgv[4];
#pragma unroll
                for (int j = 0; j < 4; ++j) { g2v0[j] = *(const f32x4*)(mod + (m0 >> 13) * 6144 + 5120 + 4 * lane + 256 * j); g2v1[j] = *(const f32x4*)(mod + (m1 >> 13) * 6144 + 5120 + 4 * lane + 256 * j);
                    fgv[j] = *(const f32x4*)(args.in[I_FG] + 4 * lane + 256 * j); }
                u32x2 xv[4][4]; unsigned yw[4][4][4];
                auto issue = [&](int mbase, int arow_r, int i, u32x2 (&xx)[4], unsigned (&yy)[4][4]) { const int m = mbase + i;
#pragma unroll
                    for (int j = 0; j < 4; ++j) xx[j] = __builtin_nontemporal_load((const u32x2*)(args.out + (size_t)m * D) + lane + 64 * j);
#pragma unroll
                    for (int k = 0; k < 4; ++k) { const int row = __builtin_amdgcn_readlane(arow_r, 4 * i + k); const unsigned* yp = (const unsigned*)((const unsigned char*)YPAD + (size_t)row * D) + lane;
#pragma unroll
                        for (int j = 0; j < 4; ++j) yy[k][j] = __builtin_nontemporal_load(yp + 64 * j); } };
                issue(m0, arow0, 0, xv[0], yw[0]); issue(m0, arow0, 1, xv[1], yw[1]); issue(m0, arow0, 2, xv[2], yw[2]);
#pragma unroll 1
                for (int kb = 0; kb < 2; ++kb) {
                    const int mb = kb ? m1 : m0; const int arow_c = kb ? arow1 : arow0; const float gate_c = kb ? gate1 : gate0;
                    f32x4 g2c[4];
#pragma unroll
                    for (int j = 0; j < 4; ++j) g2c[j] = kb ? g2v1[j] : g2v0[j];
                    auto ahead = [&](int t, u32x2 (&xx)[4], unsigned (&yy)[4][4]) { const bool nx = t >= 16;
                        issue(nx ? m1 : mb, nx ? arow1 : arow_c, nx ? (kb ? 15 : t - 16) : t, xx, yy); };
                    auto finish = [&](int i, const u32x2 (&xx)[4], const unsigned (&yy)[4][4]) { const int m = mb + i; f32x4 v[4]; float ss = 0.f;
#pragma unroll
                        for (int j = 0; j < 4; ++j) { f32x4 y = {0.f, 0.f, 0.f, 0.f};
#pragma unroll
                            for (int k = 0; k < 4; ++k) { const float gk = lane_f(gate_c, 4 * i + k); const int w = (int)yy[k][j]; const f32x2 lo = __builtin_amdgcn_cvt_pk_f32_fp8(w, false), hi = __builtin_amdgcn_cvt_pk_f32_fp8(w, true);
                                y.x += gk * lo.x; y.y += gk * lo.y; y.z += gk * hi.x; y.w += gk * hi.y; }
                            v[j] = (f32x4){bflo(xx[j].x), bfhi(xx[j].x), bflo(xx[j].y), bfhi(xx[j].y)} + g2c[j] * y; ss += (v[j].x * v[j].x + v[j].y * v[j].y) + (v[j].z * v[j].z + v[j].w * v[j].w); }
                        const float rstd = 1.0f / sqrtf(wave_sum(ss) * (1.0f / D) + EPS);
#pragma unroll
                        for (int j = 0; j < 4; ++j) ((f32x4*)((DRY(13) ? (float*)(ws + WS_DUMMY) + (size_t)((m - r * RTOK) & 16383) * D : args.out + (size_t)m * D)) + lane)[64 * j] = v[j] * rstd * fgv[j]; };
#pragma unroll 1
                    for (int i = 0; i < 16; i += 4) {
                        ahead(i + 3, xv[3], yw[3]); finish(i, xv[0], yw[0]);
                        ahead(i + 4, xv[0], yw[0]); finish(i + 1, xv[1], yw[1]);
                        ahead(i + 5, xv[1], yw[1]); finish(i + 2, xv[2], yw[2]);
                        ahead(i + 6, xv[2], yw[2]); finish(i + 3, xv[3], yw[3]);
                    }
                }
            } else {
            for (int mb = r * RTOK + gw * 16; mb < (r + 1) * RTOK; mb += NGW * 16) {
                const int arow_l = AROW[mb * 4 + lane]; const float gate_l = GATE[mb * 4 + lane];
                const int b = mb >> 13;
                f32x4 g2v[4], fgv[4];
#pragma unroll
                for (int j = 0; j < 4; ++j) { g2v[j] = *(const f32x4*)(mod + b * 6144 + 5120 + 4 * lane + 256 * j); fgv[j] = *(const f32x4*)(args.in[I_FG] + 4 * lane + 256 * j); }
                u32x2 xv[2][4]; unsigned yw[2][4][4];
                auto issue = [&](int i, u32x2 (&xx)[4], unsigned (&yy)[4][4]) { const int m = mb + i;
#pragma unroll
                    for (int j = 0; j < 4; ++j) xx[j] = __builtin_nontemporal_load((const u32x2*)(args.out + (size_t)m * D) + lane + 64 * j);
#pragma unroll
                    for (int k = 0; k < 4; ++k) { const int row = __builtin_amdgcn_readlane(arow_l, 4 * i + k); const unsigned* yp = (const unsigned*)((const unsigned char*)YPAD + (size_t)row * D) + lane;
#pragma unroll
                        for (int j = 0; j < 4; ++j) yy[k][j] = __builtin_nontemporal_load(yp + 64 * j); } };
                auto finish = [&](int i, const u32x2 (&xx)[4], const unsigned (&yy)[4][4]) { const int m = mb + i; f32x4 v[4]; float ss = 0.f;
#pragma unroll
                    for (int j = 0; j < 4; ++j) { f32x4 y = {0.f, 0.f, 0.f, 0.f};
#pragma unroll
                        for (int k = 0; k < 4; ++k) { const float gk = lane_f(gate_l, 4 * i + k); const int w = (int)yy[k][j]; const f32x2 lo = __builtin_amdgcn_cvt_pk_f32_fp8(w, false), hi = __builtin_amdgcn_cvt_pk_f32_fp8(w, true);
                            y.x += gk * lo.x; y.y += gk * lo.y; y.z += gk * hi.x; y.w += gk * hi.y; }
                        v[j] = (f32x4){bflo(xx[j].x), bfhi(xx[j].x), bflo(xx[j].y), bfhi(xx[j].y)} + g2v[j] * y; ss += (v[j].x * v[j].x + v[j].y * v[j].y) + (v[j].z * v[j].z + v[j].w * v[j].w); }
                    const float rstd = 1.0f / sqrtf(wave_sum(ss) * (1.0f / D) + EPS);
#pragma unroll
                    for (int j = 0; j < 4; ++j) ((f32x4*)((DRY(13) ? (float*)(ws + WS_DUMMY) + (size_t)((m - r * RTOK) & 16383) * D : args.out + (size_t)m * D)) + lane)[64 * j] = v[j] * rstd * fgv[j]; };
                issue(0, xv[0], yw[0]);
#pragma unroll 1
                for (int i = 0; i < 16; i += 2) {
                    issue(i + 1, xv[1], yw[1]);
                    finish(i, xv[0], yw[0]);
                    if (i + 2 < 16) issue(i + 2, xv[0], yw[0]);
                    finish(i + 1, xv[1], yw[1]);
                }
            }
            }
            if (r + 1 < NRANGE) { MOE_TABLES(); MOE_SCATTER(r + 1); }
        }
        if (r + 1 < NRANGE) SEAM(s0 + 2);
        STAMP(13);
    }
#if MK_PROBE
    {
        unsigned* PR = (unsigned*)(ws + WS_CTL) + 8192;
        xcd_barrier(bar);
        if (bid == 0 && threadIdx.x == 0) { PR[0] = MISC[16 + PROBE_SEL1]; PR[1] = MISC[16 + PROBE_SEL2]; }
        xcd_barrier(bar);
        const float d1 = (float)__hip_atomic_load(PR, __ATOMIC_RELAXED, __HIP_MEMORY_SCOPE_AGENT) * 0.01f, d2 = (float)__hip_atomic_load(PR + 1, __ATOMIC_RELAXED, __HIP_MEMORY_SCOPE_AGENT) * 0.01f;
        const float sc = 1.0f + sqrtf(d1 * 1e-4f);
        for (size_t i = (size_t)bid * NTHR + threadIdx.x; i < (size_t)NTOK * D / 4; i += (size_t)G * NTHR) { f32x4 v = ((f32x4*)args.out)[i]; v *= sc; if (i == 0) v.x += d2 * 0.25f; ((f32x4*)args.out)[i] = v; }
    }
#endif
#undef IN
#undef SEAM
}

extern "C" void kernel_launch(void* const* d_in, const int* in_sizes, int n_in, void* d_out, int out_size, void* d_ws, size_t ws_size, hipStream_t stream) {
    static int grid = 0;
    if (grid == 0) {
        if (n_in != 26 || in_sizes[0] != NTOK * D || out_size != NTOK * D || ws_size < WS_END) { fprintf(stderr, "kernel_launch: unexpected shapes (n_in %d, in0 %d, out %d, ws %zu); nothing launched\n", n_in, n_in > 0 ? in_sizes[0] : -1, out_size, ws_size); grid = -1; return; }
        int dev = 0, cus = 0, per_cu = 0;
        if (hipGetDevice(&dev) != hipSuccess || hipDeviceGetAttribute(&cus, hipDeviceAttributeMultiprocessorCount, dev) != hipSuccess) { grid = -1; return; }
        if (hipFuncSetAttribute((const void*)fwd_kernel, hipFuncAttributeMaxDynamicSharedMemorySize, LDS_BYTES) != hipSuccess) { fprintf(stderr, "kernel_launch: hipFuncSetAttribute failed\n"); grid = -1; return; }
        if (hipOccupancyMaxActiveBlocksPerMultiprocessor(&per_cu, (const void*)fwd_kernel, NTHR, LDS_BYTES) != hipSuccess || per_cu < 1) fprintf(stderr, "kernel_launch: occupancy query reports %d\n", per_cu);
        (void)hipGetLastError();
        grid = cus;
    }
    if (grid < 0) return;
    if (hipMemsetAsync((char*)d_ws + WS_CTL, 0, CTL_ZERO_BYTES, stream) != hipSuccess) return;
    Args a{};
    for (int i = 0; i < 26; ++i) a.in[i] = (const float*)d_in[i];
    a.out = (float*)d_out; a.ws = (unsigned char*)d_ws;
#if MK_PER_PHASE
    for (int s = 0; s < ST_END; ++s) { a.lo = s; a.hi = s + 1; hipLaunchKernelGGL(fwd_kernel, dim3(grid), dim3(NTHR), LDS_BYTES, stream, a); }
#else
    a.lo = 0; a.hi = ST_END;
    hipLaunchKernelGGL(fwd_kernel, dim3(grid), dim3(NTHR), LDS_BYTES, stream, a);
#endif
    const hipError_t le = hipPeekAtLastError();
    if (le != hipSuccess) fprintf(stderr, "kernel_launch: launch failed: %s\n", hipGetErrorName(le));
}
```
